# Optimizing an MI355X kernel written in HIP

```python
import math
import jax, jax.numpy as jnp
from jax import lax
import numpy as np

D_MODEL = 1024
BATCH = 16
SEQ = 256
DEPTH = 2
DEC_BATCH = 4
DEC_SEQ = 1024
PAST_LEN = 256

GRID_W = 64
EPS = 1e-6
MLA_HEADS = 8
MLA_NOPE = 64
MLA_ROPE = 32
MLA_QK = MLA_NOPE + MLA_ROPE
MLA_V = 64
MLA_Q_RANK = 384
MLA_KV_RANK = 256
MLA_WIDTH = MLA_HEADS * MLA_V
ROPE_THETA = 10000.0
ATTN_BLOCK = 128
GDN_HEADS = 4
GDN_DK = 128
GDN_DV = 128
GDN_KW = GDN_HEADS * GDN_DK
GDN_VW = GDN_HEADS * GDN_DV
GDN_CHUNK = 64
CONV_W = 5
CM_GROUPS = 4
CM_CHUNK = 128
CM_WIDTH = 512
CM_GW = CM_WIDTH // CM_GROUPS
N_BRANCH = 3
BRANCH_W = 512
SPLIT_SIZES = (MLA_Q_RANK, MLA_KV_RANK, MLA_ROPE, MLA_WIDTH,
               2 * GDN_KW + GDN_VW, 2 * GDN_HEADS, 2 * GDN_HEADS, GDN_VW,
               CM_WIDTH, CM_WIDTH, CM_WIDTH, N_BRANCH * D_MODEL)
D_IN = sum(SPLIT_SIZES)

kernel_name = "hybrid_mla_gdn_chunkmlp_prefix_diffusion_step"


def _rms(x, g):
    xf = x.astype(jnp.float32)
    y = xf * lax.rsqrt(jnp.mean(xf * xf, axis=-1, keepdims=True) + EPS)
    return (y * g.astype(jnp.float32)).astype(x.dtype)


def _l2n(x):
    xf = x.astype(jnp.float32)
    return xf * lax.rsqrt(jnp.sum(xf * xf, axis=-1, keepdims=True) + EPS)


def _axial_rope(x, rows):
    row = jnp.repeat(jnp.arange(rows, dtype=jnp.float32), GRID_W)
    col = jnp.tile(jnp.arange(GRID_W, dtype=jnp.float32), rows)
    half = MLA_ROPE // 2
    nf = half // 2
    inv = ROPE_THETA ** (-jnp.arange(nf, dtype=jnp.float32) / nf)
    xf = x.astype(jnp.float32)

    def rot(xa, pos):
        ang = pos[:, None] * inv[None, :]
        cos = jnp.cos(ang)[:, None, :]
        sin = jnp.sin(ang)[:, None, :]
        x1, x2 = xa[..., :nf], xa[..., nf:]
        return jnp.concatenate([x1 * cos - x2 * sin, x1 * sin + x2 * cos], axis=-1)

    return jnp.concatenate([rot(xf[..., :half], row), rot(xf[..., half:], col)], axis=-1).astype(x.dtype)


def _attend(q, k, v):
    B, Tq, H, d = q.shape
    nb = Tq // ATTN_BLOCK
    qb = jnp.moveaxis(q.reshape(B, nb, ATTN_BLOCK, H, d), 1, 0)
    scale = 1.0 / math.sqrt(d)

    def one(qi):
        s = jnp.einsum('bqhd,bkhd->bhqk', qi, k).astype(jnp.float32) * scale
        pr = jax.nn.softmax(s, axis=-1)
        return jnp.einsum('bhqk,bkhd->bqhd', pr.astype(v.dtype), v)

    o = lax.map(one, qb)
    return jnp.moveaxis(o, 0, 1).reshape(B, Tq, H, v.shape[-1])


def _mla_kv(ckv_n, krope, p):
    B, T, _ = ckv_n.shape
    kv = (ckv_n @ p['w_ukv']).reshape(B, T, MLA_HEADS, MLA_NOPE + MLA_V)
    kr = jnp.broadcast_to(krope[:, :, None, :], (B, T, MLA_HEADS, MLA_ROPE))
    k = _rms(jnp.concatenate([kv[..., :MLA_NOPE], kr], axis=-1), p['k_norm'])
    return k, kv[..., MLA_NOPE:]


def _dwconv(x, w):
    return lax.conv_general_dilated(x, w[:, None, :], window_strides=(1,),
                                    padding=[(CONV_W // 2, CONV_W // 2)],
                                    dimension_numbers=('NWC', 'WIO', 'NWC'),
                                    feature_group_count=x.shape[-1])


def _gdn_chunk(q, k, v, g, beta, s0):
    B, T, H, dk = q.shape
    C = GDN_CHUNK
    N = T // C

    def blk(a):
        a = a.reshape((B, N, C, H) + a.shape[3:])
        return jnp.moveaxis(jnp.moveaxis(a, 1, 0), 3, 2)

    qc, kc, vc = blk(q * (dk ** -0.5)), blk(k), blk(v)
    gc = jnp.cumsum(blk(g), axis=-1)
    bc = blk(beta)
    kb = kc * bc[..., None]
    vb = vc * bc[..., None]
    incl = jnp.tril(jnp.ones((C, C), bool))
    strict = jnp.tril(jnp.ones((C, C), bool), -1)
    diff = gc[..., :, None] - gc[..., None, :]
    decay = jnp.where(incl, jnp.exp(jnp.where(incl, diff, 0.0)), 0.0)
    A = jnp.where(strict, jnp.einsum('nbhid,nbhjd->nbhij', kb, kc) * decay, 0.0)
    eye = jnp.eye(C, dtype=A.dtype)
    Tinv = lax.linalg.triangular_solve(A + eye, jnp.broadcast_to(eye, A.shape),
                                       left_side=True, lower=True, unit_diagonal=True)
    u = Tinv @ vb
    w = Tinv @ (kb * jnp.exp(gc)[..., None])

    def step(S, xs):
        qi, ki, ui, wi, gi, di = xs
        v_new = ui - wi @ S
        att = jnp.einsum('bhid,bhjd->bhij', qi, ki) * di
        o = (qi * jnp.exp(gi)[..., None]) @ S + att @ v_new
        gl = gi[..., -1:]
        S = S * jnp.exp(gl)[..., None] + jnp.einsum('bhcd,bhce->bhde', ki * jnp.exp(gl - gi)[..., None], v_new)
        return S, o

    S, o = lax.scan(step, s0, (qc, kc, u, w, gc, decay))
    o = jnp.moveaxis(jnp.moveaxis(o, 2, 3), 0, 1).reshape(B, T, H, v.shape[-1])
    return o, S


def _chunk_mlp(u, v, p):
    B, T, _ = u.shape
    u = jax.nn.gelu(u)
    vf = jax.nn.gelu(v).astype(jnp.float32)
    mu = jnp.mean(vf, axis=-1, keepdims=True)
    var = jnp.mean(jnp.square(vf - mu), axis=-1, keepdims=True)
    vn = ((vf - mu) * lax.rsqrt(var + EPS) * p['cm_ln_g'] + p['cm_ln_b']).astype(u.dtype)
    vr = vn.reshape(B, T // CM_CHUNK, CM_CHUNK, CM_GROUPS, CM_GW)
    sv = jnp.einsum('gpq,bnqgc->bnpgc', p['w_s'], vr) + jnp.swapaxes(p['b_s'], 0, 1)[:, :, None]
    return u * sv.reshape(B, T, CM_WIDTH)


def _layer(x, mod, p, cache=None):
    B, T, _ = x.shape
    f32 = jnp.float32
    shift, scale, gate = jnp.split(mod, 3, axis=-1)
    h = _rms(x, p['norm_g']) * (1 + scale) + shift
    proj = h @ p['w_in']
    split_pts = np.cumsum(SPLIT_SIZES)[:-1].tolist()
    (cq, ckv, krope, z_a, qkv_b, ga, gb, z_b, cu, cv, z_c, gl) = jnp.split(proj, split_pts, axis=-1)

    q = (_rms(cq, p['q_a_norm']) @ p['w_uq']).reshape(B, T, MLA_HEADS, MLA_QK)
    q = _rms(q, p['q_norm'])
    ckv_n = _rms(ckv, p['kv_a_norm'])
    k, v = _mla_kv(ckv_n, krope, p)
    if cache is None:
        o_a = _attend(q, k, v)
        s0 = jnp.zeros((B, 2, GDN_HEADS, GDN_DK, GDN_DV), f32)
    else:
        c_ckv, c_krope, s0 = cache
        rows = T // GRID_W
        q = jnp.concatenate([q[..., :MLA_NOPE], _axial_rope(q[..., MLA_NOPE:], rows)], axis=-1)
        k = jnp.concatenate([k[..., :MLA_NOPE], _axial_rope(k[..., MLA_NOPE:], rows)], axis=-1)
        kc, vc = _mla_kv(c_ckv, c_krope, p)
        o_a = _attend(q, jnp.concatenate([kc, k], axis=1), jnp.concatenate([vc, v], axis=1))
    o_a = o_a.reshape(B, T, MLA_WIDTH)

    qkv = jax.nn.silu(_dwconv(qkv_b, p['conv_w']))
    gq, gk, gv = jnp.split(qkv, [GDN_KW, 2 * GDN_KW], axis=-1)
    gq = _l2n(gq.reshape(B, T, GDN_HEADS, GDN_DK))
    gk = _l2n(gk.reshape(B, T, GDN_HEADS, GDN_DK))
    gv = gv.reshape(B, T, GDN_HEADS, GDN_DV).astype(f32)
    beta = jax.nn.sigmoid(gb.astype(f32)).reshape(B, T, 2, GDN_HEADS)
    g = -jnp.exp(p['a_log'].astype(f32)) * jax.nn.softplus(
        ga.astype(f32).reshape(B, T, 2, GDN_HEADS) + p['dt_bias'].astype(f32))
    s0 = s0.astype(f32)
    o_f, s_f = _gdn_chunk(gq, gk, gv, g[:, :, 0], beta[:, :, 0], s0[:, 0])
    fl = lambda t: jnp.flip(t, axis=1)
    o_bw, s_b = _gdn_chunk(fl(gq), fl(gk), fl(gv), fl(g[:, :, 1]), fl(beta[:, :, 1]), s0[:, 1])
    o_b = _rms(o_f + fl(o_bw), p['gdn_onorm']).astype(x.dtype).reshape(B, T, GDN_VW)

    o_c = _chunk_mlp(cu, cv, p)

    br = jnp.stack([o_a * jax.nn.silu(z_a), o_b * jax.nn.silu(z_b), o_c * jax.nn.silu(z_c)], axis=2)
    yb = jnp.einsum('btnw,nwd->btnd', br, p['w_branch'])
    gates = jax.nn.sigmoid(gl.reshape(B, T, N_BRANCH, D_MODEL))
    y = jnp.sum(gates * yb, axis=2) @ p['w_o']
    x = x + gate * y
    if cache is None:
        return x, (ckv_n, krope, jnp.stack([s_f, s_b], axis=1))
    return x, None


def setup_inputs(seed: int = 0) -> dict:
    key = jax.random.key(seed)
    ks = jax.random.split(key, 32)
    f32 = jnp.float32
    L = DEPTH

    def nrm(k, shape, s):
        return s * jax.random.normal(k, shape, f32)

    dt = jnp.exp(jax.random.uniform(ks[20], (L, 2, GDN_HEADS), f32, math.log(1e-3), math.log(1e-1)))
    return {
        'x_prompt': nrm(ks[0], (BATCH, SEQ, D_MODEL), 1.0),
        'x_sample': nrm(ks[1], (DEC_BATCH, DEC_SEQ, D_MODEL), 1.0),
        'cache_ckv': nrm(ks[2], (DEC_BATCH, DEPTH, PAST_LEN, MLA_KV_RANK), 1.0),
        'cache_krope': nrm(ks[3], (DEC_BATCH, DEPTH, PAST_LEN, MLA_ROPE), 1.0),
        'state_gdn': nrm(ks[4], (DEC_BATCH, DEPTH, 2, GDN_HEADS, GDN_DK, GDN_DV), 0.3),
        'c': nrm(ks[5], (DEC_BATCH, D_MODEL), 1.0),
        'c_ctx': nrm(ks[6], (D_MODEL,), 1.0),
        'norm_g': 1.0 + nrm(ks[7], (L, D_MODEL), 0.02),
        'w_mod': nrm(ks[8], (L, D_MODEL, 3 * D_MODEL), 0.5 * D_MODEL ** -0.5),
        'b_mod': nrm(ks[9], (L, 3 * D_MODEL), 0.02),
        'w_in': nrm(ks[10], (L, D_MODEL, D_IN), D_MODEL ** -0.5),
        'q_a_norm': 1.0 + nrm(ks[11], (L, MLA_Q_RANK), 0.02),
        'w_uq': nrm(ks[12], (L, MLA_Q_RANK, MLA_HEADS * MLA_QK), MLA_Q_RANK ** -0.5),
        'kv_a_norm': 1.0 + nrm(ks[13], (L, MLA_KV_RANK), 0.02),
        'w_ukv': nrm(ks[14], (L, MLA_KV_RANK, MLA_HEADS * (MLA_NOPE + MLA_V)), MLA_KV_RANK ** -0.5),
        'q_norm': 1.0 + nrm(ks[15], (L, MLA_QK), 0.02),
        'k_norm': 1.0 + nrm(ks[16], (L, MLA_QK), 0.02),
        'conv_w': nrm(ks[17], (L, CONV_W, 2 * GDN_KW + GDN_VW), CONV_W ** -0.5),
        'a_log': jnp.log(jax.random.uniform(ks[18], (L, 2, GDN_HEADS), f32, 1.0, 16.0)),
        'dt_bias': dt + jnp.log(-jnp.expm1(-dt)),
        'gdn_onorm': 1.0 + nrm(ks[19], (L, GDN_DV), 0.02),
        'cm_ln_g': 1.0 + nrm(ks[21], (L, CM_WIDTH), 0.02),
        'cm_ln_b': nrm(ks[22], (L, CM_WIDTH), 0.02),
        'w_s': nrm(ks[23], (L, CM_GROUPS, CM_CHUNK, CM_CHUNK), CM_CHUNK ** -0.5),
        'b_s': 1.0 + nrm(ks[24], (L, CM_GROUPS, CM_CHUNK), 0.02),
        'w_branch': nrm(ks[25], (L, N_BRANCH, BRANCH_W, D_MODEL), BRANCH_W ** -0.5),
        'w_o': nrm(ks[26], (L, D_MODEL, D_MODEL), D_MODEL ** -0.5),
    }


def reference(x_prompt, x_sample, cache_ckv, cache_krope, state_gdn, c, c_ctx, norm_g, w_mod, b_mod,
              w_in, q_a_norm, w_uq, kv_a_norm, w_ukv, q_norm, k_norm, conv_w, a_log, dt_bias,
              gdn_onorm, cm_ln_g, cm_ln_b, w_s, b_s, w_branch, w_o):
    yp = x_prompt
    ys = x_sample
    ckvs, kropes, states = [], [], []
    for l in range(DEPTH):
        p = {'norm_g': norm_g[l], 'w_in': w_in[l], 'q_a_norm': q_a_norm[l], 'w_uq': w_uq[l],
             'kv_a_norm': kv_a_norm[l], 'w_ukv': w_ukv[l], 'q_norm': q_norm[l], 'k_norm': k_norm[l],
             'conv_w': conv_w[l], 'a_log': a_log[l], 'dt_bias': dt_bias[l], 'gdn_onorm': gdn_onorm[l],
             'cm_ln_g': cm_ln_g[l], 'cm_ln_b': cm_ln_b[l], 'w_s': w_s[l], 'b_s': b_s[l],
             'w_branch': w_branch[l], 'w_o': w_o[l]}
        mod_ctx = (jax.nn.silu(c_ctx) @ w_mod[l] + b_mod[l])[None, None, :]
        mod_lat = (jax.nn.silu(c) @ w_mod[l] + b_mod[l])[:, None, :]
        yp, (ckv_l, kr_l, s_l) = _layer(yp, mod_ctx, p)
        ys, _ = _layer(ys, mod_lat, p, (cache_ckv[:, l], cache_krope[:, l], state_gdn[:, l]))
        ckvs.append(ckv_l)
        kropes.append(kr_l)
        states.append(s_l)
    new_ckv = jnp.stack(ckvs, axis=1)
    new_krope = jnp.stack(kropes, axis=1)
    new_state = jnp.stack(states, axis=1)
    return (yp, ys, new_ckv, new_krope, new_state)
```

```cpp
#include <hip/hip_runtime.h>
#include <hip/hip_cooperative_groups.h>
#include <stdint.h>
#include <stdio.h>
namespace cg = cooperative_groups;

#ifndef COOP
#define COOP 1
#endif

typedef unsigned short bf16_t;
typedef __attribute__((ext_vector_type(8))) short bf16x8;
typedef __attribute__((ext_vector_type(4))) float f32x4;
typedef __attribute__((ext_vector_type(4))) unsigned int u32x4;
typedef __attribute__((ext_vector_type(2))) unsigned int u32x2;
#define DEV __device__ __forceinline__

#define NTOK 8192
#define DM 1024
#define DIN 7856
#define EPSF 1e-6f
#define P1W 3232
#define P2W 1536
#define BRW 1536
#define REC_EL 36864

#define OFF_CTR  0ull
#define OFF_BAR  8192ull
#define OFF_MOD  32768ull
#define OFF_GAB  (OFF_MOD + 122880ull)
#define OFF_EGL  (OFF_GAB + 524288ull)
#define OFF_WTA  (OFF_EGL + 4096ull)
#define OFF_WGL  (OFF_WTA + 9961472ull)
#define OFF_WUQ  (OFF_WGL + 6291456ull)
#define OFF_WUKV (OFF_WUQ + 589824ull)
#define OFF_WBR  (OFF_WUKV + 524288ull)
#define OFF_WO   (OFF_WBR + 3145728ull)
#define OFF_H    (OFF_WO + 2097152ull)
#define OFF_P1   (OFF_H + 16777216ull)
#define OFF_ODIR OFF_P1
#define OFF_M    (OFF_P1 + 33554432ull)
#define OFF_P2   (OFF_P1 + 52953088ull)
#define OFF_GDN  (OFF_P2 + 25165824ull)
#define OFF_Q    (OFF_GDN + 75497472ull)
#define OFF_K    (OFF_Q + 12582912ull)
#define OFF_VT   (OFF_K + 14155776ull)
#define OFF_BR   (OFF_VT + 9437184ull)
#define WS_END   (OFF_BR + 25165824ull)
#define VT_LAT_EL 2097152

#define OUT_CKV   8388608
#define OUT_KROPE 10485760
#define OUT_STATE 10747904

#define LDS_BYTES 75776
#define LDS_SMALL 73728

struct Params {
  const float* in[27];
  float* out;
  char* ws;
};
enum { I_XP = 0, I_XS, I_CCKV, I_CKR, I_SGDN, I_C, I_CCTX, I_NORMG, I_WMOD, I_BMOD, I_WIN, I_QAN, I_WUQ, I_KVAN, I_WUKV,
       I_QN, I_KN, I_CONVW, I_ALOG, I_DTB, I_ONORM, I_LNG, I_LNB, I_WS, I_BS, I_WBR, I_WO };

DEV float bf2f(bf16_t b) { return __uint_as_float(((unsigned)b) << 16); }
typedef __bf16 hwbf2 __attribute__((ext_vector_type(2)));
typedef float hwf2 __attribute__((ext_vector_type(2)));
DEV unsigned pack2(float a, float b) { hwf2 v = {a, b}; return __builtin_bit_cast(unsigned, __builtin_convertvector(v, hwbf2)); }
DEV bf16_t f2bf(float f) { return (bf16_t)(pack2(f, 0.f) & 0xffffu); }
DEV void unpack8(u32x4 v, float* f) {
  f[0] = __uint_as_float(v.x << 16); f[1] = __uint_as_float(v.x & 0xffff0000u);
  f[2] = __uint_as_float(v.y << 16); f[3] = __uint_as_float(v.y & 0xffff0000u);
  f[4] = __uint_as_float(v.z << 16); f[5] = __uint_as_float(v.z & 0xffff0000u);
  f[6] = __uint_as_float(v.w << 16); f[7] = __uint_as_float(v.w & 0xffff0000u);
}
DEV void unpack4(u32x2 v, float* f) {
  f[0] = __uint_as_float(v.x << 16); f[1] = __uint_as_float(v.x & 0xffff0000u);
  f[2] = __uint_as_float(v.y << 16); f[3] = __uint_as_float(v.y & 0xffff0000u);
}
DEV u32x4 pack8(const float* f) {
  u32x4 v; v.x = pack2(f[0], f[1]); v.y = pack2(f[2], f[3]); v.z = pack2(f[4], f[5]); v.w = pack2(f[6], f[7]); return v;
}
DEV u32x2 pack4(float a, float b, float c, float d) { u32x2 v; v.x = pack2(a, b); v.y = pack2(c, d); return v; }
DEV bf16x8 as_frag(u32x4 v) { union { u32x4 u; bf16x8 b; } x; x.u = v; return x.b; }
DEV bf16x8 frag_from(f32x4 a, f32x4 b) {
  u32x4 v; v.x = pack2(a[0], a[1]); v.y = pack2(a[2], a[3]); v.z = pack2(b[0], b[1]); v.w = pack2(b[2], b[3]); return as_frag(v);
}
DEV bf16x8 ld2(const bf16_t* p) {
  u32x2 a = *(const u32x2*)p; u32x2 b = *(const u32x2*)(p + 16);
  u32x4 v; v.x = a.x; v.y = a.y; v.z = b.x; v.w = b.y; return as_frag(v);
}
DEV float frcp(float x) { return __builtin_amdgcn_rcpf(x); }
DEV float siluf(float x) { return x * frcp(1.f + __expf(-x)); }
DEV float sigmf(float x) { return frcp(1.f + __expf(-x)); }
DEV float geluf(float x) { float u = 0.7978845608028654f * (x + 0.044715f * x * x * x); return x * frcp(1.f + __expf(-2.f * u)); }
#define MFMA(a, b, c) __builtin_amdgcn_mfma_f32_16x16x32_bf16((a), (b), (c), 0, 0, 0)

DEV int otid() { int t = threadIdx.x; asm volatile("" : "+v"(t)); return t; }
DEV int next_task(unsigned* ctr, int* sh, int n, bool precheck) {
  __syncthreads();
  if (threadIdx.x == 0) {
    int v = n;
    if (!precheck || (int)__hip_atomic_load(ctr, __ATOMIC_RELAXED, __HIP_MEMORY_SCOPE_AGENT) < n) v = (int)atomicAdd(ctr, 1u);
    *sh = v;
  }
  __syncthreads();
  return *sh;
}

#define XB_TMO      128
#define XB_XCNT(j)  (256  + 64 * (j))
#define XB_XSUB(j)  (1280 + 64 * (j))
#define XB_XGEN(j)  (2304 + 64 * (j))
#define XB_TOP      3328
#define XB_TOPGEN   3392
#define XCD_BAR_WORDS 3456
#define XB_SPIN_CAP (1u << 22)
#define LAS __attribute__((address_space(3)))
DEV unsigned xb_ld(unsigned* p) { return __hip_atomic_load(p, __ATOMIC_RELAXED, __HIP_MEMORY_SCOPE_AGENT); }
DEV unsigned xb_add(unsigned* p, unsigned v) { return __hip_atomic_fetch_add(p, v, __ATOMIC_RELAXED, __HIP_MEMORY_SCOPE_AGENT); }
DEV unsigned xb_xcc_id() { return (unsigned)__builtin_amdgcn_s_getreg((3 << 11) | 20) & 0xFu; }
#define XB_SPIN(cond, bar) do { unsigned _sp = 0; while (cond) { __builtin_amdgcn_s_sleep(1); \
    if ((++_sp & 255u) == 0u) { if (xb_ld(&(bar)[XB_TMO])) break; if (_sp > XB_SPIN_CAP) { atomicAdd(&(bar)[XB_TMO], 1u); break; } } } } while (0)
struct XcdBarrier { unsigned* bar; unsigned x; volatile LAS unsigned* st; };
DEV XcdBarrier xcd_barrier_post(unsigned* bar, volatile LAS unsigned* st) {
  XcdBarrier b; b.bar = bar; b.x = xb_xcc_id(); b.st = st;
  if (threadIdx.x == 0) (void)xb_add(&bar[XB_XCNT(b.x)], 1u);
  return b;
}
DEV void xcd_barrier_complete(unsigned* bar, unsigned x, unsigned& nloc, unsigned& nx) {
  const unsigned G = gridDim.x * gridDim.y * gridDim.z;
  unsigned sum, cnt, mine, sp = 0u;
  for (;;) {
    sum = 0u; cnt = 0u; mine = 0u;
#pragma unroll
    for (unsigned j = 0; j < 16; ++j) { const unsigned c = xb_ld(&bar[XB_XCNT(j)]); sum += c; cnt += (c > 0u) ? 1u : 0u; mine = (j == x) ? c : mine; }
    if (sum == G) break;
    __builtin_amdgcn_s_sleep(1);
    if ((++sp & 255u) == 0u) { if (xb_ld(&bar[XB_TMO])) break; if (sp > XB_SPIN_CAP) { atomicAdd(&bar[XB_TMO], 1u); break; } }
  }
  nloc = mine > 0u ? mine : 1u; nx = cnt > 0u ? cnt : 1u;
}
DEV void xcd_barrier(const XcdBarrier& b) {
  asm volatile("s_waitcnt vmcnt(0)" ::: "memory");
  __syncthreads();
  if (threadIdx.x == 0) {
    unsigned* bar = b.bar;
    __builtin_amdgcn_s_waitcnt(0);
    unsigned nloc = b.st[0], nx = b.st[1];
    if (nloc == 0u) { xcd_barrier_complete(bar, b.x, nloc, nx); b.st[0] = nloc; b.st[1] = nx; }
    const unsigned old = xb_add(&bar[XB_XSUB(b.x)], 1u);
    const unsigned gen = old / nloc;
    if (old + 1u == (gen + 1u) * nloc) {
      __builtin_amdgcn_fence(__ATOMIC_RELEASE, "agent");
      asm volatile("s_waitcnt vmcnt(0)" ::: "memory");
      const unsigned og = xb_add(&bar[XB_TOP], 1u);
      const unsigned tg = og / nx;
      if (og + 1u == (tg + 1u) * nx) xb_add(&bar[XB_TOPGEN], 1u);
      else XB_SPIN(xb_ld(&bar[XB_TOPGEN]) == tg, bar);
      __builtin_amdgcn_fence(__ATOMIC_ACQUIRE, "agent");
      xb_add(&bar[XB_XGEN(b.x)], 1u);
      asm volatile("s_waitcnt vmcnt(0)" ::: "memory");
    } else {
      XB_SPIN(xb_ld(&bar[XB_XGEN(b.x)]) == gen, bar);
      __builtin_amdgcn_fence(__ATOMIC_ACQUIRE, "agent");
      asm volatile("s_waitcnt vmcnt(0)" ::: "memory");
    }
  }
  __syncthreads();
}

DEV const float* xrow_ptr(const Params& p, int l, int row) {
  if (l == 0) return row < 4096 ? p.in[I_XP] + (size_t)row * DM : p.in[I_XS] + (size_t)(row - 4096) * DM;
  return p.out + (size_t)row * DM;
}
DEV int modrow(int row) { return row < 4096 ? 0 : 1 + ((row - 4096) >> 10); }

struct ALPlain {
  const bf16_t* base; int ld;
  DEV u32x4 operator()(int row, int k) const { return *(const u32x4*)(base + (size_t)row * ld + k); }
};
struct ALScaled {
  const bf16_t* base; int ld; const float* rs; const float* g;
  DEV u32x4 operator()(int row, int k) const {
    u32x4 v = *(const u32x4*)(base + (size_t)row * ld + k);
    float f[8]; unpack8(v, f);
    const float r = rs[row];
    const f32x4 g0 = *(const f32x4*)(g + k), g1 = *(const f32x4*)(g + k + 4);
    f[0] *= r * g0.x; f[1] *= r * g0.y; f[2] *= r * g0.z; f[3] *= r * g0.w;
    f[4] *= r * g1.x; f[5] *= r * g1.y; f[6] *= r * g1.z; f[7] *= r * g1.w;
    return pack8(f);
  }
};
struct ALF32 {
  const float* base; int ld;
  DEV u32x4 operator()(int row, int k) const {
    const f32x4 a = *(const f32x4*)(base + (size_t)row * ld + k);
    const f32x4 b = *(const f32x4*)(base + (size_t)row * ld + k + 4);
    u32x4 v; v.x = pack2(a.x, a.y); v.y = pack2(a.z, a.w); v.z = pack2(b.x, b.y); v.w = pack2(b.z, b.w); return v;
  }
};

template <int TN>
DEV void gemm_compute(const bf16_t* As, const bf16_t* Bs, f32x4 (&acc)[4][TN / 32], int wm, int wn, int l16, int quad) {
  constexpr int NF = TN / 32;
#pragma unroll
  for (int ks = 0; ks < 2; ks++) {
    bf16x8 a[4], b[NF];
#pragma unroll
    for (int mi = 0; mi < 4; mi++) a[mi] = *(const bf16x8*)(As + (wm * 64 + mi * 16 + l16) * 72 + ks * 32 + quad * 8);
#pragma unroll
    for (int ni = 0; ni < NF; ni++) b[ni] = *(const bf16x8*)(Bs + (wn * (TN / 2) + ni * 16 + l16) * 72 + ks * 32 + quad * 8);
#pragma unroll
    for (int mi = 0; mi < 4; mi++)
#pragma unroll
      for (int ni = 0; ni < NF; ni++) acc[mi][ni] = MFMA(a[mi], b[ni], acc[mi][ni]);
  }
}
template <int TN, class AL>
DEV void gemm_core(const AL& al, const bf16_t* __restrict__ Bt, int ldb, int K, f32x4 (&acc)[4][TN / 32], char* lds) {
  constexpr int BUF = (128 + TN) * 72;
  constexpr int NF = TN / 32;
  bf16_t* L0 = (bf16_t*)lds;
  bf16_t* L1 = L0 + BUF;
  const int tid = otid(), lane = tid & 63, wave = tid >> 6;
  const int wm = wave >> 1, wn = wave & 1, l16 = lane & 15, quad = lane >> 4;
  u32x4 a0[4], b0[NF], a1[4], b1[NF];
#define G_LOAD(RA, RB, KK) { _Pragma("unroll") for (int i = 0; i < 4; i++) { int it = tid + 256 * i; RA[i] = al(it >> 3, (KK) + (it & 7) * 8); } \
                             _Pragma("unroll") for (int i = 0; i < NF; i++) { int it = tid + 256 * i; RB[i] = *(const u32x4*)(Bt + (size_t)(it >> 3) * ldb + (KK) + (it & 7) * 8); } }
#define G_STORE(LB, RA, RB) { _Pragma("unroll") for (int i = 0; i < 4; i++) { int it = tid + 256 * i; *(u32x4*)((LB) + (it >> 3) * 72 + (it & 7) * 8) = RA[i]; } \
                              _Pragma("unroll") for (int i = 0; i < NF; i++) { int it = tid + 256 * i; *(u32x4*)((LB) + 128 * 72 + (it >> 3) * 72 + (it & 7) * 8) = RB[i]; } }
  G_LOAD(a0, b0, 0);
  G_LOAD(a1, b1, 64);
  __syncthreads();
  G_STORE(L0, a0, b0);
  __syncthreads();
  for (int k0 = 0; k0 + 128 < K; k0 += 128) {
    G_LOAD(a0, b0, k0 + 128);
    __builtin_amdgcn_sched_barrier(0);
    gemm_compute<TN>(L0, L0 + 128 * 72, acc, wm, wn, l16, quad);
    G_STORE(L1, a1, b1);
    __syncthreads();
    G_LOAD(a1, b1, k0 + 192);
    __builtin_amdgcn_sched_barrier(0);
    gemm_compute<TN>(L1, L1 + 128 * 72, acc, wm, wn, l16, quad);
    G_STORE(L0, a0, b0);
    __syncthreads();
  }
  gemm_compute<TN>(L0, L0 + 128 * 72, acc, wm, wn, l16, quad);
  G_STORE(L1, a1, b1);
  __syncthreads();
  gemm_compute<TN>(L1, L1 + 128 * 72, acc, wm, wn, l16, quad);
#undef G_LOAD
#undef G_STORE
}

template <int TN>
DEV void acc_to_lds(f32x4 (&acc)[4][TN / 32], float* Cs) {
  const int tid = otid(), lane = tid & 63, wave = tid >> 6;
  const int wm = wave >> 1, wn = wave & 1, l16 = lane & 15, quad = lane >> 4;
  __syncthreads();
#pragma unroll
  for (int mi = 0; mi < 4; mi++)
#pragma unroll
    for (int ni = 0; ni < TN / 32; ni++)
#pragma unroll
      for (int j = 0; j < 4; j++)
        Cs[(wm * 64 + mi * 16 + quad * 4 + j) * (TN + 4) + wn * (TN / 2) + ni * 16 + l16] = acc[mi][ni][j];
  __syncthreads();
}
template <int NF>
DEV void zero_acc(f32x4 (&acc)[4][NF]) {
#pragma unroll
  for (int mi = 0; mi < 4; mi++)
#pragma unroll
    for (int ni = 0; ni < NF; ni++) acc[mi][ni] = f32x4{0.f, 0.f, 0.f, 0.f};
}

DEV void transpose_tile(const float* __restrict__ src, int ld, int col0, int ncols, int K, bf16_t* dst, int nt, int kt, float* tile) {
  const int tid = otid();
  const int n = tid & 63, kk = tid >> 6, gn = nt * 64 + n;
#pragma unroll
  for (int i = 0; i < 16; i++) {
    int k = kk + 4 * i;
    float v = (gn < ncols) ? src[(size_t)(kt * 64 + k) * ld + col0 + gn] : 0.f;
    tile[k * 65 + n] = v;
  }
  __syncthreads();
#pragma unroll
  for (int i = 0; i < 2; i++) {
    int it = tid + 256 * i, nn = it >> 3, kg = it & 7;
    float f[8];
#pragma unroll
    for (int j = 0; j < 8; j++) f[j] = tile[(kg * 8 + j) * 65 + nn];
    *(u32x4*)(dst + (size_t)(nt * 64 + nn) * K + kt * 64 + kg * 8) = pack8(f);
  }
}
#define NCONV_TASKS 2760
DEV void convert_task(const Params& p, int l, int t, char* lds) {
  char* ws_ = p.ws; asm volatile("" : "+s"(ws_));
  float* tile = (float*)lds;
  char* ws = ws_;
  if (t < 1216) { transpose_tile(p.in[I_WIN] + (size_t)l * 1024 * DIN, DIN, 0, 4784, 1024, (bf16_t*)(ws + OFF_WTA), t % 76, t / 76, tile); return; }
  t -= 1216;
  if (t < 768) { transpose_tile(p.in[I_WIN] + (size_t)l * 1024 * DIN, DIN, 4784, 3072, 1024, (bf16_t*)(ws + OFF_WGL), t % 48, t / 48, tile); return; }
  t -= 768;
  if (t < 72) { transpose_tile(p.in[I_WUQ] + (size_t)l * 384 * 768, 768, 0, 768, 384, (bf16_t*)(ws + OFF_WUQ), t % 12, t / 12, tile); return; }
  t -= 72;
  if (t < 64) { transpose_tile(p.in[I_WUKV] + (size_t)l * 256 * 1024, 1024, 0, 1024, 256, (bf16_t*)(ws + OFF_WUKV), t % 16, t / 16, tile); return; }
  t -= 64;
  if (t < 384) {
    int n = t / 128, tt = t % 128;
    transpose_tile(p.in[I_WBR] + (size_t)(l * 3 + n) * 512 * 1024, 1024, 0, 1024, 512, (bf16_t*)(ws + OFF_WBR) + (size_t)n * 1024 * 512, tt % 16, tt / 16, tile);
    return;
  }
  t -= 384;
  transpose_tile(p.in[I_WO] + (size_t)l * 1024 * 1024, 1024, 0, 1024, 1024, (bf16_t*)(ws + OFF_WO), t % 16, t / 16, tile);
}
DEV void mod_task(const Params& p, int t, char* lds) {
  char* ws_ = p.ws; asm volatile("" : "+s"(ws_));
  const int tid = otid();
  const int l = t / 192, n0 = (t % 192) * 16;
  float* s = (float*)lds;
  float* red = (float*)(lds + 32768);
  for (int idx = tid; idx < 5120; idx += 256) {
    int r = idx >> 10, k = idx & 1023;
    float v = (r == 0) ? p.in[I_CCTX][k] : p.in[I_C][(r - 1) * 1024 + k];
    s[idx] = v * frcp(1.f + __expf(-v));
  }
  __syncthreads();
  const int col = tid & 15, ksl = tid >> 4;
  float acc[5] = {0.f, 0.f, 0.f, 0.f, 0.f};
  const float* w = p.in[I_WMOD] + (size_t)l * 1024 * 3072 + n0 + col;
#pragma unroll 16
  for (int k = ksl * 64; k < ksl * 64 + 64; k++) {
    float wv = w[(size_t)k * 3072];
#pragma unroll
    for (int r = 0; r < 5; r++) acc[r] += s[r * 1024 + k] * wv;
  }
#pragma unroll
  for (int r = 0; r < 5; r++) red[(ksl * 5 + r) * 16 + col] = acc[r];
  __syncthreads();
  float* mod = (float*)(ws_ + OFF_MOD);
  if (tid < 80) {
    int r = tid >> 4, c = tid & 15;
    float v = p.in[I_BMOD][l * 3072 + n0 + c];
#pragma unroll
    for (int q = 0; q < 16; q++) v += red[(q * 5 + r) * 16 + c];
    mod[(l * 5 + r) * 3072 + n0 + c] = v;
  }
}

DEV void norm_task(const Params& p, int l, int t) {
  char* ws_ = p.ws; asm volatile("" : "+s"(ws_));
  const int tid = otid(), lane = tid & 63, wave = tid >> 6;
  const float* mod = (const float*)(ws_ + OFF_MOD);
  bf16_t* H = (bf16_t*)(ws_ + OFF_H);
#pragma unroll
  for (int rr = 0; rr < 2; rr++) {
    const int row = t * 8 + wave * 2 + rr;
    const float* x = xrow_ptr(p, l, row);
    const float* mr = mod + (size_t)(l * 5 + modrow(row)) * 3072;
    f32x4 v[4];
    float ss = 0.f;
#pragma unroll
    for (int i = 0; i < 4; i++) { v[i] = *(const f32x4*)(x + lane * 4 + 256 * i); ss += v[i].x * v[i].x + v[i].y * v[i].y + v[i].z * v[i].z + v[i].w * v[i].w; }
#pragma unroll
    for (int o = 32; o >= 1; o >>= 1) ss += __shfl_xor(ss, o);
    const float rstd = __builtin_amdgcn_rsqf(ss * (1.f / 1024.f) + EPSF);
#pragma unroll
    for (int i = 0; i < 4; i++) {
      const int col = lane * 4 + 256 * i;
      const f32x4 g = *(const f32x4*)(p.in[I_NORMG] + l * 1024 + col);
      const f32x4 sh = *(const f32x4*)(mr + col);
      const f32x4 sc = *(const f32x4*)(mr + 1024 + col);
      float a = v[i].x * rstd * g.x * (1.f + sc.x) + sh.x;
      float b = v[i].y * rstd * g.y * (1.f + sc.y) + sh.y;
      float c = v[i].z * rstd * g.z * (1.f + sc.z) + sh.z;
      float d = v[i].w * rstd * g.w * (1.f + sc.w) + sh.w;
      *(u32x2*)(H + (size_t)row * 1024 + col) = pack4(a, b, c, d);
    }
  }
}

DEV void projA_task(const Params& p, int l, int t, char* lds) {
  char* ws_ = p.ws; asm volatile("" : "+s"(ws_));
  const int tid = otid();
  const int nt = t / 64, mt = t % 64;
  f32x4 acc[4][4]; zero_acc<4>(acc);
  ALPlain al{(const bf16_t*)(ws_ + OFF_H) + (size_t)mt * 128 * 1024, 1024};
  gemm_core<128>(al, (const bf16_t*)(ws_ + OFF_WTA) + (size_t)nt * 128 * 1024, 1024, 1024, acc, lds);
  float* Cs = (float*)lds;
  acc_to_lds<128>(acc, Cs);
  bf16_t* P1 = (bf16_t*)(ws_ + OFF_P1);
  bf16_t* P2 = (bf16_t*)(ws_ + OFF_P2);
  float* GAB = (float*)(ws_ + OFF_GAB);
#pragma unroll
  for (int i = 0; i < 8; i++) {
    const int it = tid + 256 * i, r = it >> 4, c8 = it & 15;
    const int n = nt * 128 + c8 * 8;
    if (n >= 4784) continue;
    const int row = mt * 128 + r;
    float f[8];
    const f32x4 a = *(const f32x4*)(Cs + r * 132 + c8 * 8);
    const f32x4 b = *(const f32x4*)(Cs + r * 132 + c8 * 8 + 4);
    f[0] = a.x; f[1] = a.y; f[2] = a.z; f[3] = a.w; f[4] = b.x; f[5] = b.y; f[6] = b.z; f[7] = b.w;
    if (n >= 2720 && n < 2736) {
      *(f32x4*)(GAB + (size_t)row * 16 + (n - 2720)) = a;
      *(f32x4*)(GAB + (size_t)row * 16 + (n - 2720) + 4) = b;
      continue;
    }
    if (n >= 640 && n < 672 && row < 4096) {
      float* o = p.out + OUT_KROPE + ((size_t)((row >> 8) * 2 + l) * 256 + (row & 255)) * 32 + (n - 640);
      *(f32x4*)o = a; *(f32x4*)(o + 4) = b;
    }
    bf16_t* dst;
    if (n < 672) dst = P1 + (size_t)row * P1W + n;
    else if (n < 1184) dst = P2 + (size_t)row * P2W + (n - 672);
    else if (n < 2720) dst = P1 + (size_t)row * P1W + 672 + (n - 1184);
    else if (n < 3248) dst = P2 + (size_t)row * P2W + 512 + (n - 2736);
    else if (n < 3760) dst = P1 + (size_t)row * P1W + 2208 + (n - 3248);
    else if (n < 4272) dst = P1 + (size_t)row * P1W + 2720 + (n - 3760);
    else dst = P2 + (size_t)row * P2W + 1024 + (n - 4272);
    *(u32x4*)dst = pack8(f);
  }
}

DEV void rope32(float* r, int prow, int pcol) {
  const float inv[8] = {1.f, 0.31622776601683794f, 0.1f, 0.031622776601683794f, 0.01f, 0.0031622776601683794f, 0.001f, 0.00031622776601683794f};
#pragma unroll
  for (int i = 0; i < 8; i++) {
    float a1 = (float)prow * inv[i], a2 = (float)pcol * inv[i];
    float c1 = __cosf(a1), s1 = __sinf(a1), c2 = __cosf(a2), s2 = __sinf(a2);
    float x1 = r[i], x2 = r[8 + i];
    r[i] = x1 * c1 - x2 * s1; r[8 + i] = x1 * s1 + x2 * c1;
    float y1 = r[16 + i], y2 = r[24 + i];
    r[16 + i] = y1 * c2 - y2 * s2; r[24 + i] = y1 * s2 + y2 * c2;
  }
}
DEV void finish_qk(float* v  , int half, const float* normw  , bool do_rope, int pos, float scale, bf16_t* dst  ) {
  float ss = 0.f;
#pragma unroll
  for (int i = 0; i < 48; i++) ss += v[i] * v[i];
  ss += __shfl_xor(ss, 1);
  const float rstd = __builtin_amdgcn_rsqf(ss * (1.f / 96.f) + EPSF);
#pragma unroll
  for (int i = 0; i < 12; i++) {
    const f32x4 w = *(const f32x4*)(normw + half * 48 + i * 4);
    v[i * 4] *= rstd * w.x; v[i * 4 + 1] *= rstd * w.y; v[i * 4 + 2] *= rstd * w.z; v[i * 4 + 3] *= rstd * w.w;
  }
  if (do_rope && half == 1) rope32(v + 16, pos >> 6, pos & 63);
#pragma unroll
  for (int i = 0; i < 6; i++) {
    float f[8];
#pragma unroll
    for (int j = 0; j < 8; j++) f[j] = v[i * 8 + j] * scale;
    *(u32x4*)(dst + half * 48 + i * 8) = pack8(f);
  }
}

#define QSCALE 0.14724306f
DEV void q_task(const Params& p, int l, int t, char* lds) {
  char* ws_ = p.ws; asm volatile("" : "+s"(ws_));
  const int tid = otid();
  const int mt = t & 63, h = t >> 6;
  const bf16_t* P1 = (const bf16_t*)(ws_ + OFF_P1);
  float* rs = (float*)(lds + LDS_SMALL);
  {
    const int row = tid >> 1, half = tid & 1;
    const bf16_t* src = P1 + (size_t)(mt * 128 + row) * P1W + half * 192;
    float ss = 0.f;
#pragma unroll 12
    for (int i = 0; i < 24; i++) { float f[8]; unpack8(*(const u32x4*)(src + i * 8), f);
#pragma unroll
      for (int j = 0; j < 8; j++) ss += f[j] * f[j]; }
    ss += __shfl_xor(ss, 1);
    if (!half) rs[row] = __builtin_amdgcn_rsqf(ss * (1.f / 384.f) + EPSF);
  }
  __syncthreads();
  f32x4 acc[4][3]; zero_acc<3>(acc);
  ALScaled al{P1 + (size_t)mt * 128 * P1W, P1W, rs, p.in[I_QAN] + l * 384};
  gemm_core<96>(al, (const bf16_t*)(ws_ + OFF_WUQ) + (size_t)h * 96 * 384, 384, 384, acc, lds);
  float* Cs = (float*)lds;
  acc_to_lds<96>(acc, Cs);
  const int row = tid >> 1, half = tid & 1, grow = mt * 128 + row;
  float v[48];
#pragma unroll
  for (int i = 0; i < 48; i++) v[i] = Cs[row * 100 + half * 48 + i];
  finish_qk(v, half, p.in[I_QN] + l * 96, grow >= 4096, (grow - 4096) & 1023, QSCALE,
            (bf16_t*)(ws_ + OFF_Q) + ((size_t)grow * 8 + h) * 96);
}

DEV void kv_task(const Params& p, int l, int t, char* lds) {
  char* ws_ = p.ws; asm volatile("" : "+s"(ws_));
  const int tid = otid();
  const int h = t / 72, mt = t % 72;
  const bf16_t* P1 = (const bf16_t*)(ws_ + OFF_P1);
  float* rs = (float*)(lds + LDS_SMALL);
  f32x4 acc[4][4]; zero_acc<4>(acc);
  const bf16_t* Bt = (const bf16_t*)(ws_ + OFF_WUKV) + (size_t)h * 128 * 256;
  if (mt < 64) {
    {
      const int row = tid >> 1, half = tid & 1;
      const bf16_t* src = P1 + (size_t)(mt * 128 + row) * P1W + 384 + half * 128;
      float ss = 0.f;
#pragma unroll
      for (int i = 0; i < 16; i++) { float f[8]; unpack8(*(const u32x4*)(src + i * 8), f);
#pragma unroll
        for (int j = 0; j < 8; j++) ss += f[j] * f[j]; }
      ss += __shfl_xor(ss, 1);
      if (!half) rs[row] = __builtin_amdgcn_rsqf(ss * (1.f / 256.f) + EPSF);
    }
    __syncthreads();
    if (h == 0 && mt < 32) {
#pragma unroll 8
      for (int it = tid; it < 128 * 32; it += 256) {
        const int r = it >> 5, c8 = it & 31, row = mt * 128 + r;
        float f[8]; unpack8(*(const u32x4*)(P1 + (size_t)row * P1W + 384 + c8 * 8), f);
        const float rr = rs[r];
        const float* g = p.in[I_KVAN] + l * 256 + c8 * 8;
        float* o = p.out + OUT_CKV + ((size_t)((row >> 8) * 2 + l) * 256 + (row & 255)) * 256 + c8 * 8;
        *(f32x4*)o = f32x4{f[0] * rr * g[0], f[1] * rr * g[1], f[2] * rr * g[2], f[3] * rr * g[3]};
        *(f32x4*)(o + 4) = f32x4{f[4] * rr * g[4], f[5] * rr * g[5], f[6] * rr * g[6], f[7] * rr * g[7]};
      }
    }
    ALScaled al{P1 + (size_t)mt * 128 * P1W + 384, P1W, rs, p.in[I_KVAN] + l * 256};
    gemm_core<128>(al, Bt, 256, 256, acc, lds);
  } else {
    const int b = (mt - 64) >> 1, p0 = ((mt - 64) & 1) * 128;
    ALF32 al{p.in[I_CCKV] + ((size_t)(b * 2 + l) * 256 + p0) * 256, 256};
    gemm_core<128>(al, Bt, 256, 256, acc, lds);
  }
  float* Cs = (float*)lds;
  acc_to_lds<128>(acc, Cs);
  {
    const int row = tid >> 1, half = tid & 1;
    float v[48];
    int krow; bool do_rope = false; int pos = 0;
    if (mt < 64) {
      const int grow = mt * 128 + row;
      krow = grow; do_rope = grow >= 4096; pos = (grow - 4096) & 1023;
      if (half == 0) {
#pragma unroll
        for (int i = 0; i < 48; i++) v[i] = Cs[row * 132 + i];
      } else {
#pragma unroll
        for (int i = 0; i < 16; i++) v[i] = Cs[row * 132 + 48 + i];
        const bf16_t* kr = P1 + (size_t)grow * P1W + 640;
#pragma unroll
        for (int i = 0; i < 4; i++) { float f[8]; unpack8(*(const u32x4*)(kr + i * 8), f);
#pragma unroll
          for (int j = 0; j < 8; j++) v[16 + i * 8 + j] = f[j]; }
      }
    } else {
      const int b = (mt - 64) >> 1, pp = ((mt - 64) & 1) * 128 + row;
      krow = 8192 + b * 256 + pp;
      if (half == 0) {
#pragma unroll
        for (int i = 0; i < 48; i++) v[i] = Cs[row * 132 + i];
      } else {
#pragma unroll
        for (int i = 0; i < 16; i++) v[i] = Cs[row * 132 + 48 + i];
        const float* kr = p.in[I_CKR] + ((size_t)(b * 2 + l) * 256 + pp) * 32;
#pragma unroll
        for (int i = 0; i < 8; i++) { const f32x4 w = *(const f32x4*)(kr + i * 4); v[16 + i * 4] = w.x; v[17 + i * 4] = w.y; v[18 + i * 4] = w.z; v[19 + i * 4] = w.w; }
      }
    }
    finish_qk(v, half, p.in[I_KN] + l * 96, do_rope, pos, 1.f, (bf16_t*)(ws_ + OFF_K) + ((size_t)krow * 8 + h) * 96);
  }
  {
    size_t vbase; int Tk, key0;
    if (mt < 32) { const int b = mt >> 1; Tk = 256; key0 = (mt & 1) * 128; vbase = (size_t)(b * 8 + h) * 64 * 256; }
    else if (mt < 64) { const int b = (mt - 32) >> 3; Tk = 1280; key0 = 256 + ((mt - 32) & 7) * 128; vbase = VT_LAT_EL + (size_t)(b * 8 + h) * 64 * 1280; }
    else { const int b = (mt - 64) >> 1; Tk = 1280; key0 = ((mt - 64) & 1) * 128; vbase = VT_LAT_EL + (size_t)(b * 8 + h) * 64 * 1280; }
    bf16_t* Vt = (bf16_t*)(ws_ + OFF_VT) + vbase;
#pragma unroll
    for (int i = 0; i < 4; i++) {
      const int it = tid + 256 * i, dv = it & 63, kg = it >> 6;
      float f[8];
#pragma unroll
      for (int j = 0; j < 8; j++) f[j] = Cs[(kg * 8 + j) * 132 + 64 + dv];
      *(u32x4*)(Vt + (size_t)dv * Tk + key0 + kg * 8) = pack8(f);
    }
  }
}

DEV void conv_pass(const Params& p, int l, int seg, int h, int row0, int sbeg, int send, float* F, bf16_t* Vtile) {
  char* ws_ = p.ws; asm volatile("" : "+s"(ws_));
  const int tid = otid(), c8 = tid & 15, tg = tid >> 4;
  const bf16_t* src = (const bf16_t*)(ws_ + OFF_P1) + 672 + seg * 512 + h * 128 + c8 * 8;
  const float* cwp = p.in[I_CONVW] + (size_t)l * 5 * 1536 + seg * 512 + h * 128 + c8 * 8;
  float cw[5][8];
#pragma unroll
  for (int j = 0; j < 5; j++) {
    const f32x4 a = *(const f32x4*)(cwp + j * 1536), b = *(const f32x4*)(cwp + j * 1536 + 4);
    cw[j][0] = a.x; cw[j][1] = a.y; cw[j][2] = a.z; cw[j][3] = a.w; cw[j][4] = b.x; cw[j][5] = b.y; cw[j][6] = b.z; cw[j][7] = b.w;
  }
  const int t0 = row0 + tg * 4;
  u32x4 raw[8];
#pragma unroll
  for (int r = 0; r < 8; r++) {
    const int row = t0 - 2 + r;
    raw[r] = (row >= sbeg && row < send) ? *(const u32x4*)(src + (size_t)row * P1W) : u32x4{0u, 0u, 0u, 0u};
  }
  float acc[4][8];
#pragma unroll
  for (int tt = 0; tt < 4; tt++)
#pragma unroll
    for (int c = 0; c < 8; c++) acc[tt][c] = 0.f;
#pragma unroll
  for (int r = 0; r < 8; r++) {
    float f[8]; unpack8(raw[r], f);
#pragma unroll
    for (int tt = 0; tt < 4; tt++) {
      const int j = r - tt;
      if (j >= 0 && j < 5) {
#pragma unroll
        for (int c = 0; c < 8; c++) acc[tt][c] += cw[j][c] * f[c];
      }
    }
  }
#pragma unroll
  for (int tt = 0; tt < 4; tt++) {
    float y[8];
#pragma unroll
    for (int c = 0; c < 8; c++) y[c] = siluf(acc[tt][c]);
    if (F) {
#pragma unroll
      for (int c = 0; c < 8; c++) F[(tg * 4 + tt) * 129 + c8 * 8 + c] = y[c];
    } else {
      *(u32x4*)(Vtile + (tg * 4 + tt) * 136 + c8 * 8) = pack8(y);
    }
  }
}
DEV void l2norm_rows(const float* F, bf16_t* T) {
  const int tid = otid(), row = tid >> 2, part = tid & 3;
  float ss = 0.f;
#pragma unroll
  for (int i = 0; i < 32; i++) { float x = F[row * 129 + part * 32 + i]; ss += x * x; }
  ss += __shfl_xor(ss, 1); ss += __shfl_xor(ss, 2);
  const float inv = __builtin_amdgcn_rsqf(ss + EPSF);
#pragma unroll
  for (int i = 0; i < 32; i++) T[row * 136 + part * 32 + i] = f2bf(F[row * 129 + part * 32 + i] * inv);
}
DEV void mm64(const bf16_t* At, const bf16_t* Bt_, float* Out, int wave, int l16, int quad) {
  f32x4 acc[4];
#pragma unroll
  for (int ni = 0; ni < 4; ni++) acc[ni] = f32x4{0.f, 0.f, 0.f, 0.f};
#pragma unroll
  for (int ks = 0; ks < 4; ks++) {
    bf16x8 a = *(const bf16x8*)(At + (wave * 16 + l16) * 136 + ks * 32 + quad * 8);
#pragma unroll
    for (int ni = 0; ni < 4; ni++) {
      bf16x8 b = *(const bf16x8*)(Bt_ + (ni * 16 + l16) * 136 + ks * 32 + quad * 8);
      acc[ni] = MFMA(a, b, acc[ni]);
    }
  }
#pragma unroll
  for (int ni = 0; ni < 4; ni++)
#pragma unroll
    for (int j = 0; j < 4; j++) Out[(wave * 16 + quad * 4 + j) * 65 + ni * 16 + l16] = acc[ni][j];
}
DEV void gdn_prep_task(const Params& p, int l, int t, char* lds) {
  char* ws_ = p.ws; asm volatile("" : "+s"(ws_));
  const int tid = otid(), lane = tid & 63, wave = tid >> 6, l16 = lane & 15, quad = lane >> 4;
  const int chunk = t >> 2, h = t & 3, row0 = chunk * 64;
  int sbeg, send;
  if (row0 < 4096) { sbeg = row0 & ~255; send = sbeg + 256; } else { sbeg = 4096 + ((row0 - 4096) & ~1023); send = sbeg + 1024; }
  bf16_t* Kt = (bf16_t*)lds;
  bf16_t* Qt = Kt + 64 * 136;
  float* F = (float*)(lds + 34816);
  float* G = F;
  float* Pm = (float*)(lds + 34816 + 17408);
  float* Am = Pm;
  float* gcs = (float*)(lds + LDS_SMALL);
  float* betas = gcs + 128;
  const float* GAB = (const float*)(ws_ + OFF_GAB);
  if (tid < 128) {
    const int dir = tid >> 6, ip = tid & 63, tok = dir ? 63 - ip : ip, row = row0 + tok;
    const float ga = GAB[(size_t)row * 16 + dir * 4 + h], gb = GAB[(size_t)row * 16 + 8 + dir * 4 + h];
    const float a = __expf(p.in[I_ALOG][(l * 2 + dir) * 4 + h]);
    const float x = ga + p.in[I_DTB][(l * 2 + dir) * 4 + h];
    const float ex = __expf(fminf(x, 20.f));
    const float sp = x > 20.f ? x : (ex < 0.01f ? ex * (1.f - ex * (0.5f - ex * (1.f / 3.f))) : __logf(1.f + ex));
    float g = -a * sp;
#pragma unroll
    for (int off = 1; off < 64; off <<= 1) { float v = __shfl_up(g, off); if (ip >= off) g += v; }
    gcs[dir * 64 + ip] = g;
    betas[dir * 64 + ip] = frcp(1.f + __expf(-gb));
  }
  conv_pass(p, l, 1, h, row0, sbeg, send, F, nullptr);
  __syncthreads();
  l2norm_rows(F, Kt);
  __syncthreads();
  conv_pass(p, l, 0, h, row0, sbeg, send, F, nullptr);
  __syncthreads();
  l2norm_rows(F, Qt);
  __syncthreads();
  mm64(Qt, Kt, Pm, wave, l16, quad);
  bf16_t* recbase = (bf16_t*)(ws_ + OFF_GDN) + (size_t)(chunk * 4 + h) * 2 * REC_EL;
#pragma unroll 1
  for (int dir = 0; dir < 2; dir++) {
    bf16_t* rec = recbase + (size_t)dir * REC_EL;
    const float* gc = gcs + dir * 64;
    const float gl = gc[63];
#pragma unroll
    for (int i = 0; i < 4; i++) {
      const int it = tid + 256 * i, ip = it >> 4, c8 = it & 15, tok = dir ? 63 - ip : ip;
      const float sc = 0.08838834764831845f * __expf(gc[ip]);
      float f[8]; unpack8(*(const u32x4*)(Qt + tok * 136 + c8 * 8), f);
#pragma unroll
      for (int j = 0; j < 8; j++) f[j] *= sc;
      *(u32x4*)(rec + 8192 + ip * 128 + c8 * 8) = pack8(f);
    }
#pragma unroll
    for (int i = 0; i < 4; i++) {
      const int it = tid + 256 * i, d = it & 127, ig = it >> 7;
      float f[8];
#pragma unroll
      for (int j = 0; j < 8; j++) { const int ip = ig * 8 + j, tok = dir ? 63 - ip : ip; f[j] = bf2f(Kt[tok * 136 + d]) * __expf(gl - gc[ip]); }
      *(u32x4*)(rec + 20480 + d * 64 + ig * 8) = pack8(f);
    }
    if (tid == 0) ((float*)(ws_ + OFF_EGL))[(chunk * 4 + h) * 2 + dir] = __expf(gl);
  }
  __syncthreads();
  conv_pass(p, l, 2, h, row0, sbeg, send, nullptr, Qt);
#pragma unroll 1
  for (int dir = 0; dir < 2; dir++) {
    bf16_t* rec = recbase + (size_t)dir * REC_EL;
    const float* gc = gcs + dir * 64;
#pragma unroll
    for (int i = 0; i < 2; i++) {
      const int it = tid + 256 * i, ip = it >> 3, j8 = it & 7, ti = dir ? 63 - ip : ip;
      float f[8];
#pragma unroll
      for (int j = 0; j < 8; j++) {
        const int jp = j8 * 8 + j, tj = dir ? 63 - jp : jp;
        const float e = __expf(fminf(gc[ip] - gc[jp], 0.f));
        f[j] = (ip >= jp) ? Pm[ti * 65 + tj] * 0.08838834764831845f * e : 0.f;
      }
      *(u32x4*)(rec + 16384 + ip * 64 + j8 * 8) = pack8(f);
    }
  }
  __syncthreads();
  const bf16_t* Vtile = Qt;
  float* T = G;
#pragma unroll 1
  for (int dir = 0; dir < 2; dir++) {
    bf16_t* rec = recbase + (size_t)dir * REC_EL;
    const float* gc = gcs + dir * 64;
    const float* be = betas + dir * 64;
    mm64(Kt, Kt, G, wave, l16, quad);
    __syncthreads();
#pragma unroll 2
    for (int i = 0; i < 16; i++) {
      const int it = tid + 256 * i, ip = it >> 6, jp = it & 63;
      const int ti = dir ? 63 - ip : ip, tj = dir ? 63 - jp : jp;
      const float e = __expf(fminf(gc[ip] - gc[jp], 0.f));
      Am[ip * 68 + jp] = (ip > jp) ? be[ip] * G[ti * 65 + tj] * e : 0.f;
    }
    __syncthreads();
    {
      const int cl = lane >> 2, q = lane & 3, c = wave * 16 + cl;
      float r[16];
#pragma unroll
      for (int m = 0; m < 16; m++) r[m] = (q + 4 * m == c) ? 1.f : 0.f;
#pragma unroll
      for (int j = 0; j < 63; j++) {
        const int mj = j >> 2;
        float t;
        switch (j & 3) {
          case 0: t = __int_as_float(__builtin_amdgcn_update_dpp(0, __float_as_int(r[mj]), 0x00, 0xF, 0xF, true)); break;
          case 1: t = __int_as_float(__builtin_amdgcn_update_dpp(0, __float_as_int(r[mj]), 0x55, 0xF, 0xF, true)); break;
          case 2: t = __int_as_float(__builtin_amdgcn_update_dpp(0, __float_as_int(r[mj]), 0xAA, 0xF, 0xF, true)); break;
          default: t = __int_as_float(__builtin_amdgcn_update_dpp(0, __float_as_int(r[mj]), 0xFF, 0xF, 0xF, true)); break;
        }
#pragma unroll
        for (int m = mj; m < 16; m++) r[m] -= Am[(q + 4 * m) * 68 + j] * t;
        if ((j & 7) == 7) asm volatile("" ::: "memory");
      }
#pragma unroll
      for (int m = 0; m < 16; m++) T[(q + 4 * m) * 68 + c] = r[m];
    }
    __syncthreads();
#pragma unroll 1
    for (int which = 0; which < 2; which++) {
      const bf16_t* srcT = which ? Kt : Vtile;
      f32x4 ac[4][2];
      zero_acc<2>(ac);
#pragma unroll
      for (int ks = 0; ks < 2; ks++) {
        float cs[8];
        unsigned short e[2][8];
#pragma unroll
        for (int s = 0; s < 8; s++) {
          const int j = ks * 32 + quad * 8 + s, tok = dir ? 63 - j : j;
          cs[s] = which ? be[j] * __expf(gc[j]) : be[j];
#pragma unroll
          for (int nf = 0; nf < 2; nf++) e[nf][s] = srcT[tok * 136 + wave * 32 + nf * 16 + l16];
        }
        bf16x8 bfr[2];
#pragma unroll
        for (int nf = 0; nf < 2; nf++) {
          u32x4 v;
          v.x = e[nf][0] | ((unsigned)e[nf][1] << 16); v.y = e[nf][2] | ((unsigned)e[nf][3] << 16);
          v.z = e[nf][4] | ((unsigned)e[nf][5] << 16); v.w = e[nf][6] | ((unsigned)e[nf][7] << 16);
          bfr[nf] = as_frag(v);
        }
#pragma unroll
        for (int mi = 0; mi < 4; mi++) {
          const float* tr = T + (mi * 16 + l16) * 68 + ks * 32 + quad * 8;
          const f32x4 t0 = *(const f32x4*)tr, t1 = *(const f32x4*)(tr + 4);
          const float tv[8] = {t0.x, t0.y, t0.z, t0.w, t1.x, t1.y, t1.z, t1.w};
          float a[8], hi[8], lo[8];
#pragma unroll
          for (int s = 0; s < 8; s++) a[s] = tv[s] * cs[s];
          const u32x4 ph = pack8(a);
          unpack8(ph, hi);
#pragma unroll
          for (int s = 0; s < 8; s++) lo[s] = a[s] - hi[s];
          const bf16x8 fh = as_frag(ph), fl = as_frag(pack8(lo));
#pragma unroll
          for (int nf = 0; nf < 2; nf++) { ac[mi][nf] = MFMA(fh, bfr[nf], ac[mi][nf]); ac[mi][nf] = MFMA(fl, bfr[nf], ac[mi][nf]); }
        }
      }
      int qs = quad, ls = l16;
      asm volatile("" : "+v"(qs), "+v"(ls));
      bf16_t* dst = rec + (which ? 0 : 28672);
      const float sg = which ? -1.f : 1.f;
#pragma unroll
      for (int mi = 0; mi < 4; mi++)
#pragma unroll
        for (int nf = 0; nf < 2; nf++)
#pragma unroll
          for (int j = 0; j < 4; j++) {
            const int ip = mi * 16 + qs * 4 + j, col = wave * 32 + nf * 16 + ls;
            dst[ip * 128 + col] = f2bf(sg * ac[mi][nf][j]);
          }
    }
    __syncthreads();
  }
}

DEV void cmlp_task(const Params& p, int l, int t, char* lds) {
  char* ws_ = p.ws; asm volatile("" : "+s"(ws_));
  const int tid = otid(), lane = tid & 63, wave = tid >> 6, l16 = lane & 15, quad = lane >> 4;
  const int wm = wave >> 1, wn = wave & 1;
  const int c = t >> 2, g = t & 3, r0 = c * 128;
  const bf16_t* P1 = (const bf16_t*)(ws_ + OFF_P1);
  const bf16_t* P2 = (const bf16_t*)(ws_ + OFF_P2);
  bf16_t* BR = (bf16_t*)(ws_ + OFF_BR);
  bf16_t* VnT = (bf16_t*)lds;
  bf16_t* Ws = VnT + 128 * 136;
  float* mu = (float*)(lds + LDS_SMALL);
  float* rstd = mu + 128;
  {
    const int row = tid >> 1, half = tid & 1;
    const bf16_t* src = P1 + (size_t)(r0 + row) * P1W + 2720 + half * 256;
    float s = 0.f, ss = 0.f;
#pragma unroll 16
    for (int i = 0; i < 32; i++) { float f[8]; unpack8(*(const u32x4*)(src + i * 8), f);
#pragma unroll
      for (int j = 0; j < 8; j++) { float y = geluf(f[j]); s += y; ss += y * y; } }
    s += __shfl_xor(s, 1); ss += __shfl_xor(ss, 1);
    const float mean = s * (1.f / 512.f), var = fmaxf(ss * (1.f / 512.f) - mean * mean, 0.f);
    if (!half) { mu[row] = mean; rstd[row] = __builtin_amdgcn_rsqf(var + EPSF); }
  }
  __syncthreads();
#pragma unroll
  for (int i = 0; i < 8; i++) {
    const int it = tid + 256 * i, q = it >> 4, c8 = it & 15;
    float f[8]; unpack8(*(const u32x4*)(P1 + (size_t)(r0 + q) * P1W + 2720 + g * 128 + c8 * 8), f);
    const float m = mu[q], rs = rstd[q];
#pragma unroll
    for (int j = 0; j < 8; j++) {
      const int cc = c8 * 8 + j;
      const float val = (geluf(f[j]) - m) * rs * p.in[I_LNG][l * 512 + g * 128 + cc] + p.in[I_LNB][l * 512 + g * 128 + cc];
      VnT[cc * 136 + q] = f2bf(val);
    }
  }
#pragma unroll
  for (int i = 0; i < 16; i++) {
    const int it = tid + 256 * i, pp = it >> 5, q4 = it & 31;
    const f32x4 w = *(const f32x4*)(p.in[I_WS] + ((size_t)(l * 4 + g) * 128 + pp) * 128 + q4 * 4);
    *(u32x2*)(Ws + pp * 136 + q4 * 4) = pack4(w.x, w.y, w.z, w.w);
  }
  __syncthreads();
  f32x4 acc[4][4]; zero_acc<4>(acc);
#pragma unroll
  for (int ks = 0; ks < 4; ks++) {
    bf16x8 a[4], b[4];
#pragma unroll
    for (int mi = 0; mi < 4; mi++) a[mi] = *(const bf16x8*)(Ws + (wm * 64 + mi * 16 + l16) * 136 + ks * 32 + quad * 8);
#pragma unroll
    for (int ni = 0; ni < 4; ni++) b[ni] = *(const bf16x8*)(VnT + (wn * 64 + ni * 16 + l16) * 136 + ks * 32 + quad * 8);
#pragma unroll
    for (int mi = 0; mi < 4; mi++)
#pragma unroll
      for (int ni = 0; ni < 4; ni++) acc[mi][ni] = MFMA(a[mi], b[ni], acc[mi][ni]);
  }
  float* Cs = (float*)lds;
  __syncthreads();
#pragma unroll
  for (int mi = 0; mi < 4; mi++)
#pragma unroll
    for (int j = 0; j < 4; j++) {
      const int pp = wm * 64 + mi * 16 + quad * 4 + j;
      const float bias = p.in[I_BS][(l * 4 + g) * 128 + pp];
#pragma unroll
      for (int ni = 0; ni < 4; ni++) Cs[pp * 132 + wn * 64 + ni * 16 + l16] = acc[mi][ni][j] + bias;
    }
  __syncthreads();
  u32x4 uu[8], zz[8];
#pragma unroll
  for (int i = 0; i < 8; i++) {
    const int it = tid + 256 * i, r = it >> 4, c8 = it & 15;
    const size_t row = (size_t)(r0 + r);
    uu[i] = *(const u32x4*)(P1 + row * P1W + 2208 + g * 128 + c8 * 8);
    zz[i] = *(const u32x4*)(P2 + row * P2W + 1024 + g * 128 + c8 * 8);
  }
#pragma unroll
  for (int i = 0; i < 8; i++) {
    const int it = tid + 256 * i, r = it >> 4, c8 = it & 15;
    float u[8], z[8], o[8];
    unpack8(uu[i], u); unpack8(zz[i], z);
    const f32x4 s0 = *(const f32x4*)(Cs + r * 132 + c8 * 8), s1 = *(const f32x4*)(Cs + r * 132 + c8 * 8 + 4);
    const float sv[8] = {s0.x, s0.y, s0.z, s0.w, s1.x, s1.y, s1.z, s1.w};
#pragma unroll
    for (int j = 0; j < 8; j++) o[j] = geluf(u[j]) * sv[j] * siluf(z[j]);
    *(u32x4*)(BR + (size_t)(r0 + r) * BRW + 1024 + g * 128 + c8 * 8) = pack8(o);
  }
}

DEV void attn_task(const Params& p, int l, int t, char* lds) {
  char* ws_ = p.ws; asm volatile("" : "+s"(ws_));
  const int tid = otid(), lane = tid & 63, wave = tid >> 6, l16 = lane & 15, quad = lane >> 4;
  int b, h, qrow0, nkt, Tk; size_t vtb;
  const bool lat = t < 256;
  if (lat) { b = t >> 6; h = (t >> 3) & 7; const int qb = t & 7; qrow0 = 4096 + b * 1024 + qb * 128; nkt = 20; Tk = 1280; vtb = VT_LAT_EL + (size_t)(b * 8 + h) * 64 * 1280; }
  else { const int tt = t - 256; b = tt >> 4; h = (tt >> 1) & 7; const int qb = tt & 1; qrow0 = b * 256 + qb * 128; nkt = 4; Tk = 256; vtb = (size_t)(b * 8 + h) * 64 * 256; }
  const bf16_t* Qg = (const bf16_t*)(ws_ + OFF_Q);
  const bf16_t* Kg = (const bf16_t*)(ws_ + OFF_K);
  const bf16_t* Vg = (const bf16_t*)(ws_ + OFF_VT) + vtb;
  bf16_t* Qs = (bf16_t*)lds;
  bf16_t* Ks = Qs + 128 * 104;
  bf16_t* Vs = Ks + 64 * 104;
#pragma unroll
  for (int i = 0; i < 6; i++) {
    const int it = tid + 256 * i, r = it / 12, cc = it % 12;
    *(u32x4*)(Qs + r * 104 + cc * 8) = *(const u32x4*)(Qg + ((size_t)(qrow0 + r) * 8 + h) * 96 + cc * 8);
  }
  __syncthreads();
  bf16x8 qf[2][3];
#pragma unroll
  for (int ni = 0; ni < 2; ni++)
#pragma unroll
    for (int ks = 0; ks < 3; ks++) qf[ni][ks] = *(const bf16x8*)(Qs + (wave * 32 + ni * 16 + l16) * 104 + ks * 32 + quad * 8);
  f32x4 o[4][2];
#pragma unroll
  for (int di = 0; di < 4; di++) { o[di][0] = f32x4{0.f, 0.f, 0.f, 0.f}; o[di][1] = f32x4{0.f, 0.f, 0.f, 0.f}; }
  float mrun[2] = {-1e30f, -1e30f}, lsum[2] = {0.f, 0.f};
  u32x4 pk[3], pv[2];
  {
    const int krow0 = lat ? (8192 + b * 256) : (b * 256);
#pragma unroll
    for (int i = 0; i < 3; i++) { const int it = tid + 256 * i, r = it / 12, cc = it % 12; pk[i] = *(const u32x4*)(Kg + ((size_t)(krow0 + r) * 8 + h) * 96 + cc * 8); }
#pragma unroll
    for (int i = 0; i < 2; i++) { const int it = tid + 256 * i, dv = it >> 3, kg = it & 7; pv[i] = *(const u32x4*)(Vg + (size_t)dv * Tk + kg * 8); }
  }
  for (int kt = 0; kt < nkt; kt++) {
    __syncthreads();
#pragma unroll
    for (int i = 0; i < 3; i++) { const int it = tid + 256 * i, r = it / 12, cc = it % 12; *(u32x4*)(Ks + r * 104 + cc * 8) = pk[i]; }
#pragma unroll
    for (int i = 0; i < 2; i++) { const int it = tid + 256 * i, dv = it >> 3, kg = it & 7; *(u32x4*)(Vs + dv * 72 + kg * 8) = pv[i]; }
    __syncthreads();
    if (kt + 1 < nkt) {
      const int kn = kt + 1;
      int krow0;
      if (lat) krow0 = (kn < 4) ? (8192 + b * 256 + kn * 64) : (4096 + b * 1024 + (kn - 4) * 64);
      else krow0 = b * 256 + kn * 64;
#pragma unroll
      for (int i = 0; i < 3; i++) { const int it = tid + 256 * i, r = it / 12, cc = it % 12; pk[i] = *(const u32x4*)(Kg + ((size_t)(krow0 + r) * 8 + h) * 96 + cc * 8); }
#pragma unroll
      for (int i = 0; i < 2; i++) { const int it = tid + 256 * i, dv = it >> 3, kg = it & 7; pv[i] = *(const u32x4*)(Vg + (size_t)dv * Tk + kn * 64 + kg * 8); }
    }
    __builtin_amdgcn_sched_barrier(0);
    f32x4 s[4][2];
#pragma unroll
    for (int mi = 0; mi < 4; mi++) { s[mi][0] = f32x4{0.f, 0.f, 0.f, 0.f}; s[mi][1] = f32x4{0.f, 0.f, 0.f, 0.f}; }
#pragma unroll
    for (int ks = 0; ks < 3; ks++)
#pragma unroll
      for (int mi = 0; mi < 4; mi++) {
        bf16x8 kf = *(const bf16x8*)(Ks + (mi * 16 + l16) * 104 + ks * 32 + quad * 8);
        s[mi][0] = MFMA(kf, qf[0][ks], s[mi][0]);
        s[mi][1] = MFMA(kf, qf[1][ks], s[mi][1]);
      }
#pragma unroll
    for (int ni = 0; ni < 2; ni++) {
      float mx = -1e30f;
#pragma unroll
      for (int mi = 0; mi < 4; mi++)
#pragma unroll
        for (int j = 0; j < 4; j++) mx = fmaxf(mx, s[mi][ni][j]);
      mx = fmaxf(mx, __shfl_xor(mx, 16)); mx = fmaxf(mx, __shfl_xor(mx, 32));
      const float mnew = fmaxf(mrun[ni], mx);
      const float alpha = __builtin_amdgcn_exp2f(mrun[ni] - mnew);
      mrun[ni] = mnew;
      float rsum = 0.f;
#pragma unroll
      for (int mi = 0; mi < 4; mi++)
#pragma unroll
        for (int j = 0; j < 4; j++) { float pv = __builtin_amdgcn_exp2f(s[mi][ni][j] - mnew); s[mi][ni][j] = pv; rsum += pv; }
      lsum[ni] = lsum[ni] * alpha + rsum;
#pragma unroll
      for (int di = 0; di < 4; di++) o[di][ni] *= alpha;
    }
#pragma unroll
    for (int g = 0; g < 2; g++) {
      bf16x8 pf0 = frag_from(s[2 * g][0], s[2 * g + 1][0]);
      bf16x8 pf1 = frag_from(s[2 * g][1], s[2 * g + 1][1]);
#pragma unroll
      for (int di = 0; di < 4; di++) {
        bf16x8 vf = ld2(Vs + (di * 16 + l16) * 72 + g * 32 + quad * 4);
        o[di][0] = MFMA(vf, pf0, o[di][0]);
        o[di][1] = MFMA(vf, pf1, o[di][1]);
      }
    }
  }
  const bf16_t* P2 = (const bf16_t*)(ws_ + OFF_P2);
  bf16_t* BR = (bf16_t*)(ws_ + OFF_BR);
#pragma unroll
  for (int ni = 0; ni < 2; ni++) {
    float lt = lsum[ni];
    lt += __shfl_xor(lt, 16); lt += __shfl_xor(lt, 32);
    const float inv = frcp(lt);
    const size_t qrow = (size_t)(qrow0 + wave * 32 + ni * 16 + l16);
#pragma unroll
    for (int di = 0; di < 4; di++) {
      const int col = h * 64 + di * 16 + quad * 4;
      float z[4]; unpack4(*(const u32x2*)(P2 + qrow * P2W + col), z);
      *(u32x2*)(BR + qrow * BRW + col) = pack4(o[di][ni][0] * inv * siluf(z[0]), o[di][ni][1] * inv * siluf(z[1]),
                                               o[di][ni][2] * inv * siluf(z[2]), o[di][ni][3] * inv * siluf(z[3]));
    }
  }
}

struct ScanPf { u32x4 w[4], q[4], a[2], k[4], u[2]; float egl; };
DEV void scan_prefetch(ScanPf& f, const bf16_t* rec, const float* eglp, int half, int tid) {
#pragma unroll
  for (int i = 0; i < 4; i++) { const int c = tid + 256 * i; f.w[i] = *(const u32x4*)(rec + c * 8); f.q[i] = *(const u32x4*)(rec + 8192 + c * 8); f.k[i] = *(const u32x4*)(rec + 20480 + c * 8); }
#pragma unroll
  for (int i = 0; i < 2; i++) { const int c = tid + 256 * i; f.a[i] = *(const u32x4*)(rec + 16384 + c * 8); f.u[i] = *(const u32x4*)(rec + 28672 + (c >> 3) * 128 + half * 64 + (c & 7) * 8); }
  f.egl = *eglp;
}
DEV void gdn_scan_task(const Params& p, int l, int t, char* lds) {
  char* ws_ = p.ws; asm volatile("" : "+s"(ws_));
  const int tid = otid(), lane = tid & 63, wave = tid >> 6, l16 = lane & 15, quad = lane >> 4;
  __builtin_amdgcn_s_setprio(3);
  int chain, half, b, chunk0, N; bool lat = t < 64;
  if (lat) { chain = t >> 1; half = t & 1; } else { chain = (t - 64) >> 1; half = (t - 64) & 1; }
  const int dir = chain & 1, h = (chain >> 1) & 3;
  b = chain >> 3;
  if (lat) { chunk0 = 64 + b * 16; N = 16; } else { chunk0 = b * 4; N = 4; }
  const int e0 = (half * 4 + wave) * 16;
  bf16_t* Wl = (bf16_t*)lds;
  bf16_t* Ql = Wl + 64 * 136;
  bf16_t* Al = Ql + 64 * 136;
  bf16_t* Kl = Al + 64 * 72;
  bf16_t* Ul = Kl + 128 * 72;
  f32x4 S[8];
  if (lat) {
    const float* s0 = p.in[I_SGDN] + ((size_t)((b * 2 + l) * 2 + dir) * 4 + h) * 16384;
#pragma unroll
    for (int mf = 0; mf < 8; mf++)
#pragma unroll
      for (int j = 0; j < 4; j++) S[mf][j] = s0[(mf * 16 + quad * 4 + j) * 128 + e0 + l16];
  } else {
#pragma unroll
    for (int mf = 0; mf < 8; mf++) S[mf] = f32x4{0.f, 0.f, 0.f, 0.f};
  }
  float* OD = (float*)(ws_ + OFF_ODIR) + (size_t)dir * NTOK * 512;
  const float* EGL = (const float*)(ws_ + OFF_EGL);
  const bf16_t* GD = (const bf16_t*)(ws_ + OFF_GDN);
  ScanPf pf;
  {
    const int cidx = chunk0 + (dir ? N - 1 : 0);
    scan_prefetch(pf, GD + ((size_t)(cidx * 4 + h) * 2 + dir) * REC_EL, EGL + (cidx * 4 + h) * 2 + dir, half, tid);
  }
#pragma unroll 1
  for (int n = 0; n < N; n++) {
    const int cidx = chunk0 + (dir ? N - 1 - n : n);
    __syncthreads();
#pragma unroll
    for (int i = 0; i < 4; i++) {
      const int c = tid + 256 * i;
      *(u32x4*)(Wl + (c >> 4) * 136 + (c & 15) * 8) = pf.w[i];
      *(u32x4*)(Ql + (c >> 4) * 136 + (c & 15) * 8) = pf.q[i];
      *(u32x4*)(Kl + (c >> 3) * 72 + (c & 7) * 8) = pf.k[i];
    }
#pragma unroll
    for (int i = 0; i < 2; i++) {
      const int c = tid + 256 * i;
      *(u32x4*)(Al + (c >> 3) * 72 + (c & 7) * 8) = pf.a[i];
      *(u32x4*)(Ul + (c >> 3) * 72 + (c & 7) * 8) = pf.u[i];
    }
    const float egl = pf.egl;
    __syncthreads();
    if (n + 1 < N) {
      const int cn = chunk0 + (dir ? N - 2 - n : n + 1);
      scan_prefetch(pf, GD + ((size_t)(cn * 4 + h) * 2 + dir) * REC_EL, EGL + (cn * 4 + h) * 2 + dir, half, tid);
    }
    __builtin_amdgcn_sched_barrier(0);
    bf16x8 Sb[4];
#pragma unroll
    for (int ks = 0; ks < 4; ks++) Sb[ks] = frag_from(S[2 * ks], S[2 * ks + 1]);
    f32x4 vn[4];
#pragma unroll
    for (int mi = 0; mi < 4; mi++)
#pragma unroll
      for (int j = 0; j < 4; j++) vn[mi][j] = bf2f(Ul[(mi * 16 + quad * 4 + j) * 72 + wave * 16 + l16]);
#pragma unroll
    for (int mi = 0; mi < 4; mi++)
#pragma unroll
      for (int ks = 0; ks < 4; ks++) vn[mi] = MFMA(ld2(Wl + (mi * 16 + l16) * 136 + ks * 32 + quad * 4), Sb[ks], vn[mi]);
    bf16x8 vb[2];
    vb[0] = frag_from(vn[0], vn[1]); vb[1] = frag_from(vn[2], vn[3]);
#pragma unroll
    for (int mi = 0; mi < 4; mi++) {
      f32x4 o = f32x4{0.f, 0.f, 0.f, 0.f};
#pragma unroll
      for (int ks = 0; ks < 4; ks++) o = MFMA(ld2(Ql + (mi * 16 + l16) * 136 + ks * 32 + quad * 4), Sb[ks], o);
#pragma unroll
      for (int k2 = 0; k2 < 2; k2++) o = MFMA(ld2(Al + (mi * 16 + l16) * 72 + k2 * 32 + quad * 4), vb[k2], o);
#pragma unroll
      for (int j = 0; j < 4; j++) {
        const int ip = mi * 16 + quad * 4 + j, tok = dir ? 63 - ip : ip;
        OD[(size_t)(cidx * 64 + tok) * 512 + h * 128 + e0 + l16] = o[j];
      }
    }
#pragma unroll
    for (int mf = 0; mf < 8; mf++) {
      S[mf] *= egl;
#pragma unroll
      for (int k2 = 0; k2 < 2; k2++) S[mf] = MFMA(ld2(Kl + (mf * 16 + l16) * 72 + k2 * 32 + quad * 4), vb[k2], S[mf]);
    }
  }
  if (!lat) {
    float* so = p.out + OUT_STATE + ((size_t)((b * 2 + l) * 2 + dir) * 4 + h) * 16384;
#pragma unroll
    for (int mf = 0; mf < 8; mf++)
#pragma unroll
      for (int j = 0; j < 4; j++) so[(mf * 16 + quad * 4 + j) * 128 + e0 + l16] = S[mf][j];
  }
  __builtin_amdgcn_s_setprio(0);
}

DEV void onorm_task(const Params& p, int l, int t) {
  char* ws_ = p.ws; asm volatile("" : "+s"(ws_));
  const int tid = otid(), lane = tid & 63, wave = tid >> 6;
  const float* OD = (const float*)(ws_ + OFF_ODIR);
  const bf16_t* P2 = (const bf16_t*)(ws_ + OFF_P2);
  bf16_t* BR = (bf16_t*)(ws_ + OFF_BR);
#pragma unroll
  for (int rr = 0; rr < 4; rr++) {
    const size_t row = (size_t)t * 16 + wave * 4 + rr;
    const f32x4 a0 = *(const f32x4*)(OD + row * 512 + lane * 8), a1 = *(const f32x4*)(OD + row * 512 + lane * 8 + 4);
    const f32x4 b0 = *(const f32x4*)(OD + (NTOK + row) * 512 + lane * 8), b1 = *(const f32x4*)(OD + (NTOK + row) * 512 + lane * 8 + 4);
    float x[8] = {a0.x + b0.x, a0.y + b0.y, a0.z + b0.z, a0.w + b0.w, a1.x + b1.x, a1.y + b1.y, a1.z + b1.z, a1.w + b1.w};
    float ss = 0.f;
#pragma unroll
    for (int i = 0; i < 8; i++) ss += x[i] * x[i];
#pragma unroll
    for (int o = 8; o >= 1; o >>= 1) ss += __shfl_xor(ss, o);
    const float rstd = __builtin_amdgcn_rsqf(ss * (1.f / 128.f) + EPSF);
    float z[8]; unpack8(*(const u32x4*)(P2 + row * P2W + 512 + lane * 8), z);
    const float* g = p.in[I_ONORM] + l * 128 + (lane & 15) * 8;
    float y[8];
#pragma unroll
    for (int i = 0; i < 8; i++) y[i] = x[i] * rstd * g[i] * siluf(z[i]);
    *(u32x4*)(BR + row * BRW + 512 + lane * 8) = pack8(y);
  }
}

DEV void gate_task(const Params& p, int l, int t, char* lds) {
  char* ws_ = p.ws; asm volatile("" : "+s"(ws_));
  const int tid = otid();
  const int nt = t / 64, mt = t % 64;
  f32x4 acc[4][4]; zero_acc<4>(acc);
  ALPlain al{(const bf16_t*)(ws_ + OFF_H) + (size_t)mt * 128 * 1024, 1024};
  gemm_core<128>(al, (const bf16_t*)(ws_ + OFF_WGL) + (size_t)nt * 128 * 1024, 1024, 1024, acc, lds);
  float* Cs = (float*)lds;
  acc_to_lds<128>(acc, Cs);
  bf16_t* GT = (bf16_t*)(ws_ + OFF_GDN);
#pragma unroll
  for (int i = 0; i < 8; i++) {
    const int it = tid + 256 * i, r = it >> 4, c8 = it & 15;
    const f32x4 a = *(const f32x4*)(Cs + r * 132 + c8 * 8), b = *(const f32x4*)(Cs + r * 132 + c8 * 8 + 4);
    float f[8] = {sigmf(a.x), sigmf(a.y), sigmf(a.z), sigmf(a.w), sigmf(b.x), sigmf(b.y), sigmf(b.z), sigmf(b.w)};
    *(u32x4*)(GT + (size_t)(mt * 128 + r) * 3072 + nt * 128 + c8 * 8) = pack8(f);
  }
}
DEV void d1_task(const Params& p, int l, int t, char* lds) {
  char* ws_ = p.ws; asm volatile("" : "+s"(ws_));
  const int tid = otid(), lane = tid & 63, wave = tid >> 6, l16 = lane & 15, quad = lane >> 4;
  const int wm = wave >> 1, wn = wave & 1;
  const int nt = t >> 6, mt = t & 63;
  const bf16_t* GT = (const bf16_t*)(ws_ + OFF_GDN);
  f32x4 macc[4][2]; zero_acc<2>(macc);
#pragma unroll 1
  for (int n = 0; n < 3; n++) {
    unsigned short gv[4][2][4];
#pragma unroll
    for (int mi = 0; mi < 4; mi++)
#pragma unroll
      for (int ni = 0; ni < 2; ni++)
#pragma unroll
        for (int j = 0; j < 4; j++)
          gv[mi][ni][j] = GT[(size_t)(mt * 128 + wm * 64 + mi * 16 + quad * 4 + j) * 3072 + n * 1024 + nt * 64 + wn * 32 + ni * 16 + l16];
    f32x4 y[4][2]; zero_acc<2>(y);
    ALPlain alb{(const bf16_t*)(ws_ + OFF_BR) + (size_t)mt * 128 * BRW + n * 512, BRW};
    gemm_core<64>(alb, (const bf16_t*)(ws_ + OFF_WBR) + (size_t)(n * 1024 + nt * 64) * 512, 512, 512, y, lds);
#pragma unroll
    for (int mi = 0; mi < 4; mi++)
#pragma unroll
      for (int ni = 0; ni < 2; ni++)
#pragma unroll
        for (int j = 0; j < 4; j++) macc[mi][ni][j] += bf2f(gv[mi][ni][j]) * y[mi][ni][j];
  }
  float* Cs = (float*)lds;
  acc_to_lds<64>(macc, Cs);
  bf16_t* M = (bf16_t*)(ws_ + OFF_M);
#pragma unroll
  for (int i = 0; i < 4; i++) {
    const int it = tid + 256 * i, r = it >> 3, c8 = it & 7;
    float f[8];
#pragma unroll
    for (int j = 0; j < 8; j++) f[j] = Cs[r * 68 + c8 * 8 + j];
    *(u32x4*)(M + (size_t)(mt * 128 + r) * 1024 + nt * 64 + c8 * 8) = pack8(f);
  }
}

DEV void d2_task(const Params& p, int l, int t, char* lds) {
  char* ws_ = p.ws; asm volatile("" : "+s"(ws_));
  const int tid = otid();
  const int nt = t >> 6, mt = t & 63;
  f32x4 acc[4][4]; zero_acc<4>(acc);
  ALPlain al{(const bf16_t*)(ws_ + OFF_M) + (size_t)mt * 128 * 1024, 1024};
  gemm_core<128>(al, (const bf16_t*)(ws_ + OFF_WO) + (size_t)nt * 128 * 1024, 1024, 1024, acc, lds);
  float* Cs = (float*)lds;
  acc_to_lds<128>(acc, Cs);
  const float* mod = (const float*)(ws_ + OFF_MOD);
#pragma unroll
  for (int i = 0; i < 8; i++) {
    const int it = tid + 256 * i, r = it >> 4, c8 = it & 15;
    const int row = mt * 128 + r, col = nt * 128 + c8 * 8;
    const float* x = xrow_ptr(p, l, row) + col;
    const float* gt = mod + (size_t)(l * 5 + modrow(row)) * 3072 + 2048 + col;
    const f32x4 y0 = *(const f32x4*)(Cs + r * 132 + c8 * 8), y1 = *(const f32x4*)(Cs + r * 132 + c8 * 8 + 4);
    const f32x4 x0 = *(const f32x4*)x, x1 = *(const f32x4*)(x + 4);
    const f32x4 g0 = *(const f32x4*)gt, g1 = *(const f32x4*)(gt + 4);
    float* o = p.out + (size_t)row * DM + col;
    *(f32x4*)o = f32x4{x0.x + g0.x * y0.x, x0.y + g0.y * y0.y, x0.z + g0.z * y0.z, x0.w + g0.w * y0.w};
    *(f32x4*)(o + 4) = f32x4{x1.x + g1.x * y1.x, x1.y + g1.y * y1.y, x1.z + g1.z * y1.z, x1.w + g1.w * y1.w};
  }
}

#define NPHASES 15
DEV int phase_nsub(int ph) {
  if (ph == 0) return 48 + 152;
  const int l = (ph - 1) / 7, s = (ph - 1) % 7;
  switch (s) {
    case 0: return 128 + (l == 0 ? 113 : 32);
    case 1: return 304 + (l == 0 ? 80 : 0);
    case 2: return 64 + 72 + 64 + 32;
    case 3: return 8 + 32 + 32 + 32;
    case 4: return 192 + 64 + (l == 0 ? 169 : 0);
    case 5: return 128 + (l == 0 ? 96 : 0);
    default: return 64 + (l == 0 ? 48 : 0);
  }
}
DEV void run_task(const Params& p, int ph, int x, int i, char* lds) {
  if (ph == 0) { if (i < 48) mod_task(p, i * 8 + x, lds); else convert_task(p, 0, (i - 48) * 8 + x, lds); return; }
  const int l = (ph - 1) / 7, s = (ph - 1) % 7;
  switch (s) {
    case 0:
      if (i < 128) norm_task(p, l, i * 8 + x);
      else if (l == 0) convert_task(p, 0, 1216 + (i - 128) * 8 + x, lds);
      else convert_task(p, 1, 2504 + (i - 128) * 8 + x, lds);
      break;
    case 1:
      if (i < 304) projA_task(p, l, (i >> 3) * 64 + (i & 7) * 8 + x, lds);
      else convert_task(p, 0, 2120 + (i - 304) * 8 + x, lds);
      break;
    case 2:
      if (i < 64) gdn_prep_task(p, l, i * 8 + x, lds);
      else if (i < 136) { const int j = i - 64; kv_task(p, l, (j / 9) * 72 + (j % 9) * 8 + x, lds); }
      else if (i < 200) { const int j = i - 136; q_task(p, l, (j >> 3) * 64 + (j & 7) * 8 + x, lds); }
      else cmlp_task(p, l, (i - 200) * 8 + x, lds);
      break;
    case 3:
      if (i < 8) gdn_scan_task(p, l, i * 8 + x, lds);
      else if (i < 40) attn_task(p, l, x * 32 + (i - 8), lds);
      else if (i < 72) gdn_scan_task(p, l, 64 + (i - 40) * 8 + x, lds);
      else attn_task(p, l, 256 + x * 32 + (i - 72), lds);
      break;
    case 4:
      if (i < 192) gate_task(p, l, (i >> 3) * 64 + (i & 7) * 8 + x, lds);
      else if (i < 256) onorm_task(p, l, (i - 192) * 8 + x);
      else if (i < 408) convert_task(p, 1, (i - 256) * 8 + x, lds);
      else convert_task(p, 1, 1984 + (i - 408) * 8 + x, lds);
      break;
    case 5:
      if (i < 128) d1_task(p, l, (i >> 3) * 64 + (i & 7) * 8 + x, lds);
      else convert_task(p, 1, 1216 + (i - 128) * 8 + x, lds);
      break;
    case 6:
      if (i < 64) d2_task(p, l, (i >> 3) * 64 + (i & 7) * 8 + x, lds);
      else convert_task(p, 1, 2120 + (i - 64) * 8 + x, lds);
      break;
  }
}
#ifndef REP_S
#define REP_S -1
#endif
DEV void run_phase(const Params& p, int ph, char* lds, int* sh, int myx, int rep = 0) {
  unsigned* cb = (unsigned*)(p.ws + OFF_CTR) + ph * 128 + rep * 6144;
  const int n = phase_nsub(ph);
#pragma unroll 1
  for (int xo = 0; xo < 8; xo++) {
    const int x = (myx + xo) & 7;
    unsigned* c = cb + x * 16;
    int i;
    while ((i = next_task(c, sh, n, xo > 0)) < n) run_task(p, ph, x, i, lds);
  }
}

__global__ void __launch_bounds__(256, 2) k_phase(Params p, int ph) {
  __shared__ __attribute__((aligned(16))) char lds[LDS_BYTES];
  __shared__ int sh[4];
  const Params& pr = *(const Params*)__builtin_amdgcn_kernarg_segment_ptr();
  run_phase(pr, ph, lds, sh, (int)(xb_xcc_id() & 7u));
}

__global__ void __launch_bounds__(256, 2) k_mega(Params p) {
  __shared__ __attribute__((aligned(16))) char lds[LDS_BYTES];
  __shared__ __attribute__((aligned(16))) unsigned xbw[4];
  __shared__ int sh[4];
  const Params& pr = *(const Params*)__builtin_amdgcn_kernarg_segment_ptr();
  if (threadIdx.x == 0) { xbw[0] = 0u; xbw[1] = 0u; xbw[2] = 0u; xbw[3] = 0u; }
  __syncthreads();
  XcdBarrier xb = xcd_barrier_post((unsigned*)(pr.ws + OFF_BAR), (volatile LAS unsigned*)xbw);
  const int myx = (int)(xb.x & 7u);
  if (pr.out == nullptr) cg::this_grid().sync();
#pragma unroll
  for (int ph = 0; ph < NPHASES; ph++) {
    run_phase(pr, ph, lds, sh, myx);
    if ((REP_S == 7 && ph == 0) || (REP_S >= 0 && ph > 0 && (ph - 1) % 7 == REP_S && !(REP_S == 6 && ph > 7))) run_phase(pr, ph, lds, sh, myx, 1);
    if (ph + 1 < NPHASES) xcd_barrier(xb);
  }
}

extern "C" void kernel_launch(void* const* d_in, const int* in_sizes, int n_in, void* d_out, int out_size, void* d_ws,
                              size_t ws_size, hipStream_t stream) {
  Params p{};
  for (int i = 0; i < 27; i++) p.in[i] = (const float*)d_in[i];
  p.out = (float*)d_out;
  p.ws = (char*)d_ws;
  if (ws_size < WS_END) { fprintf(stderr, "workspace too small: %zu < %llu\n", ws_size, (unsigned long long)WS_END); return; }
  (void)hipMemsetAsync(d_ws, 0, 32768, stream);
#if COOP
  static int grid_blocks = 0;
  if (!grid_blocks) {
    int dev = 0, cus = 0, per_cu = 0;
    hipGetDevice(&dev);
    hipDeviceGetAttribute(&cus, hipDeviceAttributeMultiprocessorCount, dev);
    hipOccupancyMaxActiveBlocksPerMultiprocessor(&per_cu, k_mega, 256, 0);
    if (per_cu > 2) per_cu = 2;
    if (per_cu < 1) per_cu = 1;
    grid_blocks = cus * per_cu;
  }
  void* args[] = {&p};
  hipError_t e = hipLaunchCooperativeKernel((void*)k_mega, dim3(grid_blocks), dim3(256), args, 0, stream);
  if (e != hipSuccess) fprintf(stderr, "cooperative launch failed: %s (grid %d)\n", hipGetErrorString(e), grid_blocks);
#else
  for (int ph = 0; ph < NPHASES; ph++) k_phase<<<512, 256, 0, stream>>>(p, ph);
#endif
}
```

```cpp
#include <hip/hip_runtime.h>
#include <hip/hip_cooperative_groups.h>
#include <stdint.h>
#include <stdio.h>
namespace cg = cooperative_groups;

#ifndef COOP
#define COOP 1
#endif

typedef unsigned short bf16_t;
typedef __attribute__((ext_vector_type(8))) short bf16x8;
typedef __attribute__((ext_vector_type(4))) float f32x4;
typedef __attribute__((ext_vector_type(4))) unsigned int u32x4;
typedef __attribute__((ext_vector_type(2))) unsigned int u32x2;
#define DEV __device__ __forceinline__

#define NTOK 8192
#define DM 1024
#define DIN 7856
#define EPSF 1e-6f
#define P1W 3232
#define P2W 1536
#define BRW 1536
#define REC_EL 36864

#define OFF_CTR  0ull
#define OFF_BAR  8192ull
#define OFF_MOD  32768ull
#define OFF_GAB  (OFF_MOD + 122880ull)
#define OFF_EGL  (OFF_GAB + 524288ull)
#define OFF_WTA  (OFF_EGL + 4096ull)
#define OFF_WGL  (OFF_WTA + 9961472ull)
#define OFF_WUQ  (OFF_WGL + 6291456ull)
#define OFF_WUKV (OFF_WUQ + 589824ull)
#define OFF_WBR  (OFF_WUKV + 524288ull)
#define OFF_WO   (OFF_WBR + 3145728ull)
#define OFF_H    (OFF_WO + 2097152ull)
#define OFF_P1   (OFF_H + 16777216ull)
#define OFF_ODIR OFF_P1
#define OFF_M    (OFF_P1 + 33554432ull)
#define OFF_P2   (OFF_P1 + 52953088ull)
#define OFF_GDN  (OFF_P2 + 25165824ull)
#define OFF_Q    (OFF_GDN + 75497472ull)
#define OFF_K    (OFF_Q + 12582912ull)
#define OFF_VT   (OFF_K + 14155776ull)
#define OFF_BR   (OFF_VT + 9437184ull)
#define WS_END   (OFF_BR + 25165824ull)
#define VT_LAT_EL 2097152

#define OUT_CKV   8388608
#define OUT_KROPE 10485760
#define OUT_STATE 10747904

#define LDS_BYTES 75776
#define LDS_SMALL 73728

struct Params {
  const float* in[27];
  float* out;
  char* ws;
};
enum { I_XP = 0, I_XS, I_CCKV, I_CKR, I_SGDN, I_C, I_CCTX, I_NORMG, I_WMOD, I_BMOD, I_WIN, I_QAN, I_WUQ, I_KVAN, I_WUKV,
       I_QN, I_KN, I_CONVW, I_ALOG, I_DTB, I_ONORM, I_LNG, I_LNB, I_WS, I_BS, I_WBR, I_WO };

DEV float bf2f(bf16_t b) { return __uint_as_float(((unsigned)b) << 16); }
typedef __bf16 hwbf2 __attribute__((ext_vector_type(2)));
typedef float hwf2 __attribute__((ext_vector_type(2)));
DEV unsigned pack2(float a, float b) { hwf2 v = {a, b}; return __builtin_bit_cast(unsigned, __builtin_convertvector(v, hwbf2)); }
DEV bf16_t f2bf(float f) { return (bf16_t)(pack2(f, 0.f) & 0xffffu); }
DEV void unpack8(u32x4 v, float* f) {
  f[0] = __uint_as_float(v.x << 16); f[1] = __uint_as_float(v.x & 0xffff0000u);
  f[2] = __uint_as_float(v.y << 16); f[3] = __uint_as_float(v.y & 0xffff0000u);
  f[4] = __uint_as_float(v.z << 16); f[5] = __uint_as_float(v.z & 0xffff0000u);
  f[6] = __uint_as_float(v.w << 16); f[7] = __uint_as_float(v.w & 0xffff0000u);
}
DEV void unpack4(u32x2 v, float* f) {
  f[0] = __uint_as_float(v.x << 16); f[1] = __uint_as_float(v.x & 0xffff0000u);
  f[2] = __uint_as_float(v.y << 16); f[3] = __uint_as_float(v.y & 0xffff0000u);
}
DEV u32x4 pack8(const float* f) {
  u32x4 v; v.x = pack2(f[0], f[1]); v.y = pack2(f[2], f[3]); v.z = pack2(f[4], f[5]); v.w = pack2(f[6], f[7]); return v;
}
DEV u32x2 pack4(float a, float b, float c, float d) { u32x2 v; v.x = pack2(a, b); v.y = pack2(c, d); return v; }
DEV bf16x8 as_frag(u32x4 v) { union { u32x4 u; bf16x8 b; } x; x.u = v; return x.b; }
DEV bf16x8 frag_from(f32x4 a, f32x4 b) {
  u32x4 v; v.x = pack2(a[0], a[1]); v.y = pack2(a[2], a[3]); v.z = pack2(b[0], b[1]); v.w = pack2(b[2], b[3]); return as_frag(v);
}
DEV bf16x8 ld2(const bf16_t* p) {
  u32x2 a = *(const u32x2*)p; u32x2 b = *(const u32x2*)(p + 16);
  u32x4 v; v.x = a.x; v.y = a.y; v.z = b.x; v.w = b.y; return as_frag(v);
}
DEV float frcp(float x) { return __builtin_amdgcn_rcpf(x); }
DEV float siluf(float x) { return x * frcp(1.f + __expf(-x)); }
DEV float sigmf(float x) { return frcp(1.f + __expf(-x)); }
DEV float geluf(float x) { float u = 0.7978845608028654f * (x + 0.044715f * x * x * x); return x * frcp(1.f + __expf(-2.f * u)); }
#define MFMA(a, b, c) __builtin_amdgcn_mfma_f32_16x16x32_bf16((a), (b), (c), 0, 0, 0)

DEV int otid() { int t = threadIdx.x; asm volatile("" : "+v"(t)); return t; }
DEV int next_task(unsigned* ctr, int* sh, int n, bool precheck) {
  __syncthreads();
  if (threadIdx.x == 0) {
    int v = n;
    if (!precheck || (int)__hip_atomic_load(ctr, __ATOMIC_RELAXED, __HIP_MEMORY_SCOPE_AGENT) < n) v = (int)atomicAdd(ctr, 1u);
    *sh = v;
  }
  __syncthreads();
  return *sh;
}

#define XB_TMO      128
#define XB_XCNT(j)  (256  + 64 * (j))
#define XB_XSUB(j)  (1280 + 64 * (j))
#define XB_XGEN(j)  (2304 + 64 * (j))
#define XB_TOP      3328
#define XB_TOPGEN   3392
#define XCD_BAR_WORDS 3456
#define XB_SPIN_CAP (1u << 22)
#define LAS __attribute__((address_space(3)))
DEV unsigned xb_ld(unsigned* p) { return __hip_atomic_load(p, __ATOMIC_RELAXED, __HIP_MEMORY_SCOPE_AGENT); }
DEV unsigned xb_add(unsigned* p, unsigned v) { return __hip_atomic_fetch_add(p, v, __ATOMIC_RELAXED, __HIP_MEMORY_SCOPE_AGENT); }
DEV unsigned xb_xcc_id() { return (unsigned)__builtin_amdgcn_s_getreg((3 << 11) | 20) & 0xFu; }
#define XB_SPIN(cond, bar) do { unsigned _sp = 0; while (cond) { __builtin_amdgcn_s_sleep(1); \
    if ((++_sp & 255u) == 0u) { if (xb_ld(&(bar)[XB_TMO])) break; if (_sp > XB_SPIN_CAP) { atomicAdd(&(bar)[XB_TMO], 1u); break; } } } } while (0)
struct XcdBarrier { unsigned* bar; unsigned x; volatile LAS unsigned* st; };
DEV XcdBarrier xcd_barrier_post(unsigned* bar, volatile LAS unsigned* st) {
  XcdBarrier b; b.bar = bar; b.x = xb_xcc_id(); b.st = st;
  if (threadIdx.x == 0) st[2] = xb_add(&bar[XB_XCNT(b.x)], 1u);
  return b;
}
DEV void xcd_barrier_complete(unsigned* bar, unsigned x, unsigned& nloc, unsigned& nx) {
  const unsigned G = gridDim.x * gridDim.y * gridDim.z;
  unsigned sum, cnt, mine, sp = 0u;
  for (;;) {
    sum = 0u; cnt = 0u; mine = 0u;
#pragma unroll
    for (unsigned j = 0; j < 16; ++j) { const unsigned c = xb_ld(&bar[XB_XCNT(j)]); sum += c; cnt += (c > 0u) ? 1u : 0u; mine = (j == x) ? c : mine; }
    if (sum == G) break;
    __builtin_amdgcn_s_sleep(1);
    if ((++sp & 255u) == 0u) { if (xb_ld(&bar[XB_TMO])) break; if (sp > XB_SPIN_CAP) { atomicAdd(&bar[XB_TMO], 1u); break; } }
  }
  nloc = mine > 0u ? mine : 1u; nx = cnt > 0u ? cnt : 1u;
}
DEV void xcd_barrier(const XcdBarrier& b) {
  asm volatile("s_waitcnt vmcnt(0)" ::: "memory");
  __syncthreads();
  if (threadIdx.x == 0) {
    unsigned* bar = b.bar;
    __builtin_amdgcn_s_waitcnt(0);
    unsigned nloc = b.st[0], nx = b.st[1];
    if (nloc == 0u) { xcd_barrier_complete(bar, b.x, nloc, nx); b.st[0] = nloc; b.st[1] = nx; }
    const unsigned old = xb_add(&bar[XB_XSUB(b.x)], 1u);
    const unsigned gen = old / nloc;
    if (old + 1u == (gen + 1u) * nloc) {
      __builtin_amdgcn_fence(__ATOMIC_RELEASE, "agent");
      asm volatile("s_waitcnt vmcnt(0)" ::: "memory");
      const unsigned og = xb_add(&bar[XB_TOP], 1u);
      const unsigned tg = og / nx;
      if (og + 1u == (tg + 1u) * nx) xb_add(&bar[XB_TOPGEN], 1u);
      else XB_SPIN(xb_ld(&bar[XB_TOPGEN]) == tg, bar);
      __builtin_amdgcn_fence(__ATOMIC_ACQUIRE, "agent");
      xb_add(&bar[XB_XGEN(b.x)], 1u);
      asm volatile("s_waitcnt vmcnt(0)" ::: "memory");
    } else {
      XB_SPIN(xb_ld(&bar[XB_XGEN(b.x)]) == gen, bar);
      __builtin_amdgcn_fence(__ATOMIC_ACQUIRE, "agent");
      asm volatile("s_waitcnt vmcnt(0)" ::: "memory");
    }
  }
  __syncthreads();
}

DEV const float* xrow_ptr(const Params& p, int l, int row) {
  if (l == 0) return row < 4096 ? p.in[I_XP] + (size_t)row * DM : p.in[I_XS] + (size_t)(row - 4096) * DM;
  return p.out + (size_t)row * DM;
}
DEV int modrow(int row) { return row < 4096 ? 0 : 1 + ((row - 4096) >> 10); }

struct ALPlain {
  const bf16_t* base; int ld;
  DEV u32x4 operator()(int row, int k) const { return *(const u32x4*)(base + (size_t)row * ld + k); }
};
struct ALScaled {
  const bf16_t* base; int ld; const float* rs; const float* g;
  DEV u32x4 operator()(int row, int k) const {
    u32x4 v = *(const u32x4*)(base + (size_t)row * ld + k);
    float f[8]; unpack8(v, f);
    const float r = rs[row];
    const f32x4 g0 = *(const f32x4*)(g + k), g1 = *(const f32x4*)(g + k + 4);
    f[0] *= r * g0.x; f[1] *= r * g0.y; f[2] *= r * g0.z; f[3] *= r * g0.w;
    f[4] *= r * g1.x; f[5] *= r * g1.y; f[6] *= r * g1.z; f[7] *= r * g1.w;
    return pack8(f);
  }
};
struct ALF32 {
  const float* base; int ld;
  DEV u32x4 operator()(int row, int k) const {
    const f32x4 a = *(const f32x4*)(base + (size_t)row * ld + k);
    const f32x4 b = *(const f32x4*)(base + (size_t)row * ld + k + 4);
    u32x4 v; v.x = pack2(a.x, a.y); v.y = pack2(a.z, a.w); v.z = pack2(b.x, b.y); v.w = pack2(b.z, b.w); return v;
  }
};

template <int TN>
DEV void gemm_compute(const bf16_t* As, const bf16_t* Bs, f32x4 (&acc)[4][TN / 32], int wm, int wn, int l16, int quad) {
  constexpr int NF = TN / 32;
#pragma unroll
  for (int ks = 0; ks < 2; ks++) {
    bf16x8 a[4], b[NF];
#pragma unroll
    for (int mi = 0; mi < 4; mi++) a[mi] = *(const bf16x8*)(As + (wm * 64 + mi * 16 + l16) * 72 + ks * 32 + quad * 8);
#pragma unroll
    for (int ni = 0; ni < NF; ni++) b[ni] = *(const bf16x8*)(Bs + (wn * (TN / 2) + ni * 16 + l16) * 72 + ks * 32 + quad * 8);
#pragma unroll
    for (int mi = 0; mi < 4; mi++)
#pragma unroll
      for (int ni = 0; ni < NF; ni++) acc[mi][ni] = MFMA(a[mi], b[ni], acc[mi][ni]);
  }
}
template <int TN, class AL>
DEV void gemm_core(const AL& al, const bf16_t* __restrict__ Bt, int ldb, int K, f32x4 (&acc)[4][TN / 32], char* lds) {
  constexpr int BUF = (128 + TN) * 72;
  constexpr int NF = TN / 32;
  bf16_t* L0 = (bf16_t*)lds;
  bf16_t* L1 = L0 + BUF;
  const int tid = otid(), lane = tid & 63, wave = tid >> 6;
  const int wm = wave >> 1, wn = wave & 1, l16 = lane & 15, quad = lane >> 4;
  u32x4 a0[4], b0[NF], a1[4], b1[NF];
#define G_LOAD(RA, RB, KK) { _Pragma("unroll") for (int i = 0; i < 4; i++) { int it = tid + 256 * i; RA[i] = al(it >> 3, (KK) + (it & 7) * 8); } \
                             _Pragma("unroll") for (int i = 0; i < NF; i++) { int it = tid + 256 * i; RB[i] = *(const u32x4*)(Bt + (size_t)(it >> 3) * ldb + (KK) + (it & 7) * 8); } }
#define G_STORE(LB, RA, RB) { _Pragma("unroll") for (int i = 0; i < 4; i++) { int it = tid + 256 * i; *(u32x4*)((LB) + (it >> 3) * 72 + (it & 7) * 8) = RA[i]; } \
                              _Pragma("unroll") for (int i = 0; i < NF; i++) { int it = tid + 256 * i; *(u32x4*)((LB) + 128 * 72 + (it >> 3) * 72 + (it & 7) * 8) = RB[i]; } }
  G_LOAD(a0, b0, 0);
  G_LOAD(a1, b1, 64);
  __syncthreads();
  G_STORE(L0, a0, b0);
  __syncthreads();
  for (int k0 = 0; k0 + 128 < K; k0 += 128) {
    G_LOAD(a0, b0, k0 + 128);
    __builtin_amdgcn_sched_barrier(0);
    gemm_compute<TN>(L0, L0 + 128 * 72, acc, wm, wn, l16, quad);
    G_STORE(L1, a1, b1);
    __syncthreads();
    G_LOAD(a1, b1, k0 + 192);
    __builtin_amdgcn_sched_barrier(0);
    gemm_compute<TN>(L1, L1 + 128 * 72, acc, wm, wn, l16, quad);
    G_STORE(L0, a0, b0);
    __syncthreads();
  }
  gemm_compute<TN>(L0, L0 + 128 * 72, acc, wm, wn, l16, quad);
  G_STORE(L1, a1, b1);
  __syncthreads();
  gemm_compute<TN>(L1, L1 + 128 * 72, acc, wm, wn, l16, quad);
#undef G_LOAD
#undef G_STORE
}

template <int TN>
DEV void acc_to_lds(f32x4 (&acc)[4][TN / 32], float* Cs) {
  const int tid = otid(), lane = tid & 63, wave = tid >> 6;
  const int wm = wave >> 1, wn = wave & 1, l16 = lane & 15, quad = lane >> 4;
  __syncthreads();
#pragma unroll
  for (int mi = 0; mi < 4; mi++)
#pragma unroll
    for (int ni = 0; ni < TN / 32; ni++)
#pragma unroll
      for (int j = 0; j < 4; j++)
        Cs[(wm * 64 + mi * 16 + quad * 4 + j) * (TN + 4) + wn * (TN / 2) + ni * 16 + l16] = acc[mi][ni][j];
  __syncthreads();
}
template <int NF>
DEV void zero_acc(f32x4 (&acc)[4][NF]) {
#pragma unroll
  for (int mi = 0; mi < 4; mi++)
#pragma unroll
    for (int ni = 0; ni < NF; ni++) acc[mi][ni] = f32x4{0.f, 0.f, 0.f, 0.f};
}

DEV void transpose_tile(const float* __restrict__ src, int ld, int col0, int ncols, int K, bf16_t* dst, int nt, int kt, float* tile) {
  const int tid = otid();
  const int n = tid & 63, kk = tid >> 6, gn = nt * 64 + n;
#pragma unroll
  for (int i = 0; i < 16; i++) {
    int k = kk + 4 * i;
    float v = (gn < ncols) ? src[(size_t)(kt * 64 + k) * ld + col0 + gn] : 0.f;
    tile[k * 65 + n] = v;
  }
  __syncthreads();
#pragma unroll
  for (int i = 0; i < 2; i++) {
    int it = tid + 256 * i, nn = it >> 3, kg = it & 7;
    float f[8];
#pragma unroll
    for (int j = 0; j < 8; j++) f[j] = tile[(kg * 8 + j) * 65 + nn];
    *(u32x4*)(dst + (size_t)(nt * 64 + nn) * K + kt * 64 + kg * 8) = pack8(f);
  }
}
#define NCONV_TASKS 2760
DEV void convert_task(const Params& p, int l, int t, char* lds) {
  char* ws_ = p.ws; asm volatile("" : "+s"(ws_));
  float* tile = (float*)lds;
  char* ws = ws_;
  if (t < 1216) { transpose_tile(p.in[I_WIN] + (size_t)l * 1024 * DIN, DIN, 0, 4784, 1024, (bf16_t*)(ws + OFF_WTA), t % 76, t / 76, tile); return; }
  t -= 1216;
  if (t < 768) { transpose_tile(p.in[I_WIN] + (size_t)l * 1024 * DIN, DIN, 4784, 3072, 1024, (bf16_t*)(ws + OFF_WGL), t % 48, t / 48, tile); return; }
  t -= 768;
  if (t < 72) { transpose_tile(p.in[I_WUQ] + (size_t)l * 384 * 768, 768, 0, 768, 384, (bf16_t*)(ws + OFF_WUQ), t % 12, t / 12, tile); return; }
  t -= 72;
  if (t < 64) { transpose_tile(p.in[I_WUKV] + (size_t)l * 256 * 1024, 1024, 0, 1024, 256, (bf16_t*)(ws + OFF_WUKV), t % 16, t / 16, tile); return; }
  t -= 64;
  if (t < 384) {
    int n = t / 128, tt = t % 128;
    transpose_tile(p.in[I_WBR] + (size_t)(l * 3 + n) * 512 * 1024, 1024, 0, 1024, 512, (bf16_t*)(ws + OFF_WBR) + (size_t)n * 1024 * 512, tt % 16, tt / 16, tile);
    return;
  }
  t -= 384;
  transpose_tile(p.in[I_WO] + (size_t)l * 1024 * 1024, 1024, 0, 1024, 1024, (bf16_t*)(ws + OFF_WO), t % 16, t / 16, tile);
}
DEV void mod_task(const Params& p, int t, char* lds) {
  char* ws_ = p.ws; asm volatile("" : "+s"(ws_));
  const int tid = otid();
  const int l = t / 192, n0 = (t % 192) * 16;
  float* s = (float*)lds;
  float* red = (float*)(lds + 32768);
  for (int idx = tid; idx < 5120; idx += 256) {
    int r = idx >> 10, k = idx & 1023;
    float v = (r == 0) ? p.in[I_CCTX][k] : p.in[I_C][(r - 1) * 1024 + k];
    s[idx] = v * frcp(1.f + __expf(-v));
  }
  __syncthreads();
  const int col = tid & 15, ksl = tid >> 4;
  float acc[5] = {0.f, 0.f, 0.f, 0.f, 0.f};
  const float* w = p.in[I_WMOD] + (size_t)l * 1024 * 3072 + n0 + col;
#pragma unroll 16
  for (int k = ksl * 64; k < ksl * 64 + 64; k++) {
    float wv = w[(size_t)k * 3072];
#pragma unroll
    for (int r = 0; r < 5; r++) acc[r] += s[r * 1024 + k] * wv;
  }
#pragma unroll
  for (int r = 0; r < 5; r++) red[(ksl * 5 + r) * 16 + col] = acc[r];
  __syncthreads();
  float* mod = (float*)(ws_ + OFF_MOD);
  if (tid < 80) {
    int r = tid >> 4, c = tid & 15;
    float v = p.in[I_BMOD][l * 3072 + n0 + c];
#pragma unroll
    for (int q = 0; q < 16; q++) v += red[(q * 5 + r) * 16 + c];
    mod[(l * 5 + r) * 3072 + n0 + c] = v;
  }
}

DEV void norm_task(const Params& p, int l, int t) {
  char* ws_ = p.ws; asm volatile("" : "+s"(ws_));
  const int tid = otid(), lane = tid & 63, wave = tid >> 6;
  const float* mod = (const float*)(ws_ + OFF_MOD);
  bf16_t* H = (bf16_t*)(ws_ + OFF_H);
#pragma unroll
  for (int rr = 0; rr < 2; rr++) {
    const int row = t * 8 + wave * 2 + rr;
    const float* x = xrow_ptr(p, l, row);
    const float* mr = mod + (size_t)(l * 5 + modrow(row)) * 3072;
    f32x4 v[4];
    float ss = 0.f;
#pragma unroll
    for (int i = 0; i < 4; i++) { v[i] = *(const f32x4*)(x + lane * 4 + 256 * i); ss += v[i].x * v[i].x + v[i].y * v[i].y + v[i].z * v[i].z + v[i].w * v[i].w; }
#pragma unroll
    for (int o = 32; o >= 1; o >>= 1) ss += __shfl_xor(ss, o);
    const float rstd = __builtin_amdgcn_rsqf(ss * (1.f / 1024.f) + EPSF);
#pragma unroll
    for (int i = 0; i < 4; i++) {
      const int col = lane * 4 + 256 * i;
      const f32x4 g = *(const f32x4*)(p.in[I_NORMG] + l * 1024 + col);
      const f32x4 sh = *(const f32x4*)(mr + col);
      const f32x4 sc = *(const f32x4*)(mr + 1024 + col);
      float a = v[i].x * rstd * g.x * (1.f + sc.x) + sh.x;
      float b = v[i].y * rstd * g.y * (1.f + sc.y) + sh.y;
      float c = v[i].z * rstd * g.z * (1.f + sc.z) + sh.z;
      float d = v[i].w * rstd * g.w * (1.f + sc.w) + sh.w;
      *(u32x2*)(H + (size_t)row * 1024 + col) = pack4(a, b, c, d);
    }
  }
}

DEV void projA_task(const Params& p, int l, int t, char* lds) {
  char* ws_ = p.ws; asm volatile("" : "+s"(ws_));
  const int tid = otid();
  const int nt = t / 64, mt = t % 64;
  f32x4 acc[4][4]; zero_acc<4>(acc);
  ALPlain al{(const bf16_t*)(ws_ + OFF_H) + (size_t)mt * 128 * 1024, 1024};
  gemm_core<128>(al, (const bf16_t*)(ws_ + OFF_WTA) + (size_t)nt * 128 * 1024, 1024, 1024, acc, lds);
  float* Cs = (float*)lds;
  acc_to_lds<128>(acc, Cs);
  bf16_t* P1 = (bf16_t*)(ws_ + OFF_P1);
  bf16_t* P2 = (bf16_t*)(ws_ + OFF_P2);
  float* GAB = (float*)(ws_ + OFF_GAB);
#pragma unroll
  for (int i = 0; i < 8; i++) {
    const int it = tid + 256 * i, r = it >> 4, c8 = it & 15;
    const int n = nt * 128 + c8 * 8;
    if (n >= 4784) continue;
    const int row = mt * 128 + r;
    float f[8];
    const f32x4 a = *(const f32x4*)(Cs + r * 132 + c8 * 8);
    const f32x4 b = *(const f32x4*)(Cs + r * 132 + c8 * 8 + 4);
    f[0] = a.x; f[1] = a.y; f[2] = a.z; f[3] = a.w; f[4] = b.x; f[5] = b.y; f[6] = b.z; f[7] = b.w;
    if (n >= 2720 && n < 2736) {
      *(f32x4*)(GAB + (size_t)row * 16 + (n - 2720)) = a;
      *(f32x4*)(GAB + (size_t)row * 16 + (n - 2720) + 4) = b;
      continue;
    }
    if (n >= 640 && n < 672 && row < 4096) {
      float* o = p.out + OUT_KROPE + ((size_t)((row >> 8) * 2 + l) * 256 + (row & 255)) * 32 + (n - 640);
      *(f32x4*)o = a; *(f32x4*)(o + 4) = b;
    }
    bf16_t* dst;
    if (n < 672) dst = P1 + (size_t)row * P1W + n;
    else if (n < 1184) dst = P2 + (size_t)row * P2W + (n - 672);
    else if (n < 2720) dst = P1 + (size_t)row * P1W + 672 + (n - 1184);
    else if (n < 3248) dst = P2 + (size_t)row * P2W + 512 + (n - 2736);
    else if (n < 3760) dst = P1 + (size_t)row * P1W + 2208 + (n - 3248);
    else if (n < 4272) dst = P1 + (size_t)row * P1W + 2720 + (n - 3760);
    else dst = P2 + (size_t)row * P2W + 1024 + (n - 4272);
    *(u32x4*)dst = pack8(f);
  }
}

DEV void rope32(float* r, int prow, int pcol) {
  const float inv[8] = {1.f, 0.31622776601683794f, 0.1f, 0.031622776601683794f, 0.01f, 0.0031622776601683794f, 0.001f, 0.00031622776601683794f};
#pragma unroll
  for (int i = 0; i < 8; i++) {
    float a1 = (float)prow * inv[i], a2 = (float)pcol * inv[i];
    float c1 = __cosf(a1), s1 = __sinf(a1), c2 = __cosf(a2), s2 = __sinf(a2);
    float x1 = r[i], x2 = r[8 + i];
    r[i] = x1 * c1 - x2 * s1; r[8 + i] = x1 * s1 + x2 * c1;
    float y1 = r[16 + i], y2 = r[24 + i];
    r[16 + i] = y1 * c2 - y2 * s2; r[24 + i] = y1 * s2 + y2 * c2;
  }
}
DEV void finish_qk(float* v  , int half, const float* normw  , bool do_rope, int pos, float scale, bf16_t* dst  ) {
  float ss = 0.f;
#pragma unroll
  for (int i = 0; i < 48; i++) ss += v[i] * v[i];
  ss += __shfl_xor(ss, 1);
  const float rstd = __builtin_amdgcn_rsqf(ss * (1.f / 96.f) + EPSF);
#pragma unroll
  for (int i = 0; i < 12; i++) {
    const f32x4 w = *(const f32x4*)(normw + half * 48 + i * 4);
    v[i * 4] *= rstd * w.x; v[i * 4 + 1] *= rstd * w.y; v[i * 4 + 2] *= rstd * w.z; v[i * 4 + 3] *= rstd * w.w;
  }
  if (do_rope && half == 1) rope32(v + 16, pos >> 6, pos & 63);
#pragma unroll
  for (int i = 0; i < 6; i++) {
    float f[8];
#pragma unroll
    for (int j = 0; j < 8; j++) f[j] = v[i * 8 + j] * scale;
    *(u32x4*)(dst + half * 48 + i * 8) = pack8(f);
  }
}

#define QSCALE 0.14724306f
DEV void q_task(const Params& p, int l, int t, char* lds) {
  char* ws_ = p.ws; asm volatile("" : "+s"(ws_));
  const int tid = otid();
  const int mt = t & 63, h = t >> 6;
  const bf16_t* P1 = (const bf16_t*)(ws_ + OFF_P1);
  float* rs = (float*)(lds + LDS_SMALL);
  {
    const int row = tid >> 1, half = tid & 1;
    const bf16_t* src = P1 + (size_t)(mt * 128 + row) * P1W + half * 192;
    float ss = 0.f;
#pragma unroll 12
    for (int i = 0; i < 24; i++) { float f[8]; unpack8(*(const u32x4*)(src + i * 8), f);
#pragma unroll
      for (int j = 0; j < 8; j++) ss += f[j] * f[j]; }
    ss += __shfl_xor(ss, 1);
    if (!half) rs[row] = __builtin_amdgcn_rsqf(ss * (1.f / 384.f) + EPSF);
  }
  __syncthreads();
  f32x4 acc[4][3]; zero_acc<3>(acc);
  ALScaled al{P1 + (size_t)mt * 128 * P1W, P1W, rs, p.in[I_QAN] + l * 384};
  gemm_core<96>(al, (const bf16_t*)(ws_ + OFF_WUQ) + (size_t)h * 96 * 384, 384, 384, acc, lds);
  float* Cs = (float*)lds;
  acc_to_lds<96>(acc, Cs);
  const int row = tid >> 1, half = tid & 1, grow = mt * 128 + row;
  float v[48];
#pragma unroll
  for (int i = 0; i < 48; i++) v[i] = Cs[row * 100 + half * 48 + i];
  finish_qk(v, half, p.in[I_QN] + l * 96, grow >= 4096, (grow - 4096) & 1023, QSCALE,
            (bf16_t*)(ws_ + OFF_Q) + ((size_t)grow * 8 + h) * 96);
}

DEV void kv_task(const Params& p, int l, int t, char* lds) {
  char* ws_ = p.ws; asm volatile("" : "+s"(ws_));
  const int tid = otid();
  const int h = t / 72, mt = t % 72;
  const bf16_t* P1 = (const bf16_t*)(ws_ + OFF_P1);
  float* rs = (float*)(lds + LDS_SMALL);
  f32x4 acc[4][4]; zero_acc<4>(acc);
  const bf16_t* Bt = (const bf16_t*)(ws_ + OFF_WUKV) + (size_t)h * 128 * 256;
  if (mt < 64) {
    {
      const int row = tid >> 1, half = tid & 1;
      const bf16_t* src = P1 + (size_t)(mt * 128 + row) * P1W + 384 + half * 128;
      float ss = 0.f;
#pragma unroll
      for (int i = 0; i < 16; i++) { float f[8]; unpack8(*(const u32x4*)(src + i * 8), f);
#pragma unroll
        for (int j = 0; j < 8; j++) ss += f[j] * f[j]; }
      ss += __shfl_xor(ss, 1);
      if (!half) rs[row] = __builtin_amdgcn_rsqf(ss * (1.f / 256.f) + EPSF);
    }
    __syncthreads();
    if (h == 0 && mt < 32) {
#pragma unroll 8
      for (int it = tid; it < 128 * 32; it += 256) {
        const int r = it >> 5, c8 = it & 31, row = mt * 128 + r;
        float f[8]; unpack8(*(const u32x4*)(P1 + (size_t)row * P1W + 384 + c8 * 8), f);
        const float rr = rs[r];
        const float* g = p.in[I_KVAN] + l * 256 + c8 * 8;
        float* o = p.out + OUT_CKV + ((size_t)((row >> 8) * 2 + l) * 256 + (row & 255)) * 256 + c8 * 8;
        *(f32x4*)o = f32x4{f[0] * rr * g[0], f[1] * rr * g[1], f[2] * rr * g[2], f[3] * rr * g[3]};
        *(f32x4*)(o + 4) = f32x4{f[4] * rr * g[4], f[5] * rr * g[5], f[6] * rr * g[6], f[7] * rr * g[7]};
      }
    }
    ALScaled al{P1 + (size_t)mt * 128 * P1W + 384, P1W, rs, p.in[I_KVAN] + l * 256};
    gemm_core<128>(al, Bt, 256, 256, acc, lds);
  } else {
    const int b = (mt - 64) >> 1, p0 = ((mt - 64) & 1) * 128;
    ALF32 al{p.in[I_CCKV] + ((size_t)(b * 2 + l) * 256 + p0) * 256, 256};
    gemm_core<128>(al, Bt, 256, 256, acc, lds);
  }
  float* Cs = (float*)lds;
  acc_to_lds<128>(acc, Cs);
  {
    const int row = tid >> 1, half = tid & 1;
    float v[48];
    int krow; bool do_rope = false; int pos = 0;
    if (mt < 64) {
      const int grow = mt * 128 + row;
      krow = grow; do_rope = grow >= 4096; pos = (grow - 4096) & 1023;
      if (half == 0) {
#pragma unroll
        for (int i = 0; i < 48; i++) v[i] = Cs[row * 132 + i];
      } else {
#pragma unroll
        for (int i = 0; i < 16; i++) v[i] = Cs[row * 132 + 48 + i];
        const bf16_t* kr = P1 + (size_t)grow * P1W + 640;
#pragma unroll
        for (int i = 0; i < 4; i++) { float f[8]; unpack8(*(const u32x4*)(kr + i * 8), f);
#pragma unroll
          for (int j = 0; j < 8; j++) v[16 + i * 8 + j] = f[j]; }
      }
    } else {
      const int b = (mt - 64) >> 1, pp = ((mt - 64) & 1) * 128 + row;
      krow = 8192 + b * 256 + pp;
      if (half == 0) {
#pragma unroll
        for (int i = 0; i < 48; i++) v[i] = Cs[row * 132 + i];
      } else {
#pragma unroll
        for (int i = 0; i < 16; i++) v[i] = Cs[row * 132 + 48 + i];
        const float* kr = p.in[I_CKR] + ((size_t)(b * 2 + l) * 256 + pp) * 32;
#pragma unroll
        for (int i = 0; i < 8; i++) { const f32x4 w = *(const f32x4*)(kr + i * 4); v[16 + i * 4] = w.x; v[17 + i * 4] = w.y; v[18 + i * 4] = w.z; v[19 + i * 4] = w.w; }
      }
    }
    finish_qk(v, half, p.in[I_KN] + l * 96, do_rope, pos, 1.f, (bf16_t*)(ws_ + OFF_K) + ((size_t)krow * 8 + h) * 96);
  }
  {
    size_t vbase; int Tk, key0;
    if (mt < 32) { const int b = mt >> 1; Tk = 256; key0 = (mt & 1) * 128; vbase = (size_t)(b * 8 + h) * 64 * 256; }
    else if (mt < 64) { const int b = (mt - 32) >> 3; Tk = 1280; key0 = 256 + ((mt - 32) & 7) * 128; vbase = VT_LAT_EL + (size_t)(b * 8 + h) * 64 * 1280; }
    else { const int b = (mt - 64) >> 1; Tk = 1280; key0 = ((mt - 64) & 1) * 128; vbase = VT_LAT_EL + (size_t)(b * 8 + h) * 64 * 1280; }
    bf16_t* Vt = (bf16_t*)(ws_ + OFF_VT) + vbase;
#pragma unroll
    for (int i = 0; i < 4; i++) {
      const int it = tid + 256 * i, dv = it & 63, kg = it >> 6;
      float f[8];
#pragma unroll
      for (int j = 0; j < 8; j++) f[j] = Cs[(kg * 8 + j) * 132 + 64 + dv];
      *(u32x4*)(Vt + (size_t)dv * Tk + key0 + kg * 8) = pack8(f);
    }
  }
}

DEV void conv_pass(const Params& p, int l, int seg, int h, int row0, int sbeg, int send, float* F, bf16_t* Vtile) {
  char* ws_ = p.ws; asm volatile("" : "+s"(ws_));
  const int tid = otid(), c8 = tid & 15, tg = tid >> 4;
  const bf16_t* src = (const bf16_t*)(ws_ + OFF_P1) + 672 + seg * 512 + h * 128 + c8 * 8;
  const float* cwp = p.in[I_CONVW] + (size_t)l * 5 * 1536 + seg * 512 + h * 128 + c8 * 8;
  float cw[5][8];
#pragma unroll
  for (int j = 0; j < 5; j++) {
    const f32x4 a = *(const f32x4*)(cwp + j * 1536), b = *(const f32x4*)(cwp + j * 1536 + 4);
    cw[j][0] = a.x; cw[j][1] = a.y; cw[j][2] = a.z; cw[j][3] = a.w; cw[j][4] = b.x; cw[j][5] = b.y; cw[j][6] = b.z; cw[j][7] = b.w;
  }
  const int t0 = row0 + tg * 4;
  u32x4 raw[8];
#pragma unroll
  for (int r = 0; r < 8; r++) {
    const int row = t0 - 2 + r;
    raw[r] = (row >= sbeg && row < send) ? *(const u32x4*)(src + (size_t)row * P1W) : u32x4{0u, 0u, 0u, 0u};
  }
  float acc[4][8];
#pragma unroll
  for (int tt = 0; tt < 4; tt++)
#pragma unroll
    for (int c = 0; c < 8; c++) acc[tt][c] = 0.f;
#pragma unroll
  for (int r = 0; r < 8; r++) {
    float f[8]; unpack8(raw[r], f);
#pragma unroll
    for (int tt = 0; tt < 4; tt++) {
      const int j = r - tt;
      if (j >= 0 && j < 5) {
#pragma unroll
        for (int c = 0; c < 8; c++) acc[tt][c] += cw[j][c] * f[c];
      }
    }
  }
#pragma unroll
  for (int tt = 0; tt < 4; tt++) {
    float y[8];
#pragma unroll
    for (int c = 0; c < 8; c++) y[c] = siluf(acc[tt][c]);
    if (F) {
#pragma unroll
      for (int c = 0; c < 8; c++) F[(tg * 4 + tt) * 129 + c8 * 8 + c] = y[c];
    } else {
      *(u32x4*)(Vtile + (tg * 4 + tt) * 136 + c8 * 8) = pack8(y);
    }
  }
}
DEV void l2norm_rows(const float* F, bf16_t* T) {
  const int tid = otid(), row = tid >> 2, part = tid & 3;
  float ss = 0.f;
#pragma unroll
  for (int i = 0; i < 32; i++) { float x = F[row * 129 + part * 32 + i]; ss += x * x; }
  ss += __shfl_xor(ss, 1); ss += __shfl_xor(ss, 2);
  const float inv = __builtin_amdgcn_rsqf(ss + EPSF);
#pragma unroll
  for (int i = 0; i < 32; i++) T[row * 136 + part * 32 + i] = f2bf(F[row * 129 + part * 32 + i] * inv);
}
DEV void mm64(const bf16_t* At, const bf16_t* Bt_, float* Out, int wave, int l16, int quad) {
  f32x4 acc[4];
#pragma unroll
  for (int ni = 0; ni < 4; ni++) acc[ni] = f32x4{0.f, 0.f, 0.f, 0.f};
#pragma unroll
  for (int ks = 0; ks < 4; ks++) {
    bf16x8 a = *(const bf16x8*)(At + (wave * 16 + l16) * 136 + ks * 32 + quad * 8);
#pragma unroll
    for (int ni = 0; ni < 4; ni++) {
      bf16x8 b = *(const bf16x8*)(Bt_ + (ni * 16 + l16) * 136 + ks * 32 + quad * 8);
      acc[ni] = MFMA(a, b, acc[ni]);
    }
  }
#pragma unroll
  for (int ni = 0; ni < 4; ni++)
#pragma unroll
    for (int j = 0; j < 4; j++) Out[(wave * 16 + quad * 4 + j) * 65 + ni * 16 + l16] = acc[ni][j];
}
DEV void gdn_prep_task(const Params& p, int l, int t, char* lds) {
  char* ws_ = p.ws; asm volatile("" : "+s"(ws_));
  const int tid = otid(), lane = tid & 63, wave = tid >> 6, l16 = lane & 15, quad = lane >> 4;
  const int chunk = t >> 2, h = t & 3, row0 = chunk * 64;
  int sbeg, send;
  if (row0 < 4096) { sbeg = row0 & ~255; send = sbeg + 256; } else { sbeg = 4096 + ((row0 - 4096) & ~1023); send = sbeg + 1024; }
  bf16_t* Kt = (bf16_t*)lds;
  bf16_t* Qt = Kt + 64 * 136;
  float* F = (float*)(lds + 34816);
  float* G = F;
  float* Pm = (float*)(lds + 34816 + 17408);
  float* Am = Pm;
  float* gcs = (float*)(lds + LDS_SMALL);
  float* betas = gcs + 128;
  const float* GAB = (const float*)(ws_ + OFF_GAB);
  if (tid < 128) {
    const int dir = tid >> 6, ip = tid & 63, tok = dir ? 63 - ip : ip, row = row0 + tok;
    const float ga = GAB[(size_t)row * 16 + dir * 4 + h], gb = GAB[(size_t)row * 16 + 8 + dir * 4 + h];
    const float a = __expf(p.in[I_ALOG][(l * 2 + dir) * 4 + h]);
    const float x = ga + p.in[I_DTB][(l * 2 + dir) * 4 + h];
    const float ex = __expf(fminf(x, 20.f));
    const float sp = x > 20.f ? x : (ex < 0.01f ? ex * (1.f - ex * (0.5f - ex * (1.f / 3.f))) : __logf(1.f + ex));
    float g = -a * sp;
#pragma unroll
    for (int off = 1; off < 64; off <<= 1) { float v = __shfl_up(g, off); if (ip >= off) g += v; }
    gcs[dir * 64 + ip] = g;
    betas[dir * 64 + ip] = frcp(1.f + __expf(-gb));
  }
  conv_pass(p, l, 1, h, row0, sbeg, send, F, nullptr);
  __syncthreads();
  l2norm_rows(F, Kt);
  __syncthreads();
  conv_pass(p, l, 0, h, row0, sbeg, send, F, nullptr);
  __syncthreads();
  l2norm_rows(F, Qt);
  __syncthreads();
  mm64(Qt, Kt, Pm, wave, l16, quad);
  bf16_t* recbase = (bf16_t*)(ws_ + OFF_GDN) + (size_t)(chunk * 4 + h) * 2 * REC_EL;
#pragma unroll 1
  for (int dir = 0; dir < 2; dir++) {
    bf16_t* rec = recbase + (size_t)dir * REC_EL;
    const float* gc = gcs + dir * 64;
    const float gl = gc[63];
#pragma unroll
    for (int i = 0; i < 4; i++) {
      const int it = tid + 256 * i, ip = it >> 4, c8 = it & 15, tok = dir ? 63 - ip : ip;
      const float sc = 0.08838834764831845f * __expf(gc[ip]);
      float f[8]; unpack8(*(const u32x4*)(Qt + tok * 136 + c8 * 8), f);
#pragma unroll
      for (int j = 0; j < 8; j++) f[j] *= sc;
      *(u32x4*)(rec + 8192 + ip * 128 + c8 * 8) = pack8(f);
    }
#pragma unroll
    for (int i = 0; i < 4; i++) {
      const int it = tid + 256 * i, d = it & 127, ig = it >> 7;
      float f[8];
#pragma unroll
      for (int j = 0; j < 8; j++) { const int ip = ig * 8 + j, tok = dir ? 63 - ip : ip; f[j] = bf2f(Kt[tok * 136 + d]) * __expf(gl - gc[ip]); }
      *(u32x4*)(rec + 20480 + d * 64 + ig * 8) = pack8(f);
    }
    if (tid == 0) ((float*)(ws_ + OFF_EGL))[(chunk * 4 + h) * 2 + dir] = __expf(gl);
  }
  __syncthreads();
  conv_pass(p, l, 2, h, row0, sbeg, send, nullptr, Qt);
#pragma unroll 1
  for (int dir = 0; dir < 2; dir++) {
    bf16_t* rec = recbase + (size_t)dir * REC_EL;
    const float* gc = gcs + dir * 64;
#pragma unroll
    for (int i = 0; i < 2; i++) {
      const int it = tid + 256 * i, ip = it >> 3, j8 = it & 7, ti = dir ? 63 - ip : ip;
      float f[8];
#pragma unroll
      for (int j = 0; j < 8; j++) {
        const int jp = j8 * 8 + j, tj = dir ? 63 - jp : jp;
        const float e = __expf(fminf(gc[ip] - gc[jp], 0.f));
        f[j] = (ip >= jp) ? Pm[ti * 65 + tj] * 0.08838834764831845f * e : 0.f;
      }
      *(u32x4*)(rec + 16384 + ip * 64 + j8 * 8) = pack8(f);
    }
  }
  __syncthreads();
  const bf16_t* Vtile = Qt;
  float* T = G;
#pragma unroll 1
  for (int dir = 0; dir < 2; dir++) {
    bf16_t* rec = recbase + (size_t)dir * REC_EL;
    const float* gc = gcs + dir * 64;
    const float* be = betas + dir * 64;
    mm64(Kt, Kt, G, wave, l16, quad);
    __syncthreads();
#pragma unroll 2
    for (int i = 0; i < 16; i++) {
      const int it = tid + 256 * i, ip = it >> 6, jp = it & 63;
      const int ti = dir ? 63 - ip : ip, tj = dir ? 63 - jp : jp;
      const float e = __expf(fminf(gc[ip] - gc[jp], 0.f));
      Am[ip * 68 + jp] = (ip > jp) ? be[ip] * G[ti * 65 + tj] * e : 0.f;
    }
    __syncthreads();
    {
      const int cl = lane >> 2, q = lane & 3, c = wave * 16 + cl;
      float r[16];
#pragma unroll
      for (int m = 0; m < 16; m++) r[m] = (q + 4 * m == c) ? 1.f : 0.f;
#pragma unroll
      for (int j = 0; j < 63; j++) {
        const int mj = j >> 2;
        float t;
        switch (j & 3) {
          case 0: t = __int_as_float(__builtin_amdgcn_update_dpp(0, __float_as_int(r[mj]), 0x00, 0xF, 0xF, true)); break;
          case 1: t = __int_as_float(__builtin_amdgcn_update_dpp(0, __float_as_int(r[mj]), 0x55, 0xF, 0xF, true)); break;
          case 2: t = __int_as_float(__builtin_amdgcn_update_dpp(0, __float_as_int(r[mj]), 0xAA, 0xF, 0xF, true)); break;
          default: t = __int_as_float(__builtin_amdgcn_update_dpp(0, __float_as_int(r[mj]), 0xFF, 0xF, 0xF, true)); break;
        }
#pragma unroll
        for (int m = mj; m < 16; m++) r[m] -= Am[(q + 4 * m) * 68 + j] * t;
        if ((j & 7) == 7) asm volatile("" ::: "memory");
      }
#pragma unroll
      for (int m = 0; m < 16; m++) T[(q + 4 * m) * 68 + c] = r[m];
    }
    __syncthreads();
#pragma unroll 1
    for (int which = 0; which < 2; which++) {
      const bf16_t* srcT = which ? Kt : Vtile;
      f32x4 ac[4][2];
      zero_acc<2>(ac);
#pragma unroll
      for (int ks = 0; ks < 2; ks++) {
        float cs[8];
        unsigned short e[2][8];
#pragma unroll
        for (int s = 0; s < 8; s++) {
          const int j = ks * 32 + quad * 8 + s, tok = dir ? 63 - j : j;
          cs[s] = which ? be[j] * __expf(gc[j]) : be[j];
#pragma unroll
          for (int nf = 0; nf < 2; nf++) e[nf][s] = srcT[tok * 136 + wave * 32 + nf * 16 + l16];
        }
        bf16x8 bfr[2];
#pragma unroll
        for (int nf = 0; nf < 2; nf++) {
          u32x4 v;
          v.x = e[nf][0] | ((unsigned)e[nf][1] << 16); v.y = e[nf][2] | ((unsigned)e[nf][3] << 16);
          v.z = e[nf][4] | ((unsigned)e[nf][5] << 16); v.w = e[nf][6] | ((unsigned)e[nf][7] << 16);
          bfr[nf] = as_frag(v);
        }
#pragma unroll
        for (int mi = 0; mi < 4; mi++) {
          const float* tr = T + (mi * 16 + l16) * 68 + ks * 32 + quad * 8;
          const f32x4 t0 = *(const f32x4*)tr, t1 = *(const f32x4*)(tr + 4);
          const float tv[8] = {t0.x, t0.y, t0.z, t0.w, t1.x, t1.y, t1.z, t1.w};
          float a[8], hi[8], lo[8];
#pragma unroll
          for (int s = 0; s < 8; s++) a[s] = tv[s] * cs[s];
          const u32x4 ph = pack8(a);
          unpack8(ph, hi);
#pragma unroll
          for (int s = 0; s < 8; s++) lo[s] = a[s] - hi[s];
          const bf16x8 fh = as_frag(ph), fl = as_frag(pack8(lo));
#pragma unroll
          for (int nf = 0; nf < 2; nf++) { ac[mi][nf] = MFMA(fh, bfr[nf], ac[mi][nf]); ac[mi][nf] = MFMA(fl, bfr[nf], ac[mi][nf]); }
        }
      }
      int qs = quad, ls = l16;
      asm volatile("" : "+v"(qs), "+v"(ls));
      bf16_t* dst = rec + (which ? 0 : 28672);
      const float sg = which ? -1.f : 1.f;
#pragma unroll
      for (int mi = 0; mi < 4; mi++)
#pragma unroll
        for (int nf = 0; nf < 2; nf++)
#pragma unroll
          for (int j = 0; j < 4; j++) {
            const int ip = mi * 16 + qs * 4 + j, col = wave * 32 + nf * 16 + ls;
            dst[ip * 128 + col] = f2bf(sg * ac[mi][nf][j]);
          }
    }
    __syncthreads();
  }
}

DEV void cmlp_task(const Params& p, int l, int t, char* lds) {
  char* ws_ = p.ws; asm volatile("" : "+s"(ws_));
  const int tid = otid(), lane = tid & 63, wave = tid >> 6, l16 = lane & 15, quad = lane >> 4;
  const int wm = wave >> 1, wn = wave & 1;
  const int c = t >> 2, g = t & 3, r0 = c * 128;
  const bf16_t* P1 = (const bf16_t*)(ws_ + OFF_P1);
  const bf16_t* P2 = (const bf16_t*)(ws_ + OFF_P2);
  bf16_t* BR = (bf16_t*)(ws_ + OFF_BR);
  bf16_t* VnT = (bf16_t*)lds;
  bf16_t* Ws = VnT + 128 * 136;
  float* mu = (float*)(lds + LDS_SMALL);
  float* rstd = mu + 128;
  {
    const int row = tid >> 1, half = tid & 1;
    const bf16_t* src = P1 + (size_t)(r0 + row) * P1W + 2720 + half * 256;
    float s = 0.f, ss = 0.f;
#pragma unroll 16
    for (int i = 0; i < 32; i++) { float f[8]; unpack8(*(const u32x4*)(src + i * 8), f);
#pragma unroll
      for (int j = 0; j < 8; j++) { float y = geluf(f[j]); s += y; ss += y * y; } }
    s += __shfl_xor(s, 1); ss += __shfl_xor(ss, 1);
    const float mean = s * (1.f / 512.f), var = fmaxf(ss * (1.f / 512.f) - mean * mean, 0.f);
    if (!half) { mu[row] = mean; rstd[row] = __builtin_amdgcn_rsqf(var + EPSF); }
  }
  __syncthreads();
#pragma unroll
  for (int i = 0; i < 8; i++) {
    const int it = tid + 256 * i, q = it >> 4, c8 = it & 15;
    float f[8]; unpack8(*(const u32x4*)(P1 + (size_t)(r0 + q) * P1W + 2720 + g * 128 + c8 * 8), f);
    const float m = mu[q], rs = rstd[q];
#pragma unroll
    for (int j = 0; j < 8; j++) {
      const int cc = c8 * 8 + j;
      const float val = (geluf(f[j]) - m) * rs * p.in[I_LNG][l * 512 + g * 128 + cc] + p.in[I_LNB][l * 512 + g * 128 + cc];
      VnT[cc * 136 + q] = f2bf(val);
    }
  }
#pragma unroll
  for (int i = 0; i < 16; i++) {
    const int it = tid + 256 * i, pp = it >> 5, q4 = it & 31;
    const f32x4 w = *(const f32x4*)(p.in[I_WS] + ((size_t)(l * 4 + g) * 128 + pp) * 128 + q4 * 4);
    *(u32x2*)(Ws + pp * 136 + q4 * 4) = pack4(w.x, w.y, w.z, w.w);
  }
  __syncthreads();
  f32x4 acc[4][4]; zero_acc<4>(acc);
#pragma unroll
  for (int ks = 0; ks < 4; ks++) {
    bf16x8 a[4], b[4];
#pragma unroll
    for (int mi = 0; mi < 4; mi++) a[mi] = *(const bf16x8*)(Ws + (wm * 64 + mi * 16 + l16) * 136 + ks * 32 + quad * 8);
#pragma unroll
    for (int ni = 0; ni < 4; ni++) b[ni] = *(const bf16x8*)(VnT + (wn * 64 + ni * 16 + l16) * 136 + ks * 32 + quad * 8);
#pragma unroll
    for (int mi = 0; mi < 4; mi++)
#pragma unroll
      for (int ni = 0; ni < 4; ni++) acc[mi][ni] = MFMA(a[mi], b[ni], acc[mi][ni]);
  }
  float* Cs = (float*)lds;
  __syncthreads();
#pragma unroll
  for (int mi = 0; mi < 4; mi++)
#pragma unroll
    for (int j = 0; j < 4; j++) {
      const int pp = wm * 64 + mi * 16 + quad * 4 + j;
      const float bias = p.in[I_BS][(l * 4 + g) * 128 + pp];
#pragma unroll
      for (int ni = 0; ni < 4; ni++) Cs[pp * 132 + wn * 64 + ni * 16 + l16] = acc[mi][ni][j] + bias;
    }
  __syncthreads();
  u32x4 uu[8], zz[8];
#pragma unroll
  for (int i = 0; i < 8; i++) {
    const int it = tid + 256 * i, r = it >> 4, c8 = it & 15;
    const size_t row = (size_t)(r0 + r);
    uu[i] = *(const u32x4*)(P1 + row * P1W + 2208 + g * 128 + c8 * 8);
    zz[i] = *(const u32x4*)(P2 + row * P2W + 1024 + g * 128 + c8 * 8);
  }
#pragma unroll
  for (int i = 0; i < 8; i++) {
    const int it = tid + 256 * i, r = it >> 4, c8 = it & 15;
    float u[8], z[8], o[8];
    unpack8(uu[i], u); unpack8(zz[i], z);
    const f32x4 s0 = *(const f32x4*)(Cs + r * 132 + c8 * 8), s1 = *(const f32x4*)(Cs + r * 132 + c8 * 8 + 4);
    const float sv[8] = {s0.x, s0.y, s0.z, s0.w, s1.x, s1.y, s1.z, s1.w};
#pragma unroll
    for (int j = 0; j < 8; j++) o[j] = geluf(u[j]) * sv[j] * siluf(z[j]);
    *(u32x4*)(BR + (size_t)(r0 + r) * BRW + 1024 + g * 128 + c8 * 8) = pack8(o);
  }
}

DEV void attn_task(const Params& p, int l, int t, char* lds) {
  char* ws_ = p.ws; asm volatile("" : "+s"(ws_));
  const int tid = otid(), lane = tid & 63, wave = tid >> 6, l16 = lane & 15, quad = lane >> 4;
  int b, h, qrow0, nkt, Tk; size_t vtb;
  const bool lat = t < 256;
  if (lat) { b = t >> 6; h = (t >> 3) & 7; const int qb = t & 7; qrow0 = 4096 + b * 1024 + qb * 128; nkt = 20; Tk = 1280; vtb = VT_LAT_EL + (size_t)(b * 8 + h) * 64 * 1280; }
  else { const int tt = t - 256; b = tt >> 4; h = (tt >> 1) & 7; const int qb = tt & 1; qrow0 = b * 256 + qb * 128; nkt = 4; Tk = 256; vtb = (size_t)(b * 8 + h) * 64 * 256; }
  const bf16_t* Qg = (const bf16_t*)(ws_ + OFF_Q);
  const bf16_t* Kg = (const bf16_t*)(ws_ + OFF_K);
  const bf16_t* Vg = (const bf16_t*)(ws_ + OFF_VT) + vtb;
  bf16_t* Qs = (bf16_t*)lds;
  bf16_t* Ks = Qs + 128 * 104;
  bf16_t* Vs = Ks + 64 * 104;
#pragma unroll
  for (int i = 0; i < 6; i++) {
    const int it = tid + 256 * i, r = it / 12, cc = it % 12;
    *(u32x4*)(Qs + r * 104 + cc * 8) = *(const u32x4*)(Qg + ((size_t)(qrow0 + r) * 8 + h) * 96 + cc * 8);
  }
  __syncthreads();
  bf16x8 qf[2][3];
#pragma unroll
  for (int ni = 0; ni < 2; ni++)
#pragma unroll
    for (int ks = 0; ks < 3; ks++) qf[ni][ks] = *(const bf16x8*)(Qs + (wave * 32 + ni * 16 + l16) * 104 + ks * 32 + quad * 8);
  f32x4 o[4][2];
#pragma unroll
  for (int di = 0; di < 4; di++) { o[di][0] = f32x4{0.f, 0.f, 0.f, 0.f}; o[di][1] = f32x4{0.f, 0.f, 0.f, 0.f}; }
  float mrun[2] = {-1e30f, -1e30f}, lsum[2] = {0.f, 0.f};
  u32x4 pk[3], pv[2];
  {
    const int krow0 = lat ? (8192 + b * 256) : (b * 256);
#pragma unroll
    for (int i = 0; i < 3; i++) { const int it = tid + 256 * i, r = it / 12, cc = it % 12; pk[i] = *(const u32x4*)(Kg + ((size_t)(krow0 + r) * 8 + h) * 96 + cc * 8); }
#pragma unroll
    for (int i = 0; i < 2; i++) { const int it = tid + 256 * i, dv = it >> 3, kg = it & 7; pv[i] = *(const u32x4*)(Vg + (size_t)dv * Tk + kg * 8); }
  }
  for (int kt = 0; kt < nkt; kt++) {
    __syncthreads();
#pragma unroll
    for (int i = 0; i < 3; i++) { const int it = tid + 256 * i, r = it / 12, cc = it % 12; *(u32x4*)(Ks + r * 104 + cc * 8) = pk[i]; }
#pragma unroll
    for (int i = 0; i < 2; i++) { const int it = tid + 256 * i, dv = it >> 3, kg = it & 7; *(u32x4*)(Vs + dv * 72 + kg * 8) = pv[i]; }
    __syncthreads();
    if (kt + 1 < nkt) {
      const int kn = kt + 1;
      int krow0;
      if (lat) krow0 = (kn < 4) ? (8192 + b * 256 + kn * 64) : (4096 + b * 1024 + (kn - 4) * 64);
      else krow0 = b * 256 + kn * 64;
#pragma unroll
      for (int i = 0; i < 3; i++) { const int it = tid + 256 * i, r = it / 12, cc = it % 12; pk[i] = *(const u32x4*)(Kg + ((size_t)(krow0 + r) * 8 + h) * 96 + cc * 8); }
#pragma unroll
      for (int i = 0; i < 2; i++) { const int it = tid + 256 * i, dv = it >> 3, kg = it & 7; pv[i] = *(const u32x4*)(Vg + (size_t)dv * Tk + kn * 64 + kg * 8); }
    }
    __builtin_amdgcn_sched_barrier(0);
    f32x4 s[4][2];
#pragma unroll
    for (int mi = 0; mi < 4; mi++) { s[mi][0] = f32x4{0.f, 0.f, 0.f, 0.f}; s[mi][1] = f32x4{0.f, 0.f, 0.f, 0.f}; }
#pragma unroll
    for (int ks = 0; ks < 3; ks++)
#pragma unroll
      for (int mi = 0; mi < 4; mi++) {
        bf16x8 kf = *(const bf16x8*)(Ks + (mi * 16 + l16) * 104 + ks * 32 + quad * 8);
        s[mi][0] = MFMA(kf, qf[0][ks], s[mi][0]);
        s[mi][1] = MFMA(kf, qf[1][ks], s[mi][1]);
      }
#pragma unroll
    for (int ni = 0; ni < 2; ni++) {
      float mx = -1e30f;
#pragma unroll
      for (int mi = 0; mi < 4; mi++)
#pragma unroll
        for (int j = 0; j < 4; j++) mx = fmaxf(mx, s[mi][ni][j]);
      mx = fmaxf(mx, __shfl_xor(mx, 16)); mx = fmaxf(mx, __shfl_xor(mx, 32));
      const float mnew = fmaxf(mrun[ni], mx);
      const float alpha = __builtin_amdgcn_exp2f(mrun[ni] - mnew);
      mrun[ni] = mnew;
      float rsum = 0.f;
#pragma unroll
      for (int mi = 0; mi < 4; mi++)
#pragma unroll
        for (int j = 0; j < 4; j++) { float pv = __builtin_amdgcn_exp2f(s[mi][ni][j] - mnew); s[mi][ni][j] = pv; rsum += pv; }
      lsum[ni] = lsum[ni] * alpha + rsum;
#pragma unroll
      for (int di = 0; di < 4; di++) o[di][ni] *= alpha;
    }
#pragma unroll
    for (int g = 0; g < 2; g++) {
      bf16x8 pf0 = frag_from(s[2 * g][0], s[2 * g + 1][0]);
      bf16x8 pf1 = frag_from(s[2 * g][1], s[2 * g + 1][1]);
#pragma unroll
      for (int di = 0; di < 4; di++) {
        bf16x8 vf = ld2(Vs + (di * 16 + l16) * 72 + g * 32 + quad * 4);
        o[di][0] = MFMA(vf, pf0, o[di][0]);
        o[di][1] = MFMA(vf, pf1, o[di][1]);
      }
    }
  }
  const bf16_t* P2 = (const bf16_t*)(ws_ + OFF_P2);
  bf16_t* BR = (bf16_t*)(ws_ + OFF_BR);
#pragma unroll
  for (int ni = 0; ni < 2; ni++) {
    float lt = lsum[ni];
    lt += __shfl_xor(lt, 16); lt += __shfl_xor(lt, 32);
    const float inv = frcp(lt);
    const size_t qrow = (size_t)(qrow0 + wave * 32 + ni * 16 + l16);
#pragma unroll
    for (int di = 0; di < 4; di++) {
      const int col = h * 64 + di * 16 + quad * 4;
      float z[4]; unpack4(*(const u32x2*)(P2 + qrow * P2W + col), z);
      *(u32x2*)(BR + qrow * BRW + col) = pack4(o[di][ni][0] * inv * siluf(z[0]), o[di][ni][1] * inv * siluf(z[1]),
                                               o[di][ni][2] * inv * siluf(z[2]), o[di][ni][3] * inv * siluf(z[3]));
    }
  }
}

struct ScanPf { u32x4 w[4], q[4], a[2], k[4], u[2]; float egl; };
DEV void scan_prefetch(ScanPf& f, const bf16_t* rec, const float* eglp, int half, int tid) {
#pragma unroll
  for (int i = 0; i < 4; i++) { const int c = tid + 256 * i; f.w[i] = *(const u32x4*)(rec + c * 8); f.q[i] = *(const u32x4*)(rec + 8192 + c * 8); f.k[i] = *(const u32x4*)(rec + 20480 + c * 8); }
#pragma unroll
  for (int i = 0; i < 2; i++) { const int c = tid + 256 * i; f.a[i] = *(const u32x4*)(rec + 16384 + c * 8); f.u[i] = *(const u32x4*)(rec + 28672 + (c >> 3) * 128 + half * 64 + (c & 7) * 8); }
  f.egl = *eglp;
}
DEV void gdn_scan_task(const Params& p, int l, int t, char* lds) {
  char* ws_ = p.ws; asm volatile("" : "+s"(ws_));
  const int tid = otid(), lane = tid & 63, wave = tid >> 6, l16 = lane & 15, quad = lane >> 4;
  __builtin_amdgcn_s_setprio(3);
  int chain, half, b, chunk0, N; bool lat = t < 64;
  if (lat) { chain = t >> 1; half = t & 1; } else { chain = (t - 64) >> 1; half = (t - 64) & 1; }
  const int dir = chain & 1, h = (chain >> 1) & 3;
  b = chain >> 3;
  if (lat) { chunk0 = 64 + b * 16; N = 16; } else { chunk0 = b * 4; N = 4; }
  const int e0 = (half * 4 + wave) * 16;
  bf16_t* Wl = (bf16_t*)lds;
  bf16_t* Ql = Wl + 64 * 136;
  bf16_t* Al = Ql + 64 * 136;
  bf16_t* Kl = Al + 64 * 72;
  bf16_t* Ul = Kl + 128 * 72;
  f32x4 S[8];
  if (lat) {
    const float* s0 = p.in[I_SGDN] + ((size_t)((b * 2 + l) * 2 + dir) * 4 + h) * 16384;
#pragma unroll
    for (int mf = 0; mf < 8; mf++)
#pragma unroll
      for (int j = 0; j < 4; j++) S[mf][j] = s0[(mf * 16 + quad * 4 + j) * 128 + e0 + l16];
  } else {
#pragma unroll
    for (int mf = 0; mf < 8; mf++) S[mf] = f32x4{0.f, 0.f, 0.f, 0.f};
  }
  float* OD = (float*)(ws_ + OFF_ODIR) + (size_t)dir * NTOK * 512;
  const float* EGL = (const float*)(ws_ + OFF_EGL);
  const bf16_t* GD = (const bf16_t*)(ws_ + OFF_GDN);
  ScanPf pf;
  {
    const int cidx = chunk0 + (dir ? N - 1 : 0);
    scan_prefetch(pf, GD + ((size_t)(cidx * 4 + h) * 2 + dir) * REC_EL, EGL + (cidx * 4 + h) * 2 + dir, half, tid);
  }
#pragma unroll 1
  for (int n = 0; n < N; n++) {
    const int cidx = chunk0 + (dir ? N - 1 - n : n);
    __syncthreads();
#pragma unroll
    for (int i = 0; i < 4; i++) {
      const int c = tid + 256 * i;
      *(u32x4*)(Wl + (c >> 4) * 136 + (c & 15) * 8) = pf.w[i];
      *(u32x4*)(Ql + (c >> 4) * 136 + (c & 15) * 8) = pf.q[i];
      *(u32x4*)(Kl + (c >> 3) * 72 + (c & 7) * 8) = pf.k[i];
    }
#pragma unroll
    for (int i = 0; i < 2; i++) {
      const int c = tid + 256 * i;
      *(u32x4*)(Al + (c >> 3) * 72 + (c & 7) * 8) = pf.a[i];
      *(u32x4*)(Ul + (c >> 3) * 72 + (c & 7) * 8) = pf.u[i];
    }
    const float egl = pf.egl;
    __syncthreads();
    if (n + 1 < N) {
      const int cn = chunk0 + (dir ? N - 2 - n : n + 1);
      scan_prefetch(pf, GD + ((size_t)(cn * 4 + h) * 2 + dir) * REC_EL, EGL + (cn * 4 + h) * 2 + dir, half, tid);
    }
    __builtin_amdgcn_sched_barrier(0);
    bf16x8 Sb[4];
#pragma unroll
    for (int ks = 0; ks < 4; ks++) Sb[ks] = frag_from(S[2 * ks], S[2 * ks + 1]);
    f32x4 vn[4];
#pragma unroll
    for (int mi = 0; mi < 4; mi++)
#pragma unroll
      for (int j = 0; j < 4; j++) vn[mi][j] = bf2f(Ul[(mi * 16 + quad * 4 + j) * 72 + wave * 16 + l16]);
#pragma unroll
    for (int mi = 0; mi < 4; mi++)
#pragma unroll
      for (int ks = 0; ks < 4; ks++) vn[mi] = MFMA(ld2(Wl + (mi * 16 + l16) * 136 + ks * 32 + quad * 4), Sb[ks], vn[mi]);
    bf16x8 vb[2];
    vb[0] = frag_from(vn[0], vn[1]); vb[1] = frag_from(vn[2], vn[3]);
#pragma unroll
    for (int mi = 0; mi < 4; mi++) {
      f32x4 o = f32x4{0.f, 0.f, 0.f, 0.f};
#pragma unroll
      for (int ks = 0; ks < 4; ks++) o = MFMA(ld2(Ql + (mi * 16 + l16) * 136 + ks * 32 + quad * 4), Sb[ks], o);
#pragma unroll
      for (int k2 = 0; k2 < 2; k2++) o = MFMA(ld2(Al + (mi * 16 + l16) * 72 + k2 * 32 + quad * 4), vb[k2], o);
#pragma unroll
      for (int j = 0; j < 4; j++) {
        const int ip = mi * 16 + quad * 4 + j, tok = dir ? 63 - ip : ip;
        OD[(size_t)(cidx * 64 + tok) * 512 + h * 128 + e0 + l16] = o[j];
      }
    }
#pragma unroll
    for (int mf = 0; mf < 8; mf++) {
      S[mf] *= egl;
#pragma unroll
      for (int k2 = 0; k2 < 2; k2++) S[mf] = MFMA(ld2(Kl + (mf * 16 + l16) * 72 + k2 * 32 + quad * 4), vb[k2], S[mf]);
    }
  }
  if (!lat) {
    float* so = p.out + OUT_STATE + ((size_t)((b * 2 + l) * 2 + dir) * 4 + h) * 16384;
#pragma unroll
    for (int mf = 0; mf < 8; mf++)
#pragma unroll
      for (int j = 0; j < 4; j++) so[(mf * 16 + quad * 4 + j) * 128 + e0 + l16] = S[mf][j];
  }
  __builtin_amdgcn_s_setprio(0);
}

DEV void onorm_task(const Params& p, int l, int t) {
  char* ws_ = p.ws; asm volatile("" : "+s"(ws_));
  const int tid = otid(), lane = tid & 63, wave = tid >> 6;
  const float* OD = (const float*)(ws_ + OFF_ODIR);
  const bf16_t* P2 = (const bf16_t*)(ws_ + OFF_P2);
  bf16_t* BR = (bf16_t*)(ws_ + OFF_BR);
#pragma unroll
  for (int rr = 0; rr < 4; rr++) {
    const size_t row = (size_t)t * 16 + wave * 4 + rr;
    const f32x4 a0 = *(const f32x4*)(OD + row * 512 + lane * 8), a1 = *(const f32x4*)(OD + row * 512 + lane * 8 + 4);
    const f32x4 b0 = *(const f32x4*)(OD + (NTOK + row) * 512 + lane * 8), b1 = *(const f32x4*)(OD + (NTOK + row) * 512 + lane * 8 + 4);
    float x[8] = {a0.x + b0.x, a0.y + b0.y, a0.z + b0.z, a0.w + b0.w, a1.x + b1.x, a1.y + b1.y, a1.z + b1.z, a1.w + b1.w};
    float ss = 0.f;
#pragma unroll
    for (int i = 0; i < 8; i++) ss += x[i] * x[i];
#pragma unroll
    for (int o = 8; o >= 1; o >>= 1) ss += __shfl_xor(ss, o);
    const float rstd = __builtin_amdgcn_rsqf(ss * (1.f / 128.f) + EPSF);
    float z[8]; unpack8(*(const u32x4*)(P2 + row * P2W + 512 + lane * 8), z);
    const float* g = p.in[I_ONORM] + l * 128 + (lane & 15) * 8;
    float y[8];
#pragma unroll
    for (int i = 0; i < 8; i++) y[i] = x[i] * rstd * g[i] * siluf(z[i]);
    *(u32x4*)(BR + row * BRW + 512 + lane * 8) = pack8(y);
  }
}

DEV void gate_task(const Params& p, int l, int t, char* lds) {
  char* ws_ = p.ws; asm volatile("" : "+s"(ws_));
  const int tid = otid();
  const int nt = t / 64, mt = t % 64;
  f32x4 acc[4][4]; zero_acc<4>(acc);
  ALPlain al{(const bf16_t*)(ws_ + OFF_H) + (size_t)mt * 128 * 1024, 1024};
  gemm_core<128>(al, (const bf16_t*)(ws_ + OFF_WGL) + (size_t)nt * 128 * 1024, 1024, 1024, acc, lds);
  float* Cs = (float*)lds;
  acc_to_lds<128>(acc, Cs);
  bf16_t* GT = (bf16_t*)(ws_ + OFF_GDN);
#pragma unroll
  for (int i = 0; i < 8; i++) {
    const int it = tid + 256 * i, r = it >> 4, c8 = it & 15;
    const f32x4 a = *(const f32x4*)(Cs + r * 132 + c8 * 8), b = *(const f32x4*)(Cs + r * 132 + c8 * 8 + 4);
    float f[8] = {sigmf(a.x), sigmf(a.y), sigmf(a.z), sigmf(a.w), sigmf(b.x), sigmf(b.y), sigmf(b.z), sigmf(b.w)};
    *(u32x4*)(GT + (size_t)(mt * 128 + r) * 3072 + nt * 128 + c8 * 8) = pack8(f);
  }
}
DEV void d1_task(const Params& p, int l, int t, char* lds) {
  char* ws_ = p.ws; asm volatile("" : "+s"(ws_));
  const int tid = otid(), lane = tid & 63, wave = tid >> 6, l16 = lane & 15, quad = lane >> 4;
  const int wm = wave >> 1, wn = wave & 1;
  const int nt = t >> 6, mt = t & 63;
  const bf16_t* GT = (const bf16_t*)(ws_ + OFF_GDN);
  f32x4 macc[4][2]; zero_acc<2>(macc);
#pragma unroll 1
  for (int n = 0; n < 3; n++) {
    unsigned short gv[4][2][4];
#pragma unroll
    for (int mi = 0; mi < 4; mi++)
#pragma unroll
      for (int ni = 0; ni < 2; ni++)
#pragma unroll
        for (int j = 0; j < 4; j++)
          gv[mi][ni][j] = GT[(size_t)(mt * 128 + wm * 64 + mi * 16 + quad * 4 + j) * 3072 + n * 1024 + nt * 64 + wn * 32 + ni * 16 + l16];
    f32x4 y[4][2]; zero_acc<2>(y);
    ALPlain alb{(const bf16_t*)(ws_ + OFF_BR) + (size_t)mt * 128 * BRW + n * 512, BRW};
    gemm_core<64>(alb, (const bf16_t*)(ws_ + OFF_WBR) + (size_t)(n * 1024 + nt * 64) * 512, 512, 512, y, lds);
#pragma unroll
    for (int mi = 0; mi < 4; mi++)
#pragma unroll
      for (int ni = 0; ni < 2; ni++)
#pragma unroll
        for (int j = 0; j < 4; j++) macc[mi][ni][j] += bf2f(gv[mi][ni][j]) * y[mi][ni][j];
  }
  float* Cs = (float*)lds;
  acc_to_lds<64>(macc, Cs);
  bf16_t* M = (bf16_t*)(ws_ + OFF_M);
#pragma unroll
  for (int i = 0; i < 4; i++) {
    const int it = tid + 256 * i, r = it >> 3, c8 = it & 7;
    float f[8];
#pragma unroll
    for (int j = 0; j < 8; j++) f[j] = Cs[r * 68 + c8 * 8 + j];
    *(u32x4*)(M + (size_t)(mt * 128 + r) * 1024 + nt * 64 + c8 * 8) = pack8(f);
  }
}

DEV void d2_task(const Params& p, int l, int t, char* lds) {
  char* ws_ = p.ws; asm volatile("" : "+s"(ws_));
  const int tid = otid();
  const int nt = t >> 6, mt = t & 63;
  f32x4 acc[4][4]; zero_acc<4>(acc);
  ALPlain al{(const bf16_t*)(ws_ + OFF_M) + (size_t)mt * 128 * 1024, 1024};
  gemm_core<128>(al, (const bf16_t*)(ws_ + OFF_WO) + (size_t)nt * 128 * 1024, 1024, 1024, acc, lds);
  float* Cs = (float*)lds;
  acc_to_lds<128>(acc, Cs);
  const float* mod = (const float*)(ws_ + OFF_MOD);
#pragma unroll
  for (int i = 0; i < 8; i++) {
    const int it = tid + 256 * i, r = it >> 4, c8 = it & 15;
    const int row = mt * 128 + r, col = nt * 128 + c8 * 8;
    const float* x = xrow_ptr(p, l, row) + col;
    const float* gt = mod + (size_t)(l * 5 + modrow(row)) * 3072 + 2048 + col;
    const f32x4 y0 = *(const f32x4*)(Cs + r * 132 + c8 * 8), y1 = *(const f32x4*)(Cs + r * 132 + c8 * 8 + 4);
    const f32x4 x0 = *(const f32x4*)x, x1 = *(const f32x4*)(x + 4);
    const f32x4 g0 = *(const f32x4*)gt, g1 = *(const f32x4*)(gt + 4);
    float* o = p.out + (size_t)row * DM + col;
    *(f32x4*)o = f32x4{x0.x + g0.x * y0.x, x0.y + g0.y * y0.y, x0.z + g0.z * y0.z, x0.w + g0.w * y0.w};
    *(f32x4*)(o + 4) = f32x4{x1.x + g1.x * y1.x, x1.y + g1.y * y1.y, x1.z + g1.z * y1.z, x1.w + g1.w * y1.w};
  }
}

#define NPHASES 15
DEV int phase_nsub(int ph) {
  if (ph == 0) return 48 + 152;
  const int l = (ph - 1) / 7, s = (ph - 1) % 7;
  switch (s) {
    case 0: return 128 + (l == 0 ? 113 : 32);
    case 1: return 304 + (l == 0 ? 80 : 0);
    case 2: return 64 + 72 + 64 + 32;
    case 3: return 8 + 32 + 32 + 32;
    case 4: return 192 + 64 + (l == 0 ? 169 : 0);
    case 5: return 128 + (l == 0 ? 96 : 0);
    default: return 64 + (l == 0 ? 48 : 0);
  }
}
DEV void run_task(const Params& p, int ph, int x, int i, char* lds) {
  if (ph == 0) { if (i < 48) mod_task(p, i * 8 + x, lds); else convert_task(p, 0, (i - 48) * 8 + x, lds); return; }
  const int l = (ph - 1) / 7, s = (ph - 1) % 7;
  switch (s) {
    case 0:
      if (i < 128) norm_task(p, l, i * 8 + x);
      else if (l == 0) convert_task(p, 0, 1216 + (i - 128) * 8 + x, lds);
      else convert_task(p, 1, 2504 + (i - 128) * 8 + x, lds);
      break;
    case 1:
      if (i < 304) projA_task(p, l, (i >> 3) * 64 + (i & 7) * 8 + x, lds);
      else convert_task(p, 0, 2120 + (i - 304) * 8 + x, lds);
      break;
    case 2:
      if (i < 64) gdn_prep_task(p, l, i * 8 + x, lds);
      else if (i < 136) { const int j = i - 64; kv_task(p, l, (j / 9) * 72 + (j % 9) * 8 + x, lds); }
      else if (i < 200) { const int j = i - 136; q_task(p, l, (j >> 3) * 64 + (j & 7) * 8 + x, lds); }
      else cmlp_task(p, l, (i - 200) * 8 + x, lds);
      break;
    case 3:
      if (i < 8) gdn_scan_task(p, l, i * 8 + x, lds);
      else if (i < 40) attn_task(p, l, x * 32 + (i - 8), lds);
      else if (i < 72) gdn_scan_task(p, l, 64 + (i - 40) * 8 + x, lds);
      else attn_task(p, l, 256 + x * 32 + (i - 72), lds);
      break;
    case 4:
      if (i < 192) gate_task(p, l, (i >> 3) * 64 + (i & 7) * 8 + x, lds);
      else if (i < 256) onorm_task(p, l, (i - 192) * 8 + x);
      else if (i < 408) convert_task(p, 1, (i - 256) * 8 + x, lds);
      else convert_task(p, 1, 1984 + (i - 408) * 8 + x, lds);
      break;
    case 5:
      if (i < 128) d1_task(p, l, (i >> 3) * 64 + (i & 7) * 8 + x, lds);
      else convert_task(p, 1, 1216 + (i - 128) * 8 + x, lds);
      break;
    case 6:
      if (i < 64) d2_task(p, l, (i >> 3) * 64 + (i & 7) * 8 + x, lds);
      else convert_task(p, 1, 2120 + (i - 64) * 8 + x, lds);
      break;
  }
}
#ifndef REP_S
#define REP_S -1
#endif
DEV void run_phase(const Params& p, int ph, char* lds, int* sh, int myx, int rep = 0, int rank = 0, int nloc = 0) {
  unsigned* cb = (unsigned*)(p.ws + OFF_CTR) + ph * 128 + rep * 6144;
  const int n = phase_nsub(ph);
  if (nloc > 0) {
#pragma unroll 1
    for (int i = rank; i < n; i += nloc) { __syncthreads(); run_task(p, ph, myx, i, lds); }
    return;
  }
#pragma unroll 1
  for (int xo = 0; xo < 8; xo++) {
    const int x = (myx + xo) & 7;
    unsigned* c = cb + x * 16;
    int i;
    while ((i = next_task(c, sh, n, xo > 0)) < n) run_task(p, ph, x, i, lds);
  }
}

__global__ void __launch_bounds__(256, 2) k_phase(Params p, int ph) {
  __shared__ __attribute__((aligned(16))) char lds[LDS_BYTES];
  __shared__ int sh[4];
  const Params& pr = *(const Params*)__builtin_amdgcn_kernarg_segment_ptr();
  run_phase(pr, ph, lds, sh, (int)(xb_xcc_id() & 7u));
}

__global__ void __launch_bounds__(256, 2) k_mega(Params p) {
  __shared__ __attribute__((aligned(16))) char lds[LDS_BYTES];
  __shared__ __attribute__((aligned(16))) unsigned xbw[4];
  __shared__ int sh[4];
  const Params& pr = *(const Params*)__builtin_amdgcn_kernarg_segment_ptr();
  if (threadIdx.x == 0) { xbw[0] = 0u; xbw[1] = 0u; xbw[2] = 0u; xbw[3] = 0u; }
  __syncthreads();
  XcdBarrier xb = xcd_barrier_post((unsigned*)(pr.ws + OFF_BAR), (volatile LAS unsigned*)xbw);
  const int myx = (int)(xb.x & 7u);
  if (pr.out == nullptr) cg::this_grid().sync();
#pragma unroll
  for (int ph = 0; ph < NPHASES; ph++) {
    {
      const int sub = ph > 0 ? (ph - 1) % 7 : -1;
      const bool uniform = (sub == 0 || sub == 1 || sub == 4 || sub == 5 || sub == 6);
      int nloc = 0, rank = 0;
      if (ph > 0 && uniform && xbw[1] == 8u) { nloc = (int)xbw[0]; rank = (int)xbw[2]; }
      run_phase(pr, ph, lds, sh, myx, 0, rank, nloc);
    }
    if ((REP_S == 7 && ph == 0) || (REP_S >= 0 && ph > 0 && (ph - 1) % 7 == REP_S && !(REP_S == 6 && ph > 7))) run_phase(pr, ph, lds, sh, myx, 1);
    if (ph + 1 < NPHASES) xcd_barrier(xb);
  }
}

extern "C" void kernel_launch(void* const* d_in, const int* in_sizes, int n_in, void* d_out, int out_size, void* d_ws,
                              size_t ws_size, hipStream_t stream) {
  Params p{};
  for (int i = 0; i < 27; i++) p.in[i] = (const float*)d_in[i];
  p.out = (float*)d_out;
  p.ws = (char*)d_ws;
  if (ws_size < WS_END) { fprintf(stderr, "workspace too small: %zu < %llu\n", ws_size, (unsigned long long)WS_END); return; }
  (void)hipMemsetAsync(d_ws, 0, 32768, stream);
#if COOP
  static int grid_blocks = 0;
  if (!grid_blocks) {
    int dev = 0, cus = 0, per_cu = 0;
    hipGetDevice(&dev);
    hipDeviceGetAttribute(&cus, hipDeviceAttributeMultiprocessorCount, dev);
    hipOccupancyMaxActiveBlocksPerMultiprocessor(&per_cu, k_mega, 256, 0);
    if (per_cu > 2) per_cu = 2;
    if (per_cu < 1) per_cu = 1;
    grid_blocks = cus * per_cu;
  }
  void* args[] = {&p};
  hipError_t e = hipLaunchCooperativeKernel((void*)k_mega, dim3(grid_blocks), dim3(256), args, 0, stream);
  if (e != hipSuccess) fprintf(stderr, "cooperative launch failed: %s (grid %d)\n", hipGetErrorString(e), grid_blocks);
#else
  for (int ph = 0; ph < NPHASES; ph++) k_phase<<<512, 256, 0, stream>>>(p, ph);
#endif
}
```

```cpp
#include <hip/hip_runtime.h>
#include <hip/hip_cooperative_groups.h>
#include <stdint.h>
#include <stdio.h>
namespace cg = cooperative_groups;

#ifndef COOP
#define COOP 1
#endif

typedef unsigned short bf16_t;
typedef __attribute__((ext_vector_type(8))) short bf16x8;
typedef __attribute__((ext_vector_type(4))) float f32x4;
typedef __attribute__((ext_vector_type(4))) unsigned int u32x4;
typedef __attribute__((ext_vector_type(2))) unsigned int u32x2;
#define DEV __device__ __forceinline__

#define NTOK 8192
#define DM 1024
#define DIN 7856
#define EPSF 1e-6f
#define P1W 2208
#define P3W 1024
#define P2W 1536
#define BRW 1536
#define REC_EL 36864

#define OFF_CTR  0ull
#define OFF_BAR  8192ull
#define OFF_MOD  32768ull
#define OFF_GAB  (OFF_MOD + 122880ull)
#define OFF_EGL  (OFF_GAB + 524288ull)
#define OFF_WTA  (OFF_EGL + 4096ull)
#define OFF_WGL  (OFF_WTA + 9961472ull)
#define OFF_WUQ  (OFF_WGL + 6291456ull)
#define OFF_WUKV (OFF_WUQ + 589824ull)
#define OFF_WBR  (OFF_WUKV + 524288ull)
#define OFF_WO   (OFF_WBR + 3145728ull)
#define OFF_H    (OFF_WO + 2097152ull)
#define OFF_P1   (OFF_H + 16777216ull)
#define OFF_ODIR OFF_P1
#define OFF_P3   (OFF_P1 + 36175872ull)
#define OFF_M    OFF_P3
#define OFF_P2   (OFF_P1 + 52953088ull)
#define OFF_GDN  (OFF_P2 + 25165824ull)
#define OFF_Q    (OFF_GDN + 75497472ull)
#define OFF_K    (OFF_Q + 12582912ull)
#define OFF_VT   (OFF_K + 14155776ull)
#define OFF_BR   (OFF_VT + 9437184ull)
#define WS_END   (OFF_BR + 25165824ull)
#define VT_LAT_EL 2097152

#define OUT_CKV   8388608
#define OUT_KROPE 10485760
#define OUT_STATE 10747904

#define LDS_BYTES 75776
#define LDS_SMALL 73728

struct Params {
  const float* in[27];
  float* out;
  char* ws;
};
enum { I_XP = 0, I_XS, I_CCKV, I_CKR, I_SGDN, I_C, I_CCTX, I_NORMG, I_WMOD, I_BMOD, I_WIN, I_QAN, I_WUQ, I_KVAN, I_WUKV,
       I_QN, I_KN, I_CONVW, I_ALOG, I_DTB, I_ONORM, I_LNG, I_LNB, I_WS, I_BS, I_WBR, I_WO };

DEV float bf2f(bf16_t b) { return __uint_as_float(((unsigned)b) << 16); }
typedef __bf16 hwbf2 __attribute__((ext_vector_type(2)));
typedef float hwf2 __attribute__((ext_vector_type(2)));
DEV unsigned pack2(float a, float b) { hwf2 v = {a, b}; return __builtin_bit_cast(unsigned, __builtin_convertvector(v, hwbf2)); }
DEV bf16_t f2bf(float f) { return (bf16_t)(pack2(f, 0.f) & 0xffffu); }
DEV void unpack8(u32x4 v, float* f) {
  f[0] = __uint_as_float(v.x << 16); f[1] = __uint_as_float(v.x & 0xffff0000u);
  f[2] = __uint_as_float(v.y << 16); f[3] = __uint_as_float(v.y & 0xffff0000u);
  f[4] = __uint_as_float(v.z << 16); f[5] = __uint_as_float(v.z & 0xffff0000u);
  f[6] = __uint_as_float(v.w << 16); f[7] = __uint_as_float(v.w & 0xffff0000u);
}
DEV void unpack4(u32x2 v, float* f) {
  f[0] = __uint_as_float(v.x << 16); f[1] = __uint_as_float(v.x & 0xffff0000u);
  f[2] = __uint_as_float(v.y << 16); f[3] = __uint_as_float(v.y & 0xffff0000u);
}
DEV u32x4 pack8(const float* f) {
  u32x4 v; v.x = pack2(f[0], f[1]); v.y = pack2(f[2], f[3]); v.z = pack2(f[4], f[5]); v.w = pack2(f[6], f[7]); return v;
}
DEV u32x2 pack4(float a, float b, float c, float d) { u32x2 v; v.x = pack2(a, b); v.y = pack2(c, d); return v; }
DEV bf16x8 as_frag(u32x4 v) { union { u32x4 u; bf16x8 b; } x; x.u = v; return x.b; }
DEV bf16x8 frag_from(f32x4 a, f32x4 b) {
  u32x4 v; v.x = pack2(a[0], a[1]); v.y = pack2(a[2], a[3]); v.z = pack2(b[0], b[1]); v.w = pack2(b[2], b[3]); return as_frag(v);
}
DEV bf16x8 ld2(const bf16_t* p) {
  u32x2 a = *(const u32x2*)p; u32x2 b = *(const u32x2*)(p + 16);
  u32x4 v; v.x = a.x; v.y = a.y; v.z = b.x; v.w = b.y; return as_frag(v);
}
DEV float frcp(float x) { return __builtin_amdgcn_rcpf(x); }
DEV float siluf(float x) { return x * frcp(1.f + __expf(-x)); }
DEV float sigmf(float x) { return frcp(1.f + __expf(-x)); }
DEV float geluf(float x) { float u = 0.7978845608028654f * (x + 0.044715f * x * x * x); return x * frcp(1.f + __expf(-2.f * u)); }
#define MFMA(a, b, c) __builtin_amdgcn_mfma_f32_16x16x32_bf16((a), (b), (c), 0, 0, 0)

DEV int otid() { int t = threadIdx.x; asm volatile("" : "+v"(t)); return t; }
DEV int next_task(unsigned* ctr, int* sh, int n, bool precheck) {
  __syncthreads();
  if (threadIdx.x == 0) {
    int v = n;
    if (!precheck || (int)__hip_atomic_load(ctr, __ATOMIC_RELAXED, __HIP_MEMORY_SCOPE_AGENT) < n) v = (int)atomicAdd(ctr, 1u);
    *sh = v;
  }
  __syncthreads();
  return *sh;
}

#define XB_TMO      128
#define XB_XCNT(j)  (256  + 64 * (j))
#define XB_XSUB(j)  (1280 + 64 * (j))
#define XB_XGEN(j)  (2304 + 64 * (j))
#define XB_TOP      3328
#define XB_TOPGEN   3392
#define XCD_BAR_WORDS 3456
#define XB_SPIN_CAP (1u << 22)
#define LAS __attribute__((address_space(3)))
DEV unsigned xb_ld(unsigned* p) { return __hip_atomic_load(p, __ATOMIC_RELAXED, __HIP_MEMORY_SCOPE_AGENT); }
DEV unsigned xb_add(unsigned* p, unsigned v) { return __hip_atomic_fetch_add(p, v, __ATOMIC_RELAXED, __HIP_MEMORY_SCOPE_AGENT); }
DEV unsigned xb_xcc_id() { return (unsigned)__builtin_amdgcn_s_getreg((3 << 11) | 20) & 0xFu; }
#define XB_SPIN(cond, bar) do { unsigned _sp = 0; while (cond) { __builtin_amdgcn_s_sleep(1); \
    if ((++_sp & 255u) == 0u) { if (xb_ld(&(bar)[XB_TMO])) break; if (_sp > XB_SPIN_CAP) { atomicAdd(&(bar)[XB_TMO], 1u); break; } } } } while (0)
struct XcdBarrier { unsigned* bar; unsigned x; volatile LAS unsigned* st; };
DEV XcdBarrier xcd_barrier_post(unsigned* bar, volatile LAS unsigned* st) {
  XcdBarrier b; b.bar = bar; b.x = xb_xcc_id(); b.st = st;
  if (threadIdx.x == 0) st[2] = xb_add(&bar[XB_XCNT(b.x)], 1u);
  return b;
}
DEV void xcd_barrier_complete(unsigned* bar, unsigned x, unsigned& nloc, unsigned& nx) {
  const unsigned G = gridDim.x * gridDim.y * gridDim.z;
  unsigned sum, cnt, mine, sp = 0u;
  for (;;) {
    sum = 0u; cnt = 0u; mine = 0u;
#pragma unroll
    for (unsigned j = 0; j < 16; ++j) { const unsigned c = xb_ld(&bar[XB_XCNT(j)]); sum += c; cnt += (c > 0u) ? 1u : 0u; mine = (j == x) ? c : mine; }
    if (sum == G) break;
    __builtin_amdgcn_s_sleep(1);
    if ((++sp & 255u) == 0u) { if (xb_ld(&bar[XB_TMO])) break; if (sp > XB_SPIN_CAP) { atomicAdd(&bar[XB_TMO], 1u); break; } }
  }
  nloc = mine > 0u ? mine : 1u; nx = cnt > 0u ? cnt : 1u;
}
DEV void xcd_barrier(const XcdBarrier& b) {
  asm volatile("s_waitcnt vmcnt(0)" ::: "memory");
  __syncthreads();
  if (threadIdx.x == 0) {
    unsigned* bar = b.bar;
    __builtin_amdgcn_s_waitcnt(0);
    unsigned nloc = b.st[0], nx = b.st[1];
    if (nloc == 0u) { xcd_barrier_complete(bar, b.x, nloc, nx); b.st[0] = nloc; b.st[1] = nx; }
    const unsigned old = xb_add(&bar[XB_XSUB(b.x)], 1u);
    const unsigned gen = old / nloc;
    if (old + 1u == (gen + 1u) * nloc) {
      __builtin_amdgcn_fence(__ATOMIC_RELEASE, "agent");
      asm volatile("s_waitcnt vmcnt(0)" ::: "memory");
      const unsigned og = xb_add(&bar[XB_TOP], 1u);
      const unsigned tg = og / nx;
      if (og + 1u == (tg + 1u) * nx) xb_add(&bar[XB_TOPGEN], 1u);
      else XB_SPIN(xb_ld(&bar[XB_TOPGEN]) == tg, bar);
      __builtin_amdgcn_fence(__ATOMIC_ACQUIRE, "agent");
      xb_add(&bar[XB_XGEN(b.x)], 1u);
      asm volatile("s_waitcnt vmcnt(0)" ::: "memory");
    } else {
      XB_SPIN(xb_ld(&bar[XB_XGEN(b.x)]) == gen, bar);
      __builtin_amdgcn_fence(__ATOMIC_ACQUIRE, "agent");
      asm volatile("s_waitcnt vmcnt(0)" ::: "memory");
    }
  }
  __syncthreads();
}

DEV const float* xrow_ptr(const Params& p, int l, int row) {
  if (l == 0) return row < 4096 ? p.in[I_XP] + (size_t)row * DM : p.in[I_XS] + (size_t)(row - 4096) * DM;
  return p.out + (size_t)row * DM;
}
DEV int modrow(int row) { return row < 4096 ? 0 : 1 + ((row - 4096) >> 10); }

struct ALPlain {
  const bf16_t* base; int ld;
  DEV u32x4 operator()(int row, int k) const { return *(const u32x4*)(base + (size_t)row * ld + k); }
};
struct ALScaled {
  const bf16_t* base; int ld; const float* rs; const float* g;
  DEV u32x4 operator()(int row, int k) const {
    u32x4 v = *(const u32x4*)(base + (size_t)row * ld + k);
    float f[8]; unpack8(v, f);
    const float r = rs[row];
    const f32x4 g0 = *(const f32x4*)(g + k), g1 = *(const f32x4*)(g + k + 4);
    f[0] *= r * g0.x; f[1] *= r * g0.y; f[2] *= r * g0.z; f[3] *= r * g0.w;
    f[4] *= r * g1.x; f[5] *= r * g1.y; f[6] *= r * g1.z; f[7] *= r * g1.w;
    return pack8(f);
  }
};
struct ALF32 {
  const float* base; int ld;
  DEV u32x4 operator()(int row, int k) const {
    const f32x4 a = *(const f32x4*)(base + (size_t)row * ld + k);
    const f32x4 b = *(const f32x4*)(base + (size_t)row * ld + k + 4);
    u32x4 v; v.x = pack2(a.x, a.y); v.y = pack2(a.z, a.w); v.z = pack2(b.x, b.y); v.w = pack2(b.z, b.w); return v;
  }
};

template <int TN>
DEV void gemm_compute(const bf16_t* As, const bf16_t* Bs, f32x4 (&acc)[4][TN / 32], int wm, int wn, int l16, int quad) {
  constexpr int NF = TN / 32;
#pragma unroll
  for (int ks = 0; ks < 2; ks++) {
    bf16x8 a[4], b[NF];
#pragma unroll
    for (int mi = 0; mi < 4; mi++) a[mi] = *(const bf16x8*)(As + (wm * 64 + mi * 16 + l16) * 72 + ks * 32 + quad * 8);
#pragma unroll
    for (int ni = 0; ni < NF; ni++) b[ni] = *(const bf16x8*)(Bs + (wn * (TN / 2) + ni * 16 + l16) * 72 + ks * 32 + quad * 8);
#pragma unroll
    for (int mi = 0; mi < 4; mi++)
#pragma unroll
      for (int ni = 0; ni < NF; ni++) acc[mi][ni] = MFMA(a[mi], b[ni], acc[mi][ni]);
  }
}
template <int TN, class AL>
DEV void gemm_core(const AL& al, const bf16_t* __restrict__ Bt, int ldb, int K, f32x4 (&acc)[4][TN / 32], char* lds) {
  constexpr int BUF = (128 + TN) * 72;
  constexpr int NF = TN / 32;
  bf16_t* L0 = (bf16_t*)lds;
  bf16_t* L1 = L0 + BUF;
  const int tid = otid(), lane = tid & 63, wave = tid >> 6;
  const int wm = wave >> 1, wn = wave & 1, l16 = lane & 15, quad = lane >> 4;
  u32x4 a0[4], b0[NF], a1[4], b1[NF];
#define G_LOAD(RA, RB, KK) { _Pragma("unroll") for (int i = 0; i < 4; i++) { int it = tid + 256 * i; RA[i] = al(it >> 3, (KK) + (it & 7) * 8); } \
                             _Pragma("unroll") for (int i = 0; i < NF; i++) { int it = tid + 256 * i; RB[i] = *(const u32x4*)(Bt + (size_t)(it >> 3) * ldb + (KK) + (it & 7) * 8); } }
#define G_STORE(LB, RA, RB) { _Pragma("unroll") for (int i = 0; i < 4; i++) { int it = tid + 256 * i; *(u32x4*)((LB) + (it >> 3) * 72 + (it & 7) * 8) = RA[i]; } \
                              _Pragma("unroll") for (int i = 0; i < NF; i++) { int it = tid + 256 * i; *(u32x4*)((LB) + 128 * 72 + (it >> 3) * 72 + (it & 7) * 8) = RB[i]; } }
  G_LOAD(a0, b0, 0);
  G_LOAD(a1, b1, 64);
  __syncthreads();
  G_STORE(L0, a0, b0);
  __syncthreads();
  for (int k0 = 0; k0 + 128 < K; k0 += 128) {
    G_LOAD(a0, b0, k0 + 128);
    __builtin_amdgcn_sched_barrier(0);
    gemm_compute<TN>(L0, L0 + 128 * 72, acc, wm, wn, l16, quad);
    G_STORE(L1, a1, b1);
    __syncthreads();
    G_LOAD(a1, b1, k0 + 192);
    __builtin_amdgcn_sched_barrier(0);
    gemm_compute<TN>(L1, L1 + 128 * 72, acc, wm, wn, l16, quad);
    G_STORE(L0, a0, b0);
    __syncthreads();
  }
  gemm_compute<TN>(L0, L0 + 128 * 72, acc, wm, wn, l16, quad);
  G_STORE(L1, a1, b1);
  __syncthreads();
  gemm_compute<TN>(L1, L1 + 128 * 72, acc, wm, wn, l16, quad);
#undef G_LOAD
#undef G_STORE
}

template <int TN>
DEV void acc_to_lds(f32x4 (&acc)[4][TN / 32], float* Cs) {
  const int tid = otid(), lane = tid & 63, wave = tid >> 6;
  const int wm = wave >> 1, wn = wave & 1, l16 = lane & 15, quad = lane >> 4;
  __syncthreads();
#pragma unroll
  for (int mi = 0; mi < 4; mi++)
#pragma unroll
    for (int ni = 0; ni < TN / 32; ni++)
#pragma unroll
      for (int j = 0; j < 4; j++)
        Cs[(wm * 64 + mi * 16 + quad * 4 + j) * (TN + 4) + wn * (TN / 2) + ni * 16 + l16] = acc[mi][ni][j];
  __syncthreads();
}
template <int NF>
DEV void zero_acc(f32x4 (&acc)[4][NF]) {
#pragma unroll
  for (int mi = 0; mi < 4; mi++)
#pragma unroll
    for (int ni = 0; ni < NF; ni++) acc[mi][ni] = f32x4{0.f, 0.f, 0.f, 0.f};
}

DEV void transpose_tile(const float* __restrict__ src, int ld, int col0, int ncols, int K, bf16_t* dst, int nt, int kt, float* tile) {
  const int tid = otid();
  const int n = tid & 63, kk = tid >> 6, gn = nt * 64 + n;
#pragma unroll
  for (int i = 0; i < 16; i++) {
    int k = kk + 4 * i;
    float v = (gn < ncols) ? src[(size_t)(kt * 64 + k) * ld + col0 + gn] : 0.f;
    tile[k * 65 + n] = v;
  }
  __syncthreads();
#pragma unroll
  for (int i = 0; i < 2; i++) {
    int it = tid + 256 * i, nn = it >> 3, kg = it & 7;
    float f[8];
#pragma unroll
    for (int j = 0; j < 8; j++) f[j] = tile[(kg * 8 + j) * 65 + nn];
    *(u32x4*)(dst + (size_t)(nt * 64 + nn) * K + kt * 64 + kg * 8) = pack8(f);
  }
}
#define NCONV_TASKS 2760
DEV void convert_task(const Params& p, int l, int t, char* lds) {
  char* ws_ = p.ws; asm volatile("" : "+s"(ws_));
  float* tile = (float*)lds;
  char* ws = ws_;
  if (t < 1216) { transpose_tile(p.in[I_WIN] + (size_t)l * 1024 * DIN, DIN, 0, 4784, 1024, (bf16_t*)(ws + OFF_WTA), t % 76, t / 76, tile); return; }
  t -= 1216;
  if (t < 768) { transpose_tile(p.in[I_WIN] + (size_t)l * 1024 * DIN, DIN, 4784, 3072, 1024, (bf16_t*)(ws + OFF_WGL), t % 48, t / 48, tile); return; }
  t -= 768;
  if (t < 72) { transpose_tile(p.in[I_WUQ] + (size_t)l * 384 * 768, 768, 0, 768, 384, (bf16_t*)(ws + OFF_WUQ), t % 12, t / 12, tile); return; }
  t -= 72;
  if (t < 64) { transpose_tile(p.in[I_WUKV] + (size_t)l * 256 * 1024, 1024, 0, 1024, 256, (bf16_t*)(ws + OFF_WUKV), t % 16, t / 16, tile); return; }
  t -= 64;
  if (t < 384) {
    int n = t / 128, tt = t % 128;
    transpose_tile(p.in[I_WBR] + (size_t)(l * 3 + n) * 512 * 1024, 1024, 0, 1024, 512, (bf16_t*)(ws + OFF_WBR) + (size_t)n * 1024 * 512, tt % 16, tt / 16, tile);
    return;
  }
  t -= 384;
  transpose_tile(p.in[I_WO] + (size_t)l * 1024 * 1024, 1024, 0, 1024, 1024, (bf16_t*)(ws + OFF_WO), t % 16, t / 16, tile);
}
DEV void mod_task(const Params& p, int t, char* lds) {
  char* ws_ = p.ws; asm volatile("" : "+s"(ws_));
  const int tid = otid();
  const int l = t / 192, n0 = (t % 192) * 16;
  float* s = (float*)lds;
  float* red = (float*)(lds + 32768);
  for (int idx = tid; idx < 5120; idx += 256) {
    int r = idx >> 10, k = idx & 1023;
    float v = (r == 0) ? p.in[I_CCTX][k] : p.in[I_C][(r - 1) * 1024 + k];
    s[idx] = v * frcp(1.f + __expf(-v));
  }
  __syncthreads();
  const int col = tid & 15, ksl = tid >> 4;
  float acc[5] = {0.f, 0.f, 0.f, 0.f, 0.f};
  const float* w = p.in[I_WMOD] + (size_t)l * 1024 * 3072 + n0 + col;
#pragma unroll 16
  for (int k = ksl * 64; k < ksl * 64 + 64; k++) {
    float wv = w[(size_t)k * 3072];
#pragma unroll
    for (int r = 0; r < 5; r++) acc[r] += s[r * 1024 + k] * wv;
  }
#pragma unroll
  for (int r = 0; r < 5; r++) red[(ksl * 5 + r) * 16 + col] = acc[r];
  __syncthreads();
  float* mod = (float*)(ws_ + OFF_MOD);
  if (tid < 80) {
    int r = tid >> 4, c = tid & 15;
    float v = p.in[I_BMOD][l * 3072 + n0 + c];
#pragma unroll
    for (int q = 0; q < 16; q++) v += red[(q * 5 + r) * 16 + c];
    mod[(l * 5 + r) * 3072 + n0 + c] = v;
  }
}

DEV void norm_task(const Params& p, int l, int t) {
  char* ws_ = p.ws; asm volatile("" : "+s"(ws_));
  const int tid = otid(), lane = tid & 63, wave = tid >> 6;
  const float* mod = (const float*)(ws_ + OFF_MOD);
  bf16_t* H = (bf16_t*)(ws_ + OFF_H);
#pragma unroll
  for (int rr = 0; rr < 2; rr++) {
    const int row = t * 8 + wave * 2 + rr;
    const float* x = xrow_ptr(p, l, row);
    const float* mr = mod + (size_t)(l * 5 + modrow(row)) * 3072;
    f32x4 v[4];
    float ss = 0.f;
#pragma unroll
    for (int i = 0; i < 4; i++) { v[i] = *(const f32x4*)(x + lane * 4 + 256 * i); ss += v[i].x * v[i].x + v[i].y * v[i].y + v[i].z * v[i].z + v[i].w * v[i].w; }
#pragma unroll
    for (int o = 32; o >= 1; o >>= 1) ss += __shfl_xor(ss, o);
    const float rstd = __builtin_amdgcn_rsqf(ss * (1.f / 1024.f) + EPSF);
#pragma unroll
    for (int i = 0; i < 4; i++) {
      const int col = lane * 4 + 256 * i;
      const f32x4 g = *(const f32x4*)(p.in[I_NORMG] + l * 1024 + col);
      const f32x4 sh = *(const f32x4*)(mr + col);
      const f32x4 sc = *(const f32x4*)(mr + 1024 + col);
      float a = v[i].x * rstd * g.x * (1.f + sc.x) + sh.x;
      float b = v[i].y * rstd * g.y * (1.f + sc.y) + sh.y;
      float c = v[i].z * rstd * g.z * (1.f + sc.z) + sh.z;
      float d = v[i].w * rstd * g.w * (1.f + sc.w) + sh.w;
      *(u32x2*)(H + (size_t)row * 1024 + col) = pack4(a, b, c, d);
    }
  }
}

DEV void projA_task(const Params& p, int l, int t, char* lds) {
  char* ws_ = p.ws; asm volatile("" : "+s"(ws_));
  const int tid = otid();
  const int nt = t / 64, mt = t % 64;
  f32x4 acc[4][4]; zero_acc<4>(acc);
  ALPlain al{(const bf16_t*)(ws_ + OFF_H) + (size_t)mt * 128 * 1024, 1024};
  gemm_core<128>(al, (const bf16_t*)(ws_ + OFF_WTA) + (size_t)nt * 128 * 1024, 1024, 1024, acc, lds);
  float* Cs = (float*)lds;
  acc_to_lds<128>(acc, Cs);
  bf16_t* P1 = (bf16_t*)(ws_ + OFF_P1);
  bf16_t* P2 = (bf16_t*)(ws_ + OFF_P2);
  bf16_t* P3 = (bf16_t*)(ws_ + OFF_P3);
  float* GAB = (float*)(ws_ + OFF_GAB);
#pragma unroll
  for (int i = 0; i < 8; i++) {
    const int it = tid + 256 * i, r = it >> 4, c8 = it & 15;
    const int n = nt * 128 + c8 * 8;
    if (n >= 4784) continue;
    const int row = mt * 128 + r;
    float f[8];
    const f32x4 a = *(const f32x4*)(Cs + r * 132 + c8 * 8);
    const f32x4 b = *(const f32x4*)(Cs + r * 132 + c8 * 8 + 4);
    f[0] = a.x; f[1] = a.y; f[2] = a.z; f[3] = a.w; f[4] = b.x; f[5] = b.y; f[6] = b.z; f[7] = b.w;
    if (n >= 2720 && n < 2736) {
      *(f32x4*)(GAB + (size_t)row * 16 + (n - 2720)) = a;
      *(f32x4*)(GAB + (size_t)row * 16 + (n - 2720) + 4) = b;
      continue;
    }
    if (n >= 640 && n < 672 && row < 4096) {
      float* o = p.out + OUT_KROPE + ((size_t)((row >> 8) * 2 + l) * 256 + (row & 255)) * 32 + (n - 640);
      *(f32x4*)o = a; *(f32x4*)(o + 4) = b;
    }
    bf16_t* dst;
    if (n < 672) dst = P1 + (size_t)row * P1W + n;
    else if (n < 1184) dst = P2 + (size_t)row * P2W + (n - 672);
    else if (n < 2720) dst = P1 + (size_t)row * P1W + 672 + (n - 1184);
    else if (n < 3248) dst = P2 + (size_t)row * P2W + 512 + (n - 2736);
    else if (n < 3760) dst = P3 + (size_t)row * P3W + (n - 3248);
    else if (n < 4272) dst = P3 + (size_t)row * P3W + 512 + (n - 3760);
    else dst = P2 + (size_t)row * P2W + 1024 + (n - 4272);
    *(u32x4*)dst = pack8(f);
  }
}

DEV void rope32(float* r, int prow, int pcol) {
  const float inv[8] = {1.f, 0.31622776601683794f, 0.1f, 0.031622776601683794f, 0.01f, 0.0031622776601683794f, 0.001f, 0.00031622776601683794f};
#pragma unroll
  for (int i = 0; i < 8; i++) {
    float a1 = (float)prow * inv[i], a2 = (float)pcol * inv[i];
    float c1 = __cosf(a1), s1 = __sinf(a1), c2 = __cosf(a2), s2 = __sinf(a2);
    float x1 = r[i], x2 = r[8 + i];
    r[i] = x1 * c1 - x2 * s1; r[8 + i] = x1 * s1 + x2 * c1;
    float y1 = r[16 + i], y2 = r[24 + i];
    r[16 + i] = y1 * c2 - y2 * s2; r[24 + i] = y1 * s2 + y2 * c2;
  }
}
DEV void finish_qk(float* v  , int half, const float* normw  , bool do_rope, int pos, float scale, bf16_t* dst  ) {
  float ss = 0.f;
#pragma unroll
  for (int i = 0; i < 48; i++) ss += v[i] * v[i];
  ss += __shfl_xor(ss, 1);
  const float rstd = __builtin_amdgcn_rsqf(ss * (1.f / 96.f) + EPSF);
#pragma unroll
  for (int i = 0; i < 12; i++) {
    const f32x4 w = *(const f32x4*)(normw + half * 48 + i * 4);
    v[i * 4] *= rstd * w.x; v[i * 4 + 1] *= rstd * w.y; v[i * 4 + 2] *= rstd * w.z; v[i * 4 + 3] *= rstd * w.w;
  }
  if (do_rope && half == 1) rope32(v + 16, pos >> 6, pos & 63);
#pragma unroll
  for (int i = 0; i < 6; i++) {
    float f[8];
#pragma unroll
    for (int j = 0; j < 8; j++) f[j] = v[i * 8 + j] * scale;
    *(u32x4*)(dst + half * 48 + i * 8) = pack8(f);
  }
}

#define QSCALE 0.14724306f
DEV void q_task(const Params& p, int l, int t, char* lds) {
  char* ws_ = p.ws; asm volatile("" : "+s"(ws_));
  const int tid = otid();
  const int mt = t & 63, h = t >> 6;
  const bf16_t* P1 = (const bf16_t*)(ws_ + OFF_P1);
  float* rs = (float*)(lds + LDS_SMALL);
  {
    const int row = tid >> 1, half = tid & 1;
    const bf16_t* src = P1 + (size_t)(mt * 128 + row) * P1W + half * 192;
    float ss = 0.f;
#pragma unroll 12
    for (int i = 0; i < 24; i++) { float f[8]; unpack8(*(const u32x4*)(src + i * 8), f);
#pragma unroll
      for (int j = 0; j < 8; j++) ss += f[j] * f[j]; }
    ss += __shfl_xor(ss, 1);
    if (!half) rs[row] = __builtin_amdgcn_rsqf(ss * (1.f / 384.f) + EPSF);
  }
  __syncthreads();
  f32x4 acc[4][3]; zero_acc<3>(acc);
  ALScaled al{P1 + (size_t)mt * 128 * P1W, P1W, rs, p.in[I_QAN] + l * 384};
  gemm_core<96>(al, (const bf16_t*)(ws_ + OFF_WUQ) + (size_t)h * 96 * 384, 384, 384, acc, lds);
  float* Cs = (float*)lds;
  acc_to_lds<96>(acc, Cs);
  const int row = tid >> 1, half = tid & 1, grow = mt * 128 + row;
  float v[48];
#pragma unroll
  for (int i = 0; i < 48; i++) v[i] = Cs[row * 100 + half * 48 + i];
  finish_qk(v, half, p.in[I_QN] + l * 96, grow >= 4096, (grow - 4096) & 1023, QSCALE,
            (bf16_t*)(ws_ + OFF_Q) + ((size_t)grow * 8 + h) * 96);
}

DEV void kv_task(const Params& p, int l, int t, char* lds) {
  char* ws_ = p.ws; asm volatile("" : "+s"(ws_));
  const int tid = otid();
  const int h = t / 72, mt = t % 72;
  const bf16_t* P1 = (const bf16_t*)(ws_ + OFF_P1);
  float* rs = (float*)(lds + LDS_SMALL);
  f32x4 acc[4][4]; zero_acc<4>(acc);
  const bf16_t* Bt = (const bf16_t*)(ws_ + OFF_WUKV) + (size_t)h * 128 * 256;
  if (mt < 64) {
    {
      const int row = tid >> 1, half = tid & 1;
      const bf16_t* src = P1 + (size_t)(mt * 128 + row) * P1W + 384 + half * 128;
      float ss = 0.f;
#pragma unroll
      for (int i = 0; i < 16; i++) { float f[8]; unpack8(*(const u32x4*)(src + i * 8), f);
#pragma unroll
        for (int j = 0; j < 8; j++) ss += f[j] * f[j]; }
      ss += __shfl_xor(ss, 1);
      if (!half) rs[row] = __builtin_amdgcn_rsqf(ss * (1.f / 256.f) + EPSF);
    }
    __syncthreads();
    if (h == 0 && mt < 32) {
#pragma unroll 8
      for (int it = tid; it < 128 * 32; it += 256) {
        const int r = it >> 5, c8 = it & 31, row = mt * 128 + r;
        float f[8]; unpack8(*(const u32x4*)(P1 + (size_t)row * P1W + 384 + c8 * 8), f);
        const float rr = rs[r];
        const float* g = p.in[I_KVAN] + l * 256 + c8 * 8;
        float* o = p.out + OUT_CKV + ((size_t)((row >> 8) * 2 + l) * 256 + (row & 255)) * 256 + c8 * 8;
        *(f32x4*)o = f32x4{f[0] * rr * g[0], f[1] * rr * g[1], f[2] * rr * g[2], f[3] * rr * g[3]};
        *(f32x4*)(o + 4) = f32x4{f[4] * rr * g[4], f[5] * rr * g[5], f[6] * rr * g[6], f[7] * rr * g[7]};
      }
    }
    ALScaled al{P1 + (size_t)mt * 128 * P1W + 384, P1W, rs, p.in[I_KVAN] + l * 256};
    gemm_core<128>(al, Bt, 256, 256, acc, lds);
  } else {
    const int b = (mt - 64) >> 1, p0 = ((mt - 64) & 1) * 128;
    ALF32 al{p.in[I_CCKV] + ((size_t)(b * 2 + l) * 256 + p0) * 256, 256};
    gemm_core<128>(al, Bt, 256, 256, acc, lds);
  }
  float* Cs = (float*)lds;
  acc_to_lds<128>(acc, Cs);
  {
    const int row = tid >> 1, half = tid & 1;
    float v[48];
    int krow; bool do_rope = false; int pos = 0;
    if (mt < 64) {
      const int grow = mt * 128 + row;
      krow = grow; do_rope = grow >= 4096; pos = (grow - 4096) & 1023;
      if (half == 0) {
#pragma unroll
        for (int i = 0; i < 48; i++) v[i] = Cs[row * 132 + i];
      } else {
#pragma unroll
        for (int i = 0; i < 16; i++) v[i] = Cs[row * 132 + 48 + i];
        const bf16_t* kr = P1 + (size_t)grow * P1W + 640;
#pragma unroll
        for (int i = 0; i < 4; i++) { float f[8]; unpack8(*(const u32x4*)(kr + i * 8), f);
#pragma unroll
          for (int j = 0; j < 8; j++) v[16 + i * 8 + j] = f[j]; }
      }
    } else {
      const int b = (mt - 64) >> 1, pp = ((mt - 64) & 1) * 128 + row;
      krow = 8192 + b * 256 + pp;
      if (half == 0) {
#pragma unroll
        for (int i = 0; i < 48; i++) v[i] = Cs[row * 132 + i];
      } else {
#pragma unroll
        for (int i = 0; i < 16; i++) v[i] = Cs[row * 132 + 48 + i];
        const float* kr = p.in[I_CKR] + ((size_t)(b * 2 + l) * 256 + pp) * 32;
#pragma unroll
        for (int i = 0; i < 8; i++) { const f32x4 w = *(const f32x4*)(kr + i * 4); v[16 + i * 4] = w.x; v[17 + i * 4] = w.y; v[18 + i * 4] = w.z; v[19 + i * 4] = w.w; }
      }
    }
    finish_qk(v, half, p.in[I_KN] + l * 96, do_rope, pos, 1.f, (bf16_t*)(ws_ + OFF_K) + ((size_t)krow * 8 + h) * 96);
  }
  {
    size_t vbase; int Tk, key0;
    if (mt < 32) { const int b = mt >> 1; Tk = 256; key0 = (mt & 1) * 128; vbase = (size_t)(b * 8 + h) * 64 * 256; }
    else if (mt < 64) { const int b = (mt - 32) >> 3; Tk = 1280; key0 = 256 + ((mt - 32) & 7) * 128; vbase = VT_LAT_EL + (size_t)(b * 8 + h) * 64 * 1280; }
    else { const int b = (mt - 64) >> 1; Tk = 1280; key0 = ((mt - 64) & 1) * 128; vbase = VT_LAT_EL + (size_t)(b * 8 + h) * 64 * 1280; }
    bf16_t* Vt = (bf16_t*)(ws_ + OFF_VT) + vbase;
#pragma unroll
    for (int i = 0; i < 4; i++) {
      const int it = tid + 256 * i, dv = it & 63, kg = it >> 6;
      float f[8];
#pragma unroll
      for (int j = 0; j < 8; j++) f[j] = Cs[(kg * 8 + j) * 132 + 64 + dv];
      *(u32x4*)(Vt + (size_t)dv * Tk + key0 + kg * 8) = pack8(f);
    }
  }
}

DEV void conv_pass(const Params& p, int l, int seg, int h, int row0, int sbeg, int send, float* F, bf16_t* Vtile) {
  char* ws_ = p.ws; asm volatile("" : "+s"(ws_));
  const int tid = otid(), c8 = tid & 15, tg = tid >> 4;
  const bf16_t* src = (const bf16_t*)(ws_ + OFF_P1) + 672 + seg * 512 + h * 128 + c8 * 8;
  const float* cwp = p.in[I_CONVW] + (size_t)l * 5 * 1536 + seg * 512 + h * 128 + c8 * 8;
  float cw[5][8];
#pragma unroll
  for (int j = 0; j < 5; j++) {
    const f32x4 a = *(const f32x4*)(cwp + j * 1536), b = *(const f32x4*)(cwp + j * 1536 + 4);
    cw[j][0] = a.x; cw[j][1] = a.y; cw[j][2] = a.z; cw[j][3] = a.w; cw[j][4] = b.x; cw[j][5] = b.y; cw[j][6] = b.z; cw[j][7] = b.w;
  }
  const int t0 = row0 + tg * 4;
  u32x4 raw[8];
#pragma unroll
  for (int r = 0; r < 8; r++) {
    const int row = t0 - 2 + r;
    raw[r] = (row >= sbeg && row < send) ? *(const u32x4*)(src + (size_t)row * P1W) : u32x4{0u, 0u, 0u, 0u};
  }
  float acc[4][8];
#pragma unroll
  for (int tt = 0; tt < 4; tt++)
#pragma unroll
    for (int c = 0; c < 8; c++) acc[tt][c] = 0.f;
#pragma unroll
  for (int r = 0; r < 8; r++) {
    float f[8]; unpack8(raw[r], f);
#pragma unroll
    for (int tt = 0; tt < 4; tt++) {
      const int j = r - tt;
      if (j >= 0 && j < 5) {
#pragma unroll
        for (int c = 0; c < 8; c++) acc[tt][c] += cw[j][c] * f[c];
      }
    }
  }
#pragma unroll
  for (int tt = 0; tt < 4; tt++) {
    float y[8];
#pragma unroll
    for (int c = 0; c < 8; c++) y[c] = siluf(acc[tt][c]);
    if (F) {
#pragma unroll
      for (int c = 0; c < 8; c++) F[(tg * 4 + tt) * 129 + c8 * 8 + c] = y[c];
    } else {
      *(u32x4*)(Vtile + (tg * 4 + tt) * 136 + c8 * 8) = pack8(y);
    }
  }
}
DEV void l2norm_rows(const float* F, bf16_t* T) {
  const int tid = otid(), row = tid >> 2, part = tid & 3;
  float ss = 0.f;
#pragma unroll
  for (int i = 0; i < 32; i++) { float x = F[row * 129 + part * 32 + i]; ss += x * x; }
  ss += __shfl_xor(ss, 1); ss += __shfl_xor(ss, 2);
  const float inv = __builtin_amdgcn_rsqf(ss + EPSF);
#pragma unroll
  for (int i = 0; i < 32; i++) T[row * 136 + part * 32 + i] = f2bf(F[row * 129 + part * 32 + i] * inv);
}
DEV void mm64(const bf16_t* At, const bf16_t* Bt_, float* Out, int wave, int l16, int quad) {
  f32x4 acc[4];
#pragma unroll
  for (int ni = 0; ni < 4; ni++) acc[ni] = f32x4{0.f, 0.f, 0.f, 0.f};
#pragma unroll
  for (int ks = 0; ks < 4; ks++) {
    bf16x8 a = *(const bf16x8*)(At + (wave * 16 + l16) * 136 + ks * 32 + quad * 8);
#pragma unroll
    for (int ni = 0; ni < 4; ni++) {
      bf16x8 b = *(const bf16x8*)(Bt_ + (ni * 16 + l16) * 136 + ks * 32 + quad * 8);
      acc[ni] = MFMA(a, b, acc[ni]);
    }
  }
#pragma unroll
  for (int ni = 0; ni < 4; ni++)
#pragma unroll
    for (int j = 0; j < 4; j++) Out[(wave * 16 + quad * 4 + j) * 65 + ni * 16 + l16] = acc[ni][j];
}
DEV void gdn_prep_task(const Params& p, int l, int t, char* lds) {
  char* ws_ = p.ws; asm volatile("" : "+s"(ws_));
  const int tid = otid(), lane = tid & 63, wave = tid >> 6, l16 = lane & 15, quad = lane >> 4;
  const int chunk = t >> 2, h = t & 3, row0 = chunk * 64;
  int sbeg, send;
  if (row0 < 4096) { sbeg = row0 & ~255; send = sbeg + 256; } else { sbeg = 4096 + ((row0 - 4096) & ~1023); send = sbeg + 1024; }
  bf16_t* Kt = (bf16_t*)lds;
  bf16_t* Qt = Kt + 64 * 136;
  float* F = (float*)(lds + 34816);
  float* G = F;
  float* Pm = (float*)(lds + 34816 + 17408);
  float* Am = Pm;
  float* gcs = (float*)(lds + LDS_SMALL);
  float* betas = gcs + 128;
  const float* GAB = (const float*)(ws_ + OFF_GAB);
  if (tid < 128) {
    const int dir = tid >> 6, ip = tid & 63, tok = dir ? 63 - ip : ip, row = row0 + tok;
    const float ga = GAB[(size_t)row * 16 + dir * 4 + h], gb = GAB[(size_t)row * 16 + 8 + dir * 4 + h];
    const float a = __expf(p.in[I_ALOG][(l * 2 + dir) * 4 + h]);
    const float x = ga + p.in[I_DTB][(l * 2 + dir) * 4 + h];
    const float ex = __expf(fminf(x, 20.f));
    const float sp = x > 20.f ? x : (ex < 0.01f ? ex * (1.f - ex * (0.5f - ex * (1.f / 3.f))) : __logf(1.f + ex));
    float g = -a * sp;
#pragma unroll
    for (int off = 1; off < 64; off <<= 1) { float v = __shfl_up(g, off); if (ip >= off) g += v; }
    gcs[dir * 64 + ip] = g;
    betas[dir * 64 + ip] = frcp(1.f + __expf(-gb));
  }
  conv_pass(p, l, 1, h, row0, sbeg, send, F, nullptr);
  __syncthreads();
  l2norm_rows(F, Kt);
  __syncthreads();
  conv_pass(p, l, 0, h, row0, sbeg, send, F, nullptr);
  __syncthreads();
  l2norm_rows(F, Qt);
  __syncthreads();
  mm64(Qt, Kt, Pm, wave, l16, quad);
  bf16_t* recbase = (bf16_t*)(ws_ + OFF_GDN) + (size_t)(chunk * 4 + h) * 2 * REC_EL;
#pragma unroll 1
  for (int dir = 0; dir < 2; dir++) {
    bf16_t* rec = recbase + (size_t)dir * REC_EL;
    const float* gc = gcs + dir * 64;
    const float gl = gc[63];
#pragma unroll
    for (int i = 0; i < 4; i++) {
      const int it = tid + 256 * i, ip = it >> 4, c8 = it & 15, tok = dir ? 63 - ip : ip;
      const float sc = 0.08838834764831845f * __expf(gc[ip]);
      float f[8]; unpack8(*(const u32x4*)(Qt + tok * 136 + c8 * 8), f);
#pragma unroll
      for (int j = 0; j < 8; j++) f[j] *= sc;
      *(u32x4*)(rec + 8192 + ip * 128 + c8 * 8) = pack8(f);
    }
#pragma unroll
    for (int i = 0; i < 4; i++) {
      const int it = tid + 256 * i, d = it & 127, ig = it >> 7;
      float f[8];
#pragma unroll
      for (int j = 0; j < 8; j++) { const int ip = ig * 8 + j, tok = dir ? 63 - ip : ip; f[j] = bf2f(Kt[tok * 136 + d]) * __expf(gl - gc[ip]); }
      *(u32x4*)(rec + 20480 + d * 64 + ig * 8) = pack8(f);
    }
    if (tid == 0) ((float*)(ws_ + OFF_EGL))[(chunk * 4 + h) * 2 + dir] = __expf(gl);
  }
  __syncthreads();
  conv_pass(p, l, 2, h, row0, sbeg, send, nullptr, Qt);
#pragma unroll 1
  for (int dir = 0; dir < 2; dir++) {
    bf16_t* rec = recbase + (size_t)dir * REC_EL;
    const float* gc = gcs + dir * 64;
#pragma unroll
    for (int i = 0; i < 2; i++) {
      const int it = tid + 256 * i, ip = it >> 3, j8 = it & 7, ti = dir ? 63 - ip : ip;
      float f[8];
#pragma unroll
      for (int j = 0; j < 8; j++) {
        const int jp = j8 * 8 + j, tj = dir ? 63 - jp : jp;
        const float e = __expf(fminf(gc[ip] - gc[jp], 0.f));
        f[j] = (ip >= jp) ? Pm[ti * 65 + tj] * 0.08838834764831845f * e : 0.f;
      }
      *(u32x4*)(rec + 16384 + ip * 64 + j8 * 8) = pack8(f);
    }
  }
  __syncthreads();
  const bf16_t* Vtile = Qt;
  float* T = G;
#pragma unroll 1
  for (int dir = 0; dir < 2; dir++) {
    bf16_t* rec = recbase + (size_t)dir * REC_EL;
    const float* gc = gcs + dir * 64;
    const float* be = betas + dir * 64;
    mm64(Kt, Kt, G, wave, l16, quad);
    __syncthreads();
#pragma unroll 2
    for (int i = 0; i < 16; i++) {
      const int it = tid + 256 * i, ip = it >> 6, jp = it & 63;
      const int ti = dir ? 63 - ip : ip, tj = dir ? 63 - jp : jp;
      const float e = __expf(fminf(gc[ip] - gc[jp], 0.f));
      Am[ip * 68 + jp] = (ip > jp) ? be[ip] * G[ti * 65 + tj] * e : 0.f;
    }
    __syncthreads();
    {
      const int cl = lane >> 2, q = lane & 3, c = wave * 16 + cl;
      float r[16];
#pragma unroll
      for (int m = 0; m < 16; m++) r[m] = (q + 4 * m == c) ? 1.f : 0.f;
#pragma unroll
      for (int j = 0; j < 63; j++) {
        const int mj = j >> 2;
        float t;
        switch (j & 3) {
          case 0: t = __int_as_float(__builtin_amdgcn_update_dpp(0, __float_as_int(r[mj]), 0x00, 0xF, 0xF, true)); break;
          case 1: t = __int_as_float(__builtin_amdgcn_update_dpp(0, __float_as_int(r[mj]), 0x55, 0xF, 0xF, true)); break;
          case 2: t = __int_as_float(__builtin_amdgcn_update_dpp(0, __float_as_int(r[mj]), 0xAA, 0xF, 0xF, true)); break;
          default: t = __int_as_float(__builtin_amdgcn_update_dpp(0, __float_as_int(r[mj]), 0xFF, 0xF, 0xF, true)); break;
        }
#pragma unroll
        for (int m = mj; m < 16; m++) r[m] -= Am[(q + 4 * m) * 68 + j] * t;
        if ((j & 7) == 7) asm volatile("" ::: "memory");
      }
#pragma unroll
      for (int m = 0; m < 16; m++) T[(q + 4 * m) * 68 + c] = r[m];
    }
    __syncthreads();
#pragma unroll 1
    for (int which = 0; which < 2; which++) {
      const bf16_t* srcT = which ? Kt : Vtile;
      f32x4 ac[4][2];
      zero_acc<2>(ac);
#pragma unroll
      for (int ks = 0; ks < 2; ks++) {
        float cs[8];
        unsigned short e[2][8];
#pragma unroll
        for (int s = 0; s < 8; s++) {
          const int j = ks * 32 + quad * 8 + s, tok = dir ? 63 - j : j;
          cs[s] = which ? be[j] * __expf(gc[j]) : be[j];
#pragma unroll
          for (int nf = 0; nf < 2; nf++) e[nf][s] = srcT[tok * 136 + wave * 32 + nf * 16 + l16];
        }
        bf16x8 bfr[2];
#pragma unroll
        for (int nf = 0; nf < 2; nf++) {
          u32x4 v;
          v.x = e[nf][0] | ((unsigned)e[nf][1] << 16); v.y = e[nf][2] | ((unsigned)e[nf][3] << 16);
          v.z = e[nf][4] | ((unsigned)e[nf][5] << 16); v.w = e[nf][6] | ((unsigned)e[nf][7] << 16);
          bfr[nf] = as_frag(v);
        }
#pragma unroll
        for (int mi = 0; mi < 4; mi++) {
          const float* tr = T + (mi * 16 + l16) * 68 + ks * 32 + quad * 8;
          const f32x4 t0 = *(const f32x4*)tr, t1 = *(const f32x4*)(tr + 4);
          const float tv[8] = {t0.x, t0.y, t0.z, t0.w, t1.x, t1.y, t1.z, t1.w};
          float a[8], hi[8], lo[8];
#pragma unroll
          for (int s = 0; s < 8; s++) a[s] = tv[s] * cs[s];
          const u32x4 ph = pack8(a);
          unpack8(ph, hi);
#pragma unroll
          for (int s = 0; s < 8; s++) lo[s] = a[s] - hi[s];
          const bf16x8 fh = as_frag(ph), fl = as_frag(pack8(lo));
#pragma unroll
          for (int nf = 0; nf < 2; nf++) { ac[mi][nf] = MFMA(fh, bfr[nf], ac[mi][nf]); ac[mi][nf] = MFMA(fl, bfr[nf], ac[mi][nf]); }
        }
      }
      int qs = quad, ls = l16;
      asm volatile("" : "+v"(qs), "+v"(ls));
      bf16_t* dst = rec + (which ? 0 : 28672);
      const float sg = which ? -1.f : 1.f;
#pragma unroll
      for (int mi = 0; mi < 4; mi++)
#pragma unroll
        for (int nf = 0; nf < 2; nf++)
#pragma unroll
          for (int j = 0; j < 4; j++) {
            const int ip = mi * 16 + qs * 4 + j, col = wave * 32 + nf * 16 + ls;
            dst[ip * 128 + col] = f2bf(sg * ac[mi][nf][j]);
          }
    }
    __syncthreads();
  }
}

DEV void cmlp_task(const Params& p, int l, int t, char* lds) {
  char* ws_ = p.ws; asm volatile("" : "+s"(ws_));
  const int tid = otid(), lane = tid & 63, wave = tid >> 6, l16 = lane & 15, quad = lane >> 4;
  const int wm = wave >> 1, wn = wave & 1;
  const int c = t >> 2, g = t & 3, r0 = c * 128;
  const bf16_t* P3 = (const bf16_t*)(ws_ + OFF_P3);
  const bf16_t* P2 = (const bf16_t*)(ws_ + OFF_P2);
  bf16_t* BR = (bf16_t*)(ws_ + OFF_BR);
  bf16_t* VnT = (bf16_t*)lds;
  bf16_t* Ws = VnT + 128 * 136;
  float* mu = (float*)(lds + LDS_SMALL);
  float* rstd = mu + 128;
  {
    const int row = tid >> 1, half = tid & 1;
    const bf16_t* src = P3 + (size_t)(r0 + row) * P3W + 512 + half * 256;
    float s = 0.f, ss = 0.f;
#pragma unroll 16
    for (int i = 0; i < 32; i++) { float f[8]; unpack8(*(const u32x4*)(src + i * 8), f);
#pragma unroll
      for (int j = 0; j < 8; j++) { float y = geluf(f[j]); s += y; ss += y * y; } }
    s += __shfl_xor(s, 1); ss += __shfl_xor(ss, 1);
    const float mean = s * (1.f / 512.f), var = fmaxf(ss * (1.f / 512.f) - mean * mean, 0.f);
    if (!half) { mu[row] = mean; rstd[row] = __builtin_amdgcn_rsqf(var + EPSF); }
  }
  __syncthreads();
#pragma unroll
  for (int i = 0; i < 8; i++) {
    const int it = tid + 256 * i, q = it >> 4, c8 = it & 15;
    float f[8]; unpack8(*(const u32x4*)(P3 + (size_t)(r0 + q) * P3W + 512 + g * 128 + c8 * 8), f);
    const float m = mu[q], rs = rstd[q];
#pragma unroll
    for (int j = 0; j < 8; j++) {
      const int cc = c8 * 8 + j;
      const float val = (geluf(f[j]) - m) * rs * p.in[I_LNG][l * 512 + g * 128 + cc] + p.in[I_LNB][l * 512 + g * 128 + cc];
      VnT[cc * 136 + q] = f2bf(val);
    }
  }
#pragma unroll
  for (int i = 0; i < 16; i++) {
    const int it = tid + 256 * i, pp = it >> 5, q4 = it & 31;
    const f32x4 w = *(const f32x4*)(p.in[I_WS] + ((size_t)(l * 4 + g) * 128 + pp) * 128 + q4 * 4);
    *(u32x2*)(Ws + pp * 136 + q4 * 4) = pack4(w.x, w.y, w.z, w.w);
  }
  __syncthreads();
  f32x4 acc[4][4]; zero_acc<4>(acc);
#pragma unroll
  for (int ks = 0; ks < 4; ks++) {
    bf16x8 a[4], b[4];
#pragma unroll
    for (int mi = 0; mi < 4; mi++) a[mi] = *(const bf16x8*)(Ws + (wm * 64 + mi * 16 + l16) * 136 + ks * 32 + quad * 8);
#pragma unroll
    for (int ni = 0; ni < 4; ni++) b[ni] = *(const bf16x8*)(VnT + (wn * 64 + ni * 16 + l16) * 136 + ks * 32 + quad * 8);
#pragma unroll
    for (int mi = 0; mi < 4; mi++)
#pragma unroll
      for (int ni = 0; ni < 4; ni++) acc[mi][ni] = MFMA(a[mi], b[ni], acc[mi][ni]);
  }
  float* Cs = (float*)lds;
  __syncthreads();
#pragma unroll
  for (int mi = 0; mi < 4; mi++)
#pragma unroll
    for (int j = 0; j < 4; j++) {
      const int pp = wm * 64 + mi * 16 + quad * 4 + j;
      const float bias = p.in[I_BS][(l * 4 + g) * 128 + pp];
#pragma unroll
      for (int ni = 0; ni < 4; ni++) Cs[pp * 132 + wn * 64 + ni * 16 + l16] = acc[mi][ni][j] + bias;
    }
  __syncthreads();
  u32x4 uu[8], zz[8];
#pragma unroll
  for (int i = 0; i < 8; i++) {
    const int it = tid + 256 * i, r = it >> 4, c8 = it & 15;
    const size_t row = (size_t)(r0 + r);
    uu[i] = *(const u32x4*)(P3 + row * P3W + g * 128 + c8 * 8);
    zz[i] = *(const u32x4*)(P2 + row * P2W + 1024 + g * 128 + c8 * 8);
  }
#pragma unroll
  for (int i = 0; i < 8; i++) {
    const int it = tid + 256 * i, r = it >> 4, c8 = it & 15;
    float u[8], z[8], o[8];
    unpack8(uu[i], u); unpack8(zz[i], z);
    const f32x4 s0 = *(const f32x4*)(Cs + r * 132 + c8 * 8), s1 = *(const f32x4*)(Cs + r * 132 + c8 * 8 + 4);
    const float sv[8] = {s0.x, s0.y, s0.z, s0.w, s1.x, s1.y, s1.z, s1.w};
#pragma unroll
    for (int j = 0; j < 8; j++) o[j] = geluf(u[j]) * sv[j] * siluf(z[j]);
    *(u32x4*)(BR + (size_t)(r0 + r) * BRW + 1024 + g * 128 + c8 * 8) = pack8(o);
  }
}

DEV void attn_task(const Params& p, int l, int t, char* lds) {
  char* ws_ = p.ws; asm volatile("" : "+s"(ws_));
  const int tid = otid(), lane = tid & 63, wave = tid >> 6, l16 = lane & 15, quad = lane >> 4;
  int b, h, qrow0, nkt, Tk; size_t vtb;
  const bool lat = t < 256;
  if (lat) { b = t >> 6; h = (t >> 3) & 7; const int qb = t & 7; qrow0 = 4096 + b * 1024 + qb * 128; nkt = 20; Tk = 1280; vtb = VT_LAT_EL + (size_t)(b * 8 + h) * 64 * 1280; }
  else { const int tt = t - 256; b = tt >> 4; h = (tt >> 1) & 7; const int qb = tt & 1; qrow0 = b * 256 + qb * 128; nkt = 4; Tk = 256; vtb = (size_t)(b * 8 + h) * 64 * 256; }
  const bf16_t* Qg = (const bf16_t*)(ws_ + OFF_Q);
  const bf16_t* Kg = (const bf16_t*)(ws_ + OFF_K);
  const bf16_t* Vg = (const bf16_t*)(ws_ + OFF_VT) + vtb;
  bf16_t* Qs = (bf16_t*)lds;
  bf16_t* Ks = Qs + 128 * 104;
  bf16_t* Vs = Ks + 64 * 104;
#pragma unroll
  for (int i = 0; i < 6; i++) {
    const int it = tid + 256 * i, r = it / 12, cc = it % 12;
    *(u32x4*)(Qs + r * 104 + cc * 8) = *(const u32x4*)(Qg + ((size_t)(qrow0 + r) * 8 + h) * 96 + cc * 8);
  }
  __syncthreads();
  bf16x8 qf[2][3];
#pragma unroll
  for (int ni = 0; ni < 2; ni++)
#pragma unroll
    for (int ks = 0; ks < 3; ks++) qf[ni][ks] = *(const bf16x8*)(Qs + (wave * 32 + ni * 16 + l16) * 104 + ks * 32 + quad * 8);
  f32x4 o[4][2];
#pragma unroll
  for (int di = 0; di < 4; di++) { o[di][0] = f32x4{0.f, 0.f, 0.f, 0.f}; o[di][1] = f32x4{0.f, 0.f, 0.f, 0.f}; }
  float mrun[2] = {-1e30f, -1e30f}, lsum[2] = {0.f, 0.f};
  u32x4 pk[3], pv[2];
  {
    const int krow0 = lat ? (8192 + b * 256) : (b * 256);
#pragma unroll
    for (int i = 0; i < 3; i++) { const int it = tid + 256 * i, r = it / 12, cc = it % 12; pk[i] = *(const u32x4*)(Kg + ((size_t)(krow0 + r) * 8 + h) * 96 + cc * 8); }
#pragma unroll
    for (int i = 0; i < 2; i++) { const int it = tid + 256 * i, dv = it >> 3, kg = it & 7; pv[i] = *(const u32x4*)(Vg + (size_t)dv * Tk + kg * 8); }
  }
  for (int kt = 0; kt < nkt; kt++) {
    __syncthreads();
#pragma unroll
    for (int i = 0; i < 3; i++) { const int it = tid + 256 * i, r = it / 12, cc = it % 12; *(u32x4*)(Ks + r * 104 + cc * 8) = pk[i]; }
#pragma unroll
    for (int i = 0; i < 2; i++) { const int it = tid + 256 * i, dv = it >> 3, kg = it & 7; *(u32x4*)(Vs + dv * 72 + kg * 8) = pv[i]; }
    __syncthreads();
    if (kt + 1 < nkt) {
      const int kn = kt + 1;
      int krow0;
      if (lat) krow0 = (kn < 4) ? (8192 + b * 256 + kn * 64) : (4096 + b * 1024 + (kn - 4) * 64);
      else krow0 = b * 256 + kn * 64;
#pragma unroll
      for (int i = 0; i < 3; i++) { const int it = tid + 256 * i, r = it / 12, cc = it % 12; pk[i] = *(const u32x4*)(Kg + ((size_t)(krow0 + r) * 8 + h) * 96 + cc * 8); }
#pragma unroll
      for (int i = 0; i < 2; i++) { const int it = tid + 256 * i, dv = it >> 3, kg = it & 7; pv[i] = *(const u32x4*)(Vg + (size_t)dv * Tk + kn * 64 + kg * 8); }
    }
    __builtin_amdgcn_sched_barrier(0);
    f32x4 s[4][2];
#pragma unroll
    for (int mi = 0; mi < 4; mi++) { s[mi][0] = f32x4{0.f, 0.f, 0.f, 0.f}; s[mi][1] = f32x4{0.f, 0.f, 0.f, 0.f}; }
#pragma unroll
    for (int ks = 0; ks < 3; ks++)
#pragma unroll
      for (int mi = 0; mi < 4; mi++) {
        bf16x8 kf = *(const bf16x8*)(Ks + (mi * 16 + l16) * 104 + ks * 32 + quad * 8);
        s[mi][0] = MFMA(kf, qf[0][ks], s[mi][0]);
        s[mi][1] = MFMA(kf, qf[1][ks], s[mi][1]);
      }
#pragma unroll
    for (int ni = 0; ni < 2; ni++) {
      float mx = -1e30f;
#pragma unroll
      for (int mi = 0; mi < 4; mi++)
#pragma unroll
        for (int j = 0; j < 4; j++) mx = fmaxf(mx, s[mi][ni][j]);
      mx = fmaxf(mx, __shfl_xor(mx, 16)); mx = fmaxf(mx, __shfl_xor(mx, 32));
      const float mnew = fmaxf(mrun[ni], mx);
      const float alpha = __builtin_amdgcn_exp2f(mrun[ni] - mnew);
      mrun[ni] = mnew;
      float rsum = 0.f;
#pragma unroll
      for (int mi = 0; mi < 4; mi++)
#pragma unroll
        for (int j = 0; j < 4; j++) { float pv = __builtin_amdgcn_exp2f(s[mi][ni][j] - mnew); s[mi][ni][j] = pv; rsum += pv; }
      lsum[ni] = lsum[ni] * alpha + rsum;
#pragma unroll
      for (int di = 0; di < 4; di++) o[di][ni] *= alpha;
    }
#pragma unroll
    for (int g = 0; g < 2; g++) {
      bf16x8 pf0 = frag_from(s[2 * g][0], s[2 * g + 1][0]);
      bf16x8 pf1 = frag_from(s[2 * g][1], s[2 * g + 1][1]);
#pragma unroll
      for (int di = 0; di < 4; di++) {
        bf16x8 vf = ld2(Vs + (di * 16 + l16) * 72 + g * 32 + quad * 4);
        o[di][0] = MFMA(vf, pf0, o[di][0]);
        o[di][1] = MFMA(vf, pf1, o[di][1]);
      }
    }
  }
  const bf16_t* P2 = (const bf16_t*)(ws_ + OFF_P2);
  bf16_t* BR = (bf16_t*)(ws_ + OFF_BR);
#pragma unroll
  for (int ni = 0; ni < 2; ni++) {
    float lt = lsum[ni];
    lt += __shfl_xor(lt, 16); lt += __shfl_xor(lt, 32);
    const float inv = frcp(lt);
    const size_t qrow = (size_t)(qrow0 + wave * 32 + ni * 16 + l16);
#pragma unroll
    for (int di = 0; di < 4; di++) {
      const int col = h * 64 + di * 16 + quad * 4;
      float z[4]; unpack4(*(const u32x2*)(P2 + qrow * P2W + col), z);
      *(u32x2*)(BR + qrow * BRW + col) = pack4(o[di][ni][0] * inv * siluf(z[0]), o[di][ni][1] * inv * siluf(z[1]),
                                               o[di][ni][2] * inv * siluf(z[2]), o[di][ni][3] * inv * siluf(z[3]));
    }
  }
}

struct ScanPf { u32x4 w[4], q[4], a[2], k[4], u[2]; float egl; };
DEV void scan_prefetch(ScanPf& f, const bf16_t* rec, const float* eglp, int half, int tid) {
#pragma unroll
  for (int i = 0; i < 4; i++) { const int c = tid + 256 * i; f.w[i] = *(const u32x4*)(rec + c * 8); f.q[i] = *(const u32x4*)(rec + 8192 + c * 8); f.k[i] = *(const u32x4*)(rec + 20480 + c * 8); }
#pragma unroll
  for (int i = 0; i < 2; i++) { const int c = tid + 256 * i; f.a[i] = *(const u32x4*)(rec + 16384 + c * 8); f.u[i] = *(const u32x4*)(rec + 28672 + (c >> 3) * 128 + half * 64 + (c & 7) * 8); }
  f.egl = *eglp;
}
DEV void gdn_scan_task(const Params& p, int l, int t, char* lds) {
  char* ws_ = p.ws; asm volatile("" : "+s"(ws_));
  const int tid = otid(), lane = tid & 63, wave = tid >> 6, l16 = lane & 15, quad = lane >> 4;
  __builtin_amdgcn_s_setprio(3);
  int chain, half, b, chunk0, N; bool lat = t < 64;
  if (lat) { chain = t >> 1; half = t & 1; } else { chain = (t - 64) >> 1; half = (t - 64) & 1; }
  const int dir = chain & 1, h = (chain >> 1) & 3;
  b = chain >> 3;
  if (lat) { chunk0 = 64 + b * 16; N = 16; } else { chunk0 = b * 4; N = 4; }
  const int e0 = (half * 4 + wave) * 16;
  bf16_t* Wl = (bf16_t*)lds;
  bf16_t* Ql = Wl + 64 * 136;
  bf16_t* Al = Ql + 64 * 136;
  bf16_t* Kl = Al + 64 * 72;
  bf16_t* Ul = Kl + 128 * 72;
  f32x4 S[8];
  if (lat) {
    const float* s0 = p.in[I_SGDN] + ((size_t)((b * 2 + l) * 2 + dir) * 4 + h) * 16384;
#pragma unroll
    for (int mf = 0; mf < 8; mf++)
#pragma unroll
      for (int j = 0; j < 4; j++) S[mf][j] = s0[(mf * 16 + quad * 4 + j) * 128 + e0 + l16];
  } else {
#pragma unroll
    for (int mf = 0; mf < 8; mf++) S[mf] = f32x4{0.f, 0.f, 0.f, 0.f};
  }
  float* OD = (float*)(ws_ + OFF_ODIR) + (size_t)dir * NTOK * 512;
  const float* EGL = (const float*)(ws_ + OFF_EGL);
  const bf16_t* GD = (const bf16_t*)(ws_ + OFF_GDN);
  ScanPf pf;
  {
    const int cidx = chunk0 + (dir ? N - 1 : 0);
    scan_prefetch(pf, GD + ((size_t)(cidx * 4 + h) * 2 + dir) * REC_EL, EGL + (cidx * 4 + h) * 2 + dir, half, tid);
  }
#pragma unroll 1
  for (int n = 0; n < N; n++) {
    const int cidx = chunk0 + (dir ? N - 1 - n : n);
    __syncthreads();
#pragma unroll
    for (int i = 0; i < 4; i++) {
      const int c = tid + 256 * i;
      *(u32x4*)(Wl + (c >> 4) * 136 + (c & 15) * 8) = pf.w[i];
      *(u32x4*)(Ql + (c >> 4) * 136 + (c & 15) * 8) = pf.q[i];
      *(u32x4*)(Kl + (c >> 3) * 72 + (c & 7) * 8) = pf.k[i];
    }
#pragma unroll
    for (int i = 0; i < 2; i++) {
      const int c = tid + 256 * i;
      *(u32x4*)(Al + (c >> 3) * 72 + (c & 7) * 8) = pf.a[i];
      *(u32x4*)(Ul + (c >> 3) * 72 + (c & 7) * 8) = pf.u[i];
    }
    const float egl = pf.egl;
    __syncthreads();
    if (n + 1 < N) {
      const int cn = chunk0 + (dir ? N - 2 - n : n + 1);
      scan_prefetch(pf, GD + ((size_t)(cn * 4 + h) * 2 + dir) * REC_EL, EGL + (cn * 4 + h) * 2 + dir, half, tid);
    }
    __builtin_amdgcn_sched_barrier(0);
    bf16x8 Sb[4];
#pragma unroll
    for (int ks = 0; ks < 4; ks++) Sb[ks] = frag_from(S[2 * ks], S[2 * ks + 1]);
    f32x4 vn[4];
#pragma unroll
    for (int mi = 0; mi < 4; mi++)
#pragma unroll
      for (int j = 0; j < 4; j++) vn[mi][j] = bf2f(Ul[(mi * 16 + quad * 4 + j) * 72 + wave * 16 + l16]);
#pragma unroll
    for (int mi = 0; mi < 4; mi++)
#pragma unroll
      for (int ks = 0; ks < 4; ks++) vn[mi] = MFMA(ld2(Wl + (mi * 16 + l16) * 136 + ks * 32 + quad * 4), Sb[ks], vn[mi]);
    bf16x8 vb[2];
    vb[0] = frag_from(vn[0], vn[1]); vb[1] = frag_from(vn[2], vn[3]);
#pragma unroll
    for (int mi = 0; mi < 4; mi++) {
      f32x4 o = f32x4{0.f, 0.f, 0.f, 0.f};
#pragma unroll
      for (int ks = 0; ks < 4; ks++) o = MFMA(ld2(Ql + (mi * 16 + l16) * 136 + ks * 32 + quad * 4), Sb[ks], o);
#pragma unroll
      for (int k2 = 0; k2 < 2; k2++) o = MFMA(ld2(Al + (mi * 16 + l16) * 72 + k2 * 32 + quad * 4), vb[k2], o);
#pragma unroll
      for (int j = 0; j < 4; j++) {
        const int ip = mi * 16 + quad * 4 + j, tok = dir ? 63 - ip : ip;
        OD[(size_t)(cidx * 64 + tok) * 512 + h * 128 + e0 + l16] = o[j];
      }
    }
#pragma unroll
    for (int mf = 0; mf < 8; mf++) {
      S[mf] *= egl;
#pragma unroll
      for (int k2 = 0; k2 < 2; k2++) S[mf] = MFMA(ld2(Kl + (mf * 16 + l16) * 72 + k2 * 32 + quad * 4), vb[k2], S[mf]);
    }
  }
  if (!lat) {
    float* so = p.out + OUT_STATE + ((size_t)((b * 2 + l) * 2 + dir) * 4 + h) * 16384;
#pragma unroll
    for (int mf = 0; mf < 8; mf++)
#pragma unroll
      for (int j = 0; j < 4; j++) so[(mf * 16 + quad * 4 + j) * 128 + e0 + l16] = S[mf][j];
  }
  __builtin_amdgcn_s_setprio(0);
}

DEV void onorm_task(const Params& p, int l, int t) {
  char* ws_ = p.ws; asm volatile("" : "+s"(ws_));
  const int tid = otid(), lane = tid & 63, wave = tid >> 6;
  const float* OD = (const float*)(ws_ + OFF_ODIR);
  const bf16_t* P2 = (const bf16_t*)(ws_ + OFF_P2);
  bf16_t* BR = (bf16_t*)(ws_ + OFF_BR);
#pragma unroll
  for (int rr = 0; rr < 4; rr++) {
    const size_t row = (size_t)t * 16 + wave * 4 + rr;
    const f32x4 a0 = *(const f32x4*)(OD + row * 512 + lane * 8), a1 = *(const f32x4*)(OD + row * 512 + lane * 8 + 4);
    const f32x4 b0 = *(const f32x4*)(OD + (NTOK + row) * 512 + lane * 8), b1 = *(const f32x4*)(OD + (NTOK + row) * 512 + lane * 8 + 4);
    float x[8] = {a0.x + b0.x, a0.y + b0.y, a0.z + b0.z, a0.w + b0.w, a1.x + b1.x, a1.y + b1.y, a1.z + b1.z, a1.w + b1.w};
    float ss = 0.f;
#pragma unroll
    for (int i = 0; i < 8; i++) ss += x[i] * x[i];
#pragma unroll
    for (int o = 8; o >= 1; o >>= 1) ss += __shfl_xor(ss, o);
    const float rstd = __builtin_amdgcn_rsqf(ss * (1.f / 128.f) + EPSF);
    float z[8]; unpack8(*(const u32x4*)(P2 + row * P2W + 512 + lane * 8), z);
    const float* g = p.in[I_ONORM] + l * 128 + (lane & 15) * 8;
    float y[8];
#pragma unroll
    for (int i = 0; i < 8; i++) y[i] = x[i] * rstd * g[i] * siluf(z[i]);
    *(u32x4*)(BR + row * BRW + 512 + lane * 8) = pack8(y);
  }
}

DEV void gate_task(const Params& p, int l, int t, char* lds) {
  char* ws_ = p.ws; asm volatile("" : "+s"(ws_));
  const int tid = otid();
  const int nt = t / 64, mt = t % 64;
  f32x4 acc[4][4]; zero_acc<4>(acc);
  ALPlain al{(const bf16_t*)(ws_ + OFF_H) + (size_t)mt * 128 * 1024, 1024};
  gemm_core<128>(al, (const bf16_t*)(ws_ + OFF_WGL) + (size_t)nt * 128 * 1024, 1024, 1024, acc, lds);
  float* Cs = (float*)lds;
  acc_to_lds<128>(acc, Cs);
  bf16_t* GT = (bf16_t*)(ws_ + OFF_GDN);
#pragma unroll
  for (int i = 0; i < 8; i++) {
    const int it = tid + 256 * i, r = it >> 4, c8 = it & 15;
    const f32x4 a = *(const f32x4*)(Cs + r * 132 + c8 * 8), b = *(const f32x4*)(Cs + r * 132 + c8 * 8 + 4);
    float f[8] = {sigmf(a.x), sigmf(a.y), sigmf(a.z), sigmf(a.w), sigmf(b.x), sigmf(b.y), sigmf(b.z), sigmf(b.w)};
    *(u32x4*)(GT + (size_t)(mt * 128 + r) * 3072 + nt * 128 + c8 * 8) = pack8(f);
  }
}
DEV void d1_task(const Params& p, int l, int t, char* lds) {
  char* ws_ = p.ws; asm volatile("" : "+s"(ws_));
  const int tid = otid(), lane = tid & 63, wave = tid >> 6, l16 = lane & 15, quad = lane >> 4;
  const int wm = wave >> 1, wn = wave & 1;
  const int nt = t >> 6, mt = t & 63;
  const bf16_t* GT = (const bf16_t*)(ws_ + OFF_GDN);
  f32x4 macc[4][2]; zero_acc<2>(macc);
#pragma unroll 1
  for (int n = 0; n < 3; n++) {
    unsigned short gv[4][2][4];
#pragma unroll
    for (int mi = 0; mi < 4; mi++)
#pragma unroll
      for (int ni = 0; ni < 2; ni++)
#pragma unroll
        for (int j = 0; j < 4; j++)
          gv[mi][ni][j] = GT[(size_t)(mt * 128 + wm * 64 + mi * 16 + quad * 4 + j) * 3072 + n * 1024 + nt * 64 + wn * 32 + ni * 16 + l16];
    f32x4 y[4][2]; zero_acc<2>(y);
    ALPlain alb{(const bf16_t*)(ws_ + OFF_BR) + (size_t)mt * 128 * BRW + n * 512, BRW};
    gemm_core<64>(alb, (const bf16_t*)(ws_ + OFF_WBR) + (size_t)(n * 1024 + nt * 64) * 512, 512, 512, y, lds);
#pragma unroll
    for (int mi = 0; mi < 4; mi++)
#pragma unroll
      for (int ni = 0; ni < 2; ni++)
#pragma unroll
        for (int j = 0; j < 4; j++) macc[mi][ni][j] += bf2f(gv[mi][ni][j]) * y[mi][ni][j];
  }
  float* Cs = (float*)lds;
  acc_to_lds<64>(macc, Cs);
  bf16_t* M = (bf16_t*)(ws_ + OFF_M);
#pragma unroll
  for (int i = 0; i < 4; i++) {
    const int it = tid + 256 * i, r = it >> 3, c8 = it & 7;
    float f[8];
#pragma unroll
    for (int j = 0; j < 8; j++) f[j] = Cs[r * 68 + c8 * 8 + j];
    *(u32x4*)(M + (size_t)(mt * 128 + r) * 1024 + nt * 64 + c8 * 8) = pack8(f);
  }
}

DEV void d2_task(const Params& p, int l, int t, char* lds) {
  char* ws_ = p.ws; asm volatile("" : "+s"(ws_));
  const int tid = otid();
  const int nt = t >> 6, mt = t & 63;
  f32x4 acc[4][4]; zero_acc<4>(acc);
  ALPlain al{(const bf16_t*)(ws_ + OFF_M) + (size_t)mt * 128 * 1024, 1024};
  gemm_core<128>(al, (const bf16_t*)(ws_ + OFF_WO) + (size_t)nt * 128 * 1024, 1024, 1024, acc, lds);
  float* Cs = (float*)lds;
  acc_to_lds<128>(acc, Cs);
  const float* mod = (const float*)(ws_ + OFF_MOD);
#pragma unroll
  for (int i = 0; i < 8; i++) {
    const int it = tid + 256 * i, r = it >> 4, c8 = it & 15;
    const int row = mt * 128 + r, col = nt * 128 + c8 * 8;
    const float* x = xrow_ptr(p, l, row) + col;
    const float* gt = mod + (size_t)(l * 5 + modrow(row)) * 3072 + 2048 + col;
    const f32x4 y0 = *(const f32x4*)(Cs + r * 132 + c8 * 8), y1 = *(const f32x4*)(Cs + r * 132 + c8 * 8 + 4);
    const f32x4 x0 = *(const f32x4*)x, x1 = *(const f32x4*)(x + 4);
    const f32x4 g0 = *(const f32x4*)gt, g1 = *(const f32x4*)(gt + 4);
    float* o = p.out + (size_t)row * DM + col;
    *(f32x4*)o = f32x4{x0.x + g0.x * y0.x, x0.y + g0.y * y0.y, x0.z + g0.z * y0.z, x0.w + g0.w * y0.w};
    *(f32x4*)(o + 4) = f32x4{x1.x + g1.x * y1.x, x1.y + g1.y * y1.y, x1.z + g1.z * y1.z, x1.w + g1.w * y1.w};
  }
}

#define NPHASES 15
DEV int phase_nsub(int ph) {
  if (ph == 0) return 48 + 152;
  const int l = (ph - 1) / 7, s = (ph - 1) % 7;
  switch (s) {
    case 0: return 128 + (l == 0 ? 113 : 32);
    case 1: return 304 + (l == 0 ? 80 : 0);
    case 2: return 64 + 72 + 64;
    case 3: return 8 + 32 + 32 + 32 + 32 + (l == 0 ? 169 : 0);
    case 4: return 192 + 64;
    case 5: return 128 + (l == 0 ? 96 : 0);
    default: return 64 + (l == 0 ? 48 : 0);
  }
}
DEV void run_task(const Params& p, int ph, int x, int i, char* lds) {
  if (ph == 0) { if (i < 48) mod_task(p, i * 8 + x, lds); else convert_task(p, 0, (i - 48) * 8 + x, lds); return; }
  const int l = (ph - 1) / 7, s = (ph - 1) % 7;
  switch (s) {
    case 0:
      if (i < 128) norm_task(p, l, i * 8 + x);
      else if (l == 0) convert_task(p, 0, 1216 + (i - 128) * 8 + x, lds);
      else convert_task(p, 1, 2504 + (i - 128) * 8 + x, lds);
      break;
    case 1:
      if (i < 304) projA_task(p, l, (i >> 3) * 64 + (i & 7) * 8 + x, lds);
      else convert_task(p, 0, 2120 + (i - 304) * 8 + x, lds);
      break;
    case 2:
      if (i < 64) gdn_prep_task(p, l, i * 8 + x, lds);
      else if (i < 136) { const int j = i - 64; kv_task(p, l, (j / 9) * 72 + (j % 9) * 8 + x, lds); }
      else { const int j = i - 136; q_task(p, l, (j >> 3) * 64 + (j & 7) * 8 + x, lds); }
      break;
    case 3:
      if (i < 8) gdn_scan_task(p, l, i * 8 + x, lds);
      else if (i < 40) attn_task(p, l, x * 32 + (i - 8), lds);
      else if (i < 72) gdn_scan_task(p, l, 64 + (i - 40) * 8 + x, lds);
      else if (i < 104) attn_task(p, l, 256 + x * 32 + (i - 72), lds);
      else if (i < 136) cmlp_task(p, l, (i - 104) * 8 + x, lds);
      else if (i < 288) convert_task(p, 1, (i - 136) * 8 + x, lds);
      else convert_task(p, 1, 1984 + (i - 288) * 8 + x, lds);
      break;
    case 4:
      if (i < 192) gate_task(p, l, (i >> 3) * 64 + (i & 7) * 8 + x, lds);
      else onorm_task(p, l, (i - 192) * 8 + x);
      break;
    case 5:
      if (i < 128) d1_task(p, l, (i >> 3) * 64 + (i & 7) * 8 + x, lds);
      else convert_task(p, 1, 1216 + (i - 128) * 8 + x, lds);
      break;
    case 6:
      if (i < 64) d2_task(p, l, (i >> 3) * 64 + (i & 7) * 8 + x, lds);
      else convert_task(p, 1, 2120 + (i - 64) * 8 + x, lds);
      break;
  }
}
#ifndef REP_S
#define REP_S -1
#endif
DEV void run_phase(const Params& p, int ph, char* lds, int* sh, int myx, int rep = 0, int rank = 0, int nloc = 0) {
  unsigned* cb = (unsigned*)(p.ws + OFF_CTR) + ph * 128 + rep * 6144;
  const int n = phase_nsub(ph);
  if (nloc > 0) {
#pragma unroll 1
    for (int i = rank; i < n; i += nloc) { __syncthreads(); run_task(p, ph, myx, i, lds); }
    return;
  }
#pragma unroll 1
  for (int xo = 0; xo < 8; xo++) {
    const int x = (myx + xo) & 7;
    unsigned* c = cb + x * 16;
    int i;
    while ((i = next_task(c, sh, n, xo > 0)) < n) run_task(p, ph, x, i, lds);
  }
}

__global__ void __launch_bounds__(256, 2) k_phase(Params p, int ph) {
  __shared__ __attribute__((aligned(16))) char lds[LDS_BYTES];
  __shared__ int sh[4];
  const Params& pr = *(const Params*)__builtin_amdgcn_kernarg_segment_ptr();
  run_phase(pr, ph, lds, sh, (int)(xb_xcc_id() & 7u));
}

__global__ void __launch_bounds__(256, 2) k_mega(Params p) {
  __shared__ __attribute__((aligned(16))) char lds[LDS_BYTES];
  __shared__ __attribute__((aligned(16))) unsigned xbw[4];
  __shared__ int sh[4];
  const Params& pr = *(const Params*)__builtin_amdgcn_kernarg_segment_ptr();
  if (threadIdx.x == 0) { xbw[0] = 0u; xbw[1] = 0u; xbw[2] = 0u; xbw[3] = 0u; }
  __syncthreads();
  XcdBarrier xb = xcd_barrier_post((unsigned*)(pr.ws + OFF_BAR), (volatile LAS unsigned*)xbw);
  const int myx = (int)(xb.x & 7u);
  if (pr.out == nullptr) cg::this_grid().sync();
#pragma unroll
  for (int ph = 0; ph < NPHASES; ph++) {
    {
      const int sub = ph > 0 ? (ph - 1) % 7 : -1;
      const bool uniform = (sub == 0 || sub == 1 || sub == 4 || sub == 5 || sub == 6);
      int nloc = 0, rank = 0;
      if (ph > 0 && uniform && xbw[1] == 8u) { nloc = (int)xbw[0]; rank = (int)xbw[2]; }
      run_phase(pr, ph, lds, sh, myx, 0, rank, nloc);
    }
    if ((REP_S == 7 && ph == 0) || (REP_S >= 0 && ph > 0 && (ph - 1) % 7 == REP_S && !(REP_S == 6 && ph > 7))) run_phase(pr, ph, lds, sh, myx, 1);
    if (ph + 1 < NPHASES) xcd_barrier(xb);
  }
}

extern "C" void kernel_launch(void* const* d_in, const int* in_sizes, int n_in, void* d_out, int out_size, void* d_ws,
                              size_t ws_size, hipStream_t stream) {
  Params p{};
  for (int i = 0; i < 27; i++) p.in[i] = (const float*)d_in[i];
  p.out = (float*)d_out;
  p.ws = (char*)d_ws;
  if (ws_size < WS_END) { fprintf(stderr, "workspace too small: %zu < %llu\n", ws_size, (unsigned long long)WS_END); return; }
  (void)hipMemsetAsync(d_ws, 0, 32768, stream);
#if COOP
  static int grid_blocks = 0;
  if (!grid_blocks) {
    int dev = 0, cus = 0, per_cu = 0;
    hipGetDevice(&dev);
    hipDeviceGetAttribute(&cus, hipDeviceAttributeMultiprocessorCount, dev);
    hipOccupancyMaxActiveBlocksPerMultiprocessor(&per_cu, k_mega, 256, 0);
    if (per_cu > 2) per_cu = 2;
    if (per_cu < 1) per_cu = 1;
    grid_blocks = cus * per_cu;
  }
  void* args[] = {&p};
  hipError_t e = hipLaunchCooperativeKernel((void*)k_mega, dim3(grid_blocks), dim3(256), args, 0, stream);
  if (e != hipSuccess) fprintf(stderr, "cooperative launch failed: %s (grid %d)\n", hipGetErrorString(e), grid_blocks);
#else
  for (int ph = 0; ph < NPHASES; ph++) k_phase<<<512, 256, 0, stream>>>(p, ph);
#endif
}
```

```cpp
#include <hip/hip_runtime.h>
#include <hip/hip_cooperative_groups.h>
#include <stdint.h>
#include <stdio.h>
namespace cg = cooperative_groups;

#ifndef COOP
#define COOP 1
#endif

typedef unsigned short bf16_t;
typedef __attribute__((ext_vector_type(8))) short bf16x8;
typedef __attribute__((ext_vector_type(4))) float f32x4;
typedef __attribute__((ext_vector_type(4))) unsigned int u32x4;
typedef __attribute__((ext_vector_type(2))) unsigned int u32x2;
#define DEV __device__ __forceinline__

#define NTOK 8192
#define DM 1024
#define DIN 7856
#define EPSF 1e-6f
#define P1W 2208
#define P3W 1024
#define P2W 1536
#define BRW 1536
#define REC_EL 36864

#define OFF_CTR  0ull
#define OFF_BAR  8192ull
#define OFF_MOD  32768ull
#define OFF_GAB  (OFF_MOD + 122880ull)
#define OFF_EGL  (OFF_GAB + 524288ull)
#define OFF_WTA  (OFF_EGL + 4096ull)
#define OFF_WGL  (OFF_WTA + 9961472ull)
#define OFF_WUQ  (OFF_WGL + 6291456ull)
#define OFF_WUKV (OFF_WUQ + 589824ull)
#define OFF_WBR  (OFF_WUKV + 524288ull)
#define OFF_WO   (OFF_WBR + 3145728ull)
#define OFF_H    (OFF_WO + 2097152ull)
#define OFF_P1   (OFF_H + 16777216ull)
#define OFF_ODIR OFF_P1
#define OFF_P3   (OFF_P1 + 36175872ull)
#define OFF_M    OFF_P3
#define OFF_P2   (OFF_P1 + 52953088ull)
#define OFF_GDN  (OFF_P2 + 25165824ull)
#define OFF_Q    (OFF_GDN + 75497472ull)
#define OFF_K    (OFF_Q + 12582912ull)
#define OFF_VT   (OFF_K + 14155776ull)
#define OFF_BR   (OFF_VT + 9437184ull)
#define WS_END   (OFF_BR + 25165824ull)
#define VT_LAT_EL 2097152

#define OUT_CKV   8388608
#define OUT_KROPE 10485760
#define OUT_STATE 10747904

#define LDS_BYTES 75776
#define LDS_SMALL 73728

struct Params {
  const float* in[27];
  float* out;
  char* ws;
};
enum { I_XP = 0, I_XS, I_CCKV, I_CKR, I_SGDN, I_C, I_CCTX, I_NORMG, I_WMOD, I_BMOD, I_WIN, I_QAN, I_WUQ, I_KVAN, I_WUKV,
       I_QN, I_KN, I_CONVW, I_ALOG, I_DTB, I_ONORM, I_LNG, I_LNB, I_WS, I_BS, I_WBR, I_WO };

DEV float bf2f(bf16_t b) { return __uint_as_float(((unsigned)b) << 16); }
typedef __bf16 hwbf2 __attribute__((ext_vector_type(2)));
typedef float hwf2 __attribute__((ext_vector_type(2)));
DEV unsigned pack2(float a, float b) { hwf2 v = {a, b}; return __builtin_bit_cast(unsigned, __builtin_convertvector(v, hwbf2)); }
DEV bf16_t f2bf(float f) { return (bf16_t)(pack2(f, 0.f) & 0xffffu); }
DEV void unpack8(u32x4 v, float* f) {
  f[0] = __uint_as_float(v.x << 16); f[1] = __uint_as_float(v.x & 0xffff0000u);
  f[2] = __uint_as_float(v.y << 16); f[3] = __uint_as_float(v.y & 0xffff0000u);
  f[4] = __uint_as_float(v.z << 16); f[5] = __uint_as_float(v.z & 0xffff0000u);
  f[6] = __uint_as_float(v.w << 16); f[7] = __uint_as_float(v.w & 0xffff0000u);
}
DEV void unpack4(u32x2 v, float* f) {
  f[0] = __uint_as_float(v.x << 16); f[1] = __uint_as_float(v.x & 0xffff0000u);
  f[2] = __uint_as_float(v.y << 16); f[3] = __uint_as_float(v.y & 0xffff0000u);
}
DEV u32x4 pack8(const float* f) {
  u32x4 v; v.x = pack2(f[0], f[1]); v.y = pack2(f[2], f[3]); v.z = pack2(f[4], f[5]); v.w = pack2(f[6], f[7]); return v;
}
DEV u32x2 pack4(float a, float b, float c, float d) { u32x2 v; v.x = pack2(a, b); v.y = pack2(c, d); return v; }
DEV bf16x8 as_frag(u32x4 v) { union { u32x4 u; bf16x8 b; } x; x.u = v; return x.b; }
DEV bf16x8 frag_from(f32x4 a, f32x4 b) {
  u32x4 v; v.x = pack2(a[0], a[1]); v.y = pack2(a[2], a[3]); v.z = pack2(b[0], b[1]); v.w = pack2(b[2], b[3]); return as_frag(v);
}
DEV bf16x8 ld2(const bf16_t* p) {
  u32x2 a = *(const u32x2*)p; u32x2 b = *(const u32x2*)(p + 16);
  u32x4 v; v.x = a.x; v.y = a.y; v.z = b.x; v.w = b.y; return as_frag(v);
}
DEV float frcp(float x) { return __builtin_amdgcn_rcpf(x); }
DEV float siluf(float x) { return x * frcp(1.f + __expf(-x)); }
DEV float sigmf(float x) { return frcp(1.f + __expf(-x)); }
DEV float geluf(float x) { float u = 0.7978845608028654f * (x + 0.044715f * x * x * x); return x * frcp(1.f + __expf(-2.f * u)); }
#define MFMA(a, b, c) __builtin_amdgcn_mfma_f32_16x16x32_bf16((a), (b), (c), 0, 0, 0)

DEV int otid() { int t = threadIdx.x; asm volatile("" : "+v"(t)); return t; }
DEV int next_task(unsigned* ctr, int* sh, int n, bool precheck) {
  __syncthreads();
  if (threadIdx.x == 0) {
    int v = n;
    if (!precheck || (int)__hip_atomic_load(ctr, __ATOMIC_RELAXED, __HIP_MEMORY_SCOPE_AGENT) < n) v = (int)atomicAdd(ctr, 1u);
    *sh = v;
  }
  __syncthreads();
  return *sh;
}

#define XB_TMO      128
#define XB_XCNT(j)  (256  + 64 * (j))
#define XB_XSUB(j)  (1280 + 64 * (j))
#define XB_XGEN(j)  (2304 + 64 * (j))
#define XB_TOP      3328
#define XB_TOPGEN   3392
#define XCD_BAR_WORDS 3456
#define XB_SPIN_CAP (1u << 22)
#define LAS __attribute__((address_space(3)))
DEV unsigned xb_ld(unsigned* p) { return __hip_atomic_load(p, __ATOMIC_RELAXED, __HIP_MEMORY_SCOPE_AGENT); }
DEV unsigned xb_add(unsigned* p, unsigned v) { return __hip_atomic_fetch_add(p, v, __ATOMIC_RELAXED, __HIP_MEMORY_SCOPE_AGENT); }
DEV unsigned xb_xcc_id() { return (unsigned)__builtin_amdgcn_s_getreg((3 << 11) | 20) & 0xFu; }
#define XB_SPIN(cond, bar) do { unsigned _sp = 0; while (cond) { __builtin_amdgcn_s_sleep(1); \
    if ((++_sp & 255u) == 0u) { if (xb_ld(&(bar)[XB_TMO])) break; if (_sp > XB_SPIN_CAP) { atomicAdd(&(bar)[XB_TMO], 1u); break; } } } } while (0)
struct XcdBarrier { unsigned* bar; unsigned x; volatile LAS unsigned* st; };
DEV XcdBarrier xcd_barrier_post(unsigned* bar, volatile LAS unsigned* st) {
  XcdBarrier b; b.bar = bar; b.x = xb_xcc_id(); b.st = st;
  if (threadIdx.x == 0) st[2] = xb_add(&bar[XB_XCNT(b.x)], 1u);
  return b;
}
DEV void xcd_barrier_complete(unsigned* bar, unsigned x, unsigned& nloc, unsigned& nx) {
  const unsigned G = gridDim.x * gridDim.y * gridDim.z;
  unsigned sum, cnt, mine, sp = 0u;
  for (;;) {
    sum = 0u; cnt = 0u; mine = 0u;
#pragma unroll
    for (unsigned j = 0; j < 16; ++j) { const unsigned c = xb_ld(&bar[XB_XCNT(j)]); sum += c; cnt += (c > 0u) ? 1u : 0u; mine = (j == x) ? c : mine; }
    if (sum == G) break;
    __builtin_amdgcn_s_sleep(1);
    if ((++sp & 255u) == 0u) { if (xb_ld(&bar[XB_TMO])) break; if (sp > XB_SPIN_CAP) { atomicAdd(&bar[XB_TMO], 1u); break; } }
  }
  nloc = mine > 0u ? mine : 1u; nx = cnt > 0u ? cnt : 1u;
}
DEV void xcd_barrier(const XcdBarrier& b) {
  asm volatile("s_waitcnt vmcnt(0)" ::: "memory");
  __syncthreads();
  if (threadIdx.x == 0) {
    unsigned* bar = b.bar;
    __builtin_amdgcn_s_waitcnt(0);
    unsigned nloc = b.st[0], nx = b.st[1];
    if (nloc == 0u) { xcd_barrier_complete(bar, b.x, nloc, nx); b.st[0] = nloc; b.st[1] = nx; }
    const unsigned old = xb_add(&bar[XB_XSUB(b.x)], 1u);
    const unsigned gen = old / nloc;
    if (old + 1u == (gen + 1u) * nloc) {
      __builtin_amdgcn_fence(__ATOMIC_RELEASE, "agent");
      asm volatile("s_waitcnt vmcnt(0)" ::: "memory");
      const unsigned og = xb_add(&bar[XB_TOP], 1u);
      const unsigned tg = og / nx;
      if (og + 1u == (tg + 1u) * nx) xb_add(&bar[XB_TOPGEN], 1u);
      else XB_SPIN(xb_ld(&bar[XB_TOPGEN]) == tg, bar);
      __builtin_amdgcn_fence(__ATOMIC_ACQUIRE, "agent");
      xb_add(&bar[XB_XGEN(b.x)], 1u);
      asm volatile("s_waitcnt vmcnt(0)" ::: "memory");
    } else {
      XB_SPIN(xb_ld(&bar[XB_XGEN(b.x)]) == gen, bar);
      __builtin_amdgcn_fence(__ATOMIC_ACQUIRE, "agent");
      asm volatile("s_waitcnt vmcnt(0)" ::: "memory");
    }
  }
  __syncthreads();
}

DEV const float* xrow_ptr(const Params& p, int l, int row) {
  if (l == 0) return row < 4096 ? p.in[I_XP] + (size_t)row * DM : p.in[I_XS] + (size_t)(row - 4096) * DM;
  return p.out + (size_t)row * DM;
}
DEV int modrow(int row) { return row < 4096 ? 0 : 1 + ((row - 4096) >> 10); }

struct ALPlain {
  const bf16_t* base; int ld;
  DEV u32x4 operator()(int row, int k) const { return *(const u32x4*)(base + (size_t)row * ld + k); }
};
struct ALScaled {
  const bf16_t* base; int ld; const float* rs; const float* g;
  DEV u32x4 operator()(int row, int k) const {
    u32x4 v = *(const u32x4*)(base + (size_t)row * ld + k);
    float f[8]; unpack8(v, f);
    const float r = rs[row];
    const f32x4 g0 = *(const f32x4*)(g + k), g1 = *(const f32x4*)(g + k + 4);
    f[0] *= r * g0.x; f[1] *= r * g0.y; f[2] *= r * g0.z; f[3] *= r * g0.w;
    f[4] *= r * g1.x; f[5] *= r * g1.y; f[6] *= r * g1.z; f[7] *= r * g1.w;
    return pack8(f);
  }
};
struct ALF32 {
  const float* base; int ld;
  DEV u32x4 operator()(int row, int k) const {
    const f32x4 a = *(const f32x4*)(base + (size_t)row * ld + k);
    const f32x4 b = *(const f32x4*)(base + (size_t)row * ld + k + 4);
    u32x4 v; v.x = pack2(a.x, a.y); v.y = pack2(a.z, a.w); v.z = pack2(b.x, b.y); v.w = pack2(b.z, b.w); return v;
  }
};

template <int TN>
DEV void gemm_compute(const bf16_t* As, const bf16_t* Bs, f32x4 (&acc)[4][TN / 32], int wm, int wn, int l16, int quad) {
  constexpr int NF = TN / 32;
#pragma unroll
  for (int ks = 0; ks < 2; ks++) {
    bf16x8 a[4], b[NF];
#pragma unroll
    for (int mi = 0; mi < 4; mi++) a[mi] = *(const bf16x8*)(As + (wm * 64 + mi * 16 + l16) * 72 + ks * 32 + quad * 8);
#pragma unroll
    for (int ni = 0; ni < NF; ni++) b[ni] = *(const bf16x8*)(Bs + (wn * (TN / 2) + ni * 16 + l16) * 72 + ks * 32 + quad * 8);
#pragma unroll
    for (int mi = 0; mi < 4; mi++)
#pragma unroll
      for (int ni = 0; ni < NF; ni++) acc[mi][ni] = MFMA(a[mi], b[ni], acc[mi][ni]);
  }
}
template <int TN, class AL>
DEV void gemm_core(const AL& al, const bf16_t* __restrict__ Bt, int ldb, int K, f32x4 (&acc)[4][TN / 32], char* lds) {
  constexpr int BUF = (128 + TN) * 72;
  constexpr int NF = TN / 32;
  bf16_t* L0 = (bf16_t*)lds;
  bf16_t* L1 = L0 + BUF;
  const int tid = otid(), lane = tid & 63, wave = tid >> 6;
  const int wm = wave >> 1, wn = wave & 1, l16 = lane & 15, quad = lane >> 4;
  u32x4 a0[4], b0[NF], a1[4], b1[NF];
#define G_LOAD(RA, RB, KK) { _Pragma("unroll") for (int i = 0; i < 4; i++) { int it = tid + 256 * i; RA[i] = al(it >> 3, (KK) + (it & 7) * 8); } \
                             _Pragma("unroll") for (int i = 0; i < NF; i++) { int it = tid + 256 * i; RB[i] = *(const u32x4*)(Bt + (size_t)(it >> 3) * ldb + (KK) + (it & 7) * 8); } }
#define G_STORE(LB, RA, RB) { _Pragma("unroll") for (int i = 0; i < 4; i++) { int it = tid + 256 * i; *(u32x4*)((LB) + (it >> 3) * 72 + (it & 7) * 8) = RA[i]; } \
                              _Pragma("unroll") for (int i = 0; i < NF; i++) { int it = tid + 256 * i; *(u32x4*)((LB) + 128 * 72 + (it >> 3) * 72 + (it & 7) * 8) = RB[i]; } }
  G_LOAD(a0, b0, 0);
  G_LOAD(a1, b1, 64);
  __syncthreads();
  G_STORE(L0, a0, b0);
  __syncthreads();
  for (int k0 = 0; k0 + 128 < K; k0 += 128) {
    G_LOAD(a0, b0, k0 + 128);
    __builtin_amdgcn_sched_barrier(0);
    gemm_compute<TN>(L0, L0 + 128 * 72, acc, wm, wn, l16, quad);
    G_STORE(L1, a1, b1);
    __syncthreads();
    G_LOAD(a1, b1, k0 + 192);
    __builtin_amdgcn_sched_barrier(0);
    gemm_compute<TN>(L1, L1 + 128 * 72, acc, wm, wn, l16, quad);
    G_STORE(L0, a0, b0);
    __syncthreads();
  }
  gemm_compute<TN>(L0, L0 + 128 * 72, acc, wm, wn, l16, quad);
  G_STORE(L1, a1, b1);
  __syncthreads();
  gemm_compute<TN>(L1, L1 + 128 * 72, acc, wm, wn, l16, quad);
#undef G_LOAD
#undef G_STORE
}

template <int TN>
DEV void acc_to_lds(f32x4 (&acc)[4][TN / 32], float* Cs) {
  const int tid = otid(), lane = tid & 63, wave = tid >> 6;
  const int wm = wave >> 1, wn = wave & 1, l16 = lane & 15, quad = lane >> 4;
  __syncthreads();
#pragma unroll
  for (int mi = 0; mi < 4; mi++)
#pragma unroll
    for (int ni = 0; ni < TN / 32; ni++)
#pragma unroll
      for (int j = 0; j < 4; j++)
        Cs[(wm * 64 + mi * 16 + quad * 4 + j) * (TN + 4) + wn * (TN / 2) + ni * 16 + l16] = acc[mi][ni][j];
  __syncthreads();
}
template <int NF>
DEV void zero_acc(f32x4 (&acc)[4][NF]) {
#pragma unroll
  for (int mi = 0; mi < 4; mi++)
#pragma unroll
    for (int ni = 0; ni < NF; ni++) acc[mi][ni] = f32x4{0.f, 0.f, 0.f, 0.f};
}

DEV void transpose_tile(const float* __restrict__ src, int ld, int col0, int ncols, int K, bf16_t* dst, int nt, int kt, float* tile) {
  const int tid = otid();
  const int n = tid & 63, kk = tid >> 6, gn = nt * 64 + n;
#pragma unroll
  for (int i = 0; i < 16; i++) {
    int k = kk + 4 * i;
    float v = (gn < ncols) ? src[(size_t)(kt * 64 + k) * ld + col0 + gn] : 0.f;
    tile[k * 65 + n] = v;
  }
  __syncthreads();
#pragma unroll
  for (int i = 0; i < 2; i++) {
    int it = tid + 256 * i, nn = it >> 3, kg = it & 7;
    float f[8];
#pragma unroll
    for (int j = 0; j < 8; j++) f[j] = tile[(kg * 8 + j) * 65 + nn];
    *(u32x4*)(dst + (size_t)(nt * 64 + nn) * K + kt * 64 + kg * 8) = pack8(f);
  }
}
#define NCONV_TASKS 2760
DEV void convert_task(const Params& p, int l, int t, char* lds) {
  char* ws_ = p.ws; asm volatile("" : "+s"(ws_));
  float* tile = (float*)lds;
  char* ws = ws_;
  if (t < 1216) { transpose_tile(p.in[I_WIN] + (size_t)l * 1024 * DIN, DIN, 0, 4784, 1024, (bf16_t*)(ws + OFF_WTA), t % 76, t / 76, tile); return; }
  t -= 1216;
  if (t < 768) { transpose_tile(p.in[I_WIN] + (size_t)l * 1024 * DIN, DIN, 4784, 3072, 1024, (bf16_t*)(ws + OFF_WGL), t % 48, t / 48, tile); return; }
  t -= 768;
  if (t < 72) { transpose_tile(p.in[I_WUQ] + (size_t)l * 384 * 768, 768, 0, 768, 384, (bf16_t*)(ws + OFF_WUQ), t % 12, t / 12, tile); return; }
  t -= 72;
  if (t < 64) { transpose_tile(p.in[I_WUKV] + (size_t)l * 256 * 1024, 1024, 0, 1024, 256, (bf16_t*)(ws + OFF_WUKV), t % 16, t / 16, tile); return; }
  t -= 64;
  if (t < 384) {
    int n = t / 128, tt = t % 128;
    transpose_tile(p.in[I_WBR] + (size_t)(l * 3 + n) * 512 * 1024, 1024, 0, 1024, 512, (bf16_t*)(ws + OFF_WBR) + (size_t)n * 1024 * 512, tt % 16, tt / 16, tile);
    return;
  }
  t -= 384;
  transpose_tile(p.in[I_WO] + (size_t)l * 1024 * 1024, 1024, 0, 1024, 1024, (bf16_t*)(ws + OFF_WO), t % 16, t / 16, tile);
}
DEV void mod_task(const Params& p, int t, char* lds) {
  char* ws_ = p.ws; asm volatile("" : "+s"(ws_));
  const int tid = otid();
  const int l = t / 192, n0 = (t % 192) * 16;
  float* s = (float*)lds;
  float* red = (float*)(lds + 32768);
  for (int idx = tid; idx < 5120; idx += 256) {
    int r = idx >> 10, k = idx & 1023;
    float v = (r == 0) ? p.in[I_CCTX][k] : p.in[I_C][(r - 1) * 1024 + k];
    s[idx] = v * frcp(1.f + __expf(-v));
  }
  __syncthreads();
  const int col = tid & 15, ksl = tid >> 4;
  float acc[5] = {0.f, 0.f, 0.f, 0.f, 0.f};
  const float* w = p.in[I_WMOD] + (size_t)l * 1024 * 3072 + n0 + col;
#pragma unroll 16
  for (int k = ksl * 64; k < ksl * 64 + 64; k++) {
    float wv = w[(size_t)k * 3072];
#pragma unroll
    for (int r = 0; r < 5; r++) acc[r] += s[r * 1024 + k] * wv;
  }
#pragma unroll
  for (int r = 0; r < 5; r++) red[(ksl * 5 + r) * 16 + col] = acc[r];
  __syncthreads();
  float* mod = (float*)(ws_ + OFF_MOD);
  if (tid < 80) {
    int r = tid >> 4, c = tid & 15;
    float v = p.in[I_BMOD][l * 3072 + n0 + c];
#pragma unroll
    for (int q = 0; q < 16; q++) v += red[(q * 5 + r) * 16 + c];
    mod[(l * 5 + r) * 3072 + n0 + c] = v;
  }
}

DEV void norm_task(const Params& p, int l, int t) {
  char* ws_ = p.ws; asm volatile("" : "+s"(ws_));
  const int tid = otid(), lane = tid & 63, wave = tid >> 6;
  const float* mod = (const float*)(ws_ + OFF_MOD);
  bf16_t* H = (bf16_t*)(ws_ + OFF_H);
#pragma unroll
  for (int rr = 0; rr < 2; rr++) {
    const int row = t * 8 + wave * 2 + rr;
    const float* x = xrow_ptr(p, l, row);
    const float* mr = mod + (size_t)(l * 5 + modrow(row)) * 3072;
    f32x4 v[4];
    float ss = 0.f;
#pragma unroll
    for (int i = 0; i < 4; i++) { v[i] = *(const f32x4*)(x + lane * 4 + 256 * i); ss += v[i].x * v[i].x + v[i].y * v[i].y + v[i].z * v[i].z + v[i].w * v[i].w; }
#pragma unroll
    for (int o = 32; o >= 1; o >>= 1) ss += __shfl_xor(ss, o);
    const float rstd = __builtin_amdgcn_rsqf(ss * (1.f / 1024.f) + EPSF);
#pragma unroll
    for (int i = 0; i < 4; i++) {
      const int col = lane * 4 + 256 * i;
      const f32x4 g = *(const f32x4*)(p.in[I_NORMG] + l * 1024 + col);
      const f32x4 sh = *(const f32x4*)(mr + col);
      const f32x4 sc = *(const f32x4*)(mr + 1024 + col);
      float a = v[i].x * rstd * g.x * (1.f + sc.x) + sh.x;
      float b = v[i].y * rstd * g.y * (1.f + sc.y) + sh.y;
      float c = v[i].z * rstd * g.z * (1.f + sc.z) + sh.z;
      float d = v[i].w * rstd * g.w * (1.f + sc.w) + sh.w;
      *(u32x2*)(H + (size_t)row * 1024 + col) = pack4(a, b, c, d);
    }
  }
}

DEV void projA_task(const Params& p, int l, int t, char* lds) {
  char* ws_ = p.ws; asm volatile("" : "+s"(ws_));
  const int tid = otid();
  const int nt = t / 64, mt = t % 64;
  f32x4 acc[4][4]; zero_acc<4>(acc);
  ALPlain al{(const bf16_t*)(ws_ + OFF_H) + (size_t)mt * 128 * 1024, 1024};
  gemm_core<128>(al, (const bf16_t*)(ws_ + OFF_WTA) + (size_t)nt * 128 * 1024, 1024, 1024, acc, lds);
  float* Cs = (float*)lds;
  acc_to_lds<128>(acc, Cs);
  bf16_t* P1 = (bf16_t*)(ws_ + OFF_P1);
  bf16_t* P2 = (bf16_t*)(ws_ + OFF_P2);
  bf16_t* P3 = (bf16_t*)(ws_ + OFF_P3);
  float* GAB = (float*)(ws_ + OFF_GAB);
#pragma unroll
  for (int i = 0; i < 8; i++) {
    const int it = tid + 256 * i, r = it >> 4, c8 = it & 15;
    const int n = nt * 128 + c8 * 8;
    if (n >= 4784) continue;
    const int row = mt * 128 + r;
    float f[8];
    const f32x4 a = *(const f32x4*)(Cs + r * 132 + c8 * 8);
    const f32x4 b = *(const f32x4*)(Cs + r * 132 + c8 * 8 + 4);
    f[0] = a.x; f[1] = a.y; f[2] = a.z; f[3] = a.w; f[4] = b.x; f[5] = b.y; f[6] = b.z; f[7] = b.w;
    if (n >= 2720 && n < 2736) {
      *(f32x4*)(GAB + (size_t)row * 16 + (n - 2720)) = a;
      *(f32x4*)(GAB + (size_t)row * 16 + (n - 2720) + 4) = b;
      continue;
    }
    if (n >= 640 && n < 672 && row < 4096) {
      float* o = p.out + OUT_KROPE + ((size_t)((row >> 8) * 2 + l) * 256 + (row & 255)) * 32 + (n - 640);
      *(f32x4*)o = a; *(f32x4*)(o + 4) = b;
    }
    bf16_t* dst;
    if (n < 672) dst = P1 + (size_t)row * P1W + n;
    else if (n < 1184) dst = P2 + (size_t)row * P2W + (n - 672);
    else if (n < 2720) dst = P1 + (size_t)row * P1W + 672 + (n - 1184);
    else if (n < 3248) dst = P2 + (size_t)row * P2W + 512 + (n - 2736);
    else if (n < 3760) dst = P3 + (size_t)row * P3W + (n - 3248);
    else if (n < 4272) dst = P3 + (size_t)row * P3W + 512 + (n - 3760);
    else dst = P2 + (size_t)row * P2W + 1024 + (n - 4272);
    *(u32x4*)dst = pack8(f);
  }
}

DEV void rope32(float* r, int prow, int pcol) {
  const float inv[8] = {1.f, 0.31622776601683794f, 0.1f, 0.031622776601683794f, 0.01f, 0.0031622776601683794f, 0.001f, 0.00031622776601683794f};
#pragma unroll
  for (int i = 0; i < 8; i++) {
    float a1 = (float)prow * inv[i], a2 = (float)pcol * inv[i];
    float c1 = __cosf(a1), s1 = __sinf(a1), c2 = __cosf(a2), s2 = __sinf(a2);
    float x1 = r[i], x2 = r[8 + i];
    r[i] = x1 * c1 - x2 * s1; r[8 + i] = x1 * s1 + x2 * c1;
    float y1 = r[16 + i], y2 = r[24 + i];
    r[16 + i] = y1 * c2 - y2 * s2; r[24 + i] = y1 * s2 + y2 * c2;
  }
}
DEV void finish_qk(float* v  , int half, const float* normw  , bool do_rope, int pos, float scale, bf16_t* dst  ) {
  float ss = 0.f;
#pragma unroll
  for (int i = 0; i < 48; i++) ss += v[i] * v[i];
  ss += __shfl_xor(ss, 1);
  const float rstd = __builtin_amdgcn_rsqf(ss * (1.f / 96.f) + EPSF);
#pragma unroll
  for (int i = 0; i < 12; i++) {
    const f32x4 w = *(const f32x4*)(normw + half * 48 + i * 4);
    v[i * 4] *= rstd * w.x; v[i * 4 + 1] *= rstd * w.y; v[i * 4 + 2] *= rstd * w.z; v[i * 4 + 3] *= rstd * w.w;
  }
  if (do_rope && half == 1) rope32(v + 16, pos >> 6, pos & 63);
#pragma unroll
  for (int i = 0; i < 6; i++) {
    float f[8];
#pragma unroll
    for (int j = 0; j < 8; j++) f[j] = v[i * 8 + j] * scale;
    *(u32x4*)(dst + half * 48 + i * 8) = pack8(f);
  }
}

#define QSCALE 0.14724306f
DEV void q_task(const Params& p, int l, int t, char* lds) {
  char* ws_ = p.ws; asm volatile("" : "+s"(ws_));
  const int tid = otid();
  const int mt = t & 63, h = t >> 6;
  const bf16_t* P1 = (const bf16_t*)(ws_ + OFF_P1);
  float* rs = (float*)(lds + LDS_SMALL);
  {
    const int row = tid >> 1, half = tid & 1;
    const bf16_t* src = P1 + (size_t)(mt * 128 + row) * P1W + half * 192;
    float ss = 0.f;
#pragma unroll 12
    for (int i = 0; i < 24; i++) { float f[8]; unpack8(*(const u32x4*)(src + i * 8), f);
#pragma unroll
      for (int j = 0; j < 8; j++) ss += f[j] * f[j]; }
    ss += __shfl_xor(ss, 1);
    if (!half) rs[row] = __builtin_amdgcn_rsqf(ss * (1.f / 384.f) + EPSF);
  }
  __syncthreads();
  f32x4 acc[4][3]; zero_acc<3>(acc);
  ALScaled al{P1 + (size_t)mt * 128 * P1W, P1W, rs, p.in[I_QAN] + l * 384};
  gemm_core<96>(al, (const bf16_t*)(ws_ + OFF_WUQ) + (size_t)h * 96 * 384, 384, 384, acc, lds);
  float* Cs = (float*)lds;
  acc_to_lds<96>(acc, Cs);
  const int row = tid >> 1, half = tid & 1, grow = mt * 128 + row;
  float v[48];
#pragma unroll
  for (int i = 0; i < 48; i++) v[i] = Cs[row * 100 + half * 48 + i];
  finish_qk(v, half, p.in[I_QN] + l * 96, grow >= 4096, (grow - 4096) & 1023, QSCALE,
            (bf16_t*)(ws_ + OFF_Q) + ((size_t)grow * 8 + h) * 96);
}

DEV void kv_task(const Params& p, int l, int t, char* lds) {
  char* ws_ = p.ws; asm volatile("" : "+s"(ws_));
  const int tid = otid();
  const int h = t / 72, mt = t % 72;
  const bf16_t* P1 = (const bf16_t*)(ws_ + OFF_P1);
  float* rs = (float*)(lds + LDS_SMALL);
  f32x4 acc[4][4]; zero_acc<4>(acc);
  const bf16_t* Bt = (const bf16_t*)(ws_ + OFF_WUKV) + (size_t)h * 128 * 256;
  if (mt < 64) {
    {
      const int row = tid >> 1, half = tid & 1;
      const bf16_t* src = P1 + (size_t)(mt * 128 + row) * P1W + 384 + half * 128;
      float ss = 0.f;
#pragma unroll
      for (int i = 0; i < 16; i++) { float f[8]; unpack8(*(const u32x4*)(src + i * 8), f);
#pragma unroll
        for (int j = 0; j < 8; j++) ss += f[j] * f[j]; }
      ss += __shfl_xor(ss, 1);
      if (!half) rs[row] = __builtin_amdgcn_rsqf(ss * (1.f / 256.f) + EPSF);
    }
    __syncthreads();
    if (h == 0 && mt < 32) {
#pragma unroll 8
      for (int it = tid; it < 128 * 32; it += 256) {
        const int r = it >> 5, c8 = it & 31, row = mt * 128 + r;
        float f[8]; unpack8(*(const u32x4*)(P1 + (size_t)row * P1W + 384 + c8 * 8), f);
        const float rr = rs[r];
        const float* g = p.in[I_KVAN] + l * 256 + c8 * 8;
        float* o = p.out + OUT_CKV + ((size_t)((row >> 8) * 2 + l) * 256 + (row & 255)) * 256 + c8 * 8;
        *(f32x4*)o = f32x4{f[0] * rr * g[0], f[1] * rr * g[1], f[2] * rr * g[2], f[3] * rr * g[3]};
        *(f32x4*)(o + 4) = f32x4{f[4] * rr * g[4], f[5] * rr * g[5], f[6] * rr * g[6], f[7] * rr * g[7]};
      }
    }
    ALScaled al{P1 + (size_t)mt * 128 * P1W + 384, P1W, rs, p.in[I_KVAN] + l * 256};
    gemm_core<128>(al, Bt, 256, 256, acc, lds);
  } else {
    const int b = (mt - 64) >> 1, p0 = ((mt - 64) & 1) * 128;
    ALF32 al{p.in[I_CCKV] + ((size_t)(b * 2 + l) * 256 + p0) * 256, 256};
    gemm_core<128>(al, Bt, 256, 256, acc, lds);
  }
  float* Cs = (float*)lds;
  acc_to_lds<128>(acc, Cs);
  {
    const int row = tid >> 1, half = tid & 1;
    float v[48];
    int krow; bool do_rope = false; int pos = 0;
    if (mt < 64) {
      const int grow = mt * 128 + row;
      krow = grow; do_rope = grow >= 4096; pos = (grow - 4096) & 1023;
      if (half == 0) {
#pragma unroll
        for (int i = 0; i < 48; i++) v[i] = Cs[row * 132 + i];
      } else {
#pragma unroll
        for (int i = 0; i < 16; i++) v[i] = Cs[row * 132 + 48 + i];
        const bf16_t* kr = P1 + (size_t)grow * P1W + 640;
#pragma unroll
        for (int i = 0; i < 4; i++) { float f[8]; unpack8(*(const u32x4*)(kr + i * 8), f);
#pragma unroll
          for (int j = 0; j < 8; j++) v[16 + i * 8 + j] = f[j]; }
      }
    } else {
      const int b = (mt - 64) >> 1, pp = ((mt - 64) & 1) * 128 + row;
      krow = 8192 + b * 256 + pp;
      if (half == 0) {
#pragma unroll
        for (int i = 0; i < 48; i++) v[i] = Cs[row * 132 + i];
      } else {
#pragma unroll
        for (int i = 0; i < 16; i++) v[i] = Cs[row * 132 + 48 + i];
        const float* kr = p.in[I_CKR] + ((size_t)(b * 2 + l) * 256 + pp) * 32;
#pragma unroll
        for (int i = 0; i < 8; i++) { const f32x4 w = *(const f32x4*)(kr + i * 4); v[16 + i * 4] = w.x; v[17 + i * 4] = w.y; v[18 + i * 4] = w.z; v[19 + i * 4] = w.w; }
      }
    }
    finish_qk(v, half, p.in[I_KN] + l * 96, do_rope, pos, 1.f, (bf16_t*)(ws_ + OFF_K) + ((size_t)krow * 8 + h) * 96);
  }
  {
    size_t vbase; int Tk, key0;
    if (mt < 32) { const int b = mt >> 1; Tk = 256; key0 = (mt & 1) * 128; vbase = (size_t)(b * 8 + h) * 64 * 256; }
    else if (mt < 64) { const int b = (mt - 32) >> 3; Tk = 1280; key0 = 256 + ((mt - 32) & 7) * 128; vbase = VT_LAT_EL + (size_t)(b * 8 + h) * 64 * 1280; }
    else { const int b = (mt - 64) >> 1; Tk = 1280; key0 = ((mt - 64) & 1) * 128; vbase = VT_LAT_EL + (size_t)(b * 8 + h) * 64 * 1280; }
    bf16_t* Vt = (bf16_t*)(ws_ + OFF_VT) + vbase;
#pragma unroll
    for (int i = 0; i < 4; i++) {
      const int it = tid + 256 * i, dv = it & 63, kg = it >> 6;
      float f[8];
#pragma unroll
      for (int j = 0; j < 8; j++) f[j] = Cs[(kg * 8 + j) * 132 + 64 + dv];
      *(u32x4*)(Vt + (size_t)dv * Tk + key0 + kg * 8) = pack8(f);
    }
  }
}

DEV void conv_pass(const Params& p, int l, int seg, int h, int row0, int sbeg, int send, float* F, bf16_t* Vtile) {
  char* ws_ = p.ws; asm volatile("" : "+s"(ws_));
  const int tid = otid(), c8 = tid & 15, tg = tid >> 4;
  const bf16_t* src = (const bf16_t*)(ws_ + OFF_P1) + 672 + seg * 512 + h * 128 + c8 * 8;
  const float* cwp = p.in[I_CONVW] + (size_t)l * 5 * 1536 + seg * 512 + h * 128 + c8 * 8;
  float cw[5][8];
#pragma unroll
  for (int j = 0; j < 5; j++) {
    const f32x4 a = *(const f32x4*)(cwp + j * 1536), b = *(const f32x4*)(cwp + j * 1536 + 4);
    cw[j][0] = a.x; cw[j][1] = a.y; cw[j][2] = a.z; cw[j][3] = a.w; cw[j][4] = b.x; cw[j][5] = b.y; cw[j][6] = b.z; cw[j][7] = b.w;
  }
  const int t0 = row0 + tg * 4;
  u32x4 raw[8];
#pragma unroll
  for (int r = 0; r < 8; r++) {
    const int row = t0 - 2 + r;
    raw[r] = (row >= sbeg && row < send) ? *(const u32x4*)(src + (size_t)row * P1W) : u32x4{0u, 0u, 0u, 0u};
  }
  float acc[4][8];
#pragma unroll
  for (int tt = 0; tt < 4; tt++)
#pragma unroll
    for (int c = 0; c < 8; c++) acc[tt][c] = 0.f;
#pragma unroll
  for (int r = 0; r < 8; r++) {
    float f[8]; unpack8(raw[r], f);
#pragma unroll
    for (int tt = 0; tt < 4; tt++) {
      const int j = r - tt;
      if (j >= 0 && j < 5) {
#pragma unroll
        for (int c = 0; c < 8; c++) acc[tt][c] += cw[j][c] * f[c];
      }
    }
  }
#pragma unroll
  for (int tt = 0; tt < 4; tt++) {
    float y[8];
#pragma unroll
    for (int c = 0; c < 8; c++) y[c] = siluf(acc[tt][c]);
    if (F) {
#pragma unroll
      for (int c = 0; c < 8; c++) F[(tg * 4 + tt) * 129 + c8 * 8 + c] = y[c];
    } else {
      *(u32x4*)(Vtile + (tg * 4 + tt) * 136 + c8 * 8) = pack8(y);
    }
  }
}
DEV void l2norm_rows(const float* F, bf16_t* T) {
  const int tid = otid(), row = tid >> 2, part = tid & 3;
  float ss = 0.f;
#pragma unroll
  for (int i = 0; i < 32; i++) { float x = F[row * 129 + part * 32 + i]; ss += x * x; }
  ss += __shfl_xor(ss, 1); ss += __shfl_xor(ss, 2);
  const float inv = __builtin_amdgcn_rsqf(ss + EPSF);
#pragma unroll
  for (int i = 0; i < 32; i++) T[row * 136 + part * 32 + i] = f2bf(F[row * 129 + part * 32 + i] * inv);
}
DEV void mm64(const bf16_t* At, const bf16_t* Bt_, float* Out, int wave, int l16, int quad) {
  f32x4 acc[4];
#pragma unroll
  for (int ni = 0; ni < 4; ni++) acc[ni] = f32x4{0.f, 0.f, 0.f, 0.f};
#pragma unroll
  for (int ks = 0; ks < 4; ks++) {
    bf16x8 a = *(const bf16x8*)(At + (wave * 16 + l16) * 136 + ks * 32 + quad * 8);
#pragma unroll
    for (int ni = 0; ni < 4; ni++) {
      bf16x8 b = *(const bf16x8*)(Bt_ + (ni * 16 + l16) * 136 + ks * 32 + quad * 8);
      acc[ni] = MFMA(a, b, acc[ni]);
    }
  }
#pragma unroll
  for (int ni = 0; ni < 4; ni++)
#pragma unroll
    for (int j = 0; j < 4; j++) Out[(wave * 16 + quad * 4 + j) * 65 + ni * 16 + l16] = acc[ni][j];
}
DEV void gdn_prep_task(const Params& p, int l, int t, char* lds) {
  char* ws_ = p.ws; asm volatile("" : "+s"(ws_));
  const int tid = otid(), lane = tid & 63, wave = tid >> 6, l16 = lane & 15, quad = lane >> 4;
  const int chunk = t >> 2, h = t & 3, row0 = chunk * 64;
  int sbeg, send;
  if (row0 < 4096) { sbeg = row0 & ~255; send = sbeg + 256; } else { sbeg = 4096 + ((row0 - 4096) & ~1023); send = sbeg + 1024; }
  bf16_t* Kt = (bf16_t*)lds;
  bf16_t* Qt = Kt + 64 * 136;
  float* F = (float*)(lds + 34816);
  float* G = F;
  float* Pm = (float*)(lds + 34816 + 17408);
  float* Am = Pm;
  float* gcs = (float*)(lds + LDS_SMALL);
  float* betas = gcs + 128;
  const float* GAB = (const float*)(ws_ + OFF_GAB);
  if (tid < 128) {
    const int dir = tid >> 6, ip = tid & 63, tok = dir ? 63 - ip : ip, row = row0 + tok;
    const float ga = GAB[(size_t)row * 16 + dir * 4 + h], gb = GAB[(size_t)row * 16 + 8 + dir * 4 + h];
    const float a = __expf(p.in[I_ALOG][(l * 2 + dir) * 4 + h]);
    const float x = ga + p.in[I_DTB][(l * 2 + dir) * 4 + h];
    const float ex = __expf(fminf(x, 20.f));
    const float sp = x > 20.f ? x : (ex < 0.01f ? ex * (1.f - ex * (0.5f - ex * (1.f / 3.f))) : __logf(1.f + ex));
    float g = -a * sp;
#pragma unroll
    for (int off = 1; off < 64; off <<= 1) { float v = __shfl_up(g, off); if (ip >= off) g += v; }
    gcs[dir * 64 + ip] = g;
    betas[dir * 64 + ip] = frcp(1.f + __expf(-gb));
  }
  conv_pass(p, l, 1, h, row0, sbeg, send, F, nullptr);
  __syncthreads();
  l2norm_rows(F, Kt);
  __syncthreads();
  conv_pass(p, l, 0, h, row0, sbeg, send, F, nullptr);
  __syncthreads();
  l2norm_rows(F, Qt);
  __syncthreads();
  mm64(Qt, Kt, Pm, wave, l16, quad);
  bf16_t* recbase = (bf16_t*)(ws_ + OFF_GDN) + (size_t)(chunk * 4 + h) * 2 * REC_EL;
#pragma unroll 1
  for (int dir = 0; dir < 2; dir++) {
    bf16_t* rec = recbase + (size_t)dir * REC_EL;
    const float* gc = gcs + dir * 64;
    const float gl = gc[63];
#pragma unroll
    for (int i = 0; i < 4; i++) {
      const int it = tid + 256 * i, ip = it >> 4, c8 = it & 15, tok = dir ? 63 - ip : ip;
      const float sc = 0.08838834764831845f * __expf(gc[ip]);
      float f[8]; unpack8(*(const u32x4*)(Qt + tok * 136 + c8 * 8), f);
#pragma unroll
      for (int j = 0; j < 8; j++) f[j] *= sc;
      *(u32x4*)(rec + 8192 + ip * 128 + c8 * 8) = pack8(f);
    }
#pragma unroll
    for (int i = 0; i < 4; i++) {
      const int it = tid + 256 * i, d = it & 127, ig = it >> 7;
      float f[8];
#pragma unroll
      for (int j = 0; j < 8; j++) { const int ip = ig * 8 + j, tok = dir ? 63 - ip : ip; f[j] = bf2f(Kt[tok * 136 + d]) * __expf(gl - gc[ip]); }
      *(u32x4*)(rec + 20480 + d * 64 + ig * 8) = pack8(f);
    }
    if (tid == 0) ((float*)(ws_ + OFF_EGL))[(chunk * 4 + h) * 2 + dir] = __expf(gl);
  }
  __syncthreads();
  conv_pass(p, l, 2, h, row0, sbeg, send, nullptr, Qt);
#pragma unroll 1
  for (int dir = 0; dir < 2; dir++) {
    bf16_t* rec = recbase + (size_t)dir * REC_EL;
    const float* gc = gcs + dir * 64;
#pragma unroll
    for (int i = 0; i < 2; i++) {
      const int it = tid + 256 * i, ip = it >> 3, j8 = it & 7, ti = dir ? 63 - ip : ip;
      float f[8];
#pragma unroll
      for (int j = 0; j < 8; j++) {
        const int jp = j8 * 8 + j, tj = dir ? 63 - jp : jp;
        const float e = __expf(fminf(gc[ip] - gc[jp], 0.f));
        f[j] = (ip >= jp) ? Pm[ti * 65 + tj] * 0.08838834764831845f * e : 0.f;
      }
      *(u32x4*)(rec + 16384 + ip * 64 + j8 * 8) = pack8(f);
    }
  }
  __syncthreads();
  const bf16_t* Vtile = Qt;
  float* T = G;
#pragma unroll 1
  for (int dir = 0; dir < 2; dir++) {
    bf16_t* rec = recbase + (size_t)dir * REC_EL;
    const float* gc = gcs + dir * 64;
    const float* be = betas + dir * 64;
    mm64(Kt, Kt, G, wave, l16, quad);
    __syncthreads();
#pragma unroll 2
    for (int i = 0; i < 16; i++) {
      const int it = tid + 256 * i, ip = it >> 6, jp = it & 63;
      const int ti = dir ? 63 - ip : ip, tj = dir ? 63 - jp : jp;
      const float e = __expf(fminf(gc[ip] - gc[jp], 0.f));
      Am[ip * 68 + jp] = (ip > jp) ? be[ip] * G[ti * 65 + tj] * e : 0.f;
    }
    __syncthreads();
    {
      const int cl = lane >> 2, q = lane & 3, c = wave * 16 + cl;
      float r[16];
#pragma unroll
      for (int m = 0; m < 16; m++) r[m] = (q + 4 * m == c) ? 1.f : 0.f;
#pragma unroll
      for (int j = 0; j < 63; j++) {
        const int mj = j >> 2;
        float t;
        switch (j & 3) {
          case 0: t = __int_as_float(__builtin_amdgcn_update_dpp(0, __float_as_int(r[mj]), 0x00, 0xF, 0xF, true)); break;
          case 1: t = __int_as_float(__builtin_amdgcn_update_dpp(0, __float_as_int(r[mj]), 0x55, 0xF, 0xF, true)); break;
          case 2: t = __int_as_float(__builtin_amdgcn_update_dpp(0, __float_as_int(r[mj]), 0xAA, 0xF, 0xF, true)); break;
          default: t = __int_as_float(__builtin_amdgcn_update_dpp(0, __float_as_int(r[mj]), 0xFF, 0xF, 0xF, true)); break;
        }
#pragma unroll
        for (int m = mj; m < 16; m++) r[m] -= Am[(q + 4 * m) * 68 + j] * t;
        if ((j & 7) == 7) asm volatile("" ::: "memory");
      }
#pragma unroll
      for (int m = 0; m < 16; m++) T[(q + 4 * m) * 68 + c] = r[m];
    }
    __syncthreads();
#pragma unroll 1
    for (int which = 0; which < 2; which++) {
      const bf16_t* srcT = which ? Kt : Vtile;
      f32x4 ac[4][2];
      zero_acc<2>(ac);
#pragma unroll
      for (int ks = 0; ks < 2; ks++) {
        float cs[8];
        unsigned short e[2][8];
#pragma unroll
        for (int s = 0; s < 8; s++) {
          const int j = ks * 32 + quad * 8 + s, tok = dir ? 63 - j : j;
          cs[s] = which ? be[j] * __expf(gc[j]) : be[j];
#pragma unroll
          for (int nf = 0; nf < 2; nf++) e[nf][s] = srcT[tok * 136 + wave * 32 + nf * 16 + l16];
        }
        bf16x8 bfr[2];
#pragma unroll
        for (int nf = 0; nf < 2; nf++) {
          u32x4 v;
          v.x = e[nf][0] | ((unsigned)e[nf][1] << 16); v.y = e[nf][2] | ((unsigned)e[nf][3] << 16);
          v.z = e[nf][4] | ((unsigned)e[nf][5] << 16); v.w = e[nf][6] | ((unsigned)e[nf][7] << 16);
          bfr[nf] = as_frag(v);
        }
#pragma unroll
        for (int mi = 0; mi < 4; mi++) {
          const float* tr = T + (mi * 16 + l16) * 68 + ks * 32 + quad * 8;
          const f32x4 t0 = *(const f32x4*)tr, t1 = *(const f32x4*)(tr + 4);
          const float tv[8] = {t0.x, t0.y, t0.z, t0.w, t1.x, t1.y, t1.z, t1.w};
          float a[8], hi[8], lo[8];
#pragma unroll
          for (int s = 0; s < 8; s++) a[s] = tv[s] * cs[s];
          const u32x4 ph = pack8(a);
          unpack8(ph, hi);
#pragma unroll
          for (int s = 0; s < 8; s++) lo[s] = a[s] - hi[s];
          const bf16x8 fh = as_frag(ph), fl = as_frag(pack8(lo));
#pragma unroll
          for (int nf = 0; nf < 2; nf++) { ac[mi][nf] = MFMA(fh, bfr[nf], ac[mi][nf]); ac[mi][nf] = MFMA(fl, bfr[nf], ac[mi][nf]); }
        }
      }
      int qs = quad, ls = l16;
      asm volatile("" : "+v"(qs), "+v"(ls));
      bf16_t* dst = rec + (which ? 0 : 28672);
      const float sg = which ? -1.f : 1.f;
#pragma unroll
      for (int mi = 0; mi < 4; mi++)
#pragma unroll
        for (int nf = 0; nf < 2; nf++)
#pragma unroll
          for (int j = 0; j < 4; j++) {
            const int ip = mi * 16 + qs * 4 + j, col = wave * 32 + nf * 16 + ls;
            dst[ip * 128 + col] = f2bf(sg * ac[mi][nf][j]);
          }
    }
    __syncthreads();
  }
}

DEV void cmlp_task(const Params& p, int l, int t, char* lds) {
  char* ws_ = p.ws; asm volatile("" : "+s"(ws_));
  const int tid = otid(), lane = tid & 63, wave = tid >> 6, l16 = lane & 15, quad = lane >> 4;
  const int wm = wave >> 1, wn = wave & 1;
  const int c = t >> 2, g = t & 3, r0 = c * 128;
  const bf16_t* P3 = (const bf16_t*)(ws_ + OFF_P3);
  const bf16_t* P2 = (const bf16_t*)(ws_ + OFF_P2);
  bf16_t* BR = (bf16_t*)(ws_ + OFF_BR);
  bf16_t* VnT = (bf16_t*)lds;
  bf16_t* Ws = VnT + 128 * 136;
  float* mu = (float*)(lds + LDS_SMALL);
  float* rstd = mu + 128;
  {
    const int row = tid >> 1, half = tid & 1;
    const bf16_t* src = P3 + (size_t)(r0 + row) * P3W + 512 + half * 256;
    float s = 0.f, ss = 0.f;
#pragma unroll 16
    for (int i = 0; i < 32; i++) { float f[8]; unpack8(*(const u32x4*)(src + i * 8), f);
#pragma unroll
      for (int j = 0; j < 8; j++) { float y = geluf(f[j]); s += y; ss += y * y; } }
    s += __shfl_xor(s, 1); ss += __shfl_xor(ss, 1);
    const float mean = s * (1.f / 512.f), var = fmaxf(ss * (1.f / 512.f) - mean * mean, 0.f);
    if (!half) { mu[row] = mean; rstd[row] = __builtin_amdgcn_rsqf(var + EPSF); }
  }
  __syncthreads();
#pragma unroll
  for (int i = 0; i < 8; i++) {
    const int it = tid + 256 * i, q = it >> 4, c8 = it & 15;
    float f[8]; unpack8(*(const u32x4*)(P3 + (size_t)(r0 + q) * P3W + 512 + g * 128 + c8 * 8), f);
    const float m = mu[q], rs = rstd[q];
#pragma unroll
    for (int j = 0; j < 8; j++) {
      const int cc = c8 * 8 + j;
      const float val = (geluf(f[j]) - m) * rs * p.in[I_LNG][l * 512 + g * 128 + cc] + p.in[I_LNB][l * 512 + g * 128 + cc];
      VnT[cc * 136 + q] = f2bf(val);
    }
  }
#pragma unroll
  for (int i = 0; i < 16; i++) {
    const int it = tid + 256 * i, pp = it >> 5, q4 = it & 31;
    const f32x4 w = *(const f32x4*)(p.in[I_WS] + ((size_t)(l * 4 + g) * 128 + pp) * 128 + q4 * 4);
    *(u32x2*)(Ws + pp * 136 + q4 * 4) = pack4(w.x, w.y, w.z, w.w);
  }
  __syncthreads();
  f32x4 acc[4][4]; zero_acc<4>(acc);
#pragma unroll
  for (int ks = 0; ks < 4; ks++) {
    bf16x8 a[4], b[4];
#pragma unroll
    for (int mi = 0; mi < 4; mi++) a[mi] = *(const bf16x8*)(Ws + (wm * 64 + mi * 16 + l16) * 136 + ks * 32 + quad * 8);
#pragma unroll
    for (int ni = 0; ni < 4; ni++) b[ni] = *(const bf16x8*)(VnT + (wn * 64 + ni * 16 + l16) * 136 + ks * 32 + quad * 8);
#pragma unroll
    for (int mi = 0; mi < 4; mi++)
#pragma unroll
      for (int ni = 0; ni < 4; ni++) acc[mi][ni] = MFMA(a[mi], b[ni], acc[mi][ni]);
  }
  float* Cs = (float*)lds;
  __syncthreads();
#pragma unroll
  for (int mi = 0; mi < 4; mi++)
#pragma unroll
    for (int j = 0; j < 4; j++) {
      const int pp = wm * 64 + mi * 16 + quad * 4 + j;
      const float bias = p.in[I_BS][(l * 4 + g) * 128 + pp];
#pragma unroll
      for (int ni = 0; ni < 4; ni++) Cs[pp * 132 + wn * 64 + ni * 16 + l16] = acc[mi][ni][j] + bias;
    }
  __syncthreads();
  u32x4 uu[8], zz[8];
#pragma unroll
  for (int i = 0; i < 8; i++) {
    const int it = tid + 256 * i, r = it >> 4, c8 = it & 15;
    const size_t row = (size_t)(r0 + r);
    uu[i] = *(const u32x4*)(P3 + row * P3W + g * 128 + c8 * 8);
    zz[i] = *(const u32x4*)(P2 + row * P2W + 1024 + g * 128 + c8 * 8);
  }
#pragma unroll
  for (int i = 0; i < 8; i++) {
    const int it = tid + 256 * i, r = it >> 4, c8 = it & 15;
    float u[8], z[8], o[8];
    unpack8(uu[i], u); unpack8(zz[i], z);
    const f32x4 s0 = *(const f32x4*)(Cs + r * 132 + c8 * 8), s1 = *(const f32x4*)(Cs + r * 132 + c8 * 8 + 4);
    const float sv[8] = {s0.x, s0.y, s0.z, s0.w, s1.x, s1.y, s1.z, s1.w};
#pragma unroll
    for (int j = 0; j < 8; j++) o[j] = geluf(u[j]) * sv[j] * siluf(z[j]);
    *(u32x4*)(BR + (size_t)(r0 + r) * BRW + 1024 + g * 128 + c8 * 8) = pack8(o);
  }
}

DEV void attn_task(const Params& p, int l, int t, char* lds) {
  char* ws_ = p.ws; asm volatile("" : "+s"(ws_));
  const int tid = otid(), lane = tid & 63, wave = tid >> 6, l16 = lane & 15, quad = lane >> 4;
  int b, h, qrow0, nkt, Tk; size_t vtb;
  const bool lat = t < 256;
  if (lat) { b = t >> 6; h = (t >> 3) & 7; const int qb = t & 7; qrow0 = 4096 + b * 1024 + qb * 128; nkt = 20; Tk = 1280; vtb = VT_LAT_EL + (size_t)(b * 8 + h) * 64 * 1280; }
  else { const int tt = t - 256; b = tt >> 4; h = (tt >> 1) & 7; const int qb = tt & 1; qrow0 = b * 256 + qb * 128; nkt = 4; Tk = 256; vtb = (size_t)(b * 8 + h) * 64 * 256; }
  if (lat) __builtin_amdgcn_s_setprio(2);
  const bf16_t* Qg = (const bf16_t*)(ws_ + OFF_Q);
  const bf16_t* Kg = (const bf16_t*)(ws_ + OFF_K);
  const bf16_t* Vg = (const bf16_t*)(ws_ + OFF_VT) + vtb;
  bf16_t* Qs = (bf16_t*)lds;
  bf16_t* Ks = Qs + 128 * 104;
  bf16_t* Vs = Ks + 64 * 104;
#pragma unroll
  for (int i = 0; i < 6; i++) {
    const int it = tid + 256 * i, r = it / 12, cc = it % 12;
    *(u32x4*)(Qs + r * 104 + cc * 8) = *(const u32x4*)(Qg + ((size_t)(qrow0 + r) * 8 + h) * 96 + cc * 8);
  }
  __syncthreads();
  bf16x8 qf[2][3];
#pragma unroll
  for (int ni = 0; ni < 2; ni++)
#pragma unroll
    for (int ks = 0; ks < 3; ks++) qf[ni][ks] = *(const bf16x8*)(Qs + (wave * 32 + ni * 16 + l16) * 104 + ks * 32 + quad * 8);
  f32x4 o[4][2];
#pragma unroll
  for (int di = 0; di < 4; di++) { o[di][0] = f32x4{0.f, 0.f, 0.f, 0.f}; o[di][1] = f32x4{0.f, 0.f, 0.f, 0.f}; }
  float mrun[2] = {-1e30f, -1e30f}, lsum[2] = {0.f, 0.f};
  u32x4 pk[3], pv[2];
  {
    const int krow0 = lat ? (8192 + b * 256) : (b * 256);
#pragma unroll
    for (int i = 0; i < 3; i++) { const int it = tid + 256 * i, r = it / 12, cc = it % 12; pk[i] = *(const u32x4*)(Kg + ((size_t)(krow0 + r) * 8 + h) * 96 + cc * 8); }
#pragma unroll
    for (int i = 0; i < 2; i++) { const int it = tid + 256 * i, dv = it >> 3, kg = it & 7; pv[i] = *(const u32x4*)(Vg + (size_t)dv * Tk + kg * 8); }
  }
  for (int kt = 0; kt < nkt; kt++) {
    __syncthreads();
#pragma unroll
    for (int i = 0; i < 3; i++) { const int it = tid + 256 * i, r = it / 12, cc = it % 12; *(u32x4*)(Ks + r * 104 + cc * 8) = pk[i]; }
#pragma unroll
    for (int i = 0; i < 2; i++) { const int it = tid + 256 * i, dv = it >> 3, kg = it & 7; *(u32x4*)(Vs + dv * 72 + kg * 8) = pv[i]; }
    __syncthreads();
    if (kt + 1 < nkt) {
      const int kn = kt + 1;
      int krow0;
      if (lat) krow0 = (kn < 4) ? (8192 + b * 256 + kn * 64) : (4096 + b * 1024 + (kn - 4) * 64);
      else krow0 = b * 256 + kn * 64;
#pragma unroll
      for (int i = 0; i < 3; i++) { const int it = tid + 256 * i, r = it / 12, cc = it % 12; pk[i] = *(const u32x4*)(Kg + ((size_t)(krow0 + r) * 8 + h) * 96 + cc * 8); }
#pragma unroll
      for (int i = 0; i < 2; i++) { const int it = tid + 256 * i, dv = it >> 3, kg = it & 7; pv[i] = *(const u32x4*)(Vg + (size_t)dv * Tk + kn * 64 + kg * 8); }
    }
    __builtin_amdgcn_sched_barrier(0);
    f32x4 s[4][2];
#pragma unroll
    for (int mi = 0; mi < 4; mi++) { s[mi][0] = f32x4{0.f, 0.f, 0.f, 0.f}; s[mi][1] = f32x4{0.f, 0.f, 0.f, 0.f}; }
#pragma unroll
    for (int ks = 0; ks < 3; ks++)
#pragma unroll
      for (int mi = 0; mi < 4; mi++) {
        bf16x8 kf = *(const bf16x8*)(Ks + (mi * 16 + l16) * 104 + ks * 32 + quad * 8);
        s[mi][0] = MFMA(kf, qf[0][ks], s[mi][0]);
        s[mi][1] = MFMA(kf, qf[1][ks], s[mi][1]);
      }
#pragma unroll
    for (int ni = 0; ni < 2; ni++) {
      float mx = -1e30f;
#pragma unroll
      for (int mi = 0; mi < 4; mi++)
#pragma unroll
        for (int j = 0; j < 4; j++) mx = fmaxf(mx, s[mi][ni][j]);
      mx = fmaxf(mx, __shfl_xor(mx, 16)); mx = fmaxf(mx, __shfl_xor(mx, 32));
      const float mnew = fmaxf(mrun[ni], mx);
      const float alpha = __builtin_amdgcn_exp2f(mrun[ni] - mnew);
      mrun[ni] = mnew;
      float rsum = 0.f;
#pragma unroll
      for (int mi = 0; mi < 4; mi++)
#pragma unroll
        for (int j = 0; j < 4; j++) { float pv = __builtin_amdgcn_exp2f(s[mi][ni][j] - mnew); s[mi][ni][j] = pv; rsum += pv; }
      lsum[ni] = lsum[ni] * alpha + rsum;
#pragma unroll
      for (int di = 0; di < 4; di++) o[di][ni] *= alpha;
    }
#pragma unroll
    for (int g = 0; g < 2; g++) {
      bf16x8 pf0 = frag_from(s[2 * g][0], s[2 * g + 1][0]);
      bf16x8 pf1 = frag_from(s[2 * g][1], s[2 * g + 1][1]);
#pragma unroll
      for (int di = 0; di < 4; di++) {
        bf16x8 vf = ld2(Vs + (di * 16 + l16) * 72 + g * 32 + quad * 4);
        o[di][0] = MFMA(vf, pf0, o[di][0]);
        o[di][1] = MFMA(vf, pf1, o[di][1]);
      }
    }
  }
  const bf16_t* P2 = (const bf16_t*)(ws_ + OFF_P2);
  bf16_t* BR = (bf16_t*)(ws_ + OFF_BR);
#pragma unroll
  for (int ni = 0; ni < 2; ni++) {
    float lt = lsum[ni];
    lt += __shfl_xor(lt, 16); lt += __shfl_xor(lt, 32);
    const float inv = frcp(lt);
    const size_t qrow = (size_t)(qrow0 + wave * 32 + ni * 16 + l16);
#pragma unroll
    for (int di = 0; di < 4; di++) {
      const int col = h * 64 + di * 16 + quad * 4;
      float z[4]; unpack4(*(const u32x2*)(P2 + qrow * P2W + col), z);
      *(u32x2*)(BR + qrow * BRW + col) = pack4(o[di][ni][0] * inv * siluf(z[0]), o[di][ni][1] * inv * siluf(z[1]),
                                               o[di][ni][2] * inv * siluf(z[2]), o[di][ni][3] * inv * siluf(z[3]));
    }
  }
  __builtin_amdgcn_s_setprio(0);
}

struct ScanPf { u32x4 w[4], q[4], a[2], k[4], u[2]; float egl; };
DEV void scan_prefetch(ScanPf& f, const bf16_t* rec, const float* eglp, int half, int tid) {
#pragma unroll
  for (int i = 0; i < 4; i++) { const int c = tid + 256 * i; f.w[i] = *(const u32x4*)(rec + c * 8); f.q[i] = *(const u32x4*)(rec + 8192 + c * 8); f.k[i] = *(const u32x4*)(rec + 20480 + c * 8); }
#pragma unroll
  for (int i = 0; i < 2; i++) { const int c = tid + 256 * i; f.a[i] = *(const u32x4*)(rec + 16384 + c * 8); f.u[i] = *(const u32x4*)(rec + 28672 + (c >> 3) * 128 + half * 64 + (c & 7) * 8); }
  f.egl = *eglp;
}
DEV void gdn_scan_task(const Params& p, int l, int t, char* lds) {
  char* ws_ = p.ws; asm volatile("" : "+s"(ws_));
  const int tid = otid(), lane = tid & 63, wave = tid >> 6, l16 = lane & 15, quad = lane >> 4;
  __builtin_amdgcn_s_setprio(3);
  int chain, half, b, chunk0, N; bool lat = t < 64;
  if (lat) { chain = t >> 1; half = t & 1; } else { chain = (t - 64) >> 1; half = (t - 64) & 1; }
  const int dir = chain & 1, h = (chain >> 1) & 3;
  b = chain >> 3;
  if (lat) { chunk0 = 64 + b * 16; N = 16; } else { chunk0 = b * 4; N = 4; }
  const int e0 = (half * 4 + wave) * 16;
  bf16_t* Wl = (bf16_t*)lds;
  bf16_t* Ql = Wl + 64 * 136;
  bf16_t* Al = Ql + 64 * 136;
  bf16_t* Kl = Al + 64 * 72;
  bf16_t* Ul = Kl + 128 * 72;
  f32x4 S[8];
  if (lat) {
    const float* s0 = p.in[I_SGDN] + ((size_t)((b * 2 + l) * 2 + dir) * 4 + h) * 16384;
#pragma unroll
    for (int mf = 0; mf < 8; mf++)
#pragma unroll
      for (int j = 0; j < 4; j++) S[mf][j] = s0[(mf * 16 + quad * 4 + j) * 128 + e0 + l16];
  } else {
#pragma unroll
    for (int mf = 0; mf < 8; mf++) S[mf] = f32x4{0.f, 0.f, 0.f, 0.f};
  }
  float* OD = (float*)(ws_ + OFF_ODIR) + (size_t)dir * NTOK * 512;
  const float* EGL = (const float*)(ws_ + OFF_EGL);
  const bf16_t* GD = (const bf16_t*)(ws_ + OFF_GDN);
  ScanPf pf;
  {
    const int cidx = chunk0 + (dir ? N - 1 : 0);
    scan_prefetch(pf, GD + ((size_t)(cidx * 4 + h) * 2 + dir) * REC_EL, EGL + (cidx * 4 + h) * 2 + dir, half, tid);
  }
#pragma unroll 1
  for (int n = 0; n < N; n++) {
    const int cidx = chunk0 + (dir ? N - 1 - n : n);
    __syncthreads();
#pragma unroll
    for (int i = 0; i < 4; i++) {
      const int c = tid + 256 * i;
      *(u32x4*)(Wl + (c >> 4) * 136 + (c & 15) * 8) = pf.w[i];
      *(u32x4*)(Ql + (c >> 4) * 136 + (c & 15) * 8) = pf.q[i];
      *(u32x4*)(Kl + (c >> 3) * 72 + (c & 7) * 8) = pf.k[i];
    }
#pragma unroll
    for (int i = 0; i < 2; i++) {
      const int c = tid + 256 * i;
      *(u32x4*)(Al + (c >> 3) * 72 + (c & 7) * 8) = pf.a[i];
      *(u32x4*)(Ul + (c >> 3) * 72 + (c & 7) * 8) = pf.u[i];
    }
    const float egl = pf.egl;
    __syncthreads();
    if (n + 1 < N) {
      const int cn = chunk0 + (dir ? N - 2 - n : n + 1);
      scan_prefetch(pf, GD + ((size_t)(cn * 4 + h) * 2 + dir) * REC_EL, EGL + (cn * 4 + h) * 2 + dir, half, tid);
    }
    __builtin_amdgcn_sched_barrier(0);
    bf16x8 Sb[4];
#pragma unroll
    for (int ks = 0; ks < 4; ks++) Sb[ks] = frag_from(S[2 * ks], S[2 * ks + 1]);
    f32x4 vn[4];
#pragma unroll
    for (int mi = 0; mi < 4; mi++)
#pragma unroll
      for (int j = 0; j < 4; j++) vn[mi][j] = bf2f(Ul[(mi * 16 + quad * 4 + j) * 72 + wave * 16 + l16]);
#pragma unroll
    for (int mi = 0; mi < 4; mi++)
#pragma unroll
      for (int ks = 0; ks < 4; ks++) vn[mi] = MFMA(ld2(Wl + (mi * 16 + l16) * 136 + ks * 32 + quad * 4), Sb[ks], vn[mi]);
    bf16x8 vb[2];
    vb[0] = frag_from(vn[0], vn[1]); vb[1] = frag_from(vn[2], vn[3]);
#pragma unroll
    for (int mi = 0; mi < 4; mi++) {
      f32x4 o = f32x4{0.f, 0.f, 0.f, 0.f};
#pragma unroll
      for (int ks = 0; ks < 4; ks++) o = MFMA(ld2(Ql + (mi * 16 + l16) * 136 + ks * 32 + quad * 4), Sb[ks], o);
#pragma unroll
      for (int k2 = 0; k2 < 2; k2++) o = MFMA(ld2(Al + (mi * 16 + l16) * 72 + k2 * 32 + quad * 4), vb[k2], o);
#pragma unroll
      for (int j = 0; j < 4; j++) {
        const int ip = mi * 16 + quad * 4 + j, tok = dir ? 63 - ip : ip;
        OD[(size_t)(cidx * 64 + tok) * 512 + h * 128 + e0 + l16] = o[j];
      }
    }
#pragma unroll
    for (int mf = 0; mf < 8; mf++) {
      S[mf] *= egl;
#pragma unroll
      for (int k2 = 0; k2 < 2; k2++) S[mf] = MFMA(ld2(Kl + (mf * 16 + l16) * 72 + k2 * 32 + quad * 4), vb[k2], S[mf]);
    }
  }
  if (!lat) {
    float* so = p.out + OUT_STATE + ((size_t)((b * 2 + l) * 2 + dir) * 4 + h) * 16384;
#pragma unroll
    for (int mf = 0; mf < 8; mf++)
#pragma unroll
      for (int j = 0; j < 4; j++) so[(mf * 16 + quad * 4 + j) * 128 + e0 + l16] = S[mf][j];
  }
  __builtin_amdgcn_s_setprio(0);
}

DEV void onorm_task(const Params& p, int l, int t) {
  char* ws_ = p.ws; asm volatile("" : "+s"(ws_));
  const int tid = otid(), lane = tid & 63, wave = tid >> 6;
  const float* OD = (const float*)(ws_ + OFF_ODIR);
  const bf16_t* P2 = (const bf16_t*)(ws_ + OFF_P2);
  bf16_t* BR = (bf16_t*)(ws_ + OFF_BR);
#pragma unroll
  for (int rr = 0; rr < 4; rr++) {
    const size_t row = (size_t)t * 16 + wave * 4 + rr;
    const f32x4 a0 = *(const f32x4*)(OD + row * 512 + lane * 8), a1 = *(const f32x4*)(OD + row * 512 + lane * 8 + 4);
    const f32x4 b0 = *(const f32x4*)(OD + (NTOK + row) * 512 + lane * 8), b1 = *(const f32x4*)(OD + (NTOK + row) * 512 + lane * 8 + 4);
    float x[8] = {a0.x + b0.x, a0.y + b0.y, a0.z + b0.z, a0.w + b0.w, a1.x + b1.x, a1.y + b1.y, a1.z + b1.z, a1.w + b1.w};
    float ss = 0.f;
#pragma unroll
    for (int i = 0; i < 8; i++) ss += x[i] * x[i];
#pragma unroll
    for (int o = 8; o >= 1; o >>= 1) ss += __shfl_xor(ss, o);
    const float rstd = __builtin_amdgcn_rsqf(ss * (1.f / 128.f) + EPSF);
    float z[8]; unpack8(*(const u32x4*)(P2 + row * P2W + 512 + lane * 8), z);
    const float* g = p.in[I_ONORM] + l * 128 + (lane & 15) * 8;
    float y[8];
#pragma unroll
    for (int i = 0; i < 8; i++) y[i] = x[i] * rstd * g[i] * siluf(z[i]);
    *(u32x4*)(BR + row * BRW + 512 + lane * 8) = pack8(y);
  }
}

DEV void gate_task(const Params& p, int l, int t, char* lds) {
  char* ws_ = p.ws; asm volatile("" : "+s"(ws_));
  const int tid = otid();
  const int nt = t / 64, mt = t % 64;
  f32x4 acc[4][4]; zero_acc<4>(acc);
  ALPlain al{(const bf16_t*)(ws_ + OFF_H) + (size_t)mt * 128 * 1024, 1024};
  gemm_core<128>(al, (const bf16_t*)(ws_ + OFF_WGL) + (size_t)nt * 128 * 1024, 1024, 1024, acc, lds);
  float* Cs = (float*)lds;
  acc_to_lds<128>(acc, Cs);
  bf16_t* GT = (bf16_t*)(ws_ + OFF_GDN);
#pragma unroll
  for (int i = 0; i < 8; i++) {
    const int it = tid + 256 * i, r = it >> 4, c8 = it & 15;
    const f32x4 a = *(const f32x4*)(Cs + r * 132 + c8 * 8), b = *(const f32x4*)(Cs + r * 132 + c8 * 8 + 4);
    float f[8] = {sigmf(a.x), sigmf(a.y), sigmf(a.z), sigmf(a.w), sigmf(b.x), sigmf(b.y), sigmf(b.z), sigmf(b.w)};
    *(u32x4*)(GT + (size_t)(mt * 128 + r) * 3072 + nt * 128 + c8 * 8) = pack8(f);
  }
}
DEV void d1_task(const Params& p, int l, int t, char* lds) {
  char* ws_ = p.ws; asm volatile("" : "+s"(ws_));
  const int tid = otid(), lane = tid & 63, wave = tid >> 6, l16 = lane & 15, quad = lane >> 4;
  const int wm = wave >> 1, wn = wave & 1;
  const int nt = t >> 6, mt = t & 63;
  const bf16_t* GT = (const bf16_t*)(ws_ + OFF_GDN);
  f32x4 macc[4][2]; zero_acc<2>(macc);
#pragma unroll 1
  for (int n = 0; n < 3; n++) {
    unsigned short gv[4][2][4];
#pragma unroll
    for (int mi = 0; mi < 4; mi++)
#pragma unroll
      for (int ni = 0; ni < 2; ni++)
#pragma unroll
        for (int j = 0; j < 4; j++)
          gv[mi][ni][j] = GT[(size_t)(mt * 128 + wm * 64 + mi * 16 + quad * 4 + j) * 3072 + n * 1024 + nt * 64 + wn * 32 + ni * 16 + l16];
    f32x4 y[4][2]; zero_acc<2>(y);
    ALPlain alb{(const bf16_t*)(ws_ + OFF_BR) + (size_t)mt * 128 * BRW + n * 512, BRW};
    gemm_core<64>(alb, (const bf16_t*)(ws_ + OFF_WBR) + (size_t)(n * 1024 + nt * 64) * 512, 512, 512, y, lds);
#pragma unroll
    for (int mi = 0; mi < 4; mi++)
#pragma unroll
      for (int ni = 0; ni < 2; ni++)
#pragma unroll
        for (int j = 0; j < 4; j++) macc[mi][ni][j] += bf2f(gv[mi][ni][j]) * y[mi][ni][j];
  }
  float* Cs = (float*)lds;
  acc_to_lds<64>(macc, Cs);
  bf16_t* M = (bf16_t*)(ws_ + OFF_M);
#pragma unroll
  for (int i = 0; i < 4; i++) {
    const int it = tid + 256 * i, r = it >> 3, c8 = it & 7;
    float f[8];
#pragma unroll
    for (int j = 0; j < 8; j++) f[j] = Cs[r * 68 + c8 * 8 + j];
    *(u32x4*)(M + (size_t)(mt * 128 + r) * 1024 + nt * 64 + c8 * 8) = pack8(f);
  }
}

DEV void d2_task(const Params& p, int l, int t, char* lds) {
  char* ws_ = p.ws; asm volatile("" : "+s"(ws_));
  const int tid = otid();
  const int nt = t >> 6, mt = t & 63;
  f32x4 acc[4][4]; zero_acc<4>(acc);
  ALPlain al{(const bf16_t*)(ws_ + OFF_M) + (size_t)mt * 128 * 1024, 1024};
  gemm_core<128>(al, (const bf16_t*)(ws_ + OFF_WO) + (size_t)nt * 128 * 1024, 1024, 1024, acc, lds);
  float* Cs = (float*)lds;
  acc_to_lds<128>(acc, Cs);
  const float* mod = (const float*)(ws_ + OFF_MOD);
#pragma unroll
  for (int i = 0; i < 8; i++) {
    const int it = tid + 256 * i, r = it >> 4, c8 = it & 15;
    const int row = mt * 128 + r, col = nt * 128 + c8 * 8;
    const float* x = xrow_ptr(p, l, row) + col;
    const float* gt = mod + (size_t)(l * 5 + modrow(row)) * 3072 + 2048 + col;
    const f32x4 y0 = *(const f32x4*)(Cs + r * 132 + c8 * 8), y1 = *(const f32x4*)(Cs + r * 132 + c8 * 8 + 4);
    const f32x4 x0 = *(const f32x4*)x, x1 = *(const f32x4*)(x + 4);
    const f32x4 g0 = *(const f32x4*)gt, g1 = *(const f32x4*)(gt + 4);
    float* o = p.out + (size_t)row * DM + col;
    *(f32x4*)o = f32x4{x0.x + g0.x * y0.x, x0.y + g0.y * y0.y, x0.z + g0.z * y0.z, x0.w + g0.w * y0.w};
    *(f32x4*)(o + 4) = f32x4{x1.x + g1.x * y1.x, x1.y + g1.y * y1.y, x1.z + g1.z * y1.z, x1.w + g1.w * y1.w};
  }
}

#define NPHASES 15
DEV int phase_nsub(int ph) {
  if (ph == 0) return 48 + 152;
  const int l = (ph - 1) / 7, s = (ph - 1) % 7;
  switch (s) {
    case 0: return 128 + (l == 0 ? 113 : 32);
    case 1: return 304 + (l == 0 ? 80 : 0);
    case 2: return 64 + 72 + 64;
    case 3: return 8 + 32 + 32 + 32 + 32 + (l == 0 ? 169 : 0);
    case 4: return 192 + 64;
    case 5: return 128 + (l == 0 ? 96 : 0);
    default: return 64 + (l == 0 ? 48 : 0);
  }
}
DEV void run_task(const Params& p, int ph, int x, int i, char* lds) {
  if (ph == 0) { if (i < 48) mod_task(p, i * 8 + x, lds); else convert_task(p, 0, (i - 48) * 8 + x, lds); return; }
  const int l = (ph - 1) / 7, s = (ph - 1) % 7;
  switch (s) {
    case 0:
      if (i < 128) norm_task(p, l, i * 8 + x);
      else if (l == 0) convert_task(p, 0, 1216 + (i - 128) * 8 + x, lds);
      else convert_task(p, 1, 2504 + (i - 128) * 8 + x, lds);
      break;
    case 1:
      if (i < 304) projA_task(p, l, (i >> 3) * 64 + (i & 7) * 8 + x, lds);
      else convert_task(p, 0, 2120 + (i - 304) * 8 + x, lds);
      break;
    case 2:
      if (i < 64) gdn_prep_task(p, l, i * 8 + x, lds);
      else if (i < 136) { const int j = i - 64; kv_task(p, l, (j / 9) * 72 + (j % 9) * 8 + x, lds); }
      else { const int j = i - 136; q_task(p, l, (j >> 3) * 64 + (j & 7) * 8 + x, lds); }
      break;
    case 3:
      if (i < 8) gdn_scan_task(p, l, i * 8 + x, lds);
      else if (i < 40) attn_task(p, l, x * 32 + (i - 8), lds);
      else if (i < 72) cmlp_task(p, l, (i - 40) * 8 + x, lds);
      else if (i < 104) gdn_scan_task(p, l, 64 + (i - 72) * 8 + x, lds);
      else if (i < 136) attn_task(p, l, 256 + x * 32 + (i - 104), lds);
      else if (i < 288) convert_task(p, 1, (i - 136) * 8 + x, lds);
      else convert_task(p, 1, 1984 + (i - 288) * 8 + x, lds);
      break;
    case 4:
      if (i < 192) gate_task(p, l, (i >> 3) * 64 + (i & 7) * 8 + x, lds);
      else onorm_task(p, l, (i - 192) * 8 + x);
      break;
    case 5:
      if (i < 128) d1_task(p, l, (i >> 3) * 64 + (i & 7) * 8 + x, lds);
      else convert_task(p, 1, 1216 + (i - 128) * 8 + x, lds);
      break;
    case 6:
      if (i < 64) d2_task(p, l, (i >> 3) * 64 + (i & 7) * 8 + x, lds);
      else convert_task(p, 1, 2120 + (i - 64) * 8 + x, lds);
      break;
  }
}
#ifndef REP_S
#define REP_S -1
#endif
DEV void run_phase(const Params& p, int ph, char* lds, int* sh, int myx, int rep = 0, int rank = 0, int nloc = 0) {
  unsigned* cb = (unsigned*)(p.ws + OFF_CTR) + ph * 128 + rep * 6144;
  const int n = phase_nsub(ph);
  if (nloc > 0) {
#pragma unroll 1
    for (int i = rank; i < n; i += nloc) { __syncthreads(); run_task(p, ph, myx, i, lds); }
    return;
  }
#pragma unroll 1
  for (int xo = 0; xo < 8; xo++) {
    const int x = (myx + xo) & 7;
    unsigned* c = cb + x * 16;
    int i;
    while ((i = next_task(c, sh, n, xo > 0)) < n) run_task(p, ph, x, i, lds);
  }
}

__global__ void __launch_bounds__(256, 2) k_phase(Params p, int ph) {
  __shared__ __attribute__((aligned(16))) char lds[LDS_BYTES];
  __shared__ int sh[4];
  const Params& pr = *(const Params*)__builtin_amdgcn_kernarg_segment_ptr();
  run_phase(pr, ph, lds, sh, (int)(xb_xcc_id() & 7u));
}

__global__ void __launch_bounds__(256, 2) k_mega(Params p) {
  __shared__ __attribute__((aligned(16))) char lds[LDS_BYTES];
  __shared__ __attribute__((aligned(16))) unsigned xbw[4];
  __shared__ int sh[4];
  const Params& pr = *(const Params*)__builtin_amdgcn_kernarg_segment_ptr();
  if (threadIdx.x == 0) { xbw[0] = 0u; xbw[1] = 0u; xbw[2] = 0u; xbw[3] = 0u; }
  __syncthreads();
  XcdBarrier xb = xcd_barrier_post((unsigned*)(pr.ws + OFF_BAR), (volatile LAS unsigned*)xbw);
  const int myx = (int)(xb.x & 7u);
  if (pr.out == nullptr) cg::this_grid().sync();
#pragma unroll
  for (int ph = 0; ph < NPHASES; ph++) {
    {
      const int sub = ph > 0 ? (ph - 1) % 7 : -1;
      const bool uniform = (sub == 0 || sub == 1 || sub == 4 || sub == 5 || sub == 6);
      int nloc = 0, rank = 0;
      if (ph > 0 && uniform && xbw[1] == 8u) { nloc = (int)xbw[0]; rank = (int)xbw[2]; }
      run_phase(pr, ph, lds, sh, myx, 0, rank, nloc);
    }
    if ((REP_S == 7 && ph == 0) || (REP_S >= 0 && ph > 0 && (ph - 1) % 7 == REP_S && !(REP_S == 6 && ph > 7))) run_phase(pr, ph, lds, sh, myx, 1);
    if (ph + 1 < NPHASES) xcd_barrier(xb);
  }
}

extern "C" void kernel_launch(void* const* d_in, const int* in_sizes, int n_in, void* d_out, int out_size, void* d_ws,
                              size_t ws_size, hipStream_t stream) {
  Params p{};
  for (int i = 0; i < 27; i++) p.in[i] = (const float*)d_in[i];
  p.out = (float*)d_out;
  p.ws = (char*)d_ws;
  if (ws_size < WS_END) { fprintf(stderr, "workspace too small: %zu < %llu\n", ws_size, (unsigned long long)WS_END); return; }
  (void)hipMemsetAsync(d_ws, 0, 32768, stream);
#if COOP
  static int grid_blocks = 0;
  if (!grid_blocks) {
    int dev = 0, cus = 0, per_cu = 0;
    hipGetDevice(&dev);
    hipDeviceGetAttribute(&cus, hipDeviceAttributeMultiprocessorCount, dev);
    hipOccupancyMaxActiveBlocksPerMultiprocessor(&per_cu, k_mega, 256, 0);
    if (per_cu > 2) per_cu = 2;
    if (per_cu < 1) per_cu = 1;
    grid_blocks = cus * per_cu;
  }
  void* args[] = {&p};
  hipError_t e = hipLaunchCooperativeKernel((void*)k_mega, dim3(grid_blocks), dim3(256), args, 0, stream);
  if (e != hipSuccess) fprintf(stderr, "cooperative launch failed: %s (grid %d)\n", hipGetErrorString(e), grid_blocks);
#else
  for (int ph = 0; ph < NPHASES; ph++) k_phase<<<512, 256, 0, stream>>>(p, ph);
#endif
}
```

```cpp
#include <hip/hip_runtime.h>
#include <hip/hip_cooperative_groups.h>
#include <stdint.h>
#include <stdio.h>
namespace cg = cooperative_groups;

#ifndef COOP
#define COOP 1
#endif

typedef unsigned short bf16_t;
typedef __attribute__((ext_vector_type(8))) short bf16x8;
typedef __attribute__((ext_vector_type(4))) float f32x4;
typedef __attribute__((ext_vector_type(4))) unsigned int u32x4;
typedef __attribute__((ext_vector_type(2))) unsigned int u32x2;
#define DEV __device__ __forceinline__

#define NTOK 8192
#define DM 1024
#define DIN 7856
#define EPSF 1e-6f
#define P1W 2208
#define P3W 1024
#define P2W 1536
#define BRW 1536
#define REC_EL 36864

#define OFF_CTR  0ull
#define OFF_BAR  8192ull
#define OFF_MOD  32768ull
#define OFF_GAB  (OFF_MOD + 122880ull)
#define OFF_EGL  (OFF_GAB + 524288ull)
#define OFF_WTA  (OFF_EGL + 4096ull)
#define OFF_WGL  (OFF_WTA + 9961472ull)
#define OFF_WUQ  (OFF_WGL + 6291456ull)
#define OFF_WUKV (OFF_WUQ + 589824ull)
#define OFF_WBR  (OFF_WUKV + 524288ull)
#define OFF_WO   (OFF_WBR + 3145728ull)
#define OFF_H    (OFF_WO + 2097152ull)
#define OFF_P1   (OFF_H + 16777216ull)
#define OFF_ODIR OFF_P1
#define OFF_P3   (OFF_P1 + 36175872ull)
#define OFF_M    OFF_P3
#define OFF_P2   (OFF_P1 + 52953088ull)
#define OFF_GDN  (OFF_P2 + 25165824ull)
#define OFF_Q    (OFF_GDN + 75497472ull)
#define OFF_K    (OFF_Q + 12582912ull)
#define OFF_VT   (OFF_K + 14155776ull)
#define OFF_BR   (OFF_VT + 9437184ull)
#define WS_END   (OFF_BR + 25165824ull)
#define VT_LAT_EL 2097152

#define OUT_CKV   8388608
#define OUT_KROPE 10485760
#define OUT_STATE 10747904

#define LDS_BYTES 75776
#define LDS_SMALL 73728

struct Params {
  const float* in[27];
  float* out;
  char* ws;
};
enum { I_XP = 0, I_XS, I_CCKV, I_CKR, I_SGDN, I_C, I_CCTX, I_NORMG, I_WMOD, I_BMOD, I_WIN, I_QAN, I_WUQ, I_KVAN, I_WUKV,
       I_QN, I_KN, I_CONVW, I_ALOG, I_DTB, I_ONORM, I_LNG, I_LNB, I_WS, I_BS, I_WBR, I_WO };

DEV float bf2f(bf16_t b) { return __uint_as_float(((unsigned)b) << 16); }
typedef __bf16 hwbf2 __attribute__((ext_vector_type(2)));
typedef float hwf2 __attribute__((ext_vector_type(2)));
DEV unsigned pack2(float a, float b) { hwf2 v = {a, b}; return __builtin_bit_cast(unsigned, __builtin_convertvector(v, hwbf2)); }
DEV bf16_t f2bf(float f) { return (bf16_t)(pack2(f, 0.f) & 0xffffu); }
DEV void unpack8(u32x4 v, float* f) {
  f[0] = __uint_as_float(v.x << 16); f[1] = __uint_as_float(v.x & 0xffff0000u);
  f[2] = __uint_as_float(v.y << 16); f[3] = __uint_as_float(v.y & 0xffff0000u);
  f[4] = __uint_as_float(v.z << 16); f[5] = __uint_as_float(v.z & 0xffff0000u);
  f[6] = __uint_as_float(v.w << 16); f[7] = __uint_as_float(v.w & 0xffff0000u);
}
DEV void unpack4(u32x2 v, float* f) {
  f[0] = __uint_as_float(v.x << 16); f[1] = __uint_as_float(v.x & 0xffff0000u);
  f[2] = __uint_as_float(v.y << 16); f[3] = __uint_as_float(v.y & 0xffff0000u);
}
DEV u32x4 pack8(const float* f) {
  u32x4 v; v.x = pack2(f[0], f[1]); v.y = pack2(f[2], f[3]); v.z = pack2(f[4], f[5]); v.w = pack2(f[6], f[7]); return v;
}
DEV u32x2 pack4(float a, float b, float c, float d) { u32x2 v; v.x = pack2(a, b); v.y = pack2(c, d); return v; }
DEV bf16x8 as_frag(u32x4 v) { union { u32x4 u; bf16x8 b; } x; x.u = v; return x.b; }
DEV bf16x8 frag_from(f32x4 a, f32x4 b) {
  u32x4 v; v.x = pack2(a[0], a[1]); v.y = pack2(a[2], a[3]); v.z = pack2(b[0], b[1]); v.w = pack2(b[2], b[3]); return as_frag(v);
}
DEV bf16x8 ld2(const bf16_t* p) {
  u32x2 a = *(const u32x2*)p; u32x2 b = *(const u32x2*)(p + 16);
  u32x4 v; v.x = a.x; v.y = a.y; v.z = b.x; v.w = b.y; return as_frag(v);
}
DEV float frcp(float x) { return __builtin_amdgcn_rcpf(x); }
DEV float siluf(float x) { return x * frcp(1.f + __expf(-x)); }
DEV float sigmf(float x) { return frcp(1.f + __expf(-x)); }
DEV float geluf(float x) { float u = 0.7978845608028654f * (x + 0.044715f * x * x * x); return x * frcp(1.f + __expf(-2.f * u)); }
#define MFMA(a, b, c) __builtin_amdgcn_mfma_f32_16x16x32_bf16((a), (b), (c), 0, 0, 0)

DEV int otid() { int t = threadIdx.x; asm volatile("" : "+v"(t)); return t; }
DEV int next_task(unsigned* ctr, int* sh, int n, bool precheck) {
  __syncthreads();
  if (threadIdx.x == 0) {
    int v = n;
    if (!precheck || (int)__hip_atomic_load(ctr, __ATOMIC_RELAXED, __HIP_MEMORY_SCOPE_AGENT) < n) v = (int)atomicAdd(ctr, 1u);
    *sh = v;
  }
  __syncthreads();
  return *sh;
}

#define XB_TMO      128
#define XB_XCNT(j)  (256  + 64 * (j))
#define XB_XSUB(j)  (1280 + 64 * (j))
#define XB_XGEN(j)  (2304 + 64 * (j))
#define XB_TOP      3328
#define XB_TOPGEN   3392
#define XCD_BAR_WORDS 3456
#define XB_SPIN_CAP (1u << 22)
#define LAS __attribute__((address_space(3)))
DEV unsigned xb_ld(unsigned* p) { return __hip_atomic_load(p, __ATOMIC_RELAXED, __HIP_MEMORY_SCOPE_AGENT); }
DEV unsigned xb_add(unsigned* p, unsigned v) { return __hip_atomic_fetch_add(p, v, __ATOMIC_RELAXED, __HIP_MEMORY_SCOPE_AGENT); }
DEV unsigned xb_xcc_id() { return (unsigned)__builtin_amdgcn_s_getreg((3 << 11) | 20) & 0xFu; }
#define XB_SPIN(cond, bar) do { unsigned _sp = 0; while (cond) { __builtin_amdgcn_s_sleep(1); \
    if ((++_sp & 255u) == 0u) { if (xb_ld(&(bar)[XB_TMO])) break; if (_sp > XB_SPIN_CAP) { atomicAdd(&(bar)[XB_TMO], 1u); break; } } } } while (0)
struct XcdBarrier { unsigned* bar; unsigned x; volatile LAS unsigned* st; };
DEV XcdBarrier xcd_barrier_post(unsigned* bar, volatile LAS unsigned* st) {
  XcdBarrier b; b.bar = bar; b.x = xb_xcc_id(); b.st = st;
  if (threadIdx.x == 0) st[2] = xb_add(&bar[XB_XCNT(b.x)], 1u);
  return b;
}
DEV void xcd_barrier_complete(unsigned* bar, unsigned x, unsigned& nloc, unsigned& nx) {
  const unsigned G = gridDim.x * gridDim.y * gridDim.z;
  unsigned sum, cnt, mine, sp = 0u;
  for (;;) {
    sum = 0u; cnt = 0u; mine = 0u;
#pragma unroll
    for (unsigned j = 0; j < 16; ++j) { const unsigned c = xb_ld(&bar[XB_XCNT(j)]); sum += c; cnt += (c > 0u) ? 1u : 0u; mine = (j == x) ? c : mine; }
    if (sum == G) break;
    __builtin_amdgcn_s_sleep(1);
    if ((++sp & 255u) == 0u) { if (xb_ld(&bar[XB_TMO])) break; if (sp > XB_SPIN_CAP) { atomicAdd(&bar[XB_TMO], 1u); break; } }
  }
  nloc = mine > 0u ? mine : 1u; nx = cnt > 0u ? cnt : 1u;
}
DEV void xcd_barrier(const XcdBarrier& b) {
  asm volatile("s_waitcnt vmcnt(0)" ::: "memory");
  __syncthreads();
  if (threadIdx.x == 0) {
    unsigned* bar = b.bar;
    __builtin_amdgcn_s_waitcnt(0);
    unsigned nloc = b.st[0], nx = b.st[1];
    if (nloc == 0u) { xcd_barrier_complete(bar, b.x, nloc, nx); b.st[0] = nloc; b.st[1] = nx; }
    const unsigned old = xb_add(&bar[XB_XSUB(b.x)], 1u);
    const unsigned gen = old / nloc;
    if (old + 1u == (gen + 1u) * nloc) {
      __builtin_amdgcn_fence(__ATOMIC_RELEASE, "agent");
      asm volatile("s_waitcnt vmcnt(0)" ::: "memory");
      const unsigned og = xb_add(&bar[XB_TOP], 1u);
      const unsigned tg = og / nx;
      if (og + 1u == (tg + 1u) * nx) xb_add(&bar[XB_TOPGEN], 1u);
      else XB_SPIN(xb_ld(&bar[XB_TOPGEN]) == tg, bar);
      __builtin_amdgcn_fence(__ATOMIC_ACQUIRE, "agent");
      xb_add(&bar[XB_XGEN(b.x)], 1u);
      asm volatile("s_waitcnt vmcnt(0)" ::: "memory");
    } else {
      XB_SPIN(xb_ld(&bar[XB_XGEN(b.x)]) == gen, bar);
      __builtin_amdgcn_fence(__ATOMIC_ACQUIRE, "agent");
      asm volatile("s_waitcnt vmcnt(0)" ::: "memory");
    }
  }
  __syncthreads();
}

DEV const float* xrow_ptr(const Params& p, int l, int row) {
  if (l == 0) return row < 4096 ? p.in[I_XP] + (size_t)row * DM : p.in[I_XS] + (size_t)(row - 4096) * DM;
  return p.out + (size_t)row * DM;
}
DEV int modrow(int row) { return row < 4096 ? 0 : 1 + ((row - 4096) >> 10); }

struct ALPlain {
  const bf16_t* base; int ld;
  DEV u32x4 operator()(int row, int k) const { return *(const u32x4*)(base + (size_t)row * ld + k); }
};
struct ALScaled {
  const bf16_t* base; int ld; const float* rs; const float* g;
  DEV u32x4 operator()(int row, int k) const {
    u32x4 v = *(const u32x4*)(base + (size_t)row * ld + k);
    float f[8]; unpack8(v, f);
    const float r = rs[row];
    const f32x4 g0 = *(const f32x4*)(g + k), g1 = *(const f32x4*)(g + k + 4);
    f[0] *= r * g0.x; f[1] *= r * g0.y; f[2] *= r * g0.z; f[3] *= r * g0.w;
    f[4] *= r * g1.x; f[5] *= r * g1.y; f[6] *= r * g1.z; f[7] *= r * g1.w;
    return pack8(f);
  }
};
struct ALF32 {
  const float* base; int ld;
  DEV u32x4 operator()(int row, int k) const {
    const f32x4 a = *(const f32x4*)(base + (size_t)row * ld + k);
    const f32x4 b = *(const f32x4*)(base + (size_t)row * ld + k + 4);
    u32x4 v; v.x = pack2(a.x, a.y); v.y = pack2(a.z, a.w); v.z = pack2(b.x, b.y); v.w = pack2(b.z, b.w); return v;
  }
};

template <int TN>
DEV void gemm_compute(const bf16_t* As, const bf16_t* Bs, f32x4 (&acc)[4][TN / 32], int wm, int wn, int l16, int quad) {
  constexpr int NF = TN / 32;
#pragma unroll
  for (int ks = 0; ks < 2; ks++) {
    bf16x8 a[4], b[NF];
#pragma unroll
    for (int mi = 0; mi < 4; mi++) a[mi] = *(const bf16x8*)(As + (wm * 64 + mi * 16 + l16) * 72 + ks * 32 + quad * 8);
#pragma unroll
    for (int ni = 0; ni < NF; ni++) b[ni] = *(const bf16x8*)(Bs + (wn * (TN / 2) + ni * 16 + l16) * 72 + ks * 32 + quad * 8);
#pragma unroll
    for (int mi = 0; mi < 4; mi++)
#pragma unroll
      for (int ni = 0; ni < NF; ni++) acc[mi][ni] = MFMA(a[mi], b[ni], acc[mi][ni]);
  }
}
template <int TN, class AL>
DEV void gemm_core(const AL& al, const bf16_t* __restrict__ Bt, int ldb, int K, f32x4 (&acc)[4][TN / 32], char* lds) {
  constexpr int BUF = (128 + TN) * 72;
  constexpr int NF = TN / 32;
  bf16_t* L0 = (bf16_t*)lds;
  bf16_t* L1 = L0 + BUF;
  const int tid = otid(), lane = tid & 63, wave = tid >> 6;
  const int wm = wave >> 1, wn = wave & 1, l16 = lane & 15, quad = lane >> 4;
  u32x4 a0[4], b0[NF], a1[4], b1[NF];
#define G_LOAD(RA, RB, KK) { _Pragma("unroll") for (int i = 0; i < 4; i++) { int it = tid + 256 * i; RA[i] = al(it >> 3, (KK) + (it & 7) * 8); } \
                             _Pragma("unroll") for (int i = 0; i < NF; i++) { int it = tid + 256 * i; RB[i] = *(const u32x4*)(Bt + (size_t)(it >> 3) * ldb + (KK) + (it & 7) * 8); } }
#define G_STORE(LB, RA, RB) { _Pragma("unroll") for (int i = 0; i < 4; i++) { int it = tid + 256 * i; *(u32x4*)((LB) + (it >> 3) * 72 + (it & 7) * 8) = RA[i]; } \
                              _Pragma("unroll") for (int i = 0; i < NF; i++) { int it = tid + 256 * i; *(u32x4*)((LB) + 128 * 72 + (it >> 3) * 72 + (it & 7) * 8) = RB[i]; } }
  G_LOAD(a0, b0, 0);
  G_LOAD(a1, b1, 64);
  __syncthreads();
  G_STORE(L0, a0, b0);
  __syncthreads();
  for (int k0 = 0; k0 + 128 < K; k0 += 128) {
    G_LOAD(a0, b0, k0 + 128);
    __builtin_amdgcn_sched_barrier(0);
    gemm_compute<TN>(L0, L0 + 128 * 72, acc, wm, wn, l16, quad);
    G_STORE(L1, a1, b1);
    __syncthreads();
    G_LOAD(a1, b1, k0 + 192);
    __builtin_amdgcn_sched_barrier(0);
    gemm_compute<TN>(L1, L1 + 128 * 72, acc, wm, wn, l16, quad);
    G_STORE(L0, a0, b0);
    __syncthreads();
  }
  gemm_compute<TN>(L0, L0 + 128 * 72, acc, wm, wn, l16, quad);
  G_STORE(L1, a1, b1);
  __syncthreads();
  gemm_compute<TN>(L1, L1 + 128 * 72, acc, wm, wn, l16, quad);
#undef G_LOAD
#undef G_STORE
}

template <int TN>
DEV void acc_to_lds(f32x4 (&acc)[4][TN / 32], float* Cs) {
  const int tid = otid(), lane = tid & 63, wave = tid >> 6;
  const int wm = wave >> 1, wn = wave & 1, l16 = lane & 15, quad = lane >> 4;
  __syncthreads();
#pragma unroll
  for (int mi = 0; mi < 4; mi++)
#pragma unroll
    for (int ni = 0; ni < TN / 32; ni++)
#pragma unroll
      for (int j = 0; j < 4; j++)
        Cs[(wm * 64 + mi * 16 + quad * 4 + j) * (TN + 4) + wn * (TN / 2) + ni * 16 + l16] = acc[mi][ni][j];
  __syncthreads();
}
template <int NF>
DEV void zero_acc(f32x4 (&acc)[4][NF]) {
#pragma unroll
  for (int mi = 0; mi < 4; mi++)
#pragma unroll
    for (int ni = 0; ni < NF; ni++) acc[mi][ni] = f32x4{0.f, 0.f, 0.f, 0.f};
}

DEV void transpose_tile(const float* __restrict__ src, int ld, int col0, int ncols, int K, bf16_t* dst, int nt, int kt, float* tile) {
  const int tid = otid();
  const int n = tid & 63, kk = tid >> 6, gn = nt * 64 + n;
#pragma unroll
  for (int i = 0; i < 16; i++) {
    int k = kk + 4 * i;
    float v = (gn < ncols) ? src[(size_t)(kt * 64 + k) * ld + col0 + gn] : 0.f;
    tile[k * 65 + n] = v;
  }
  __syncthreads();
#pragma unroll
  for (int i = 0; i < 2; i++) {
    int it = tid + 256 * i, nn = it >> 3, kg = it & 7;
    float f[8];
#pragma unroll
    for (int j = 0; j < 8; j++) f[j] = tile[(kg * 8 + j) * 65 + nn];
    *(u32x4*)(dst + (size_t)(nt * 64 + nn) * K + kt * 64 + kg * 8) = pack8(f);
  }
}
#define NCONV_TASKS 2760
DEV void convert_task(const Params& p, int l, int t, char* lds) {
  char* ws_ = p.ws; asm volatile("" : "+s"(ws_));
  float* tile = (float*)lds;
  char* ws = ws_;
  if (t < 1216) { transpose_tile(p.in[I_WIN] + (size_t)l * 1024 * DIN, DIN, 0, 4784, 1024, (bf16_t*)(ws + OFF_WTA), t % 76, t / 76, tile); return; }
  t -= 1216;
  if (t < 768) { transpose_tile(p.in[I_WIN] + (size_t)l * 1024 * DIN, DIN, 4784, 3072, 1024, (bf16_t*)(ws + OFF_WGL), t % 48, t / 48, tile); return; }
  t -= 768;
  if (t < 72) { transpose_tile(p.in[I_WUQ] + (size_t)l * 384 * 768, 768, 0, 768, 384, (bf16_t*)(ws + OFF_WUQ), t % 12, t / 12, tile); return; }
  t -= 72;
  if (t < 64) { transpose_tile(p.in[I_WUKV] + (size_t)l * 256 * 1024, 1024, 0, 1024, 256, (bf16_t*)(ws + OFF_WUKV), t % 16, t / 16, tile); return; }
  t -= 64;
  if (t < 384) {
    int n = t / 128, tt = t % 128;
    transpose_tile(p.in[I_WBR] + (size_t)(l * 3 + n) * 512 * 1024, 1024, 0, 1024, 512, (bf16_t*)(ws + OFF_WBR) + (size_t)n * 1024 * 512, tt % 16, tt / 16, tile);
    return;
  }
  t -= 384;
  transpose_tile(p.in[I_WO] + (size_t)l * 1024 * 1024, 1024, 0, 1024, 1024, (bf16_t*)(ws + OFF_WO), t % 16, t / 16, tile);
}
DEV void mod_task(const Params& p, int t, char* lds) {
  char* ws_ = p.ws; asm volatile("" : "+s"(ws_));
  const int tid = otid();
  const int l = t / 192, n0 = (t % 192) * 16;
  float* s = (float*)lds;
  float* red = (float*)(lds + 32768);
  for (int idx = tid; idx < 5120; idx += 256) {
    int r = idx >> 10, k = idx & 1023;
    float v = (r == 0) ? p.in[I_CCTX][k] : p.in[I_C][(r - 1) * 1024 + k];
    s[idx] = v * frcp(1.f + __expf(-v));
  }
  __syncthreads();
  const int col = tid & 15, ksl = tid >> 4;
  float acc[5] = {0.f, 0.f, 0.f, 0.f, 0.f};
  const float* w = p.in[I_WMOD] + (size_t)l * 1024 * 3072 + n0 + col;
#pragma unroll 16
  for (int k = ksl * 64; k < ksl * 64 + 64; k++) {
    float wv = w[(size_t)k * 3072];
#pragma unroll
    for (int r = 0; r < 5; r++) acc[r] += s[r * 1024 + k] * wv;
  }
#pragma unroll
  for (int r = 0; r < 5; r++) red[(ksl * 5 + r) * 16 + col] = acc[r];
  __syncthreads();
  float* mod = (float*)(ws_ + OFF_MOD);
  if (tid < 80) {
    int r = tid >> 4, c = tid & 15;
    float v = p.in[I_BMOD][l * 3072 + n0 + c];
#pragma unroll
    for (int q = 0; q < 16; q++) v += red[(q * 5 + r) * 16 + c];
    mod[(l * 5 + r) * 3072 + n0 + c] = v;
  }
}

DEV void norm_task(const Params& p, int l, int t) {
  char* ws_ = p.ws; asm volatile("" : "+s"(ws_));
  const int tid = otid(), lane = tid & 63, wave = tid >> 6;
  const float* mod = (const float*)(ws_ + OFF_MOD);
  bf16_t* H = (bf16_t*)(ws_ + OFF_H);
#pragma unroll
  for (int rr = 0; rr < 2; rr++) {
    const int row = t * 8 + wave * 2 + rr;
    const float* x = xrow_ptr(p, l, row);
    const float* mr = mod + (size_t)(l * 5 + modrow(row)) * 3072;
    f32x4 v[4];
    float ss = 0.f;
#pragma unroll
    for (int i = 0; i < 4; i++) { v[i] = *(const f32x4*)(x + lane * 4 + 256 * i); ss += v[i].x * v[i].x + v[i].y * v[i].y + v[i].z * v[i].z + v[i].w * v[i].w; }
#pragma unroll
    for (int o = 32; o >= 1; o >>= 1) ss += __shfl_xor(ss, o);
    const float rstd = __builtin_amdgcn_rsqf(ss * (1.f / 1024.f) + EPSF);
#pragma unroll
    for (int i = 0; i < 4; i++) {
      const int col = lane * 4 + 256 * i;
      const f32x4 g = *(const f32x4*)(p.in[I_NORMG] + l * 1024 + col);
      const f32x4 sh = *(const f32x4*)(mr + col);
      const f32x4 sc = *(const f32x4*)(mr + 1024 + col);
      float a = v[i].x * rstd * g.x * (1.f + sc.x) + sh.x;
      float b = v[i].y * rstd * g.y * (1.f + sc.y) + sh.y;
      float c = v[i].z * rstd * g.z * (1.f + sc.z) + sh.z;
      float d = v[i].w * rstd * g.w * (1.f + sc.w) + sh.w;
      *(u32x2*)(H + (size_t)row * 1024 + col) = pack4(a, b, c, d);
    }
  }
}

DEV void projA_task(const Params& p, int l, int t, char* lds) {
  char* ws_ = p.ws; asm volatile("" : "+s"(ws_));
  const int tid = otid();
  const int nt = t / 64, mt = t % 64;
  f32x4 acc[4][4]; zero_acc<4>(acc);
  ALPlain al{(const bf16_t*)(ws_ + OFF_H) + (size_t)mt * 128 * 1024, 1024};
  gemm_core<128>(al, (const bf16_t*)(ws_ + OFF_WTA) + (size_t)nt * 128 * 1024, 1024, 1024, acc, lds);
  float* Cs = (float*)lds;
  acc_to_lds<128>(acc, Cs);
  bf16_t* P1 = (bf16_t*)(ws_ + OFF_P1);
  bf16_t* P2 = (bf16_t*)(ws_ + OFF_P2);
  bf16_t* P3 = (bf16_t*)(ws_ + OFF_P3);
  float* GAB = (float*)(ws_ + OFF_GAB);
#pragma unroll
  for (int i = 0; i < 8; i++) {
    const int it = tid + 256 * i, r = it >> 4, c8 = it & 15;
    const int n = nt * 128 + c8 * 8;
    if (n >= 4784) continue;
    const int row = mt * 128 + r;
    float f[8];
    const f32x4 a = *(const f32x4*)(Cs + r * 132 + c8 * 8);
    const f32x4 b = *(const f32x4*)(Cs + r * 132 + c8 * 8 + 4);
    f[0] = a.x; f[1] = a.y; f[2] = a.z; f[3] = a.w; f[4] = b.x; f[5] = b.y; f[6] = b.z; f[7] = b.w;
    if (n >= 2720 && n < 2736) {
      *(f32x4*)(GAB + (size_t)row * 16 + (n - 2720)) = a;
      *(f32x4*)(GAB + (size_t)row * 16 + (n - 2720) + 4) = b;
      continue;
    }
    if (n >= 640 && n < 672 && row < 4096) {
      float* o = p.out + OUT_KROPE + ((size_t)((row >> 8) * 2 + l) * 256 + (row & 255)) * 32 + (n - 640);
      *(f32x4*)o = a; *(f32x4*)(o + 4) = b;
    }
    bf16_t* dst;
    if (n < 672) dst = P1 + (size_t)row * P1W + n;
    else if (n < 1184) dst = P2 + (size_t)row * P2W + (n - 672);
    else if (n < 2720) dst = P1 + (size_t)row * P1W + 672 + (n - 1184);
    else if (n < 3248) dst = P2 + (size_t)row * P2W + 512 + (n - 2736);
    else if (n < 3760) dst = P3 + (size_t)row * P3W + (n - 3248);
    else if (n < 4272) dst = P3 + (size_t)row * P3W + 512 + (n - 3760);
    else dst = P2 + (size_t)row * P2W + 1024 + (n - 4272);
    *(u32x4*)dst = pack8(f);
  }
}

DEV void rope32(float* r, int prow, int pcol) {
  const float inv[8] = {1.f, 0.31622776601683794f, 0.1f, 0.031622776601683794f, 0.01f, 0.0031622776601683794f, 0.001f, 0.00031622776601683794f};
#pragma unroll
  for (int i = 0; i < 8; i++) {
    float a1 = (float)prow * inv[i], a2 = (float)pcol * inv[i];
    float c1 = __cosf(a1), s1 = __sinf(a1), c2 = __cosf(a2), s2 = __sinf(a2);
    float x1 = r[i], x2 = r[8 + i];
    r[i] = x1 * c1 - x2 * s1; r[8 + i] = x1 * s1 + x2 * c1;
    float y1 = r[16 + i], y2 = r[24 + i];
    r[16 + i] = y1 * c2 - y2 * s2; r[24 + i] = y1 * s2 + y2 * c2;
  }
}
DEV void finish_qk(float* v  , int half, const float* normw  , bool do_rope, int pos, float scale, bf16_t* dst  ) {
  float ss = 0.f;
#pragma unroll
  for (int i = 0; i < 48; i++) ss += v[i] * v[i];
  ss += __shfl_xor(ss, 1);
  const float rstd = __builtin_amdgcn_rsqf(ss * (1.f / 96.f) + EPSF);
#pragma unroll
  for (int i = 0; i < 12; i++) {
    const f32x4 w = *(const f32x4*)(normw + half * 48 + i * 4);
    v[i * 4] *= rstd * w.x; v[i * 4 + 1] *= rstd * w.y; v[i * 4 + 2] *= rstd * w.z; v[i * 4 + 3] *= rstd * w.w;
  }
  if (do_rope && half == 1) rope32(v + 16, pos >> 6, pos & 63);
#pragma unroll
  for (int i = 0; i < 6; i++) {
    float f[8];
#pragma unroll
    for (int j = 0; j < 8; j++) f[j] = v[i * 8 + j] * scale;
    *(u32x4*)(dst + half * 48 + i * 8) = pack8(f);
  }
}

#define QSCALE 0.14724306f
DEV void q_task(const Params& p, int l, int t, char* lds) {
  char* ws_ = p.ws; asm volatile("" : "+s"(ws_));
  const int tid = otid();
  const int mt = t & 63, h = t >> 6;
  const bf16_t* P1 = (const bf16_t*)(ws_ + OFF_P1);
  float* rs = (float*)(lds + LDS_SMALL);
  {
    const int row = tid >> 1, half = tid & 1;
    const bf16_t* src = P1 + (size_t)(mt * 128 + row) * P1W + half * 192;
    float ss = 0.f;
#pragma unroll 12
    for (int i = 0; i < 24; i++) { float f[8]; unpack8(*(const u32x4*)(src + i * 8), f);
#pragma unroll
      for (int j = 0; j < 8; j++) ss += f[j] * f[j]; }
    ss += __shfl_xor(ss, 1);
    if (!half) rs[row] = __builtin_amdgcn_rsqf(ss * (1.f / 384.f) + EPSF);
  }
  __syncthreads();
  f32x4 acc[4][3]; zero_acc<3>(acc);
  ALScaled al{P1 + (size_t)mt * 128 * P1W, P1W, rs, p.in[I_QAN] + l * 384};
  gemm_core<96>(al, (const bf16_t*)(ws_ + OFF_WUQ) + (size_t)h * 96 * 384, 384, 384, acc, lds);
  float* Cs = (float*)lds;
  acc_to_lds<96>(acc, Cs);
  const int row = tid >> 1, half = tid & 1, grow = mt * 128 + row;
  float v[48];
#pragma unroll
  for (int i = 0; i < 48; i++) v[i] = Cs[row * 100 + half * 48 + i];
  finish_qk(v, half, p.in[I_QN] + l * 96, grow >= 4096, (grow - 4096) & 1023, QSCALE,
            (bf16_t*)(ws_ + OFF_Q) + ((size_t)grow * 8 + h) * 96);
}

DEV void kv_task(const Params& p, int l, int t, char* lds) {
  char* ws_ = p.ws; asm volatile("" : "+s"(ws_));
  const int tid = otid();
  const int h = t / 72, mt = t % 72;
  const bf16_t* P1 = (const bf16_t*)(ws_ + OFF_P1);
  float* rs = (float*)(lds + LDS_SMALL);
  f32x4 acc[4][4]; zero_acc<4>(acc);
  const bf16_t* Bt = (const bf16_t*)(ws_ + OFF_WUKV) + (size_t)h * 128 * 256;
  if (mt < 64) {
    {
      const int row = tid >> 1, half = tid & 1;
      const bf16_t* src = P1 + (size_t)(mt * 128 + row) * P1W + 384 + half * 128;
      float ss = 0.f;
#pragma unroll
      for (int i = 0; i < 16; i++) { float f[8]; unpack8(*(const u32x4*)(src + i * 8), f);
#pragma unroll
        for (int j = 0; j < 8; j++) ss += f[j] * f[j]; }
      ss += __shfl_xor(ss, 1);
      if (!half) rs[row] = __builtin_amdgcn_rsqf(ss * (1.f / 256.f) + EPSF);
    }
    __syncthreads();
    if (h == 0 && mt < 32) {
#pragma unroll 8
      for (int it = tid; it < 128 * 32; it += 256) {
        const int r = it >> 5, c8 = it & 31, row = mt * 128 + r;
        float f[8]; unpack8(*(const u32x4*)(P1 + (size_t)row * P1W + 384 + c8 * 8), f);
        const float rr = rs[r];
        const float* g = p.in[I_KVAN] + l * 256 + c8 * 8;
        float* o = p.out + OUT_CKV + ((size_t)((row >> 8) * 2 + l) * 256 + (row & 255)) * 256 + c8 * 8;
        *(f32x4*)o = f32x4{f[0] * rr * g[0], f[1] * rr * g[1], f[2] * rr * g[2], f[3] * rr * g[3]};
        *(f32x4*)(o + 4) = f32x4{f[4] * rr * g[4], f[5] * rr * g[5], f[6] * rr * g[6], f[7] * rr * g[7]};
      }
    }
    ALScaled al{P1 + (size_t)mt * 128 * P1W + 384, P1W, rs, p.in[I_KVAN] + l * 256};
    gemm_core<128>(al, Bt, 256, 256, acc, lds);
  } else {
    const int b = (mt - 64) >> 1, p0 = ((mt - 64) & 1) * 128;
    ALF32 al{p.in[I_CCKV] + ((size_t)(b * 2 + l) * 256 + p0) * 256, 256};
    gemm_core<128>(al, Bt, 256, 256, acc, lds);
  }
  float* Cs = (float*)lds;
  acc_to_lds<128>(acc, Cs);
  {
    const int row = tid >> 1, half = tid & 1;
    float v[48];
    int krow; bool do_rope = false; int pos = 0;
    if (mt < 64) {
      const int grow = mt * 128 + row;
      krow = grow; do_rope = grow >= 4096; pos = (grow - 4096) & 1023;
      if (half == 0) {
#pragma unroll
        for (int i = 0; i < 48; i++) v[i] = Cs[row * 132 + i];
      } else {
#pragma unroll
        for (int i = 0; i < 16; i++) v[i] = Cs[row * 132 + 48 + i];
        const bf16_t* kr = P1 + (size_t)grow * P1W + 640;
#pragma unroll
        for (int i = 0; i < 4; i++) { float f[8]; unpack8(*(const u32x4*)(kr + i * 8), f);
#pragma unroll
          for (int j = 0; j < 8; j++) v[16 + i * 8 + j] = f[j]; }
      }
    } else {
      const int b = (mt - 64) >> 1, pp = ((mt - 64) & 1) * 128 + row;
      krow = 8192 + b * 256 + pp;
      if (half == 0) {
#pragma unroll
        for (int i = 0; i < 48; i++) v[i] = Cs[row * 132 + i];
      } else {
#pragma unroll
        for (int i = 0; i < 16; i++) v[i] = Cs[row * 132 + 48 + i];
        const float* kr = p.in[I_CKR] + ((size_t)(b * 2 + l) * 256 + pp) * 32;
#pragma unroll
        for (int i = 0; i < 8; i++) { const f32x4 w = *(const f32x4*)(kr + i * 4); v[16 + i * 4] = w.x; v[17 + i * 4] = w.y; v[18 + i * 4] = w.z; v[19 + i * 4] = w.w; }
      }
    }
    finish_qk(v, half, p.in[I_KN] + l * 96, do_rope, pos, 1.f, (bf16_t*)(ws_ + OFF_K) + ((size_t)krow * 8 + h) * 96);
  }
  {
    size_t vbase; int Tk, key0;
    if (mt < 32) { const int b = mt >> 1; Tk = 256; key0 = (mt & 1) * 128; vbase = (size_t)(b * 8 + h) * 64 * 256; }
    else if (mt < 64) { const int b = (mt - 32) >> 3; Tk = 1280; key0 = 256 + ((mt - 32) & 7) * 128; vbase = VT_LAT_EL + (size_t)(b * 8 + h) * 64 * 1280; }
    else { const int b = (mt - 64) >> 1; Tk = 1280; key0 = ((mt - 64) & 1) * 128; vbase = VT_LAT_EL + (size_t)(b * 8 + h) * 64 * 1280; }
    bf16_t* Vt = (bf16_t*)(ws_ + OFF_VT) + vbase;
#pragma unroll
    for (int i = 0; i < 4; i++) {
      const int it = tid + 256 * i, dv = it & 63, kg = it >> 6;
      float f[8];
#pragma unroll
      for (int j = 0; j < 8; j++) f[j] = Cs[(kg * 8 + j) * 132 + 64 + dv];
      *(u32x4*)(Vt + (size_t)dv * Tk + key0 + kg * 8) = pack8(f);
    }
  }
}

DEV void conv_pass(const Params& p, int l, int seg, int h, int row0, int sbeg, int send, float* F, bf16_t* Vtile) {
  char* ws_ = p.ws; asm volatile("" : "+s"(ws_));
  const int tid = otid(), c8 = tid & 15, tg = tid >> 4;
  const bf16_t* src = (const bf16_t*)(ws_ + OFF_P1) + 672 + seg * 512 + h * 128 + c8 * 8;
  const float* cwp = p.in[I_CONVW] + (size_t)l * 5 * 1536 + seg * 512 + h * 128 + c8 * 8;
  float cw[5][8];
#pragma unroll
  for (int j = 0; j < 5; j++) {
    const f32x4 a = *(const f32x4*)(cwp + j * 1536), b = *(const f32x4*)(cwp + j * 1536 + 4);
    cw[j][0] = a.x; cw[j][1] = a.y; cw[j][2] = a.z; cw[j][3] = a.w; cw[j][4] = b.x; cw[j][5] = b.y; cw[j][6] = b.z; cw[j][7] = b.w;
  }
  const int t0 = row0 + tg * 4;
  u32x4 raw[8];
#pragma unroll
  for (int r = 0; r < 8; r++) {
    const int row = t0 - 2 + r;
    raw[r] = (row >= sbeg && row < send) ? *(const u32x4*)(src + (size_t)row * P1W) : u32x4{0u, 0u, 0u, 0u};
  }
  float acc[4][8];
#pragma unroll
  for (int tt = 0; tt < 4; tt++)
#pragma unroll
    for (int c = 0; c < 8; c++) acc[tt][c] = 0.f;
#pragma unroll
  for (int r = 0; r < 8; r++) {
    float f[8]; unpack8(raw[r], f);
#pragma unroll
    for (int tt = 0; tt < 4; tt++) {
      const int j = r - tt;
      if (j >= 0 && j < 5) {
#pragma unroll
        for (int c = 0; c < 8; c++) acc[tt][c] += cw[j][c] * f[c];
      }
    }
  }
#pragma unroll
  for (int tt = 0; tt < 4; tt++) {
    float y[8];
#pragma unroll
    for (int c = 0; c < 8; c++) y[c] = siluf(acc[tt][c]);
    if (F) {
#pragma unroll
      for (int c = 0; c < 8; c++) F[(tg * 4 + tt) * 129 + c8 * 8 + c] = y[c];
    } else {
      *(u32x4*)(Vtile + (tg * 4 + tt) * 136 + c8 * 8) = pack8(y);
    }
  }
}
DEV void l2norm_rows(const float* F, bf16_t* T) {
  const int tid = otid(), row = tid >> 2, part = tid & 3;
  float ss = 0.f;
#pragma unroll
  for (int i = 0; i < 32; i++) { float x = F[row * 129 + part * 32 + i]; ss += x * x; }
  ss += __shfl_xor(ss, 1); ss += __shfl_xor(ss, 2);
  const float inv = __builtin_amdgcn_rsqf(ss + EPSF);
#pragma unroll
  for (int i = 0; i < 32; i++) T[row * 136 + part * 32 + i] = f2bf(F[row * 129 + part * 32 + i] * inv);
}
DEV void mm64(const bf16_t* At, const bf16_t* Bt_, float* Out, int wave, int l16, int quad) {
  f32x4 acc[4];
#pragma unroll
  for (int ni = 0; ni < 4; ni++) acc[ni] = f32x4{0.f, 0.f, 0.f, 0.f};
#pragma unroll
  for (int ks = 0; ks < 4; ks++) {
    bf16x8 a = *(const bf16x8*)(At + (wave * 16 + l16) * 136 + ks * 32 + quad * 8);
#pragma unroll
    for (int ni = 0; ni < 4; ni++) {
      bf16x8 b = *(const bf16x8*)(Bt_ + (ni * 16 + l16) * 136 + ks * 32 + quad * 8);
      acc[ni] = MFMA(a, b, acc[ni]);
    }
  }
#pragma unroll
  for (int ni = 0; ni < 4; ni++)
#pragma unroll
    for (int j = 0; j < 4; j++) Out[(wave * 16 + quad * 4 + j) * 65 + ni * 16 + l16] = acc[ni][j];
}
DEV void gdn_prep_task(const Params& p, int l, int t, char* lds) {
  char* ws_ = p.ws; asm volatile("" : "+s"(ws_));
  const int tid = otid(), lane = tid & 63, wave = tid >> 6, l16 = lane & 15, quad = lane >> 4;
  const int chunk = t >> 2, h = t & 3, row0 = chunk * 64;
  int sbeg, send;
  if (row0 < 4096) { sbeg = row0 & ~255; send = sbeg + 256; } else { sbeg = 4096 + ((row0 - 4096) & ~1023); send = sbeg + 1024; }
  bf16_t* Kt = (bf16_t*)lds;
  bf16_t* Qt = Kt + 64 * 136;
  float* F = (float*)(lds + 34816);
  float* G = F;
  float* Pm = (float*)(lds + 34816 + 17408);
  float* Am = Pm;
  float* gcs = (float*)(lds + LDS_SMALL);
  float* betas = gcs + 128;
  const float* GAB = (const float*)(ws_ + OFF_GAB);
  if (tid < 128) {
    const int dir = tid >> 6, ip = tid & 63, tok = dir ? 63 - ip : ip, row = row0 + tok;
    const float ga = GAB[(size_t)row * 16 + dir * 4 + h], gb = GAB[(size_t)row * 16 + 8 + dir * 4 + h];
    const float a = __expf(p.in[I_ALOG][(l * 2 + dir) * 4 + h]);
    const float x = ga + p.in[I_DTB][(l * 2 + dir) * 4 + h];
    const float ex = __expf(fminf(x, 20.f));
    const float sp = x > 20.f ? x : (ex < 0.01f ? ex * (1.f - ex * (0.5f - ex * (1.f / 3.f))) : __logf(1.f + ex));
    float g = -a * sp;
#pragma unroll
    for (int off = 1; off < 64; off <<= 1) { float v = __shfl_up(g, off); if (ip >= off) g += v; }
    gcs[dir * 64 + ip] = g;
    betas[dir * 64 + ip] = frcp(1.f + __expf(-gb));
  }
  conv_pass(p, l, 1, h, row0, sbeg, send, F, nullptr);
  __syncthreads();
  l2norm_rows(F, Kt);
  __syncthreads();
  conv_pass(p, l, 0, h, row0, sbeg, send, F, nullptr);
  __syncthreads();
  l2norm_rows(F, Qt);
  __syncthreads();
  mm64(Qt, Kt, Pm, wave, l16, quad);
  bf16_t* recbase = (bf16_t*)(ws_ + OFF_GDN) + (size_t)(chunk * 4 + h) * 2 * REC_EL;
#pragma unroll 1
  for (int dir = 0; dir < 2; dir++) {
    bf16_t* rec = recbase + (size_t)dir * REC_EL;
    const float* gc = gcs + dir * 64;
    const float gl = gc[63];
#pragma unroll
    for (int i = 0; i < 4; i++) {
      const int it = tid + 256 * i, ip = it >> 4, c8 = it & 15, tok = dir ? 63 - ip : ip;
      const float sc = 0.08838834764831845f * __expf(gc[ip]);
      float f[8]; unpack8(*(const u32x4*)(Qt + tok * 136 + c8 * 8), f);
#pragma unroll
      for (int j = 0; j < 8; j++) f[j] *= sc;
      *(u32x4*)(rec + 8192 + ip * 128 + c8 * 8) = pack8(f);
    }
#pragma unroll
    for (int i = 0; i < 4; i++) {
      const int it = tid + 256 * i, d = it & 127, ig = it >> 7;
      float f[8];
#pragma unroll
      for (int j = 0; j < 8; j++) { const int ip = ig * 8 + j, tok = dir ? 63 - ip : ip; f[j] = bf2f(Kt[tok * 136 + d]) * __expf(gl - gc[ip]); }
      *(u32x4*)(rec + 20480 + d * 64 + ig * 8) = pack8(f);
    }
    if (tid == 0) ((float*)(ws_ + OFF_EGL))[(chunk * 4 + h) * 2 + dir] = __expf(gl);
  }
  __syncthreads();
  conv_pass(p, l, 2, h, row0, sbeg, send, nullptr, Qt);
#pragma unroll 1
  for (int dir = 0; dir < 2; dir++) {
    bf16_t* rec = recbase + (size_t)dir * REC_EL;
    const float* gc = gcs + dir * 64;
#pragma unroll
    for (int i = 0; i < 2; i++) {
      const int it = tid + 256 * i, ip = it >> 3, j8 = it & 7, ti = dir ? 63 - ip : ip;
      float f[8];
#pragma unroll
      for (int j = 0; j < 8; j++) {
        const int jp = j8 * 8 + j, tj = dir ? 63 - jp : jp;
        const float e = __expf(fminf(gc[ip] - gc[jp], 0.f));
        f[j] = (ip >= jp) ? Pm[ti * 65 + tj] * 0.08838834764831845f * e : 0.f;
      }
      *(u32x4*)(rec + 16384 + ip * 64 + j8 * 8) = pack8(f);
    }
  }
  __syncthreads();
  const bf16_t* Vtile = Qt;
  float* T = G;
#pragma unroll 1
  for (int dir = 0; dir < 2; dir++) {
    bf16_t* rec = recbase + (size_t)dir * REC_EL;
    const float* gc = gcs + dir * 64;
    const float* be = betas + dir * 64;
    mm64(Kt, Kt, G, wave, l16, quad);
    __syncthreads();
#pragma unroll 2
    for (int i = 0; i < 16; i++) {
      const int it = tid + 256 * i, ip = it >> 6, jp = it & 63;
      const int ti = dir ? 63 - ip : ip, tj = dir ? 63 - jp : jp;
      const float e = __expf(fminf(gc[ip] - gc[jp], 0.f));
      Am[ip * 68 + jp] = (ip > jp) ? be[ip] * G[ti * 65 + tj] * e : 0.f;
    }
    __syncthreads();
    {
      const int cl = lane >> 2, q = lane & 3, c = wave * 16 + cl;
      float r[16];
#pragma unroll
      for (int m = 0; m < 16; m++) r[m] = (q + 4 * m == c) ? 1.f : 0.f;
#pragma unroll
      for (int j = 0; j < 63; j++) {
        const int mj = j >> 2;
        float t;
        switch (j & 3) {
          case 0: t = __int_as_float(__builtin_amdgcn_update_dpp(0, __float_as_int(r[mj]), 0x00, 0xF, 0xF, true)); break;
          case 1: t = __int_as_float(__builtin_amdgcn_update_dpp(0, __float_as_int(r[mj]), 0x55, 0xF, 0xF, true)); break;
          case 2: t = __int_as_float(__builtin_amdgcn_update_dpp(0, __float_as_int(r[mj]), 0xAA, 0xF, 0xF, true)); break;
          default: t = __int_as_float(__builtin_amdgcn_update_dpp(0, __float_as_int(r[mj]), 0xFF, 0xF, 0xF, true)); break;
        }
#pragma unroll
        for (int m = mj; m < 16; m++) r[m] -= Am[(q + 4 * m) * 68 + j] * t;
        if ((j & 7) == 7) asm volatile("" ::: "memory");
      }
#pragma unroll
      for (int m = 0; m < 16; m++) T[(q + 4 * m) * 68 + c] = r[m];
    }
    __syncthreads();
#pragma unroll 1
    for (int which = 0; which < 2; which++) {
      const bf16_t* srcT = which ? Kt : Vtile;
      f32x4 ac[4][2];
      zero_acc<2>(ac);
#pragma unroll
      for (int ks = 0; ks < 2; ks++) {
        float cs[8];
        unsigned short e[2][8];
#pragma unroll
        for (int s = 0; s < 8; s++) {
          const int j = ks * 32 + quad * 8 + s, tok = dir ? 63 - j : j;
          cs[s] = which ? be[j] * __expf(gc[j]) : be[j];
#pragma unroll
          for (int nf = 0; nf < 2; nf++) e[nf][s] = srcT[tok * 136 + wave * 32 + nf * 16 + l16];
        }
        bf16x8 bfr[2];
#pragma unroll
        for (int nf = 0; nf < 2; nf++) {
          u32x4 v;
          v.x = e[nf][0] | ((unsigned)e[nf][1] << 16); v.y = e[nf][2] | ((unsigned)e[nf][3] << 16);
          v.z = e[nf][4] | ((unsigned)e[nf][5] << 16); v.w = e[nf][6] | ((unsigned)e[nf][7] << 16);
          bfr[nf] = as_frag(v);
        }
#pragma unroll
        for (int mi = 0; mi < 4; mi++) {
          const float* tr = T + (mi * 16 + l16) * 68 + ks * 32 + quad * 8;
          const f32x4 t0 = *(const f32x4*)tr, t1 = *(const f32x4*)(tr + 4);
          const float tv[8] = {t0.x, t0.y, t0.z, t0.w, t1.x, t1.y, t1.z, t1.w};
          float a[8], hi[8], lo[8];
#pragma unroll
          for (int s = 0; s < 8; s++) a[s] = tv[s] * cs[s];
          const u32x4 ph = pack8(a);
          unpack8(ph, hi);
#pragma unroll
          for (int s = 0; s < 8; s++) lo[s] = a[s] - hi[s];
          const bf16x8 fh = as_frag(ph), fl = as_frag(pack8(lo));
#pragma unroll
          for (int nf = 0; nf < 2; nf++) { ac[mi][nf] = MFMA(fh, bfr[nf], ac[mi][nf]); ac[mi][nf] = MFMA(fl, bfr[nf], ac[mi][nf]); }
        }
      }
      int qs = quad, ls = l16;
      asm volatile("" : "+v"(qs), "+v"(ls));
      bf16_t* dst = rec + (which ? 0 : 28672);
      const float sg = which ? -1.f : 1.f;
#pragma unroll
      for (int mi = 0; mi < 4; mi++)
#pragma unroll
        for (int nf = 0; nf < 2; nf++)
#pragma unroll
          for (int j = 0; j < 4; j++) {
            const int ip = mi * 16 + qs * 4 + j, col = wave * 32 + nf * 16 + ls;
            dst[ip * 128 + col] = f2bf(sg * ac[mi][nf][j]);
          }
    }
    __syncthreads();
  }
}

DEV void cmlp_task(const Params& p, int l, int t, char* lds) {
  char* ws_ = p.ws; asm volatile("" : "+s"(ws_));
  const int tid = otid(), lane = tid & 63, wave = tid >> 6, l16 = lane & 15, quad = lane >> 4;
  const int wm = wave >> 1, wn = wave & 1;
  const int c = t >> 2, g = t & 3, r0 = c * 128;
  const bf16_t* P3 = (const bf16_t*)(ws_ + OFF_P3);
  const bf16_t* P2 = (const bf16_t*)(ws_ + OFF_P2);
  bf16_t* BR = (bf16_t*)(ws_ + OFF_BR);
  bf16_t* VnT = (bf16_t*)lds;
  bf16_t* Ws = VnT + 128 * 136;
  float* mu = (float*)(lds + LDS_SMALL);
  float* rstd = mu + 128;
  {
    const int row = tid >> 1, half = tid & 1;
    const bf16_t* src = P3 + (size_t)(r0 + row) * P3W + 512 + half * 256;
    float s = 0.f, ss = 0.f;
#pragma unroll 16
    for (int i = 0; i < 32; i++) { float f[8]; unpack8(*(const u32x4*)(src + i * 8), f);
#pragma unroll
      for (int j = 0; j < 8; j++) { float y = geluf(f[j]); s += y; ss += y * y; } }
    s += __shfl_xor(s, 1); ss += __shfl_xor(ss, 1);
    const float mean = s * (1.f / 512.f), var = fmaxf(ss * (1.f / 512.f) - mean * mean, 0.f);
    if (!half) { mu[row] = mean; rstd[row] = __builtin_amdgcn_rsqf(var + EPSF); }
  }
  __syncthreads();
#pragma unroll
  for (int i = 0; i < 8; i++) {
    const int it = tid + 256 * i, q = it >> 4, c8 = it & 15;
    float f[8]; unpack8(*(const u32x4*)(P3 + (size_t)(r0 + q) * P3W + 512 + g * 128 + c8 * 8), f);
    const float m = mu[q], rs = rstd[q];
#pragma unroll
    for (int j = 0; j < 8; j++) {
      const int cc = c8 * 8 + j;
      const float val = (geluf(f[j]) - m) * rs * p.in[I_LNG][l * 512 + g * 128 + cc] + p.in[I_LNB][l * 512 + g * 128 + cc];
      VnT[cc * 136 + q] = f2bf(val);
    }
  }
#pragma unroll
  for (int i = 0; i < 16; i++) {
    const int it = tid + 256 * i, pp = it >> 5, q4 = it & 31;
    const f32x4 w = *(const f32x4*)(p.in[I_WS] + ((size_t)(l * 4 + g) * 128 + pp) * 128 + q4 * 4);
    *(u32x2*)(Ws + pp * 136 + q4 * 4) = pack4(w.x, w.y, w.z, w.w);
  }
  __syncthreads();
  f32x4 acc[4][4]; zero_acc<4>(acc);
#pragma unroll
  for (int ks = 0; ks < 4; ks++) {
    bf16x8 a[4], b[4];
#pragma unroll
    for (int mi = 0; mi < 4; mi++) a[mi] = *(const bf16x8*)(Ws + (wm * 64 + mi * 16 + l16) * 136 + ks * 32 + quad * 8);
#pragma unroll
    for (int ni = 0; ni < 4; ni++) b[ni] = *(const bf16x8*)(VnT + (wn * 64 + ni * 16 + l16) * 136 + ks * 32 + quad * 8);
#pragma unroll
    for (int mi = 0; mi < 4; mi++)
#pragma unroll
      for (int ni = 0; ni < 4; ni++) acc[mi][ni] = MFMA(a[mi], b[ni], acc[mi][ni]);
  }
  float* Cs = (float*)lds;
  __syncthreads();
#pragma unroll
  for (int mi = 0; mi < 4; mi++)
#pragma unroll
    for (int j = 0; j < 4; j++) {
      const int pp = wm * 64 + mi * 16 + quad * 4 + j;
      const float bias = p.in[I_BS][(l * 4 + g) * 128 + pp];
#pragma unroll
      for (int ni = 0; ni < 4; ni++) Cs[pp * 132 + wn * 64 + ni * 16 + l16] = acc[mi][ni][j] + bias;
    }
  __syncthreads();
  u32x4 uu[8], zz[8];
#pragma unroll
  for (int i = 0; i < 8; i++) {
    const int it = tid + 256 * i, r = it >> 4, c8 = it & 15;
    const size_t row = (size_t)(r0 + r);
    uu[i] = *(const u32x4*)(P3 + row * P3W + g * 128 + c8 * 8);
    zz[i] = *(const u32x4*)(P2 + row * P2W + 1024 + g * 128 + c8 * 8);
  }
#pragma unroll
  for (int i = 0; i < 8; i++) {
    const int it = tid + 256 * i, r = it >> 4, c8 = it & 15;
    float u[8], z[8], o[8];
    unpack8(uu[i], u); unpack8(zz[i], z);
    const f32x4 s0 = *(const f32x4*)(Cs + r * 132 + c8 * 8), s1 = *(const f32x4*)(Cs + r * 132 + c8 * 8 + 4);
    const float sv[8] = {s0.x, s0.y, s0.z, s0.w, s1.x, s1.y, s1.z, s1.w};
#pragma unroll
    for (int j = 0; j < 8; j++) o[j] = geluf(u[j]) * sv[j] * siluf(z[j]);
    *(u32x4*)(BR + (size_t)(r0 + r) * BRW + 1024 + g * 128 + c8 * 8) = pack8(o);
  }
}

DEV void attn_task(const Params& p, int l, int t, char* lds) {
  char* ws_ = p.ws; asm volatile("" : "+s"(ws_));
  const int tid = otid(), lane = tid & 63, wave = tid >> 6, l16 = lane & 15, quad = lane >> 4;
  int b, h, qrow0, nkt, Tk; size_t vtb;
  const bool lat = t < 256;
  if (lat) { b = t >> 6; h = (t >> 3) & 7; const int qb = t & 7; qrow0 = 4096 + b * 1024 + qb * 128; nkt = 20; Tk = 1280; vtb = VT_LAT_EL + (size_t)(b * 8 + h) * 64 * 1280; }
  else { const int tt = t - 256; b = tt >> 4; h = (tt >> 1) & 7; const int qb = tt & 1; qrow0 = b * 256 + qb * 128; nkt = 4; Tk = 256; vtb = (size_t)(b * 8 + h) * 64 * 256; }
  if (lat) __builtin_amdgcn_s_setprio(2);
  const bf16_t* Qg = (const bf16_t*)(ws_ + OFF_Q);
  const bf16_t* Kg = (const bf16_t*)(ws_ + OFF_K);
  const bf16_t* Vg = (const bf16_t*)(ws_ + OFF_VT) + vtb;
  bf16_t* Qs = (bf16_t*)lds;
  bf16_t* Ks = Qs + 128 * 104;
  bf16_t* Vs = Ks + 64 * 104;
#pragma unroll
  for (int i = 0; i < 6; i++) {
    const int it = tid + 256 * i, r = it / 12, cc = it % 12;
    *(u32x4*)(Qs + r * 104 + cc * 8) = *(const u32x4*)(Qg + ((size_t)(qrow0 + r) * 8 + h) * 96 + cc * 8);
  }
  __syncthreads();
  bf16x8 qf[2][3];
#pragma unroll
  for (int ni = 0; ni < 2; ni++)
#pragma unroll
    for (int ks = 0; ks < 3; ks++) qf[ni][ks] = *(const bf16x8*)(Qs + (wave * 32 + ni * 16 + l16) * 104 + ks * 32 + quad * 8);
  f32x4 o[4][2];
#pragma unroll
  for (int di = 0; di < 4; di++) { o[di][0] = f32x4{0.f, 0.f, 0.f, 0.f}; o[di][1] = f32x4{0.f, 0.f, 0.f, 0.f}; }
  float mrun[2] = {-1e30f, -1e30f}, lsum[2] = {0.f, 0.f};
  u32x4 pk[3], pv[2];
  {
    const int krow0 = lat ? (8192 + b * 256) : (b * 256);
#pragma unroll
    for (int i = 0; i < 3; i++) { const int it = tid + 256 * i, r = it / 12, cc = it % 12; pk[i] = *(const u32x4*)(Kg + ((size_t)(krow0 + r) * 8 + h) * 96 + cc * 8); }
#pragma unroll
    for (int i = 0; i < 2; i++) { const int it = tid + 256 * i, dv = it >> 3, kg = it & 7; pv[i] = *(const u32x4*)(Vg + (size_t)dv * Tk + kg * 8); }
  }
  for (int kt = 0; kt < nkt; kt++) {
    __syncthreads();
#pragma unroll
    for (int i = 0; i < 3; i++) { const int it = tid + 256 * i, r = it / 12, cc = it % 12; *(u32x4*)(Ks + r * 104 + cc * 8) = pk[i]; }
#pragma unroll
    for (int i = 0; i < 2; i++) { const int it = tid + 256 * i, dv = it >> 3, kg = it & 7; *(u32x4*)(Vs + dv * 72 + kg * 8) = pv[i]; }
    __syncthreads();
    if (kt + 1 < nkt) {
      const int kn = kt + 1;
      int krow0;
      if (lat) krow0 = (kn < 4) ? (8192 + b * 256 + kn * 64) : (4096 + b * 1024 + (kn - 4) * 64);
      else krow0 = b * 256 + kn * 64;
#pragma unroll
      for (int i = 0; i < 3; i++) { const int it = tid + 256 * i, r = it / 12, cc = it % 12; pk[i] = *(const u32x4*)(Kg + ((size_t)(krow0 + r) * 8 + h) * 96 + cc * 8); }
#pragma unroll
      for (int i = 0; i < 2; i++) { const int it = tid + 256 * i, dv = it >> 3, kg = it & 7; pv[i] = *(const u32x4*)(Vg + (size_t)dv * Tk + kn * 64 + kg * 8); }
    }
    __builtin_amdgcn_sched_barrier(0);
    f32x4 s[4][2];
#pragma unroll
    for (int mi = 0; mi < 4; mi++) { s[mi][0] = f32x4{0.f, 0.f, 0.f, 0.f}; s[mi][1] = f32x4{0.f, 0.f, 0.f, 0.f}; }
#pragma unroll
    for (int ks = 0; ks < 3; ks++)
#pragma unroll
      for (int mi = 0; mi < 4; mi++) {
        bf16x8 kf = *(const bf16x8*)(Ks + (mi * 16 + l16) * 104 + ks * 32 + quad * 8);
        s[mi][0] = MFMA(kf, qf[0][ks], s[mi][0]);
        s[mi][1] = MFMA(kf, qf[1][ks], s[mi][1]);
      }
#pragma unroll
    for (int ni = 0; ni < 2; ni++) {
      float mx = -1e30f;
#pragma unroll
      for (int mi = 0; mi < 4; mi++)
#pragma unroll
        for (int j = 0; j < 4; j++) mx = fmaxf(mx, s[mi][ni][j]);
      mx = fmaxf(mx, __shfl_xor(mx, 16)); mx = fmaxf(mx, __shfl_xor(mx, 32));
      const float mnew = fmaxf(mrun[ni], mx);
      const float alpha = __builtin_amdgcn_exp2f(mrun[ni] - mnew);
      mrun[ni] = mnew;
      float rsum = 0.f;
#pragma unroll
      for (int mi = 0; mi < 4; mi++)
#pragma unroll
        for (int j = 0; j < 4; j++) { float pv = __builtin_amdgcn_exp2f(s[mi][ni][j] - mnew); s[mi][ni][j] = pv; rsum += pv; }
      lsum[ni] = lsum[ni] * alpha + rsum;
#pragma unroll
      for (int di = 0; di < 4; di++) o[di][ni] *= alpha;
    }
#pragma unroll
    for (int g = 0; g < 2; g++) {
      bf16x8 pf0 = frag_from(s[2 * g][0], s[2 * g + 1][0]);
      bf16x8 pf1 = frag_from(s[2 * g][1], s[2 * g + 1][1]);
#pragma unroll
      for (int di = 0; di < 4; di++) {
        bf16x8 vf = ld2(Vs + (di * 16 + l16) * 72 + g * 32 + quad * 4);
        o[di][0] = MFMA(vf, pf0, o[di][0]);
        o[di][1] = MFMA(vf, pf1, o[di][1]);
      }
    }
  }
  const bf16_t* P2 = (const bf16_t*)(ws_ + OFF_P2);
  bf16_t* BR = (bf16_t*)(ws_ + OFF_BR);
#pragma unroll
  for (int ni = 0; ni < 2; ni++) {
    float lt = lsum[ni];
    lt += __shfl_xor(lt, 16); lt += __shfl_xor(lt, 32);
    const float inv = frcp(lt);
    const size_t qrow = (size_t)(qrow0 + wave * 32 + ni * 16 + l16);
#pragma unroll
    for (int di = 0; di < 4; di++) {
      const int col = h * 64 + di * 16 + quad * 4;
      float z[4]; unpack4(*(const u32x2*)(P2 + qrow * P2W + col), z);
      *(u32x2*)(BR + qrow * BRW + col) = pack4(o[di][ni][0] * inv * siluf(z[0]), o[di][ni][1] * inv * siluf(z[1]),
                                               o[di][ni][2] * inv * siluf(z[2]), o[di][ni][3] * inv * siluf(z[3]));
    }
  }
  __builtin_amdgcn_s_setprio(0);
}

struct ScanPf { u32x4 w[4], q[4], a[2], k[4], u[2]; float egl; };
DEV void scan_prefetch(ScanPf& f, const bf16_t* rec, const float* eglp, int half, int tid) {
#pragma unroll
  for (int i = 0; i < 4; i++) { const int c = tid + 256 * i; f.w[i] = *(const u32x4*)(rec + c * 8); f.q[i] = *(const u32x4*)(rec + 8192 + c * 8); f.k[i] = *(const u32x4*)(rec + 20480 + c * 8); }
#pragma unroll
  for (int i = 0; i < 2; i++) { const int c = tid + 256 * i; f.a[i] = *(const u32x4*)(rec + 16384 + c * 8); f.u[i] = *(const u32x4*)(rec + 28672 + (c >> 3) * 128 + half * 64 + (c & 7) * 8); }
  f.egl = *eglp;
}
DEV void gdn_scan_task(const Params& p, int l, int t, char* lds) {
  char* ws_ = p.ws; asm volatile("" : "+s"(ws_));
  const int tid = otid(), lane = tid & 63, wave = tid >> 6, l16 = lane & 15, quad = lane >> 4;
  __builtin_amdgcn_s_setprio(3);
  int chain, half, b, chunk0, N; bool lat = t < 64;
  if (lat) { chain = t >> 1; half = t & 1; } else { chain = (t - 64) >> 1; half = (t - 64) & 1; }
  const int dir = chain & 1, h = (chain >> 1) & 3;
  b = chain >> 3;
  if (lat) { chunk0 = 64 + b * 16; N = 16; } else { chunk0 = b * 4; N = 4; }
  const int e0 = (half * 4 + wave) * 16;
  bf16_t* Wl = (bf16_t*)lds;
  bf16_t* Ql = Wl + 64 * 136;
  bf16_t* Al = Ql + 64 * 136;
  bf16_t* Kl = Al + 64 * 72;
  bf16_t* Ul = Kl + 128 * 72;
  f32x4 S[8];
  if (lat) {
    const float* s0 = p.in[I_SGDN] + ((size_t)((b * 2 + l) * 2 + dir) * 4 + h) * 16384;
#pragma unroll
    for (int mf = 0; mf < 8; mf++)
#pragma unroll
      for (int j = 0; j < 4; j++) S[mf][j] = s0[(mf * 16 + quad * 4 + j) * 128 + e0 + l16];
  } else {
#pragma unroll
    for (int mf = 0; mf < 8; mf++) S[mf] = f32x4{0.f, 0.f, 0.f, 0.f};
  }
  float* OD = (float*)(ws_ + OFF_ODIR) + (size_t)dir * NTOK * 512;
  const float* EGL = (const float*)(ws_ + OFF_EGL);
  const bf16_t* GD = (const bf16_t*)(ws_ + OFF_GDN);
  ScanPf pf;
  {
    const int cidx = chunk0 + (dir ? N - 1 : 0);
    scan_prefetch(pf, GD + ((size_t)(cidx * 4 + h) * 2 + dir) * REC_EL, EGL + (cidx * 4 + h) * 2 + dir, half, tid);
  }
#pragma unroll 1
  for (int n = 0; n < N; n++) {
    const int cidx = chunk0 + (dir ? N - 1 - n : n);
    __syncthreads();
#pragma unroll
    for (int i = 0; i < 4; i++) {
      const int c = tid + 256 * i;
      *(u32x4*)(Wl + (c >> 4) * 136 + (c & 15) * 8) = pf.w[i];
      *(u32x4*)(Ql + (c >> 4) * 136 + (c & 15) * 8) = pf.q[i];
      *(u32x4*)(Kl + (c >> 3) * 72 + (c & 7) * 8) = pf.k[i];
    }
#pragma unroll
    for (int i = 0; i < 2; i++) {
      const int c = tid + 256 * i;
      *(u32x4*)(Al + (c >> 3) * 72 + (c & 7) * 8) = pf.a[i];
      *(u32x4*)(Ul + (c >> 3) * 72 + (c & 7) * 8) = pf.u[i];
    }
    const float egl = pf.egl;
    __syncthreads();
    if (n + 1 < N) {
      const int cn = chunk0 + (dir ? N - 2 - n : n + 1);
      scan_prefetch(pf, GD + ((size_t)(cn * 4 + h) * 2 + dir) * REC_EL, EGL + (cn * 4 + h) * 2 + dir, half, tid);
    }
    __builtin_amdgcn_sched_barrier(0);
    bf16x8 Sb[4];
#pragma unroll
    for (int ks = 0; ks < 4; ks++) Sb[ks] = frag_from(S[2 * ks], S[2 * ks + 1]);
    f32x4 vn[4];
#pragma unroll
    for (int mi = 0; mi < 4; mi++)
#pragma unroll
      for (int j = 0; j < 4; j++) vn[mi][j] = bf2f(Ul[(mi * 16 + quad * 4 + j) * 72 + wave * 16 + l16]);
#pragma unroll
    for (int mi = 0; mi < 4; mi++)
#pragma unroll
      for (int ks = 0; ks < 4; ks++) vn[mi] = MFMA(ld2(Wl + (mi * 16 + l16) * 136 + ks * 32 + quad * 4), Sb[ks], vn[mi]);
    bf16x8 vb[2];
    vb[0] = frag_from(vn[0], vn[1]); vb[1] = frag_from(vn[2], vn[3]);
#pragma unroll
    for (int mi = 0; mi < 4; mi++) {
      f32x4 o = f32x4{0.f, 0.f, 0.f, 0.f};
#pragma unroll
      for (int ks = 0; ks < 4; ks++) o = MFMA(ld2(Ql + (mi * 16 + l16) * 136 + ks * 32 + quad * 4), Sb[ks], o);
#pragma unroll
      for (int k2 = 0; k2 < 2; k2++) o = MFMA(ld2(Al + (mi * 16 + l16) * 72 + k2 * 32 + quad * 4), vb[k2], o);
#pragma unroll
      for (int j = 0; j < 4; j++) {
        const int ip = mi * 16 + quad * 4 + j, tok = dir ? 63 - ip : ip;
        OD[(size_t)(cidx * 64 + tok) * 512 + h * 128 + e0 + l16] = o[j];
      }
    }
#pragma unroll
    for (int mf = 0; mf < 8; mf++) {
      S[mf] *= egl;
#pragma unroll
      for (int k2 = 0; k2 < 2; k2++) S[mf] = MFMA(ld2(Kl + (mf * 16 + l16) * 72 + k2 * 32 + quad * 4), vb[k2], S[mf]);
    }
  }
  if (!lat) {
    float* so = p.out + OUT_STATE + ((size_t)((b * 2 + l) * 2 + dir) * 4 + h) * 16384;
#pragma unroll
    for (int mf = 0; mf < 8; mf++)
#pragma unroll
      for (int j = 0; j < 4; j++) so[(mf * 16 + quad * 4 + j) * 128 + e0 + l16] = S[mf][j];
  }
  __builtin_amdgcn_s_setprio(0);
}

DEV void onorm_task(const Params& p, int l, int t) {
  char* ws_ = p.ws; asm volatile("" : "+s"(ws_));
  const int tid = otid(), lane = tid & 63, wave = tid >> 6;
  const float* OD = (const float*)(ws_ + OFF_ODIR);
  const bf16_t* P2 = (const bf16_t*)(ws_ + OFF_P2);
  bf16_t* BR = (bf16_t*)(ws_ + OFF_BR);
#pragma unroll
  for (int rr = 0; rr < 4; rr++) {
    const size_t row = (size_t)t * 16 + wave * 4 + rr;
    const f32x4 a0 = *(const f32x4*)(OD + row * 512 + lane * 8), a1 = *(const f32x4*)(OD + row * 512 + lane * 8 + 4);
    const f32x4 b0 = *(const f32x4*)(OD + (NTOK + row) * 512 + lane * 8), b1 = *(const f32x4*)(OD + (NTOK + row) * 512 + lane * 8 + 4);
    float x[8] = {a0.x + b0.x, a0.y + b0.y, a0.z + b0.z, a0.w + b0.w, a1.x + b1.x, a1.y + b1.y, a1.z + b1.z, a1.w + b1.w};
    float ss = 0.f;
#pragma unroll
    for (int i = 0; i < 8; i++) ss += x[i] * x[i];
#pragma unroll
    for (int o = 8; o >= 1; o >>= 1) ss += __shfl_xor(ss, o);
    const float rstd = __builtin_amdgcn_rsqf(ss * (1.f / 128.f) + EPSF);
    float z[8]; unpack8(*(const u32x4*)(P2 + row * P2W + 512 + lane * 8), z);
    const float* g = p.in[I_ONORM] + l * 128 + (lane & 15) * 8;
    float y[8];
#pragma unroll
    for (int i = 0; i < 8; i++) y[i] = x[i] * rstd * g[i] * siluf(z[i]);
    *(u32x4*)(BR + row * BRW + 512 + lane * 8) = pack8(y);
  }
}

DEV void gate_task(const Params& p, int l, int t, char* lds) {
  char* ws_ = p.ws; asm volatile("" : "+s"(ws_));
  const int tid = otid();
  const int nt = t / 64, mt = t % 64;
  f32x4 acc[4][4]; zero_acc<4>(acc);
  ALPlain al{(const bf16_t*)(ws_ + OFF_H) + (size_t)mt * 128 * 1024, 1024};
  gemm_core<128>(al, (const bf16_t*)(ws_ + OFF_WGL) + (size_t)nt * 128 * 1024, 1024, 1024, acc, lds);
  float* Cs = (float*)lds;
  acc_to_lds<128>(acc, Cs);
  bf16_t* GT = (bf16_t*)(ws_ + OFF_GDN);
#pragma unroll
  for (int i = 0; i < 8; i++) {
    const int it = tid + 256 * i, r = it >> 4, c8 = it & 15;
    const f32x4 a = *(const f32x4*)(Cs + r * 132 + c8 * 8), b = *(const f32x4*)(Cs + r * 132 + c8 * 8 + 4);
    float f[8] = {sigmf(a.x), sigmf(a.y), sigmf(a.z), sigmf(a.w), sigmf(b.x), sigmf(b.y), sigmf(b.z), sigmf(b.w)};
    *(u32x4*)(GT + (size_t)(mt * 128 + r) * 3072 + nt * 128 + c8 * 8) = pack8(f);
  }
}
DEV void d1_task(const Params& p, int l, int t, char* lds) {
  char* ws_ = p.ws; asm volatile("" : "+s"(ws_));
  const int tid = otid(), lane = tid & 63, wave = tid >> 6, l16 = lane & 15, quad = lane >> 4;
  const int wm = wave >> 1, wn = wave & 1;
  const int nt = t >> 6, mt = t & 63;
  const bf16_t* GT = (const bf16_t*)(ws_ + OFF_GDN);
  f32x4 macc[4][2]; zero_acc<2>(macc);
#pragma unroll 1
  for (int n = 0; n < 3; n++) {
    unsigned short gv[4][2][4];
#pragma unroll
    for (int mi = 0; mi < 4; mi++)
#pragma unroll
      for (int ni = 0; ni < 2; ni++)
#pragma unroll
        for (int j = 0; j < 4; j++)
          gv[mi][ni][j] = GT[(size_t)(mt * 128 + wm * 64 + mi * 16 + quad * 4 + j) * 3072 + n * 1024 + nt * 64 + wn * 32 + ni * 16 + l16];
    f32x4 y[4][2]; zero_acc<2>(y);
    ALPlain alb{(const bf16_t*)(ws_ + OFF_BR) + (size_t)mt * 128 * BRW + n * 512, BRW};
    gemm_core<64>(alb, (const bf16_t*)(ws_ + OFF_WBR) + (size_t)(n * 1024 + nt * 64) * 512, 512, 512, y, lds);
#pragma unroll
    for (int mi = 0; mi < 4; mi++)
#pragma unroll
      for (int ni = 0; ni < 2; ni++)
#pragma unroll
        for (int j = 0; j < 4; j++) macc[mi][ni][j] += bf2f(gv[mi][ni][j]) * y[mi][ni][j];
  }
  float* Cs = (float*)lds;
  acc_to_lds<64>(macc, Cs);
  bf16_t* M = (bf16_t*)(ws_ + OFF_M);
#pragma unroll
  for (int i = 0; i < 4; i++) {
    const int it = tid + 256 * i, r = it >> 3, c8 = it & 7;
    float f[8];
#pragma unroll
    for (int j = 0; j < 8; j++) f[j] = Cs[r * 68 + c8 * 8 + j];
    *(u32x4*)(M + (size_t)(mt * 128 + r) * 1024 + nt * 64 + c8 * 8) = pack8(f);
  }
}

DEV void d2_task(const Params& p, int l, int t, char* lds) {
  char* ws_ = p.ws; asm volatile("" : "+s"(ws_));
  const int tid = otid();
  const int nt = t >> 6, mt = t & 63;
  f32x4 acc[4][4]; zero_acc<4>(acc);
  ALPlain al{(const bf16_t*)(ws_ + OFF_M) + (size_t)mt * 128 * 1024, 1024};
  gemm_core<128>(al, (const bf16_t*)(ws_ + OFF_WO) + (size_t)nt * 128 * 1024, 1024, 1024, acc, lds);
  float* Cs = (float*)lds;
  acc_to_lds<128>(acc, Cs);
  const float* mod = (const float*)(ws_ + OFF_MOD);
#pragma unroll
  for (int i = 0; i < 8; i++) {
    const int it = tid + 256 * i, r = it >> 4, c8 = it & 15;
    const int row = mt * 128 + r, col = nt * 128 + c8 * 8;
    const float* x = xrow_ptr(p, l, row) + col;
    const float* gt = mod + (size_t)(l * 5 + modrow(row)) * 3072 + 2048 + col;
    const f32x4 y0 = *(const f32x4*)(Cs + r * 132 + c8 * 8), y1 = *(const f32x4*)(Cs + r * 132 + c8 * 8 + 4);
    const f32x4 x0 = *(const f32x4*)x, x1 = *(const f32x4*)(x + 4);
    const f32x4 g0 = *(const f32x4*)gt, g1 = *(const f32x4*)(gt + 4);
    float* o = p.out + (size_t)row * DM + col;
    *(f32x4*)o = f32x4{x0.x + g0.x * y0.x, x0.y + g0.y * y0.y, x0.z + g0.z * y0.z, x0.w + g0.w * y0.w};
    *(f32x4*)(o + 4) = f32x4{x1.x + g1.x * y1.x, x1.y + g1.y * y1.y, x1.z + g1.z * y1.z, x1.w + g1.w * y1.w};
  }
}

#define NPHASES 15
DEV int phase_nsub(int ph) {
  if (ph == 0) return 48 + 152;
  const int l = (ph - 1) / 7, s = (ph - 1) % 7;
  switch (s) {
    case 0: return 128 + (l == 0 ? 113 : 32);
    case 1: return 304 + 8 + (l == 0 ? 80 : 0);
    case 2: return 64 + 64 + 64;
    case 3: return 8 + 32 + 32 + 32 + 32 + (l == 0 ? 169 : 0);
    case 4: return 192 + 64;
    case 5: return 128 + (l == 0 ? 96 : 0);
    default: return 64 + (l == 0 ? 48 : 0);
  }
}
DEV void run_task(const Params& p, int ph, int x, int i, char* lds) {
  if (ph == 0) { if (i < 48) mod_task(p, i * 8 + x, lds); else convert_task(p, 0, (i - 48) * 8 + x, lds); return; }
  const int l = (ph - 1) / 7, s = (ph - 1) % 7;
  switch (s) {
    case 0:
      if (i < 128) norm_task(p, l, i * 8 + x);
      else if (l == 0) convert_task(p, 0, 1216 + (i - 128) * 8 + x, lds);
      else convert_task(p, 1, 2504 + (i - 128) * 8 + x, lds);
      break;
    case 1:
      if (i < 304) projA_task(p, l, (i >> 3) * 64 + (i & 7) * 8 + x, lds);
      else if (i < 312) kv_task(p, l, (i - 304) * 72 + 64 + x, lds);
      else convert_task(p, 0, 2120 + (i - 312) * 8 + x, lds);
      break;
    case 2:
      if (i < 64) gdn_prep_task(p, l, i * 8 + x, lds);
      else if (i < 128) { const int j = i - 64; kv_task(p, l, (j >> 3) * 72 + (j & 7) * 8 + x, lds); }
      else { const int j = i - 128; q_task(p, l, (j >> 3) * 64 + (j & 7) * 8 + x, lds); }
      break;
    case 3:
      if (i < 8) gdn_scan_task(p, l, i * 8 + x, lds);
      else if (i < 40) attn_task(p, l, x * 32 + (i - 8), lds);
      else if (i < 72) cmlp_task(p, l, (i - 40) * 8 + x, lds);
      else if (i < 104) gdn_scan_task(p, l, 64 + (i - 72) * 8 + x, lds);
      else if (i < 136) attn_task(p, l, 256 + x * 32 + (i - 104), lds);
      else if (i < 288) convert_task(p, 1, (i - 136) * 8 + x, lds);
      else convert_task(p, 1, 1984 + (i - 288) * 8 + x, lds);
      break;
    case 4:
      if (i < 192) gate_task(p, l, (i >> 3) * 64 + (i & 7) * 8 + x, lds);
      else onorm_task(p, l, (i - 192) * 8 + x);
      break;
    case 5:
      if (i < 128) d1_task(p, l, (i >> 3) * 64 + (i & 7) * 8 + x, lds);
      else convert_task(p, 1, 1216 + (i - 128) * 8 + x, lds);
      break;
    case 6:
      if (i < 64) d2_task(p, l, (i >> 3) * 64 + (i & 7) * 8 + x, lds);
      else convert_task(p, 1, 2120 + (i - 64) * 8 + x, lds);
      break;
  }
}
#ifndef REP_S
#define REP_S -1
#endif
DEV void run_phase(const Params& p, int ph, char* lds, int* sh, int myx, int rep = 0, int rank = 0, int nloc = 0) {
  unsigned* cb = (unsigned*)(p.ws + OFF_CTR) + ph * 128 + rep * 6144;
  const int n = phase_nsub(ph);
  if (nloc > 0) {
#pragma unroll 1
    for (int i = rank; i < n; i += nloc) { __syncthreads(); run_task(p, ph, myx, i, lds); }
    return;
  }
#pragma unroll 1
  for (int xo = 0; xo < 8; xo++) {
    const int x = (myx + xo) & 7;
    unsigned* c = cb + x * 16;
    int i;
    while ((i = next_task(c, sh, n, xo > 0)) < n) run_task(p, ph, x, i, lds);
  }
}

__global__ void __launch_bounds__(256, 2) k_phase(Params p, int ph) {
  __shared__ __attribute__((aligned(16))) char lds[LDS_BYTES];
  __shared__ int sh[4];
  const Params& pr = *(const Params*)__builtin_amdgcn_kernarg_segment_ptr();
  run_phase(pr, ph, lds, sh, (int)(xb_xcc_id() & 7u));
}

__global__ void __launch_bounds__(256, 2) k_mega(Params p) {
  __shared__ __attribute__((aligned(16))) char lds[LDS_BYTES];
  __shared__ __attribute__((aligned(16))) unsigned xbw[4];
  __shared__ int sh[4];
  const Params& pr = *(const Params*)__builtin_amdgcn_kernarg_segment_ptr();
  if (threadIdx.x == 0) { xbw[0] = 0u; xbw[1] = 0u; xbw[2] = 0u; xbw[3] = 0u; }
  __syncthreads();
  XcdBarrier xb = xcd_barrier_post((unsigned*)(pr.ws + OFF_BAR), (volatile LAS unsigned*)xbw);
  const int myx = (int)(xb.x & 7u);
  if (pr.out == nullptr) cg::this_grid().sync();
#pragma unroll
  for (int ph = 0; ph < NPHASES; ph++) {
    {
      const int sub = ph > 0 ? (ph - 1) % 7 : -1;
      const bool uniform = (sub == 0 || sub == 1 || sub == 4 || sub == 5 || sub == 6);
      int nloc = 0, rank = 0;
      if (ph > 0 && uniform && xbw[1] == 8u) { nloc = (int)xbw[0]; rank = (int)xbw[2]; }
      run_phase(pr, ph, lds, sh, myx, 0, rank, nloc);
    }
    if ((REP_S == 7 && ph == 0) || (REP_S >= 0 && ph > 0 && (ph - 1) % 7 == REP_S && !(REP_S == 6 && ph > 7))) run_phase(pr, ph, lds, sh, myx, 1);
    if (ph + 1 < NPHASES) xcd_barrier(xb);
  }
}

extern "C" void kernel_launch(void* const* d_in, const int* in_sizes, int n_in, void* d_out, int out_size, void* d_ws,
                              size_t ws_size, hipStream_t stream) {
  Params p{};
  for (int i = 0; i < 27; i++) p.in[i] = (const float*)d_in[i];
  p.out = (float*)d_out;
  p.ws = (char*)d_ws;
  if (ws_size < WS_END) { fprintf(stderr, "workspace too small: %zu < %llu\n", ws_size, (unsigned long long)WS_END); return; }
  (void)hipMemsetAsync(d_ws, 0, 32768, stream);
#if COOP
  static int grid_blocks = 0;
  if (!grid_blocks) {
    int dev = 0, cus = 0, per_cu = 0;
    hipGetDevice(&dev);
    hipDeviceGetAttribute(&cus, hipDeviceAttributeMultiprocessorCount, dev);
    hipOccupancyMaxActiveBlocksPerMultiprocessor(&per_cu, k_mega, 256, 0);
    if (per_cu > 2) per_cu = 2;
    if (per_cu < 1) per_cu = 1;
    grid_blocks = cus * per_cu;
  }
  void* args[] = {&p};
  hipError_t e = hipLaunchCooperativeKernel((void*)k_mega, dim3(grid_blocks), dim3(256), args, 0, stream);
  if (e != hipSuccess) fprintf(stderr, "cooperative launch failed: %s (grid %d)\n", hipGetErrorString(e), grid_blocks);
#else
  for (int ph = 0; ph < NPHASES; ph++) k_phase<<<512, 256, 0, stream>>>(p, ph);
#endif
}
```

```cpp
#include <hip/hip_runtime.h>
#include <hip/hip_cooperative_groups.h>
#include <stdint.h>
#include <stdio.h>
namespace cg = cooperative_groups;

#ifndef COOP
#define COOP 1
#endif

typedef unsigned short bf16_t;
typedef __attribute__((ext_vector_type(8))) short bf16x8;
typedef __attribute__((ext_vector_type(4))) float f32x4;
typedef __attribute__((ext_vector_type(4))) unsigned int u32x4;
typedef __attribute__((ext_vector_type(2))) unsigned int u32x2;
#define DEV __device__ __forceinline__

#define NTOK 8192
#define DM 1024
#define DIN 7856
#define EPSF 1e-6f
#define P1W 2208
#define P3W 1024
#define P2W 1536
#define BRW 1536
#define REC_EL 36864

#define OFF_CTR  0ull
#define OFF_BAR  8192ull
#define OFF_MOD  32768ull
#define OFF_GAB  (OFF_MOD + 122880ull)
#define OFF_EGL  (OFF_GAB + 524288ull)
#define OFF_WTA  (OFF_EGL + 4096ull)
#define OFF_WGL  (OFF_WTA + 9961472ull)
#define OFF_WUQ  (OFF_WGL + 6291456ull)
#define OFF_WUKV (OFF_WUQ + 589824ull)
#define OFF_WBR  (OFF_WUKV + 524288ull)
#define OFF_WO   (OFF_WBR + 3145728ull)
#define OFF_H    (OFF_WO + 2097152ull)
#define OFF_P1   (OFF_H + 16777216ull)
#define OFF_ODIR OFF_P1
#define OFF_P3   (OFF_P1 + 36175872ull)
#define OFF_M    OFF_P3
#define OFF_P2   (OFF_P1 + 52953088ull)
#define OFF_GDN  (OFF_P2 + 25165824ull)
#define OFF_Q    (OFF_GDN + 75497472ull)
#define OFF_K    (OFF_Q + 12582912ull)
#define OFF_VT   (OFF_K + 14155776ull)
#define OFF_BR   (OFF_VT + 9437184ull)
#define WS_END   (OFF_BR + 25165824ull)
#define VT_LAT_EL 2097152

#define OUT_CKV   8388608
#define OUT_KROPE 10485760
#define OUT_STATE 10747904

#define LDS_BYTES 75776
#define LDS_SMALL 73728

struct Params {
  const float* in[27];
  float* out;
  char* ws;
};
enum { I_XP = 0, I_XS, I_CCKV, I_CKR, I_SGDN, I_C, I_CCTX, I_NORMG, I_WMOD, I_BMOD, I_WIN, I_QAN, I_WUQ, I_KVAN, I_WUKV,
       I_QN, I_KN, I_CONVW, I_ALOG, I_DTB, I_ONORM, I_LNG, I_LNB, I_WS, I_BS, I_WBR, I_WO };

DEV float bf2f(bf16_t b) { return __uint_as_float(((unsigned)b) << 16); }
typedef __bf16 hwbf2 __attribute__((ext_vector_type(2)));
typedef float hwf2 __attribute__((ext_vector_type(2)));
DEV unsigned pack2(float a, float b) { hwf2 v = {a, b}; return __builtin_bit_cast(unsigned, __builtin_convertvector(v, hwbf2)); }
DEV bf16_t f2bf(float f) { return (bf16_t)(pack2(f, 0.f) & 0xffffu); }
DEV void unpack8(u32x4 v, float* f) {
  f[0] = __uint_as_float(v.x << 16); f[1] = __uint_as_float(v.x & 0xffff0000u);
  f[2] = __uint_as_float(v.y << 16); f[3] = __uint_as_float(v.y & 0xffff0000u);
  f[4] = __uint_as_float(v.z << 16); f[5] = __uint_as_float(v.z & 0xffff0000u);
  f[6] = __uint_as_float(v.w << 16); f[7] = __uint_as_float(v.w & 0xffff0000u);
}
DEV void unpack4(u32x2 v, float* f) {
  f[0] = __uint_as_float(v.x << 16); f[1] = __uint_as_float(v.x & 0xffff0000u);
  f[2] = __uint_as_float(v.y << 16); f[3] = __uint_as_float(v.y & 0xffff0000u);
}
DEV u32x4 pack8(const float* f) {
  u32x4 v; v.x = pack2(f[0], f[1]); v.y = pack2(f[2], f[3]); v.z = pack2(f[4], f[5]); v.w = pack2(f[6], f[7]); return v;
}
DEV u32x2 pack4(float a, float b, float c, float d) { u32x2 v; v.x = pack2(a, b); v.y = pack2(c, d); return v; }
DEV bf16x8 as_frag(u32x4 v) { union { u32x4 u; bf16x8 b; } x; x.u = v; return x.b; }
DEV bf16x8 frag_from(f32x4 a, f32x4 b) {
  u32x4 v; v.x = pack2(a[0], a[1]); v.y = pack2(a[2], a[3]); v.z = pack2(b[0], b[1]); v.w = pack2(b[2], b[3]); return as_frag(v);
}
DEV bf16x8 ld2(const bf16_t* p) {
  u32x2 a = *(const u32x2*)p; u32x2 b = *(const u32x2*)(p + 16);
  u32x4 v; v.x = a.x; v.y = a.y; v.z = b.x; v.w = b.y; return as_frag(v);
}
DEV float frcp(float x) { return __builtin_amdgcn_rcpf(x); }
DEV float siluf(float x) { return x * frcp(1.f + __expf(-x)); }
DEV float sigmf(float x) { return frcp(1.f + __expf(-x)); }
DEV float geluf(float x) { float u = 0.7978845608028654f * (x + 0.044715f * x * x * x); return x * frcp(1.f + __expf(-2.f * u)); }
#define MFMA(a, b, c) __builtin_amdgcn_mfma_f32_16x16x32_bf16((a), (b), (c), 0, 0, 0)

DEV int otid() { int t = threadIdx.x; asm volatile("" : "+v"(t)); return t; }
DEV int next_task(unsigned* ctr, int* sh, int n, bool precheck) {
  __syncthreads();
  if (threadIdx.x == 0) {
    int v = n;
    if (!precheck || (int)__hip_atomic_load(ctr, __ATOMIC_RELAXED, __HIP_MEMORY_SCOPE_AGENT) < n) v = (int)atomicAdd(ctr, 1u);
    *sh = v;
  }
  __syncthreads();
  return *sh;
}

#define XB_TMO      128
#define XB_XCNT(j)  (256  + 64 * (j))
#define XB_XSUB(j)  (1280 + 64 * (j))
#define XB_XGEN(j)  (2304 + 64 * (j))
#define XB_TOP      3328
#define XB_TOPGEN   3392
#define XCD_BAR_WORDS 3456
#define XB_SPIN_CAP (1u << 22)
#define LAS __attribute__((address_space(3)))
DEV unsigned xb_ld(unsigned* p) { return __hip_atomic_load(p, __ATOMIC_RELAXED, __HIP_MEMORY_SCOPE_AGENT); }
DEV unsigned xb_add(unsigned* p, unsigned v) { return __hip_atomic_fetch_add(p, v, __ATOMIC_RELAXED, __HIP_MEMORY_SCOPE_AGENT); }
DEV unsigned xb_xcc_id() { return (unsigned)__builtin_amdgcn_s_getreg((3 << 11) | 20) & 0xFu; }
#define XB_SPIN(cond, bar) do { unsigned _sp = 0; while (cond) { __builtin_amdgcn_s_sleep(1); \
    if ((++_sp & 255u) == 0u) { if (xb_ld(&(bar)[XB_TMO])) break; if (_sp > XB_SPIN_CAP) { atomicAdd(&(bar)[XB_TMO], 1u); break; } } } } while (0)
struct XcdBarrier { unsigned* bar; unsigned x; volatile LAS unsigned* st; };
DEV XcdBarrier xcd_barrier_post(unsigned* bar, volatile LAS unsigned* st) {
  XcdBarrier b; b.bar = bar; b.x = xb_xcc_id(); b.st = st;
  if (threadIdx.x == 0) st[2] = xb_add(&bar[XB_XCNT(b.x)], 1u);
  return b;
}
DEV void xcd_barrier_complete(unsigned* bar, unsigned x, unsigned& nloc, unsigned& nx) {
  const unsigned G = gridDim.x * gridDim.y * gridDim.z;
  unsigned sum, cnt, mine, sp = 0u;
  for (;;) {
    sum = 0u; cnt = 0u; mine = 0u;
#pragma unroll
    for (unsigned j = 0; j < 16; ++j) { const unsigned c = xb_ld(&bar[XB_XCNT(j)]); sum += c; cnt += (c > 0u) ? 1u : 0u; mine = (j == x) ? c : mine; }
    if (sum == G) break;
    __builtin_amdgcn_s_sleep(1);
    if ((++sp & 255u) == 0u) { if (xb_ld(&bar[XB_TMO])) break; if (sp > XB_SPIN_CAP) { atomicAdd(&bar[XB_TMO], 1u); break; } }
  }
  nloc = mine > 0u ? mine : 1u; nx = cnt > 0u ? cnt : 1u;
}
DEV void xcd_barrier(const XcdBarrier& b) {
  asm volatile("s_waitcnt vmcnt(0)" ::: "memory");
  __syncthreads();
  if (threadIdx.x == 0) {
    unsigned* bar = b.bar;
    __builtin_amdgcn_s_waitcnt(0);
    unsigned nloc = b.st[0], nx = b.st[1];
    if (nloc == 0u) { xcd_barrier_complete(bar, b.x, nloc, nx); b.st[0] = nloc; b.st[1] = nx; }
    const unsigned old = xb_add(&bar[XB_XSUB(b.x)], 1u);
    const unsigned gen = old / nloc;
    if (old + 1u == (gen + 1u) * nloc) {
      __builtin_amdgcn_fence(__ATOMIC_RELEASE, "agent");
      asm volatile("s_waitcnt vmcnt(0)" ::: "memory");
      const unsigned og = xb_add(&bar[XB_TOP], 1u);
      const unsigned tg = og / nx;
      if (og + 1u == (tg + 1u) * nx) xb_add(&bar[XB_TOPGEN], 1u);
      else XB_SPIN(xb_ld(&bar[XB_TOPGEN]) == tg, bar);
      __builtin_amdgcn_fence(__ATOMIC_ACQUIRE, "agent");
      xb_add(&bar[XB_XGEN(b.x)], 1u);
      asm volatile("s_waitcnt vmcnt(0)" ::: "memory");
    } else {
      XB_SPIN(xb_ld(&bar[XB_XGEN(b.x)]) == gen, bar);
      __builtin_amdgcn_fence(__ATOMIC_ACQUIRE, "agent");
      asm volatile("s_waitcnt vmcnt(0)" ::: "memory");
    }
  }
  __syncthreads();
}

DEV const float* xrow_ptr(const Params& p, int l, int row) {
  if (l == 0) return row < 4096 ? p.in[I_XP] + (size_t)row * DM : p.in[I_XS] + (size_t)(row - 4096) * DM;
  return p.out + (size_t)row * DM;
}
DEV int modrow(int row) { return row < 4096 ? 0 : 1 + ((row - 4096) >> 10); }

struct ALPlain {
  const bf16_t* base; int ld;
  DEV u32x4 operator()(int row, int k) const { return *(const u32x4*)(base + (size_t)row * ld + k); }
};
struct ALScaled {
  const bf16_t* base; int ld; const float* rs; const float* g;
  DEV u32x4 operator()(int row, int k) const {
    u32x4 v = *(const u32x4*)(base + (size_t)row * ld + k);
    float f[8]; unpack8(v, f);
    const float r = rs[row];
    const f32x4 g0 = *(const f32x4*)(g + k), g1 = *(const f32x4*)(g + k + 4);
    f[0] *= r * g0.x; f[1] *= r * g0.y; f[2] *= r * g0.z; f[3] *= r * g0.w;
    f[4] *= r * g1.x; f[5] *= r * g1.y; f[6] *= r * g1.z; f[7] *= r * g1.w;
    return pack8(f);
  }
};
struct ALF32 {
  const float* base; int ld;
  DEV u32x4 operator()(int row, int k) const {
    const f32x4 a = *(const f32x4*)(base + (size_t)row * ld + k);
    const f32x4 b = *(const f32x4*)(base + (size_t)row * ld + k + 4);
    u32x4 v; v.x = pack2(a.x, a.y); v.y = pack2(a.z, a.w); v.z = pack2(b.x, b.y); v.w = pack2(b.z, b.w); return v;
  }
};

template <int TN>
DEV void gemm_compute(const bf16_t* As, const bf16_t* Bs, f32x4 (&acc)[4][TN / 32], int wm, int wn, int l16, int quad) {
  constexpr int NF = TN / 32;
#pragma unroll
  for (int ks = 0; ks < 2; ks++) {
    bf16x8 a[4], b[NF];
#pragma unroll
    for (int mi = 0; mi < 4; mi++) a[mi] = *(const bf16x8*)(As + (wm * 64 + mi * 16 + l16) * 72 + ks * 32 + quad * 8);
#pragma unroll
    for (int ni = 0; ni < NF; ni++) b[ni] = *(const bf16x8*)(Bs + (wn * (TN / 2) + ni * 16 + l16) * 72 + ks * 32 + quad * 8);
#pragma unroll
    for (int mi = 0; mi < 4; mi++)
#pragma unroll
      for (int ni = 0; ni < NF; ni++) acc[mi][ni] = MFMA(a[mi], b[ni], acc[mi][ni]);
  }
}
template <int TN, class AL>
DEV void gemm_core(const AL& al, const bf16_t* __restrict__ Bt, int ldb, int K, f32x4 (&acc)[4][TN / 32], char* lds) {
  constexpr int BUF = (128 + TN) * 72;
  constexpr int NF = TN / 32;
  bf16_t* L0 = (bf16_t*)lds;
  bf16_t* L1 = L0 + BUF;
  const int tid = otid(), lane = tid & 63, wave = tid >> 6;
  const int wm = wave >> 1, wn = wave & 1, l16 = lane & 15, quad = lane >> 4;
  u32x4 a0[4], b0[NF], a1[4], b1[NF];
#define G_LOAD(RA, RB, KK) { _Pragma("unroll") for (int i = 0; i < 4; i++) { int it = tid + 256 * i; RA[i] = al(it >> 3, (KK) + (it & 7) * 8); } \
                             _Pragma("unroll") for (int i = 0; i < NF; i++) { int it = tid + 256 * i; RB[i] = *(const u32x4*)(Bt + (size_t)(it >> 3) * ldb + (KK) + (it & 7) * 8); } }
#define G_STORE(LB, RA, RB) { _Pragma("unroll") for (int i = 0; i < 4; i++) { int it = tid + 256 * i; *(u32x4*)((LB) + (it >> 3) * 72 + (it & 7) * 8) = RA[i]; } \
                              _Pragma("unroll") for (int i = 0; i < NF; i++) { int it = tid + 256 * i; *(u32x4*)((LB) + 128 * 72 + (it >> 3) * 72 + (it & 7) * 8) = RB[i]; } }
  G_LOAD(a0, b0, 0);
  G_LOAD(a1, b1, 64);
  __syncthreads();
  G_STORE(L0, a0, b0);
  __syncthreads();
  for (int k0 = 0; k0 + 128 < K; k0 += 128) {
    G_LOAD(a0, b0, k0 + 128);
    __builtin_amdgcn_sched_barrier(0);
    gemm_compute<TN>(L0, L0 + 128 * 72, acc, wm, wn, l16, quad);
    G_STORE(L1, a1, b1);
    __syncthreads();
    G_LOAD(a1, b1, k0 + 192);
    __builtin_amdgcn_sched_barrier(0);
    gemm_compute<TN>(L1, L1 + 128 * 72, acc, wm, wn, l16, quad);
    G_STORE(L0, a0, b0);
    __syncthreads();
  }
  gemm_compute<TN>(L0, L0 + 128 * 72, acc, wm, wn, l16, quad);
  G_STORE(L1, a1, b1);
  __syncthreads();
  gemm_compute<TN>(L1, L1 + 128 * 72, acc, wm, wn, l16, quad);
#undef G_LOAD
#undef G_STORE
}

template <int TN>
DEV void acc_to_lds(f32x4 (&acc)[4][TN / 32], float* Cs) {
  const int tid = otid(), lane = tid & 63, wave = tid >> 6;
  const int wm = wave >> 1, wn = wave & 1, l16 = lane & 15, quad = lane >> 4;
  __syncthreads();
#pragma unroll
  for (int mi = 0; mi < 4; mi++)
#pragma unroll
    for (int ni = 0; ni < TN / 32; ni++)
#pragma unroll
      for (int j = 0; j < 4; j++)
        Cs[(wm * 64 + mi * 16 + quad * 4 + j) * (TN + 4) + wn * (TN / 2) + ni * 16 + l16] = acc[mi][ni][j];
  __syncthreads();
}
template <int NF>
DEV void zero_acc(f32x4 (&acc)[4][NF]) {
#pragma unroll
  for (int mi = 0; mi < 4; mi++)
#pragma unroll
    for (int ni = 0; ni < NF; ni++) acc[mi][ni] = f32x4{0.f, 0.f, 0.f, 0.f};
}

DEV void transpose_tile(const float* __restrict__ src, int ld, int col0, int ncols, int K, bf16_t* dst, int nt, int kt, float* tile) {
  const int tid = otid();
  const int n = tid & 63, kk = tid >> 6, gn = nt * 64 + n;
#pragma unroll
  for (int i = 0; i < 16; i++) {
    int k = kk + 4 * i;
    float v = (gn < ncols) ? src[(size_t)(kt * 64 + k) * ld + col0 + gn] : 0.f;
    tile[k * 65 + n] = v;
  }
  __syncthreads();
#pragma unroll
  for (int i = 0; i < 2; i++) {
    int it = tid + 256 * i, nn = it >> 3, kg = it & 7;
    float f[8];
#pragma unroll
    for (int j = 0; j < 8; j++) f[j] = tile[(kg * 8 + j) * 65 + nn];
    *(u32x4*)(dst + (size_t)(nt * 64 + nn) * K + kt * 64 + kg * 8) = pack8(f);
  }
}
#define NCONV_TASKS 2760
DEV void convert_task(const Params& p, int l, int t, char* lds) {
  char* ws_ = p.ws; asm volatile("" : "+s"(ws_));
  float* tile = (float*)lds;
  char* ws = ws_;
  if (t < 1216) { transpose_tile(p.in[I_WIN] + (size_t)l * 1024 * DIN, DIN, 0, 4784, 1024, (bf16_t*)(ws + OFF_WTA), t % 76, t / 76, tile); return; }
  t -= 1216;
  if (t < 768) { transpose_tile(p.in[I_WIN] + (size_t)l * 1024 * DIN, DIN, 4784, 3072, 1024, (bf16_t*)(ws + OFF_WGL), t % 48, t / 48, tile); return; }
  t -= 768;
  if (t < 72) { transpose_tile(p.in[I_WUQ] + (size_t)l * 384 * 768, 768, 0, 768, 384, (bf16_t*)(ws + OFF_WUQ), t % 12, t / 12, tile); return; }
  t -= 72;
  if (t < 64) { transpose_tile(p.in[I_WUKV] + (size_t)l * 256 * 1024, 1024, 0, 1024, 256, (bf16_t*)(ws + OFF_WUKV), t % 16, t / 16, tile); return; }
  t -= 64;
  if (t < 384) {
    int n = t / 128, tt = t % 128;
    transpose_tile(p.in[I_WBR] + (size_t)(l * 3 + n) * 512 * 1024, 1024, 0, 1024, 512, (bf16_t*)(ws + OFF_WBR) + (size_t)n * 1024 * 512, tt % 16, tt / 16, tile);
    return;
  }
  t -= 384;
  transpose_tile(p.in[I_WO] + (size_t)l * 1024 * 1024, 1024, 0, 1024, 1024, (bf16_t*)(ws + OFF_WO), t % 16, t / 16, tile);
}
DEV void mod_task(const Params& p, int t, char* lds) {
  char* ws_ = p.ws; asm volatile("" : "+s"(ws_));
  const int tid = otid();
  const int l = t / 192, n0 = (t % 192) * 16;
  float* s = (float*)lds;
  float* red = (float*)(lds + 32768);
  for (int idx = tid; idx < 5120; idx += 256) {
    int r = idx >> 10, k = idx & 1023;
    float v = (r == 0) ? p.in[I_CCTX][k] : p.in[I_C][(r - 1) * 1024 + k];
    s[idx] = v * frcp(1.f + __expf(-v));
  }
  __syncthreads();
  const int col = tid & 15, ksl = tid >> 4;
  float acc[5] = {0.f, 0.f, 0.f, 0.f, 0.f};
  const float* w = p.in[I_WMOD] + (size_t)l * 1024 * 3072 + n0 + col;
#pragma unroll 16
  for (int k = ksl * 64; k < ksl * 64 + 64; k++) {
    float wv = w[(size_t)k * 3072];
#pragma unroll
    for (int r = 0; r < 5; r++) acc[r] += s[r * 1024 + k] * wv;
  }
#pragma unroll
  for (int r = 0; r < 5; r++) red[(ksl * 5 + r) * 16 + col] = acc[r];
  __syncthreads();
  float* mod = (float*)(ws_ + OFF_MOD);
  if (tid < 80) {
    int r = tid >> 4, c = tid & 15;
    float v = p.in[I_BMOD][l * 3072 + n0 + c];
#pragma unroll
    for (int q = 0; q < 16; q++) v += red[(q * 5 + r) * 16 + c];
    mod[(l * 5 + r) * 3072 + n0 + c] = v;
  }
}

DEV void norm_task(const Params& p, int l, int t) {
  char* ws_ = p.ws; asm volatile("" : "+s"(ws_));
  const int tid = otid(), lane = tid & 63, wave = tid >> 6;
  const float* mod = (const float*)(ws_ + OFF_MOD);
  bf16_t* H = (bf16_t*)(ws_ + OFF_H);
#pragma unroll
  for (int rr = 0; rr < 2; rr++) {
    const int row = t * 8 + wave * 2 + rr;
    const float* x = xrow_ptr(p, l, row);
    const float* mr = mod + (size_t)(l * 5 + modrow(row)) * 3072;
    f32x4 v[4];
    float ss = 0.f;
#pragma unroll
    for (int i = 0; i < 4; i++) { v[i] = *(const f32x4*)(x + lane * 4 + 256 * i); ss += v[i].x * v[i].x + v[i].y * v[i].y + v[i].z * v[i].z + v[i].w * v[i].w; }
#pragma unroll
    for (int o = 32; o >= 1; o >>= 1) ss += __shfl_xor(ss, o);
    const float rstd = __builtin_amdgcn_rsqf(ss * (1.f / 1024.f) + EPSF);
#pragma unroll
    for (int i = 0; i < 4; i++) {
      const int col = lane * 4 + 256 * i;
      const f32x4 g = *(const f32x4*)(p.in[I_NORMG] + l * 1024 + col);
      const f32x4 sh = *(const f32x4*)(mr + col);
      const f32x4 sc = *(const f32x4*)(mr + 1024 + col);
      float a = v[i].x * rstd * g.x * (1.f + sc.x) + sh.x;
      float b = v[i].y * rstd * g.y * (1.f + sc.y) + sh.y;
      float c = v[i].z * rstd * g.z * (1.f + sc.z) + sh.z;
      float d = v[i].w * rstd * g.w * (1.f + sc.w) + sh.w;
      *(u32x2*)(H + (size_t)row * 1024 + col) = pack4(a, b, c, d);
    }
  }
}

DEV void projA_task(const Params& p, int l, int t, char* lds) {
  char* ws_ = p.ws; asm volatile("" : "+s"(ws_));
  const int tid = otid();
  const int nt = t / 64, mt = t % 64;
  f32x4 acc[4][4]; zero_acc<4>(acc);
  ALPlain al{(const bf16_t*)(ws_ + OFF_H) + (size_t)mt * 128 * 1024, 1024};
  gemm_core<128>(al, (const bf16_t*)(ws_ + OFF_WTA) + (size_t)nt * 128 * 1024, 1024, 1024, acc, lds);
  float* Cs = (float*)lds;
  acc_to_lds<128>(acc, Cs);
  bf16_t* P1 = (bf16_t*)(ws_ + OFF_P1);
  bf16_t* P2 = (bf16_t*)(ws_ + OFF_P2);
  bf16_t* P3 = (bf16_t*)(ws_ + OFF_P3);
  float* GAB = (float*)(ws_ + OFF_GAB);
#pragma unroll
  for (int i = 0; i < 8; i++) {
    const int it = tid + 256 * i, r = it >> 4, c8 = it & 15;
    const int n = nt * 128 + c8 * 8;
    if (n >= 4784) continue;
    const int row = mt * 128 + r;
    float f[8];
    const f32x4 a = *(const f32x4*)(Cs + r * 132 + c8 * 8);
    const f32x4 b = *(const f32x4*)(Cs + r * 132 + c8 * 8 + 4);
    f[0] = a.x; f[1] = a.y; f[2] = a.z; f[3] = a.w; f[4] = b.x; f[5] = b.y; f[6] = b.z; f[7] = b.w;
    if (n >= 2720 && n < 2736) {
      *(f32x4*)(GAB + (size_t)row * 16 + (n - 2720)) = a;
      *(f32x4*)(GAB + (size_t)row * 16 + (n - 2720) + 4) = b;
      continue;
    }
    if (n >= 640 && n < 672 && row < 4096) {
      float* o = p.out + OUT_KROPE + ((size_t)((row >> 8) * 2 + l) * 256 + (row & 255)) * 32 + (n - 640);
      *(f32x4*)o = a; *(f32x4*)(o + 4) = b;
    }
    bf16_t* dst;
    if (n < 672) dst = P1 + (size_t)row * P1W + n;
    else if (n < 1184) dst = P2 + (size_t)row * P2W + (n - 672);
    else if (n < 2720) dst = P1 + (size_t)row * P1W + 672 + (n - 1184);
    else if (n < 3248) dst = P2 + (size_t)row * P2W + 512 + (n - 2736);
    else if (n < 3760) dst = P3 + (size_t)row * P3W + (n - 3248);
    else if (n < 4272) dst = P3 + (size_t)row * P3W + 512 + (n - 3760);
    else dst = P2 + (size_t)row * P2W + 1024 + (n - 4272);
    *(u32x4*)dst = pack8(f);
  }
}

DEV void rope32(float* r, int prow, int pcol) {
  const float inv[8] = {1.f, 0.31622776601683794f, 0.1f, 0.031622776601683794f, 0.01f, 0.0031622776601683794f, 0.001f, 0.00031622776601683794f};
#pragma unroll
  for (int i = 0; i < 8; i++) {
    float a1 = (float)prow * inv[i], a2 = (float)pcol * inv[i];
    float c1 = __cosf(a1), s1 = __sinf(a1), c2 = __cosf(a2), s2 = __sinf(a2);
    float x1 = r[i], x2 = r[8 + i];
    r[i] = x1 * c1 - x2 * s1; r[8 + i] = x1 * s1 + x2 * c1;
    float y1 = r[16 + i], y2 = r[24 + i];
    r[16 + i] = y1 * c2 - y2 * s2; r[24 + i] = y1 * s2 + y2 * c2;
  }
}
DEV void finish_qk(float* v  , int half, const float* normw  , bool do_rope, int pos, float scale, bf16_t* dst  ) {
  float ss = 0.f;
#pragma unroll
  for (int i = 0; i < 48; i++) ss += v[i] * v[i];
  ss += __shfl_xor(ss, 1);
  const float rstd = __builtin_amdgcn_rsqf(ss * (1.f / 96.f) + EPSF);
#pragma unroll
  for (int i = 0; i < 12; i++) {
    const f32x4 w = *(const f32x4*)(normw + half * 48 + i * 4);
    v[i * 4] *= rstd * w.x; v[i * 4 + 1] *= rstd * w.y; v[i * 4 + 2] *= rstd * w.z; v[i * 4 + 3] *= rstd * w.w;
  }
  if (do_rope && half == 1) rope32(v + 16, pos >> 6, pos & 63);
#pragma unroll
  for (int i = 0; i < 6; i++) {
    float f[8];
#pragma unroll
    for (int j = 0; j < 8; j++) f[j] = v[i * 8 + j] * scale;
    *(u32x4*)(dst + half * 48 + i * 8) = pack8(f);
  }
}

#define QSCALE 0.14724306f
DEV void q_task(const Params& p, int l, int t, char* lds) {
  char* ws_ = p.ws; asm volatile("" : "+s"(ws_));
  const int tid = otid();
  const int mt = t & 63, h = t >> 6;
  const bf16_t* P1 = (const bf16_t*)(ws_ + OFF_P1);
  float* rs = (float*)(lds + LDS_SMALL);
  {
    const int row = tid >> 1, half = tid & 1;
    const bf16_t* src = P1 + (size_t)(mt * 128 + row) * P1W + half * 192;
    float ss = 0.f;
#pragma unroll 12
    for (int i = 0; i < 24; i++) { float f[8]; unpack8(*(const u32x4*)(src + i * 8), f);
#pragma unroll
      for (int j = 0; j < 8; j++) ss += f[j] * f[j]; }
    ss += __shfl_xor(ss, 1);
    if (!half) rs[row] = __builtin_amdgcn_rsqf(ss * (1.f / 384.f) + EPSF);
  }
  __syncthreads();
  f32x4 acc[4][3]; zero_acc<3>(acc);
  ALScaled al{P1 + (size_t)mt * 128 * P1W, P1W, rs, p.in[I_QAN] + l * 384};
  gemm_core<96>(al, (const bf16_t*)(ws_ + OFF_WUQ) + (size_t)h * 96 * 384, 384, 384, acc, lds);
  float* Cs = (float*)lds;
  acc_to_lds<96>(acc, Cs);
  const int row = tid >> 1, half = tid & 1, grow = mt * 128 + row;
  float v[48];
#pragma unroll
  for (int i = 0; i < 48; i++) v[i] = Cs[row * 100 + half * 48 + i];
  finish_qk(v, half, p.in[I_QN] + l * 96, grow >= 4096, (grow - 4096) & 1023, QSCALE,
            (bf16_t*)(ws_ + OFF_Q) + ((size_t)grow * 8 + h) * 96);
}

DEV void kv_task(const Params& p, int l, int t, char* lds) {
  char* ws_ = p.ws; asm volatile("" : "+s"(ws_));
  const int tid = otid();
  const int h = t / 72, mt = t % 72;
  const bf16_t* P1 = (const bf16_t*)(ws_ + OFF_P1);
  float* rs = (float*)(lds + LDS_SMALL);
  f32x4 acc[4][4]; zero_acc<4>(acc);
  const bf16_t* Bt = (const bf16_t*)(ws_ + OFF_WUKV) + (size_t)h * 128 * 256;
  if (mt < 64) {
    {
      const int row = tid >> 1, half = tid & 1;
      const bf16_t* src = P1 + (size_t)(mt * 128 + row) * P1W + 384 + half * 128;
      float ss = 0.f;
#pragma unroll
      for (int i = 0; i < 16; i++) { float f[8]; unpack8(*(const u32x4*)(src + i * 8), f);
#pragma unroll
        for (int j = 0; j < 8; j++) ss += f[j] * f[j]; }
      ss += __shfl_xor(ss, 1);
      if (!half) rs[row] = __builtin_amdgcn_rsqf(ss * (1.f / 256.f) + EPSF);
    }
    __syncthreads();
    if (h == 0 && mt < 32) {
#pragma unroll 8
      for (int it = tid; it < 128 * 32; it += 256) {
        const int r = it >> 5, c8 = it & 31, row = mt * 128 + r;
        float f[8]; unpack8(*(const u32x4*)(P1 + (size_t)row * P1W + 384 + c8 * 8), f);
        const float rr = rs[r];
        const float* g = p.in[I_KVAN] + l * 256 + c8 * 8;
        float* o = p.out + OUT_CKV + ((size_t)((row >> 8) * 2 + l) * 256 + (row & 255)) * 256 + c8 * 8;
        *(f32x4*)o = f32x4{f[0] * rr * g[0], f[1] * rr * g[1], f[2] * rr * g[2], f[3] * rr * g[3]};
        *(f32x4*)(o + 4) = f32x4{f[4] * rr * g[4], f[5] * rr * g[5], f[6] * rr * g[6], f[7] * rr * g[7]};
      }
    }
    ALScaled al{P1 + (size_t)mt * 128 * P1W + 384, P1W, rs, p.in[I_KVAN] + l * 256};
    gemm_core<128>(al, Bt, 256, 256, acc, lds);
  } else {
    const int b = (mt - 64) >> 1, p0 = ((mt - 64) & 1) * 128;
    ALF32 al{p.in[I_CCKV] + ((size_t)(b * 2 + l) * 256 + p0) * 256, 256};
    gemm_core<128>(al, Bt, 256, 256, acc, lds);
  }
  float* Cs = (float*)lds;
  acc_to_lds<128>(acc, Cs);
  {
    const int row = tid >> 1, half = tid & 1;
    float v[48];
    int krow; bool do_rope = false; int pos = 0;
    if (mt < 64) {
      const int grow = mt * 128 + row;
      krow = grow; do_rope = grow >= 4096; pos = (grow - 4096) & 1023;
      if (half == 0) {
#pragma unroll
        for (int i = 0; i < 48; i++) v[i] = Cs[row * 132 + i];
      } else {
#pragma unroll
        for (int i = 0; i < 16; i++) v[i] = Cs[row * 132 + 48 + i];
        const bf16_t* kr = P1 + (size_t)grow * P1W + 640;
#pragma unroll
        for (int i = 0; i < 4; i++) { float f[8]; unpack8(*(const u32x4*)(kr + i * 8), f);
#pragma unroll
          for (int j = 0; j < 8; j++) v[16 + i * 8 + j] = f[j]; }
      }
    } else {
      const int b = (mt - 64) >> 1, pp = ((mt - 64) & 1) * 128 + row;
      krow = 8192 + b * 256 + pp;
      if (half == 0) {
#pragma unroll
        for (int i = 0; i < 48; i++) v[i] = Cs[row * 132 + i];
      } else {
#pragma unroll
        for (int i = 0; i < 16; i++) v[i] = Cs[row * 132 + 48 + i];
        const float* kr = p.in[I_CKR] + ((size_t)(b * 2 + l) * 256 + pp) * 32;
#pragma unroll
        for (int i = 0; i < 8; i++) { const f32x4 w = *(const f32x4*)(kr + i * 4); v[16 + i * 4] = w.x; v[17 + i * 4] = w.y; v[18 + i * 4] = w.z; v[19 + i * 4] = w.w; }
      }
    }
    finish_qk(v, half, p.in[I_KN] + l * 96, do_rope, pos, 1.f, (bf16_t*)(ws_ + OFF_K) + ((size_t)krow * 8 + h) * 96);
  }
  {
    size_t vbase; int Tk, key0;
    if (mt < 32) { const int b = mt >> 1; Tk = 256; key0 = (mt & 1) * 128; vbase = (size_t)(b * 8 + h) * 64 * 256; }
    else if (mt < 64) { const int b = (mt - 32) >> 3; Tk = 1280; key0 = 256 + ((mt - 32) & 7) * 128; vbase = VT_LAT_EL + (size_t)(b * 8 + h) * 64 * 1280; }
    else { const int b = (mt - 64) >> 1; Tk = 1280; key0 = ((mt - 64) & 1) * 128; vbase = VT_LAT_EL + (size_t)(b * 8 + h) * 64 * 1280; }
    bf16_t* Vt = (bf16_t*)(ws_ + OFF_VT) + vbase;
#pragma unroll
    for (int i = 0; i < 4; i++) {
      const int it = tid + 256 * i, dv = it & 63, kg = it >> 6;
      float f[8];
#pragma unroll
      for (int j = 0; j < 8; j++) f[j] = Cs[(kg * 8 + j) * 132 + 64 + dv];
      *(u32x4*)(Vt + (size_t)dv * Tk + key0 + kg * 8) = pack8(f);
    }
  }
}

DEV void conv_pass(const Params& p, int l, int seg, int h, int row0, int sbeg, int send, float* F, bf16_t* Vtile) {
  char* ws_ = p.ws; asm volatile("" : "+s"(ws_));
  const int tid = otid(), c8 = tid & 15, tg = tid >> 4;
  const bf16_t* src = (const bf16_t*)(ws_ + OFF_P1) + 672 + seg * 512 + h * 128 + c8 * 8;
  const float* cwp = p.in[I_CONVW] + (size_t)l * 5 * 1536 + seg * 512 + h * 128 + c8 * 8;
  float cw[5][8];
#pragma unroll
  for (int j = 0; j < 5; j++) {
    const f32x4 a = *(const f32x4*)(cwp + j * 1536), b = *(const f32x4*)(cwp + j * 1536 + 4);
    cw[j][0] = a.x; cw[j][1] = a.y; cw[j][2] = a.z; cw[j][3] = a.w; cw[j][4] = b.x; cw[j][5] = b.y; cw[j][6] = b.z; cw[j][7] = b.w;
  }
  const int t0 = row0 + tg * 4;
  u32x4 raw[8];
#pragma unroll
  for (int r = 0; r < 8; r++) {
    const int row = t0 - 2 + r;
    raw[r] = (row >= sbeg && row < send) ? *(const u32x4*)(src + (size_t)row * P1W) : u32x4{0u, 0u, 0u, 0u};
  }
  float acc[4][8];
#pragma unroll
  for (int tt = 0; tt < 4; tt++)
#pragma unroll
    for (int c = 0; c < 8; c++) acc[tt][c] = 0.f;
#pragma unroll
  for (int r = 0; r < 8; r++) {
    float f[8]; unpack8(raw[r], f);
#pragma unroll
    for (int tt = 0; tt < 4; tt++) {
      const int j = r - tt;
      if (j >= 0 && j < 5) {
#pragma unroll
        for (int c = 0; c < 8; c++) acc[tt][c] += cw[j][c] * f[c];
      }
    }
  }
#pragma unroll
  for (int tt = 0; tt < 4; tt++) {
    float y[8];
#pragma unroll
    for (int c = 0; c < 8; c++) y[c] = siluf(acc[tt][c]);
    if (F) {
#pragma unroll
      for (int c = 0; c < 8; c++) F[(tg * 4 + tt) * 129 + c8 * 8 + c] = y[c];
    } else {
      *(u32x4*)(Vtile + (tg * 4 + tt) * 136 + c8 * 8) = pack8(y);
    }
  }
}
DEV void l2norm_rows(const float* F, bf16_t* T) {
  const int tid = otid(), row = tid >> 2, part = tid & 3;
  float ss = 0.f;
#pragma unroll
  for (int i = 0; i < 32; i++) { float x = F[row * 129 + part * 32 + i]; ss += x * x; }
  ss += __shfl_xor(ss, 1); ss += __shfl_xor(ss, 2);
  const float inv = __builtin_amdgcn_rsqf(ss + EPSF);
#pragma unroll
  for (int i = 0; i < 32; i++) T[row * 136 + part * 32 + i] = f2bf(F[row * 129 + part * 32 + i] * inv);
}
DEV void mm64(const bf16_t* At, const bf16_t* Bt_, float* Out, int wave, int l16, int quad) {
  f32x4 acc[4];
#pragma unroll
  for (int ni = 0; ni < 4; ni++) acc[ni] = f32x4{0.f, 0.f, 0.f, 0.f};
#pragma unroll
  for (int ks = 0; ks < 4; ks++) {
    bf16x8 a = *(const bf16x8*)(At + (wave * 16 + l16) * 136 + ks * 32 + quad * 8);
#pragma unroll
    for (int ni = 0; ni < 4; ni++) {
      bf16x8 b = *(const bf16x8*)(Bt_ + (ni * 16 + l16) * 136 + ks * 32 + quad * 8);
      acc[ni] = MFMA(a, b, acc[ni]);
    }
  }
#pragma unroll
  for (int ni = 0; ni < 4; ni++)
#pragma unroll
    for (int j = 0; j < 4; j++) Out[(wave * 16 + quad * 4 + j) * 65 + ni * 16 + l16] = acc[ni][j];
}
DEV void gdn_prep_task(const Params& p, int l, int t, char* lds) {
  char* ws_ = p.ws; asm volatile("" : "+s"(ws_));
  const int tid = otid(), lane = tid & 63, wave = tid >> 6, l16 = lane & 15, quad = lane >> 4;
  const int chunk = t >> 2, h = t & 3, row0 = chunk * 64;
  int sbeg, send;
  if (row0 < 4096) { sbeg = row0 & ~255; send = sbeg + 256; } else { sbeg = 4096 + ((row0 - 4096) & ~1023); send = sbeg + 1024; }
  bf16_t* Kt = (bf16_t*)lds;
  bf16_t* Qt = Kt + 64 * 136;
  float* F = (float*)(lds + 34816);
  float* G = F;
  float* Pm = (float*)(lds + 34816 + 17408);
  float* Am = Pm;
  float* gcs = (float*)(lds + LDS_SMALL);
  float* betas = gcs + 128;
  const float* GAB = (const float*)(ws_ + OFF_GAB);
  if (tid < 128) {
    const int dir = tid >> 6, ip = tid & 63, tok = dir ? 63 - ip : ip, row = row0 + tok;
    const float ga = GAB[(size_t)row * 16 + dir * 4 + h], gb = GAB[(size_t)row * 16 + 8 + dir * 4 + h];
    const float a = __expf(p.in[I_ALOG][(l * 2 + dir) * 4 + h]);
    const float x = ga + p.in[I_DTB][(l * 2 + dir) * 4 + h];
    const float ex = __expf(fminf(x, 20.f));
    const float sp = x > 20.f ? x : (ex < 0.01f ? ex * (1.f - ex * (0.5f - ex * (1.f / 3.f))) : __logf(1.f + ex));
    float g = -a * sp;
#pragma unroll
    for (int off = 1; off < 64; off <<= 1) { float v = __shfl_up(g, off); if (ip >= off) g += v; }
    gcs[dir * 64 + ip] = g;
    betas[dir * 64 + ip] = frcp(1.f + __expf(-gb));
  }
  conv_pass(p, l, 1, h, row0, sbeg, send, F, nullptr);
  __syncthreads();
  l2norm_rows(F, Kt);
  __syncthreads();
  conv_pass(p, l, 0, h, row0, sbeg, send, F, nullptr);
  __syncthreads();
  l2norm_rows(F, Qt);
  __syncthreads();
  mm64(Qt, Kt, Pm, wave, l16, quad);
  bf16_t* recbase = (bf16_t*)(ws_ + OFF_GDN) + (size_t)(chunk * 4 + h) * 2 * REC_EL;
#pragma unroll 1
  for (int dir = 0; dir < 2; dir++) {
    bf16_t* rec = recbase + (size_t)dir * REC_EL;
    const float* gc = gcs + dir * 64;
    const float gl = gc[63];
#pragma unroll
    for (int i = 0; i < 4; i++) {
      const int it = tid + 256 * i, ip = it >> 4, c8 = it & 15, tok = dir ? 63 - ip : ip;
      const float sc = 0.08838834764831845f * __expf(gc[ip]);
      float f[8]; unpack8(*(const u32x4*)(Qt + tok * 136 + c8 * 8), f);
#pragma unroll
      for (int j = 0; j < 8; j++) f[j] *= sc;
      *(u32x4*)(rec + 8192 + ip * 128 + c8 * 8) = pack8(f);
    }
#pragma unroll
    for (int i = 0; i < 4; i++) {
      const int it = tid + 256 * i, d = it & 127, ig = it >> 7;
      float f[8];
#pragma unroll
      for (int j = 0; j < 8; j++) { const int ip = ig * 8 + j, tok = dir ? 63 - ip : ip; f[j] = bf2f(Kt[tok * 136 + d]) * __expf(gl - gc[ip]); }
      *(u32x4*)(rec + 20480 + d * 64 + ig * 8) = pack8(f);
    }
    if (tid == 0) ((float*)(ws_ + OFF_EGL))[(chunk * 4 + h) * 2 + dir] = __expf(gl);
  }
  __syncthreads();
  conv_pass(p, l, 2, h, row0, sbeg, send, nullptr, Qt);
#pragma unroll 1
  for (int dir = 0; dir < 2; dir++) {
    bf16_t* rec = recbase + (size_t)dir * REC_EL;
    const float* gc = gcs + dir * 64;
#pragma unroll
    for (int i = 0; i < 2; i++) {
      const int it = tid + 256 * i, ip = it >> 3, j8 = it & 7, ti = dir ? 63 - ip : ip;
      float f[8];
#pragma unroll
      for (int j = 0; j < 8; j++) {
        const int jp = j8 * 8 + j, tj = dir ? 63 - jp : jp;
        const float e = __expf(fminf(gc[ip] - gc[jp], 0.f));
        f[j] = (ip >= jp) ? Pm[ti * 65 + tj] * 0.08838834764831845f * e : 0.f;
      }
      *(u32x4*)(rec + 16384 + ip * 64 + j8 * 8) = pack8(f);
    }
  }
  __syncthreads();
  const bf16_t* Vtile = Qt;
  float* T = G;
#pragma unroll 1
  for (int dir = 0; dir < 2; dir++) {
    bf16_t* rec = recbase + (size_t)dir * REC_EL;
    const float* gc = gcs + dir * 64;
    const float* be = betas + dir * 64;
    mm64(Kt, Kt, G, wave, l16, quad);
    __syncthreads();
#pragma unroll 2
    for (int i = 0; i < 16; i++) {
      const int it = tid + 256 * i, ip = it >> 6, jp = it & 63;
      const int ti = dir ? 63 - ip : ip, tj = dir ? 63 - jp : jp;
      const float e = __expf(fminf(gc[ip] - gc[jp], 0.f));
      Am[ip * 68 + jp] = (ip > jp) ? be[ip] * G[ti * 65 + tj] * e : 0.f;
    }
    __syncthreads();
    {
      const int cl = lane >> 2, q = lane & 3, c = wave * 16 + cl;
      float r[16];
#pragma unroll
      for (int m = 0; m < 16; m++) r[m] = (q + 4 * m == c) ? 1.f : 0.f;
#pragma unroll
      for (int j = 0; j < 63; j++) {
        const int mj = j >> 2;
        float t;
        switch (j & 3) {
          case 0: t = __int_as_float(__builtin_amdgcn_update_dpp(0, __float_as_int(r[mj]), 0x00, 0xF, 0xF, true)); break;
          case 1: t = __int_as_float(__builtin_amdgcn_update_dpp(0, __float_as_int(r[mj]), 0x55, 0xF, 0xF, true)); break;
          case 2: t = __int_as_float(__builtin_amdgcn_update_dpp(0, __float_as_int(r[mj]), 0xAA, 0xF, 0xF, true)); break;
          default: t = __int_as_float(__builtin_amdgcn_update_dpp(0, __float_as_int(r[mj]), 0xFF, 0xF, 0xF, true)); break;
        }
#pragma unroll
        for (int m = mj; m < 16; m++) r[m] -= Am[(q + 4 * m) * 68 + j] * t;
        if ((j & 7) == 7) asm volatile("" ::: "memory");
      }
#pragma unroll
      for (int m = 0; m < 16; m++) T[(q + 4 * m) * 68 + c] = r[m];
    }
    __syncthreads();
#pragma unroll 1
    for (int which = 0; which < 2; which++) {
      const bf16_t* srcT = which ? Kt : Vtile;
      f32x4 ac[4][2];
      zero_acc<2>(ac);
#pragma unroll
      for (int ks = 0; ks < 2; ks++) {
        float cs[8];
        unsigned short e[2][8];
#pragma unroll
        for (int s = 0; s < 8; s++) {
          const int j = ks * 32 + quad * 8 + s, tok = dir ? 63 - j : j;
          cs[s] = which ? be[j] * __expf(gc[j]) : be[j];
#pragma unroll
          for (int nf = 0; nf < 2; nf++) e[nf][s] = srcT[tok * 136 + wave * 32 + nf * 16 + l16];
        }
        bf16x8 bfr[2];
#pragma unroll
        for (int nf = 0; nf < 2; nf++) {
          u32x4 v;
          v.x = e[nf][0] | ((unsigned)e[nf][1] << 16); v.y = e[nf][2] | ((unsigned)e[nf][3] << 16);
          v.z = e[nf][4] | ((unsigned)e[nf][5] << 16); v.w = e[nf][6] | ((unsigned)e[nf][7] << 16);
          bfr[nf] = as_frag(v);
        }
#pragma unroll
        for (int mi = 0; mi < 4; mi++) {
          const float* tr = T + (mi * 16 + l16) * 68 + ks * 32 + quad * 8;
          const f32x4 t0 = *(const f32x4*)tr, t1 = *(const f32x4*)(tr + 4);
          const float tv[8] = {t0.x, t0.y, t0.z, t0.w, t1.x, t1.y, t1.z, t1.w};
          float a[8], hi[8], lo[8];
#pragma unroll
          for (int s = 0; s < 8; s++) a[s] = tv[s] * cs[s];
          const u32x4 ph = pack8(a);
          unpack8(ph, hi);
#pragma unroll
          for (int s = 0; s < 8; s++) lo[s] = a[s] - hi[s];
          const bf16x8 fh = as_frag(ph), fl = as_frag(pack8(lo));
#pragma unroll
          for (int nf = 0; nf < 2; nf++) { ac[mi][nf] = MFMA(fh, bfr[nf], ac[mi][nf]); ac[mi][nf] = MFMA(fl, bfr[nf], ac[mi][nf]); }
        }
      }
      int qs = quad, ls = l16;
      asm volatile("" : "+v"(qs), "+v"(ls));
      bf16_t* dst = rec + (which ? 0 : 28672);
      const float sg = which ? -1.f : 1.f;
#pragma unroll
      for (int mi = 0; mi < 4; mi++)
#pragma unroll
        for (int nf = 0; nf < 2; nf++)
#pragma unroll
          for (int j = 0; j < 4; j++) {
            const int ip = mi * 16 + qs * 4 + j, col = wave * 32 + nf * 16 + ls;
            dst[ip * 128 + col] = f2bf(sg * ac[mi][nf][j]);
          }
    }
    __syncthreads();
  }
}

DEV void cmlp_task(const Params& p, int l, int t, char* lds) {
  char* ws_ = p.ws; asm volatile("" : "+s"(ws_));
  const int tid = otid(), lane = tid & 63, wave = tid >> 6, l16 = lane & 15, quad = lane >> 4;
  const int wm = wave >> 1, wn = wave & 1;
  const int c = t >> 2, g = t & 3, r0 = c * 128;
  const bf16_t* P3 = (const bf16_t*)(ws_ + OFF_P3);
  const bf16_t* P2 = (const bf16_t*)(ws_ + OFF_P2);
  bf16_t* BR = (bf16_t*)(ws_ + OFF_BR);
  bf16_t* VnT = (bf16_t*)lds;
  bf16_t* Ws = VnT + 128 * 136;
  float* mu = (float*)(lds + LDS_SMALL);
  float* rstd = mu + 128;
  {
    const int row = tid >> 1, half = tid & 1;
    const bf16_t* src = P3 + (size_t)(r0 + row) * P3W + 512 + half * 256;
    float s = 0.f, ss = 0.f;
#pragma unroll 16
    for (int i = 0; i < 32; i++) { float f[8]; unpack8(*(const u32x4*)(src + i * 8), f);
#pragma unroll
      for (int j = 0; j < 8; j++) { float y = geluf(f[j]); s += y; ss += y * y; } }
    s += __shfl_xor(s, 1); ss += __shfl_xor(ss, 1);
    const float mean = s * (1.f / 512.f), var = fmaxf(ss * (1.f / 512.f) - mean * mean, 0.f);
    if (!half) { mu[row] = mean; rstd[row] = __builtin_amdgcn_rsqf(var + EPSF); }
  }
  __syncthreads();
#pragma unroll
  for (int i = 0; i < 8; i++) {
    const int it = tid + 256 * i, q = it >> 4, c8 = it & 15;
    float f[8]; unpack8(*(const u32x4*)(P3 + (size_t)(r0 + q) * P3W + 512 + g * 128 + c8 * 8), f);
    const float m = mu[q], rs = rstd[q];
#pragma unroll
    for (int j = 0; j < 8; j++) {
      const int cc = c8 * 8 + j;
      const float val = (geluf(f[j]) - m) * rs * p.in[I_LNG][l * 512 + g * 128 + cc] + p.in[I_LNB][l * 512 + g * 128 + cc];
      VnT[cc * 136 + q] = f2bf(val);
    }
  }
#pragma unroll
  for (int i = 0; i < 16; i++) {
    const int it = tid + 256 * i, pp = it >> 5, q4 = it & 31;
    const f32x4 w = *(const f32x4*)(p.in[I_WS] + ((size_t)(l * 4 + g) * 128 + pp) * 128 + q4 * 4);
    *(u32x2*)(Ws + pp * 136 + q4 * 4) = pack4(w.x, w.y, w.z, w.w);
  }
  __syncthreads();
  f32x4 acc[4][4]; zero_acc<4>(acc);
#pragma unroll
  for (int ks = 0; ks < 4; ks++) {
    bf16x8 a[4], b[4];
#pragma unroll
    for (int mi = 0; mi < 4; mi++) a[mi] = *(const bf16x8*)(Ws + (wm * 64 + mi * 16 + l16) * 136 + ks * 32 + quad * 8);
#pragma unroll
    for (int ni = 0; ni < 4; ni++) b[ni] = *(const bf16x8*)(VnT + (wn * 64 + ni * 16 + l16) * 136 + ks * 32 + quad * 8);
#pragma unroll
    for (int mi = 0; mi < 4; mi++)
#pragma unroll
      for (int ni = 0; ni < 4; ni++) acc[mi][ni] = MFMA(a[mi], b[ni], acc[mi][ni]);
  }
  float* Cs = (float*)lds;
  __syncthreads();
#pragma unroll
  for (int mi = 0; mi < 4; mi++)
#pragma unroll
    for (int j = 0; j < 4; j++) {
      const int pp = wm * 64 + mi * 16 + quad * 4 + j;
      const float bias = p.in[I_BS][(l * 4 + g) * 128 + pp];
#pragma unroll
      for (int ni = 0; ni < 4; ni++) Cs[pp * 132 + wn * 64 + ni * 16 + l16] = acc[mi][ni][j] + bias;
    }
  __syncthreads();
  u32x4 uu[8], zz[8];
#pragma unroll
  for (int i = 0; i < 8; i++) {
    const int it = tid + 256 * i, r = it >> 4, c8 = it & 15;
    const size_t row = (size_t)(r0 + r);
    uu[i] = *(const u32x4*)(P3 + row * P3W + g * 128 + c8 * 8);
    zz[i] = *(const u32x4*)(P2 + row * P2W + 1024 + g * 128 + c8 * 8);
  }
#pragma unroll
  for (int i = 0; i < 8; i++) {
    const int it = tid + 256 * i, r = it >> 4, c8 = it & 15;
    float u[8], z[8], o[8];
    unpack8(uu[i], u); unpack8(zz[i], z);
    const f32x4 s0 = *(const f32x4*)(Cs + r * 132 + c8 * 8), s1 = *(const f32x4*)(Cs + r * 132 + c8 * 8 + 4);
    const float sv[8] = {s0.x, s0.y, s0.z, s0.w, s1.x, s1.y, s1.z, s1.w};
#pragma unroll
    for (int j = 0; j < 8; j++) o[j] = geluf(u[j]) * sv[j] * siluf(z[j]);
    *(u32x4*)(BR + (size_t)(r0 + r) * BRW + 1024 + g * 128 + c8 * 8) = pack8(o);
  }
}

DEV void attn_task(const Params& p, int l, int t, char* lds) {
  char* ws_ = p.ws; asm volatile("" : "+s"(ws_));
  const int tid = otid(), lane = tid & 63, wave = tid >> 6, l16 = lane & 15, quad = lane >> 4;
  int b, h, qrow0, nkt, Tk; size_t vtb;
  const bool lat = t < 256;
  if (lat) { b = t >> 6; h = (t >> 3) & 7; const int qb = t & 7; qrow0 = 4096 + b * 1024 + qb * 128; nkt = 20; Tk = 1280; vtb = VT_LAT_EL + (size_t)(b * 8 + h) * 64 * 1280; }
  else { const int tt = t - 256; b = tt >> 4; h = (tt >> 1) & 7; const int qb = tt & 1; qrow0 = b * 256 + qb * 128; nkt = 4; Tk = 256; vtb = (size_t)(b * 8 + h) * 64 * 256; }
  if (lat) __builtin_amdgcn_s_setprio(2);
  const bf16_t* Qg = (const bf16_t*)(ws_ + OFF_Q);
  const bf16_t* Kg = (const bf16_t*)(ws_ + OFF_K);
  const bf16_t* Vg = (const bf16_t*)(ws_ + OFF_VT) + vtb;
  bf16_t* Qs = (bf16_t*)lds;
  bf16_t* Ks = Qs + 128 * 104;
  bf16_t* Vs = Ks + 64 * 104;
#pragma unroll
  for (int i = 0; i < 6; i++) {
    const int it = tid + 256 * i, r = it / 12, cc = it % 12;
    *(u32x4*)(Qs + r * 104 + cc * 8) = *(const u32x4*)(Qg + ((size_t)(qrow0 + r) * 8 + h) * 96 + cc * 8);
  }
  __syncthreads();
  bf16x8 qf[2][3];
#pragma unroll
  for (int ni = 0; ni < 2; ni++)
#pragma unroll
    for (int ks = 0; ks < 3; ks++) qf[ni][ks] = *(const bf16x8*)(Qs + (wave * 32 + ni * 16 + l16) * 104 + ks * 32 + quad * 8);
  f32x4 o[4][2];
#pragma unroll
  for (int di = 0; di < 4; di++) { o[di][0] = f32x4{0.f, 0.f, 0.f, 0.f}; o[di][1] = f32x4{0.f, 0.f, 0.f, 0.f}; }
  float mrun[2] = {-1e30f, -1e30f}, lsum[2] = {0.f, 0.f};
  u32x4 pk[3], pv[2];
  {
    const int krow0 = lat ? (8192 + b * 256) : (b * 256);
#pragma unroll
    for (int i = 0; i < 3; i++) { const int it = tid + 256 * i, r = it / 12, cc = it % 12; pk[i] = *(const u32x4*)(Kg + ((size_t)(krow0 + r) * 8 + h) * 96 + cc * 8); }
#pragma unroll
    for (int i = 0; i < 2; i++) { const int it = tid + 256 * i, dv = it >> 3, kg = it & 7; pv[i] = *(const u32x4*)(Vg + (size_t)dv * Tk + kg * 8); }
  }
  for (int kt = 0; kt < nkt; kt++) {
    __syncthreads();
#pragma unroll
    for (int i = 0; i < 3; i++) { const int it = tid + 256 * i, r = it / 12, cc = it % 12; *(u32x4*)(Ks + r * 104 + cc * 8) = pk[i]; }
#pragma unroll
    for (int i = 0; i < 2; i++) { const int it = tid + 256 * i, dv = it >> 3, kg = it & 7; *(u32x4*)(Vs + dv * 72 + kg * 8) = pv[i]; }
    __syncthreads();
    if (kt + 1 < nkt) {
      const int kn = kt + 1;
      int krow0;
      if (lat) krow0 = (kn < 4) ? (8192 + b * 256 + kn * 64) : (4096 + b * 1024 + (kn - 4) * 64);
      else krow0 = b * 256 + kn * 64;
#pragma unroll
      for (int i = 0; i < 3; i++) { const int it = tid + 256 * i, r = it / 12, cc = it % 12; pk[i] = *(const u32x4*)(Kg + ((size_t)(krow0 + r) * 8 + h) * 96 + cc * 8); }
#pragma unroll
      for (int i = 0; i < 2; i++) { const int it = tid + 256 * i, dv = it >> 3, kg = it & 7; pv[i] = *(const u32x4*)(Vg + (size_t)dv * Tk + kn * 64 + kg * 8); }
    }
    __builtin_amdgcn_sched_barrier(0);
    f32x4 s[4][2];
#pragma unroll
    for (int mi = 0; mi < 4; mi++) { s[mi][0] = f32x4{0.f, 0.f, 0.f, 0.f}; s[mi][1] = f32x4{0.f, 0.f, 0.f, 0.f}; }
#pragma unroll
    for (int ks = 0; ks < 3; ks++)
#pragma unroll
      for (int mi = 0; mi < 4; mi++) {
        bf16x8 kf = *(const bf16x8*)(Ks + (mi * 16 + l16) * 104 + ks * 32 + quad * 8);
        s[mi][0] = MFMA(kf, qf[0][ks], s[mi][0]);
        s[mi][1] = MFMA(kf, qf[1][ks], s[mi][1]);
      }
#pragma unroll
    for (int ni = 0; ni < 2; ni++) {
      float mx = -1e30f;
#pragma unroll
      for (int mi = 0; mi < 4; mi++)
#pragma unroll
        for (int j = 0; j < 4; j++) mx = fmaxf(mx, s[mi][ni][j]);
      mx = fmaxf(mx, __shfl_xor(mx, 16)); mx = fmaxf(mx, __shfl_xor(mx, 32));
      const float mnew = fmaxf(mrun[ni], mx);
      const float alpha = __builtin_amdgcn_exp2f(mrun[ni] - mnew);
      mrun[ni] = mnew;
      float rsum = 0.f;
#pragma unroll
      for (int mi = 0; mi < 4; mi++)
#pragma unroll
        for (int j = 0; j < 4; j++) { float pv = __builtin_amdgcn_exp2f(s[mi][ni][j] - mnew); s[mi][ni][j] = pv; rsum += pv; }
      lsum[ni] = lsum[ni] * alpha + rsum;
#pragma unroll
      for (int di = 0; di < 4; di++) o[di][ni] *= alpha;
    }
#pragma unroll
    for (int g = 0; g < 2; g++) {
      bf16x8 pf0 = frag_from(s[2 * g][0], s[2 * g + 1][0]);
      bf16x8 pf1 = frag_from(s[2 * g][1], s[2 * g + 1][1]);
#pragma unroll
      for (int di = 0; di < 4; di++) {
        bf16x8 vf = ld2(Vs + (di * 16 + l16) * 72 + g * 32 + quad * 4);
        o[di][0] = MFMA(vf, pf0, o[di][0]);
        o[di][1] = MFMA(vf, pf1, o[di][1]);
      }
    }
  }
  const bf16_t* P2 = (const bf16_t*)(ws_ + OFF_P2);
  bf16_t* BR = (bf16_t*)(ws_ + OFF_BR);
#pragma unroll
  for (int ni = 0; ni < 2; ni++) {
    float lt = lsum[ni];
    lt += __shfl_xor(lt, 16); lt += __shfl_xor(lt, 32);
    const float inv = frcp(lt);
    const size_t qrow = (size_t)(qrow0 + wave * 32 + ni * 16 + l16);
#pragma unroll
    for (int di = 0; di < 4; di++) {
      const int col = h * 64 + di * 16 + quad * 4;
      float z[4]; unpack4(*(const u32x2*)(P2 + qrow * P2W + col), z);
      *(u32x2*)(BR + qrow * BRW + col) = pack4(o[di][ni][0] * inv * siluf(z[0]), o[di][ni][1] * inv * siluf(z[1]),
                                               o[di][ni][2] * inv * siluf(z[2]), o[di][ni][3] * inv * siluf(z[3]));
    }
  }
  __builtin_amdgcn_s_setprio(0);
}

struct ScanPf { u32x4 w[4], q[4], a[2], k[4], u[2]; float egl; };
DEV void scan_prefetch(ScanPf& f, const bf16_t* rec, const float* eglp, int half, int tid) {
#pragma unroll
  for (int i = 0; i < 4; i++) { const int c = tid + 256 * i; f.w[i] = *(const u32x4*)(rec + c * 8); f.q[i] = *(const u32x4*)(rec + 8192 + c * 8); f.k[i] = *(const u32x4*)(rec + 20480 + c * 8); }
#pragma unroll
  for (int i = 0; i < 2; i++) { const int c = tid + 256 * i; f.a[i] = *(const u32x4*)(rec + 16384 + c * 8); f.u[i] = *(const u32x4*)(rec + 28672 + (c >> 3) * 128 + half * 64 + (c & 7) * 8); }
  f.egl = *eglp;
}
DEV void gdn_scan_task(const Params& p, int l, int t, char* lds) {
  char* ws_ = p.ws; asm volatile("" : "+s"(ws_));
  const int tid = otid(), lane = tid & 63, wave = tid >> 6, l16 = lane & 15, quad = lane >> 4;
  __builtin_amdgcn_s_setprio(3);
  int chain, half, b, chunk0, N; bool lat = t < 64;
  if (lat) { chain = t >> 1; half = t & 1; } else { chain = (t - 64) >> 1; half = (t - 64) & 1; }
  const int dir = chain & 1, h = (chain >> 1) & 3;
  b = chain >> 3;
  if (lat) { chunk0 = 64 + b * 16; N = 16; } else { chunk0 = b * 4; N = 4; }
  const int e0 = (half * 4 + wave) * 16;
  bf16_t* Wl = (bf16_t*)lds;
  bf16_t* Ql = Wl + 64 * 136;
  bf16_t* Al = Ql + 64 * 136;
  bf16_t* Kl = Al + 64 * 72;
  bf16_t* Ul = Kl + 128 * 72;
  f32x4 S[8];
  if (lat) {
    const float* s0 = p.in[I_SGDN] + ((size_t)((b * 2 + l) * 2 + dir) * 4 + h) * 16384;
#pragma unroll
    for (int mf = 0; mf < 8; mf++)
#pragma unroll
      for (int j = 0; j < 4; j++) S[mf][j] = s0[(mf * 16 + quad * 4 + j) * 128 + e0 + l16];
  } else {
#pragma unroll
    for (int mf = 0; mf < 8; mf++) S[mf] = f32x4{0.f, 0.f, 0.f, 0.f};
  }
  float* OD = (float*)(ws_ + OFF_ODIR) + (size_t)dir * NTOK * 512;
  const float* EGL = (const float*)(ws_ + OFF_EGL);
  const bf16_t* GD = (const bf16_t*)(ws_ + OFF_GDN);
  ScanPf pf;
  {
    const int cidx = chunk0 + (dir ? N - 1 : 0);
    scan_prefetch(pf, GD + ((size_t)(cidx * 4 + h) * 2 + dir) * REC_EL, EGL + (cidx * 4 + h) * 2 + dir, half, tid);
  }
#pragma unroll 1
  for (int n = 0; n < N; n++) {
    const int cidx = chunk0 + (dir ? N - 1 - n : n);
    __syncthreads();
#pragma unroll
    for (int i = 0; i < 4; i++) {
      const int c = tid + 256 * i;
      *(u32x4*)(Wl + (c >> 4) * 136 + (c & 15) * 8) = pf.w[i];
      *(u32x4*)(Ql + (c >> 4) * 136 + (c & 15) * 8) = pf.q[i];
      *(u32x4*)(Kl + (c >> 3) * 72 + (c & 7) * 8) = pf.k[i];
    }
#pragma unroll
    for (int i = 0; i < 2; i++) {
      const int c = tid + 256 * i;
      *(u32x4*)(Al + (c >> 3) * 72 + (c & 7) * 8) = pf.a[i];
      *(u32x4*)(Ul + (c >> 3) * 72 + (c & 7) * 8) = pf.u[i];
    }
    const float egl = pf.egl;
    __syncthreads();
    if (n + 1 < N) {
      const int cn = chunk0 + (dir ? N - 2 - n : n + 1);
      scan_prefetch(pf, GD + ((size_t)(cn * 4 + h) * 2 + dir) * REC_EL, EGL + (cn * 4 + h) * 2 + dir, half, tid);
    }
    __builtin_amdgcn_sched_barrier(0);
    bf16x8 Sb[4];
#pragma unroll
    for (int ks = 0; ks < 4; ks++) Sb[ks] = frag_from(S[2 * ks], S[2 * ks + 1]);
    f32x4 vn[4];
#pragma unroll
    for (int mi = 0; mi < 4; mi++)
#pragma unroll
      for (int j = 0; j < 4; j++) vn[mi][j] = bf2f(Ul[(mi * 16 + quad * 4 + j) * 72 + wave * 16 + l16]);
#pragma unroll
    for (int mi = 0; mi < 4; mi++)
#pragma unroll
      for (int ks = 0; ks < 4; ks++) vn[mi] = MFMA(ld2(Wl + (mi * 16 + l16) * 136 + ks * 32 + quad * 4), Sb[ks], vn[mi]);
    bf16x8 vb[2];
    vb[0] = frag_from(vn[0], vn[1]); vb[1] = frag_from(vn[2], vn[3]);
#pragma unroll
    for (int mi = 0; mi < 4; mi++) {
      f32x4 o = f32x4{0.f, 0.f, 0.f, 0.f};
#pragma unroll
      for (int ks = 0; ks < 4; ks++) o = MFMA(ld2(Ql + (mi * 16 + l16) * 136 + ks * 32 + quad * 4), Sb[ks], o);
#pragma unroll
      for (int k2 = 0; k2 < 2; k2++) o = MFMA(ld2(Al + (mi * 16 + l16) * 72 + k2 * 32 + quad * 4), vb[k2], o);
#pragma unroll
      for (int j = 0; j < 4; j++) {
        const int ip = mi * 16 + quad * 4 + j, tok = dir ? 63 - ip : ip;
        OD[(size_t)(cidx * 64 + tok) * 512 + h * 128 + e0 + l16] = o[j];
      }
    }
#pragma unroll
    for (int mf = 0; mf < 8; mf++) {
      S[mf] *= egl;
#pragma unroll
      for (int k2 = 0; k2 < 2; k2++) S[mf] = MFMA(ld2(Kl + (mf * 16 + l16) * 72 + k2 * 32 + quad * 4), vb[k2], S[mf]);
    }
  }
  if (!lat) {
    float* so = p.out + OUT_STATE + ((size_t)((b * 2 + l) * 2 + dir) * 4 + h) * 16384;
#pragma unroll
    for (int mf = 0; mf < 8; mf++)
#pragma unroll
      for (int j = 0; j < 4; j++) so[(mf * 16 + quad * 4 + j) * 128 + e0 + l16] = S[mf][j];
  }
  __builtin_amdgcn_s_setprio(0);
}

DEV void onorm_task(const Params& p, int l, int t) {
  char* ws_ = p.ws; asm volatile("" : "+s"(ws_));
  const int tid = otid(), lane = tid & 63, wave = tid >> 6;
  const float* OD = (const float*)(ws_ + OFF_ODIR);
  const bf16_t* P2 = (const bf16_t*)(ws_ + OFF_P2);
  bf16_t* BR = (bf16_t*)(ws_ + OFF_BR);
#pragma unroll
  for (int rr = 0; rr < 4; rr++) {
    const size_t row = (size_t)t * 16 + wave * 4 + rr;
    const f32x4 a0 = *(const f32x4*)(OD + row * 512 + lane * 8), a1 = *(const f32x4*)(OD + row * 512 + lane * 8 + 4);
    const f32x4 b0 = *(const f32x4*)(OD + (NTOK + row) * 512 + lane * 8), b1 = *(const f32x4*)(OD + (NTOK + row) * 512 + lane * 8 + 4);
    float x[8] = {a0.x + b0.x, a0.y + b0.y, a0.z + b0.z, a0.w + b0.w, a1.x + b1.x, a1.y + b1.y, a1.z + b1.z, a1.w + b1.w};
    float ss = 0.f;
#pragma unroll
    for (int i = 0; i < 8; i++) ss += x[i] * x[i];
#pragma unroll
    for (int o = 8; o >= 1; o >>= 1) ss += __shfl_xor(ss, o);
    const float rstd = __builtin_amdgcn_rsqf(ss * (1.f / 128.f) + EPSF);
    float z[8]; unpack8(*(const u32x4*)(P2 + row * P2W + 512 + lane * 8), z);
    const float* g = p.in[I_ONORM] + l * 128 + (lane & 15) * 8;
    float y[8];
#pragma unroll
    for (int i = 0; i < 8; i++) y[i] = x[i] * rstd * g[i] * siluf(z[i]);
    *(u32x4*)(BR + row * BRW + 512 + lane * 8) = pack8(y);
  }
}

DEV void gate_task(const Params& p, int l, int t, char* lds) {
  char* ws_ = p.ws; asm volatile("" : "+s"(ws_));
  const int tid = otid();
  const int nt = t / 64, mt = t % 64;
  f32x4 acc[4][4]; zero_acc<4>(acc);
  ALPlain al{(const bf16_t*)(ws_ + OFF_H) + (size_t)mt * 128 * 1024, 1024};
  gemm_core<128>(al, (const bf16_t*)(ws_ + OFF_WGL) + (size_t)nt * 128 * 1024, 1024, 1024, acc, lds);
  float* Cs = (float*)lds;
  acc_to_lds<128>(acc, Cs);
  bf16_t* GT = (bf16_t*)(ws_ + OFF_GDN);
#pragma unroll
  for (int i = 0; i < 8; i++) {
    const int it = tid + 256 * i, r = it >> 4, c8 = it & 15;
    const f32x4 a = *(const f32x4*)(Cs + r * 132 + c8 * 8), b = *(const f32x4*)(Cs + r * 132 + c8 * 8 + 4);
    float f[8] = {sigmf(a.x), sigmf(a.y), sigmf(a.z), sigmf(a.w), sigmf(b.x), sigmf(b.y), sigmf(b.z), sigmf(b.w)};
    *(u32x4*)(GT + (size_t)(mt * 128 + r) * 3072 + nt * 128 + c8 * 8) = pack8(f);
  }
}
DEV void d1_task(const Params& p, int l, int t, char* lds) {
  char* ws_ = p.ws; asm volatile("" : "+s"(ws_));
  const int tid = otid(), lane = tid & 63, wave = tid >> 6, l16 = lane & 15, quad = lane >> 4;
  const int wm = wave >> 1, wn = wave & 1;
  const int nt = t >> 6, mt = t & 63;
  const bf16_t* GT = (const bf16_t*)(ws_ + OFF_GDN);
  f32x4 macc[4][2]; zero_acc<2>(macc);
#pragma unroll 1
  for (int n = 0; n < 3; n++) {
    unsigned short gv[4][2][4];
#pragma unroll
    for (int mi = 0; mi < 4; mi++)
#pragma unroll
      for (int ni = 0; ni < 2; ni++)
#pragma unroll
        for (int j = 0; j < 4; j++)
          gv[mi][ni][j] = GT[(size_t)(mt * 128 + wm * 64 + mi * 16 + quad * 4 + j) * 3072 + n * 1024 + nt * 64 + wn * 32 + ni * 16 + l16];
    f32x4 y[4][2]; zero_acc<2>(y);
    ALPlain alb{(const bf16_t*)(ws_ + OFF_BR) + (size_t)mt * 128 * BRW + n * 512, BRW};
    gemm_core<64>(alb, (const bf16_t*)(ws_ + OFF_WBR) + (size_t)(n * 1024 + nt * 64) * 512, 512, 512, y, lds);
#pragma unroll
    for (int mi = 0; mi < 4; mi++)
#pragma unroll
      for (int ni = 0; ni < 2; ni++)
#pragma unroll
        for (int j = 0; j < 4; j++) macc[mi][ni][j] += bf2f(gv[mi][ni][j]) * y[mi][ni][j];
  }
  float* Cs = (float*)lds;
  acc_to_lds<64>(macc, Cs);
  bf16_t* M = (bf16_t*)(ws_ + OFF_M);
#pragma unroll
  for (int i = 0; i < 4; i++) {
    const int it = tid + 256 * i, r = it >> 3, c8 = it & 7;
    float f[8];
#pragma unroll
    for (int j = 0; j < 8; j++) f[j] = Cs[r * 68 + c8 * 8 + j];
    *(u32x4*)(M + (size_t)(mt * 128 + r) * 1024 + nt * 64 + c8 * 8) = pack8(f);
  }
}

DEV void d2_task(const Params& p, int l, int t, char* lds) {
  char* ws_ = p.ws; asm volatile("" : "+s"(ws_));
  const int tid = otid();
  const int nt = t >> 6, mt = t & 63;
  f32x4 acc[4][4]; zero_acc<4>(acc);
  ALPlain al{(const bf16_t*)(ws_ + OFF_M) + (size_t)mt * 128 * 1024, 1024};
  gemm_core<128>(al, (const bf16_t*)(ws_ + OFF_WO) + (size_t)nt * 128 * 1024, 1024, 1024, acc, lds);
  float* Cs = (float*)lds;
  acc_to_lds<128>(acc, Cs);
  const float* mod = (const float*)(ws_ + OFF_MOD);
#pragma unroll
  for (int i = 0; i < 8; i++) {
    const int it = tid + 256 * i, r = it >> 4, c8 = it & 15;
    const int row = mt * 128 + r, col = nt * 128 + c8 * 8;
    const float* x = xrow_ptr(p, l, row) + col;
    const float* gt = mod + (size_t)(l * 5 + modrow(row)) * 3072 + 2048 + col;
    const f32x4 y0 = *(const f32x4*)(Cs + r * 132 + c8 * 8), y1 = *(const f32x4*)(Cs + r * 132 + c8 * 8 + 4);
    const f32x4 x0 = *(const f32x4*)x, x1 = *(const f32x4*)(x + 4);
    const f32x4 g0 = *(const f32x4*)gt, g1 = *(const f32x4*)(gt + 4);
    float* o = p.out + (size_t)row * DM + col;
    *(f32x4*)o = f32x4{x0.x + g0.x * y0.x, x0.y + g0.y * y0.y, x0.z + g0.z * y0.z, x0.w + g0.w * y0.w};
    *(f32x4*)(o + 4) = f32x4{x1.x + g1.x * y1.x, x1.y + g1.y * y1.y, x1.z + g1.z * y1.z, x1.w + g1.w * y1.w};
  }
}

#define NPHASES 15
DEV int phase_nsub(int ph) {
  if (ph == 0) return 48 + 152;
  const int l = (ph - 1) / 7, s = (ph - 1) % 7;
  switch (s) {
    case 0: return 128 + (l == 0 ? 113 : 32);
    case 1: return 304 + 8 + (l == 0 ? 80 : 0);
    case 2: return 64 + 64 + 64;
    case 3: return 8 + 32 + 32 + 32 + 32 + (l == 0 ? 169 : 0);
    case 4: return 192 + 64;
    case 5: return 128 + (l == 0 ? 96 : 0);
    default: return 64 + (l == 0 ? 48 : 0);
  }
}
DEV void run_task(const Params& p, int ph, int x, int i, char* lds) {
  if (ph == 0) { if (i < 48) mod_task(p, i * 8 + x, lds); else convert_task(p, 0, (i - 48) * 8 + x, lds); return; }
  const int l = (ph - 1) / 7, s = (ph - 1) % 7;
  switch (s) {
    case 0:
      if (i < 128) norm_task(p, l, i * 8 + x);
      else if (l == 0) convert_task(p, 0, 1216 + (i - 128) * 8 + x, lds);
      else convert_task(p, 1, 2504 + (i - 128) * 8 + x, lds);
      break;
    case 1:
      if (i < 304) projA_task(p, l, (i >> 3) * 64 + (i & 7) * 8 + x, lds);
      else if (i < 312) kv_task(p, l, (i - 304) * 72 + 64 + x, lds);
      else convert_task(p, 0, 2120 + (i - 312) * 8 + x, lds);
      break;
    case 2:
      if (i < 64) gdn_prep_task(p, l, i * 8 + x, lds);
      else if (i < 128) { const int j = i - 64; kv_task(p, l, (j >> 3) * 72 + (j & 7) * 8 + x, lds); }
      else { const int j = i - 128; q_task(p, l, (j >> 3) * 64 + (j & 7) * 8 + x, lds); }
      break;
    case 3:
      if (i < 8) gdn_scan_task(p, l, i * 8 + x, lds);
      else if (i < 40) attn_task(p, l, x * 32 + (i - 8), lds);
      else if (i < 72) cmlp_task(p, l, (i - 40) * 8 + x, lds);
      else if (i < 104) gdn_scan_task(p, l, 64 + (i - 72) * 8 + x, lds);
      else if (i < 136) attn_task(p, l, 256 + x * 32 + (i - 104), lds);
      else if (i < 288) convert_task(p, 1, (i - 136) * 8 + x, lds);
      else convert_task(p, 1, 1984 + (i - 288) * 8 + x, lds);
      break;
    case 4:
      if (i < 192) gate_task(p, l, (i >> 3) * 64 + (i & 7) * 8 + x, lds);
      else onorm_task(p, l, (i - 192) * 8 + x);
      break;
    case 5:
      if (i < 128) d1_task(p, l, (i >> 3) * 64 + (i & 7) * 8 + x, lds);
      else convert_task(p, 1, 1216 + (i - 128) * 8 + x, lds);
      break;
    case 6:
      if (i < 64) d2_task(p, l, (i >> 3) * 64 + (i & 7) * 8 + x, lds);
      else convert_task(p, 1, 2120 + (i - 64) * 8 + x, lds);
      break;
  }
}
#ifndef REP_S
#define REP_S -1
#endif
DEV void run_phase(const Params& p, int ph, char* lds, int* sh, int myx, int rep = 0, int rank = 0, int nloc = 0) {
  unsigned* cb = (unsigned*)(p.ws + OFF_CTR) + ph * 128 + rep * 6144;
  const int n = phase_nsub(ph);
  if (nloc > 0) {
#pragma unroll 1
    for (int i = rank; i < n; i += nloc) { __syncthreads(); run_task(p, ph, myx, i, lds); }
    return;
  }
#pragma unroll 1
  for (int xo = 0; xo < 8; xo++) {
    const int x = (myx + xo) & 7;
    unsigned* c = cb + x * 16;
    int i;
    while ((i = next_task(c, sh, n, xo > 0)) < n) run_task(p, ph, x, i, lds);
  }
}

__global__ void __launch_bounds__(256, 2) k_phase(Params p, int ph) {
  __shared__ __attribute__((aligned(16))) char lds[LDS_BYTES];
  __shared__ int sh[4];
  const Params& pr = *(const Params*)__builtin_amdgcn_kernarg_segment_ptr();
  run_phase(pr, ph, lds, sh, (int)(xb_xcc_id() & 7u));
}

__global__ void __launch_bounds__(256, 2) k_mega(Params p) {
  __shared__ __attribute__((aligned(16))) char lds[LDS_BYTES];
  __shared__ __attribute__((aligned(16))) unsigned xbw[4];
  __shared__ int sh[4];
  const Params& pr = *(const Params*)__builtin_amdgcn_kernarg_segment_ptr();
  if (threadIdx.x == 0) { xbw[0] = 0u; xbw[1] = 0u; xbw[2] = 0u; xbw[3] = 0u; }
  __syncthreads();
  XcdBarrier xb = xcd_barrier_post((unsigned*)(pr.ws + OFF_BAR), (volatile LAS unsigned*)xbw);
  const int myx = (int)(xb.x & 7u);
  if (pr.out == nullptr) cg::this_grid().sync();
#pragma unroll
  for (int ph = 0; ph < NPHASES; ph++) {
    {
      const int sub = ph > 0 ? (ph - 1) % 7 : -1;
      const bool uniform = (sub == 0 || sub == 1 || sub == 2 || sub == 4 || sub == 5 || sub == 6);
      int nloc = 0, rank = 0;
      if (ph > 0 && uniform && xbw[1] == 8u) { nloc = (int)xbw[0]; rank = (int)xbw[2]; }
      run_phase(pr, ph, lds, sh, myx, 0, rank, nloc);
    }
    if ((REP_S == 7 && ph == 0) || (REP_S >= 0 && ph > 0 && (ph - 1) % 7 == REP_S && !(REP_S == 6 && ph > 7))) run_phase(pr, ph, lds, sh, myx, 1);
    if (ph + 1 < NPHASES) xcd_barrier(xb);
  }
}

extern "C" void kernel_launch(void* const* d_in, const int* in_sizes, int n_in, void* d_out, int out_size, void* d_ws,
                              size_t ws_size, hipStream_t stream) {
  Params p{};
  for (int i = 0; i < 27; i++) p.in[i] = (const float*)d_in[i];
  p.out = (float*)d_out;
  p.ws = (char*)d_ws;
  if (ws_size < WS_END) { fprintf(stderr, "workspace too small: %zu < %llu\n", ws_size, (unsigned long long)WS_END); return; }
  (void)hipMemsetAsync(d_ws, 0, 32768, stream);
#if COOP
  static int grid_blocks = 0;
  if (!grid_blocks) {
    int dev = 0, cus = 0, per_cu = 0;
    hipGetDevice(&dev);
    hipDeviceGetAttribute(&cus, hipDeviceAttributeMultiprocessorCount, dev);
    hipOccupancyMaxActiveBlocksPerMultiprocessor(&per_cu, k_mega, 256, 0);
    if (per_cu > 2) per_cu = 2;
    if (per_cu < 1) per_cu = 1;
    grid_blocks = cus * per_cu;
  }
  void* args[] = {&p};
  hipError_t e = hipLaunchCooperativeKernel((void*)k_mega, dim3(grid_blocks), dim3(256), args, 0, stream);
  if (e != hipSuccess) fprintf(stderr, "cooperative launch failed: %s (grid %d)\n", hipGetErrorString(e), grid_blocks);
#else
  for (int ph = 0; ph < NPHASES; ph++) k_phase<<<512, 256, 0, stream>>>(p, ph);
#endif
}
```

```cpp
#include <hip/hip_runtime.h>
#include <hip/hip_cooperative_groups.h>
#include <stdint.h>
#include <stdio.h>
namespace cg = cooperative_groups;

#ifndef COOP
#define COOP 1
#endif

typedef unsigned short bf16_t;
typedef __attribute__((ext_vector_type(8))) short bf16x8;
typedef __attribute__((ext_vector_type(4))) float f32x4;
typedef __attribute__((ext_vector_type(4))) unsigned int u32x4;
typedef __attribute__((ext_vector_type(2))) unsigned int u32x2;
#define DEV __device__ __forceinline__

#define NTOK 8192
#define DM 1024
#define DIN 7856
#define EPSF 1e-6f
#define P1W 2208
#define P3W 1024
#define P2W 1536
#define BRW 1536
#define REC_EL 36864

#define OFF_CTR  0ull
#define OFF_BAR  8192ull
#define OFF_MOD  32768ull
#define OFF_GAB  (OFF_MOD + 122880ull)
#define OFF_EGL  (OFF_GAB + 524288ull)
#define OFF_WTA  (OFF_EGL + 4096ull)
#define OFF_WGL  (OFF_WTA + 9961472ull)
#define OFF_WUQ  (OFF_WGL + 6291456ull)
#define OFF_WUKV (OFF_WUQ + 589824ull)
#define OFF_WBR  (OFF_WUKV + 524288ull)
#define OFF_WO   (OFF_WBR + 3145728ull)
#define OFF_H    (OFF_WO + 2097152ull)
#define OFF_P1   (OFF_H + 16777216ull)
#define OFF_ODIR OFF_P1
#define OFF_P3   (OFF_P1 + 36175872ull)
#define OFF_M    OFF_P3
#define OFF_P2   (OFF_P1 + 52953088ull)
#define OFF_GDN  (OFF_P2 + 25165824ull)
#define OFF_Q    (OFF_GDN + 75497472ull)
#define OFF_K    (OFF_Q + 12582912ull)
#define OFF_VT   (OFF_K + 14155776ull)
#define OFF_BR   (OFF_VT + 9437184ull)
#define WS_END   (OFF_BR + 25165824ull)
#define VT_LAT_EL 2097152

#define OUT_CKV   8388608
#define OUT_KROPE 10485760
#define OUT_STATE 10747904

#define LDS_BYTES 75776
#define LDS_SMALL 73728

struct Params {
  const float* in[27];
  float* out;
  char* ws;
};
enum { I_XP = 0, I_XS, I_CCKV, I_CKR, I_SGDN, I_C, I_CCTX, I_NORMG, I_WMOD, I_BMOD, I_WIN, I_QAN, I_WUQ, I_KVAN, I_WUKV,
       I_QN, I_KN, I_CONVW, I_ALOG, I_DTB, I_ONORM, I_LNG, I_LNB, I_WS, I_BS, I_WBR, I_WO };

DEV float bf2f(bf16_t b) { return __uint_as_float(((unsigned)b) << 16); }
typedef __bf16 hwbf2 __attribute__((ext_vector_type(2)));
typedef float hwf2 __attribute__((ext_vector_type(2)));
DEV unsigned pack2(float a, float b) { hwf2 v = {a, b}; return __builtin_bit_cast(unsigned, __builtin_convertvector(v, hwbf2)); }
DEV bf16_t f2bf(float f) { return (bf16_t)(pack2(f, 0.f) & 0xffffu); }
DEV void unpack8(u32x4 v, float* f) {
  f[0] = __uint_as_float(v.x << 16); f[1] = __uint_as_float(v.x & 0xffff0000u);
  f[2] = __uint_as_float(v.y << 16); f[3] = __uint_as_float(v.y & 0xffff0000u);
  f[4] = __uint_as_float(v.z << 16); f[5] = __uint_as_float(v.z & 0xffff0000u);
  f[6] = __uint_as_float(v.w << 16); f[7] = __uint_as_float(v.w & 0xffff0000u);
}
DEV void unpack4(u32x2 v, float* f) {
  f[0] = __uint_as_float(v.x << 16); f[1] = __uint_as_float(v.x & 0xffff0000u);
  f[2] = __uint_as_float(v.y << 16); f[3] = __uint_as_float(v.y & 0xffff0000u);
}
DEV u32x4 pack8(const float* f) {
  u32x4 v; v.x = pack2(f[0], f[1]); v.y = pack2(f[2], f[3]); v.z = pack2(f[4], f[5]); v.w = pack2(f[6], f[7]); return v;
}
DEV u32x2 pack4(float a, float b, float c, float d) { u32x2 v; v.x = pack2(a, b); v.y = pack2(c, d); return v; }
DEV bf16x8 as_frag(u32x4 v) { union { u32x4 u; bf16x8 b; } x; x.u = v; return x.b; }
DEV bf16x8 frag_from(f32x4 a, f32x4 b) {
  u32x4 v; v.x = pack2(a[0], a[1]); v.y = pack2(a[2], a[3]); v.z = pack2(b[0], b[1]); v.w = pack2(b[2], b[3]); return as_frag(v);
}
DEV bf16x8 ld2(const bf16_t* p) {
  u32x2 a = *(const u32x2*)p; u32x2 b = *(const u32x2*)(p + 16);
  u32x4 v; v.x = a.x; v.y = a.y; v.z = b.x; v.w = b.y; return as_frag(v);
}
DEV float frcp(float x) { return __builtin_amdgcn_rcpf(x); }
DEV float siluf(float x) { return x * frcp(1.f + __expf(-x)); }
DEV float sigmf(float x) { return frcp(1.f + __expf(-x)); }
DEV float geluf(float x) { float u = 0.7978845608028654f * (x + 0.044715f * x * x * x); return x * frcp(1.f + __expf(-2.f * u)); }
#define MFMA(a, b, c) __builtin_amdgcn_mfma_f32_16x16x32_bf16((a), (b), (c), 0, 0, 0)

DEV int otid() { int t = threadIdx.x; asm volatile("" : "+v"(t)); return t; }
DEV int next_task(unsigned* ctr, int* sh, int n, bool precheck) {
  __syncthreads();
  if (threadIdx.x == 0) {
    int v = n;
    if (!precheck || (int)__hip_atomic_load(ctr, __ATOMIC_RELAXED, __HIP_MEMORY_SCOPE_AGENT) < n) v = (int)atomicAdd(ctr, 1u);
    *sh = v;
  }
  __syncthreads();
  return *sh;
}

#define XB_TMO      128
#define XB_XCNT(j)  (256  + 64 * (j))
#define XB_XSUB(j)  (1280 + 64 * (j))
#define XB_XGEN(j)  (2304 + 64 * (j))
#define XB_TOP      3328
#define XB_TOPGEN   3392
#define XCD_BAR_WORDS 3456
#define XB_SPIN_CAP (1u << 22)
#define LAS __attribute__((address_space(3)))
DEV unsigned xb_ld(unsigned* p) { return __hip_atomic_load(p, __ATOMIC_RELAXED, __HIP_MEMORY_SCOPE_AGENT); }
DEV unsigned xb_add(unsigned* p, unsigned v) { return __hip_atomic_fetch_add(p, v, __ATOMIC_RELAXED, __HIP_MEMORY_SCOPE_AGENT); }
DEV unsigned xb_xcc_id() { return (unsigned)__builtin_amdgcn_s_getreg((3 << 11) | 20) & 0xFu; }
#define XB_SPIN(cond, bar) do { unsigned _sp = 0; while (cond) { __builtin_amdgcn_s_sleep(1); \
    if ((++_sp & 255u) == 0u) { if (xb_ld(&(bar)[XB_TMO])) break; if (_sp > XB_SPIN_CAP) { atomicAdd(&(bar)[XB_TMO], 1u); break; } } } } while (0)
struct XcdBarrier { unsigned* bar; unsigned x; volatile LAS unsigned* st; };
DEV XcdBarrier xcd_barrier_post(unsigned* bar, volatile LAS unsigned* st) {
  XcdBarrier b; b.bar = bar; b.x = xb_xcc_id(); b.st = st;
  if (threadIdx.x == 0) st[2] = xb_add(&bar[XB_XCNT(b.x)], 1u);
  return b;
}
DEV void xcd_barrier_complete(unsigned* bar, unsigned x, unsigned& nloc, unsigned& nx) {
  const unsigned G = gridDim.x * gridDim.y * gridDim.z;
  unsigned sum, cnt, mine, sp = 0u;
  for (;;) {
    sum = 0u; cnt = 0u; mine = 0u;
#pragma unroll
    for (unsigned j = 0; j < 16; ++j) { const unsigned c = xb_ld(&bar[XB_XCNT(j)]); sum += c; cnt += (c > 0u) ? 1u : 0u; mine = (j == x) ? c : mine; }
    if (sum == G) break;
    __builtin_amdgcn_s_sleep(1);
    if ((++sp & 255u) == 0u) { if (xb_ld(&bar[XB_TMO])) break; if (sp > XB_SPIN_CAP) { atomicAdd(&bar[XB_TMO], 1u); break; } }
  }
  nloc = mine > 0u ? mine : 1u; nx = cnt > 0u ? cnt : 1u;
}
DEV void xcd_barrier(const XcdBarrier& b) {
  asm volatile("s_waitcnt vmcnt(0)" ::: "memory");
  __syncthreads();
  if (threadIdx.x == 0) {
    unsigned* bar = b.bar;
    __builtin_amdgcn_s_waitcnt(0);
    unsigned nloc = b.st[0], nx = b.st[1];
    if (nloc == 0u) { xcd_barrier_complete(bar, b.x, nloc, nx); b.st[0] = nloc; b.st[1] = nx; }
    const unsigned old = xb_add(&bar[XB_XSUB(b.x)], 1u);
    const unsigned gen = old / nloc;
    if (old + 1u == (gen + 1u) * nloc) {
      __builtin_amdgcn_fence(__ATOMIC_RELEASE, "agent");
      asm volatile("s_waitcnt vmcnt(0)" ::: "memory");
      const unsigned og = xb_add(&bar[XB_TOP], 1u);
      const unsigned tg = og / nx;
      if (og + 1u == (tg + 1u) * nx) xb_add(&bar[XB_TOPGEN], 1u);
      else XB_SPIN(xb_ld(&bar[XB_TOPGEN]) == tg, bar);
      __builtin_amdgcn_fence(__ATOMIC_ACQUIRE, "agent");
      xb_add(&bar[XB_XGEN(b.x)], 1u);
      asm volatile("s_waitcnt vmcnt(0)" ::: "memory");
    } else {
      XB_SPIN(xb_ld(&bar[XB_XGEN(b.x)]) == gen, bar);
      __builtin_amdgcn_fence(__ATOMIC_ACQUIRE, "agent");
      asm volatile("s_waitcnt vmcnt(0)" ::: "memory");
    }
  }
  __syncthreads();
}

DEV const float* xrow_ptr(const Params& p, int l, int row) {
  if (l == 0) return row < 4096 ? p.in[I_XP] + (size_t)row * DM : p.in[I_XS] + (size_t)(row - 4096) * DM;
  return p.out + (size_t)row * DM;
}
DEV int modrow(int row) { return row < 4096 ? 0 : 1 + ((row - 4096) >> 10); }

struct ALPlain {
  const bf16_t* base; int ld;
  DEV u32x4 operator()(int row, int k) const { return *(const u32x4*)(base + (size_t)row * ld + k); }
};
struct ALScaled {
  const bf16_t* base; int ld; const float* rs; const float* g;
  DEV u32x4 operator()(int row, int k) const {
    u32x4 v = *(const u32x4*)(base + (size_t)row * ld + k);
    float f[8]; unpack8(v, f);
    const float r = rs[row];
    const f32x4 g0 = *(const f32x4*)(g + k), g1 = *(const f32x4*)(g + k + 4);
    f[0] *= r * g0.x; f[1] *= r * g0.y; f[2] *= r * g0.z; f[3] *= r * g0.w;
    f[4] *= r * g1.x; f[5] *= r * g1.y; f[6] *= r * g1.z; f[7] *= r * g1.w;
    return pack8(f);
  }
};
struct ALF32 {
  const float* base; int ld;
  DEV u32x4 operator()(int row, int k) const {
    const f32x4 a = *(const f32x4*)(base + (size_t)row * ld + k);
    const f32x4 b = *(const f32x4*)(base + (size_t)row * ld + k + 4);
    u32x4 v; v.x = pack2(a.x, a.y); v.y = pack2(a.z, a.w); v.z = pack2(b.x, b.y); v.w = pack2(b.z, b.w); return v;
  }
};

template <int TN>
DEV void gemm_compute(const bf16_t* As, const bf16_t* Bs, f32x4 (&acc)[4][TN / 32], int wm, int wn, int l16, int quad) {
  constexpr int NF = TN / 32;
#pragma unroll
  for (int ks = 0; ks < 2; ks++) {
    bf16x8 a[4], b[NF];
#pragma unroll
    for (int mi = 0; mi < 4; mi++) a[mi] = *(const bf16x8*)(As + (wm * 64 + mi * 16 + l16) * 72 + ks * 32 + quad * 8);
#pragma unroll
    for (int ni = 0; ni < NF; ni++) b[ni] = *(const bf16x8*)(Bs + (wn * (TN / 2) + ni * 16 + l16) * 72 + ks * 32 + quad * 8);
#pragma unroll
    for (int mi = 0; mi < 4; mi++)
#pragma unroll
      for (int ni = 0; ni < NF; ni++) acc[mi][ni] = MFMA(a[mi], b[ni], acc[mi][ni]);
  }
}
template <int TN, class AL>
DEV void gemm_core(const AL& al, const bf16_t* __restrict__ Bt, int ldb, int K, f32x4 (&acc)[4][TN / 32], char* lds) {
  constexpr int BUF = (128 + TN) * 72;
  constexpr int NF = TN / 32;
  bf16_t* L0 = (bf16_t*)lds;
  bf16_t* L1 = L0 + BUF;
  const int tid = otid(), lane = tid & 63, wave = tid >> 6;
  const int wm = wave >> 1, wn = wave & 1, l16 = lane & 15, quad = lane >> 4;
  u32x4 a0[4], b0[NF], a1[4], b1[NF];
#define G_LOAD(RA, RB, KK) { _Pragma("unroll") for (int i = 0; i < 4; i++) { int it = tid + 256 * i; RA[i] = al(it >> 3, (KK) + (it & 7) * 8); } \
                             _Pragma("unroll") for (int i = 0; i < NF; i++) { int it = tid + 256 * i; RB[i] = *(const u32x4*)(Bt + (size_t)(it >> 3) * ldb + (KK) + (it & 7) * 8); } }
#define G_STORE(LB, RA, RB) { _Pragma("unroll") for (int i = 0; i < 4; i++) { int it = tid + 256 * i; *(u32x4*)((LB) + (it >> 3) * 72 + (it & 7) * 8) = RA[i]; } \
                              _Pragma("unroll") for (int i = 0; i < NF; i++) { int it = tid + 256 * i; *(u32x4*)((LB) + 128 * 72 + (it >> 3) * 72 + (it & 7) * 8) = RB[i]; } }
  G_LOAD(a0, b0, 0);
  G_LOAD(a1, b1, 64);
  __syncthreads();
  G_STORE(L0, a0, b0);
  __syncthreads();
  for (int k0 = 0; k0 + 128 < K; k0 += 128) {
    G_LOAD(a0, b0, k0 + 128);
    __builtin_amdgcn_sched_barrier(0);
    gemm_compute<TN>(L0, L0 + 128 * 72, acc, wm, wn, l16, quad);
    G_STORE(L1, a1, b1);
    __syncthreads();
    G_LOAD(a1, b1, k0 + 192);
    __builtin_amdgcn_sched_barrier(0);
    gemm_compute<TN>(L1, L1 + 128 * 72, acc, wm, wn, l16, quad);
    G_STORE(L0, a0, b0);
    __syncthreads();
  }
  gemm_compute<TN>(L0, L0 + 128 * 72, acc, wm, wn, l16, quad);
  G_STORE(L1, a1, b1);
  __syncthreads();
  gemm_compute<TN>(L1, L1 + 128 * 72, acc, wm, wn, l16, quad);
#undef G_LOAD
#undef G_STORE
}

template <int TN>
DEV void acc_to_lds(f32x4 (&acc)[4][TN / 32], float* Cs) {
  const int tid = otid(), lane = tid & 63, wave = tid >> 6;
  const int wm = wave >> 1, wn = wave & 1, l16 = lane & 15, quad = lane >> 4;
  __syncthreads();
#pragma unroll
  for (int mi = 0; mi < 4; mi++)
#pragma unroll
    for (int ni = 0; ni < TN / 32; ni++)
#pragma unroll
      for (int j = 0; j < 4; j++)
        Cs[(wm * 64 + mi * 16 + quad * 4 + j) * (TN + 4) + wn * (TN / 2) + ni * 16 + l16] = acc[mi][ni][j];
  __syncthreads();
}
template <int NF>
DEV void zero_acc(f32x4 (&acc)[4][NF]) {
#pragma unroll
  for (int mi = 0; mi < 4; mi++)
#pragma unroll
    for (int ni = 0; ni < NF; ni++) acc[mi][ni] = f32x4{0.f, 0.f, 0.f, 0.f};
}

DEV void transpose_tile(const float* __restrict__ src, int ld, int col0, int ncols, int K, bf16_t* dst, int nt, int kt, float* tile) {
  const int tid = otid();
  const int n = tid & 63, kk = tid >> 6, gn = nt * 64 + n;
#pragma unroll
  for (int i = 0; i < 16; i++) {
    int k = kk + 4 * i;
    float v = (gn < ncols) ? src[(size_t)(kt * 64 + k) * ld + col0 + gn] : 0.f;
    tile[k * 65 + n] = v;
  }
  __syncthreads();
#pragma unroll
  for (int i = 0; i < 2; i++) {
    int it = tid + 256 * i, nn = it >> 3, kg = it & 7;
    float f[8];
#pragma unroll
    for (int j = 0; j < 8; j++) f[j] = tile[(kg * 8 + j) * 65 + nn];
    *(u32x4*)(dst + (size_t)(nt * 64 + nn) * K + kt * 64 + kg * 8) = pack8(f);
  }
}
#define NCONV_TASKS 2760
DEV void convert_task(const Params& p, int l, int t, char* lds) {
  char* ws_ = p.ws; asm volatile("" : "+s"(ws_));
  float* tile = (float*)lds;
  char* ws = ws_;
  if (t < 1216) { transpose_tile(p.in[I_WIN] + (size_t)l * 1024 * DIN, DIN, 0, 4784, 1024, (bf16_t*)(ws + OFF_WTA), t % 76, t / 76, tile); return; }
  t -= 1216;
  if (t < 768) { transpose_tile(p.in[I_WIN] + (size_t)l * 1024 * DIN, DIN, 4784, 3072, 1024, (bf16_t*)(ws + OFF_WGL), t % 48, t / 48, tile); return; }
  t -= 768;
  if (t < 72) { transpose_tile(p.in[I_WUQ] + (size_t)l * 384 * 768, 768, 0, 768, 384, (bf16_t*)(ws + OFF_WUQ), t % 12, t / 12, tile); return; }
  t -= 72;
  if (t < 64) { transpose_tile(p.in[I_WUKV] + (size_t)l * 256 * 1024, 1024, 0, 1024, 256, (bf16_t*)(ws + OFF_WUKV), t % 16, t / 16, tile); return; }
  t -= 64;
  if (t < 384) {
    int n = t / 128, tt = t % 128;
    transpose_tile(p.in[I_WBR] + (size_t)(l * 3 + n) * 512 * 1024, 1024, 0, 1024, 512, (bf16_t*)(ws + OFF_WBR) + (size_t)n * 1024 * 512, tt % 16, tt / 16, tile);
    return;
  }
  t -= 384;
  transpose_tile(p.in[I_WO] + (size_t)l * 1024 * 1024, 1024, 0, 1024, 1024, (bf16_t*)(ws + OFF_WO), t % 16, t / 16, tile);
}
DEV void mod_task(const Params& p, int t, char* lds) {
  char* ws_ = p.ws; asm volatile("" : "+s"(ws_));
  const int tid = otid();
  const int l = t / 192, n0 = (t % 192) * 16;
  float* s = (float*)lds;
  float* red = (float*)(lds + 32768);
  for (int idx = tid; idx < 5120; idx += 256) {
    int r = idx >> 10, k = idx & 1023;
    float v = (r == 0) ? p.in[I_CCTX][k] : p.in[I_C][(r - 1) * 1024 + k];
    s[idx] = v * frcp(1.f + __expf(-v));
  }
  __syncthreads();
  const int col = tid & 15, ksl = tid >> 4;
  float acc[5] = {0.f, 0.f, 0.f, 0.f, 0.f};
  const float* w = p.in[I_WMOD] + (size_t)l * 1024 * 3072 + n0 + col;
#pragma unroll 16
  for (int k = ksl * 64; k < ksl * 64 + 64; k++) {
    float wv = w[(size_t)k * 3072];
#pragma unroll
    for (int r = 0; r < 5; r++) acc[r] += s[r * 1024 + k] * wv;
  }
#pragma unroll
  for (int r = 0; r < 5; r++) red[(ksl * 5 + r) * 16 + col] = acc[r];
  __syncthreads();
  float* mod = (float*)(ws_ + OFF_MOD);
  if (tid < 80) {
    int r = tid >> 4, c = tid & 15;
    float v = p.in[I_BMOD][l * 3072 + n0 + c];
#pragma unroll
    for (int q = 0; q < 16; q++) v += red[(q * 5 + r) * 16 + c];
    mod[(l * 5 + r) * 3072 + n0 + c] = v;
  }
}

DEV void norm_task(const Params& p, int l, int t) {
  char* ws_ = p.ws; asm volatile("" : "+s"(ws_));
  const int tid = otid(), lane = tid & 63, wave = tid >> 6;
  const float* mod = (const float*)(ws_ + OFF_MOD);
  bf16_t* H = (bf16_t*)(ws_ + OFF_H);
#pragma unroll
  for (int rr = 0; rr < 2; rr++) {
    const int row = t * 8 + wave * 2 + rr;
    const float* x = xrow_ptr(p, l, row);
    const float* mr = mod + (size_t)(l * 5 + modrow(row)) * 3072;
    f32x4 v[4];
    float ss = 0.f;
#pragma unroll
    for (int i = 0; i < 4; i++) { v[i] = *(const f32x4*)(x + lane * 4 + 256 * i); ss += v[i].x * v[i].x + v[i].y * v[i].y + v[i].z * v[i].z + v[i].w * v[i].w; }
#pragma unroll
    for (int o = 32; o >= 1; o >>= 1) ss += __shfl_xor(ss, o);
    const float rstd = __builtin_amdgcn_rsqf(ss * (1.f / 1024.f) + EPSF);
#pragma unroll
    for (int i = 0; i < 4; i++) {
      const int col = lane * 4 + 256 * i;
      const f32x4 g = *(const f32x4*)(p.in[I_NORMG] + l * 1024 + col);
      const f32x4 sh = *(const f32x4*)(mr + col);
      const f32x4 sc = *(const f32x4*)(mr + 1024 + col);
      float a = v[i].x * rstd * g.x * (1.f + sc.x) + sh.x;
      float b = v[i].y * rstd * g.y * (1.f + sc.y) + sh.y;
      float c = v[i].z * rstd * g.z * (1.f + sc.z) + sh.z;
      float d = v[i].w * rstd * g.w * (1.f + sc.w) + sh.w;
      *(u32x2*)(H + (size_t)row * 1024 + col) = pack4(a, b, c, d);
    }
  }
}

DEV void projA_task(const Params& p, int l, int t, char* lds) {
  char* ws_ = p.ws; asm volatile("" : "+s"(ws_));
  const int tid = otid();
  const int nt = t / 64, mt = t % 64;
  f32x4 acc[4][4]; zero_acc<4>(acc);
  ALPlain al{(const bf16_t*)(ws_ + OFF_H) + (size_t)mt * 128 * 1024, 1024};
  gemm_core<128>(al, (const bf16_t*)(ws_ + OFF_WTA) + (size_t)nt * 128 * 1024, 1024, 1024, acc, lds);
  float* Cs = (float*)lds;
  acc_to_lds<128>(acc, Cs);
  bf16_t* P1 = (bf16_t*)(ws_ + OFF_P1);
  bf16_t* P2 = (bf16_t*)(ws_ + OFF_P2);
  bf16_t* P3 = (bf16_t*)(ws_ + OFF_P3);
  float* GAB = (float*)(ws_ + OFF_GAB);
#pragma unroll
  for (int i = 0; i < 8; i++) {
    const int it = tid + 256 * i, r = it >> 4, c8 = it & 15;
    const int n = nt * 128 + c8 * 8;
    if (n >= 4784) continue;
    const int row = mt * 128 + r;
    float f[8];
    const f32x4 a = *(const f32x4*)(Cs + r * 132 + c8 * 8);
    const f32x4 b = *(const f32x4*)(Cs + r * 132 + c8 * 8 + 4);
    f[0] = a.x; f[1] = a.y; f[2] = a.z; f[3] = a.w; f[4] = b.x; f[5] = b.y; f[6] = b.z; f[7] = b.w;
    if (n >= 2720 && n < 2736) {
      *(f32x4*)(GAB + (size_t)row * 16 + (n - 2720)) = a;
      *(f32x4*)(GAB + (size_t)row * 16 + (n - 2720) + 4) = b;
      continue;
    }
    if (n >= 640 && n < 672 && row < 4096) {
      float* o = p.out + OUT_KROPE + ((size_t)((row >> 8) * 2 + l) * 256 + (row & 255)) * 32 + (n - 640);
      *(f32x4*)o = a; *(f32x4*)(o + 4) = b;
    }
    bf16_t* dst;
    if (n < 672) dst = P1 + (size_t)row * P1W + n;
    else if (n < 1184) dst = P2 + (size_t)row * P2W + (n - 672);
    else if (n < 2720) dst = P1 + (size_t)row * P1W + 672 + (n - 1184);
    else if (n < 3248) dst = P2 + (size_t)row * P2W + 512 + (n - 2736);
    else if (n < 3760) dst = P3 + (size_t)row * P3W + (n - 3248);
    else if (n < 4272) dst = P3 + (size_t)row * P3W + 512 + (n - 3760);
    else dst = P2 + (size_t)row * P2W + 1024 + (n - 4272);
    *(u32x4*)dst = pack8(f);
  }
}

DEV void rope32(float* r, int prow, int pcol) {
  const float inv[8] = {1.f, 0.31622776601683794f, 0.1f, 0.031622776601683794f, 0.01f, 0.0031622776601683794f, 0.001f, 0.00031622776601683794f};
#pragma unroll
  for (int i = 0; i < 8; i++) {
    float a1 = (float)prow * inv[i], a2 = (float)pcol * inv[i];
    float c1 = __cosf(a1), s1 = __sinf(a1), c2 = __cosf(a2), s2 = __sinf(a2);
    float x1 = r[i], x2 = r[8 + i];
    r[i] = x1 * c1 - x2 * s1; r[8 + i] = x1 * s1 + x2 * c1;
    float y1 = r[16 + i], y2 = r[24 + i];
    r[16 + i] = y1 * c2 - y2 * s2; r[24 + i] = y1 * s2 + y2 * c2;
  }
}
DEV void finish_qk(float* v  , int half, const float* normw  , bool do_rope, int pos, float scale, bf16_t* dst  ) {
  float ss = 0.f;
#pragma unroll
  for (int i = 0; i < 48; i++) ss += v[i] * v[i];
  ss += __shfl_xor(ss, 1);
  const float rstd = __builtin_amdgcn_rsqf(ss * (1.f / 96.f) + EPSF);
#pragma unroll
  for (int i = 0; i < 12; i++) {
    const f32x4 w = *(const f32x4*)(normw + half * 48 + i * 4);
    v[i * 4] *= rstd * w.x; v[i * 4 + 1] *= rstd * w.y; v[i * 4 + 2] *= rstd * w.z; v[i * 4 + 3] *= rstd * w.w;
  }
  if (do_rope && half == 1) rope32(v + 16, pos >> 6, pos & 63);
#pragma unroll
  for (int i = 0; i < 6; i++) {
    float f[8];
#pragma unroll
    for (int j = 0; j < 8; j++) f[j] = v[i * 8 + j] * scale;
    *(u32x4*)(dst + half * 48 + i * 8) = pack8(f);
  }
}

#define QSCALE 0.14724306f
DEV void q_task(const Params& p, int l, int t, char* lds) {
  char* ws_ = p.ws; asm volatile("" : "+s"(ws_));
  const int tid = otid();
  const int mt = t & 63, h = t >> 6;
  const bf16_t* P1 = (const bf16_t*)(ws_ + OFF_P1);
  float* rs = (float*)(lds + LDS_SMALL);
  {
    const int row = tid >> 1, half = tid & 1;
    const bf16_t* src = P1 + (size_t)(mt * 128 + row) * P1W + half * 192;
    float ss = 0.f;
#pragma unroll 12
    for (int i = 0; i < 24; i++) { float f[8]; unpack8(*(const u32x4*)(src + i * 8), f);
#pragma unroll
      for (int j = 0; j < 8; j++) ss += f[j] * f[j]; }
    ss += __shfl_xor(ss, 1);
    if (!half) rs[row] = __builtin_amdgcn_rsqf(ss * (1.f / 384.f) + EPSF);
  }
  __syncthreads();
  f32x4 acc[4][3]; zero_acc<3>(acc);
  ALScaled al{P1 + (size_t)mt * 128 * P1W, P1W, rs, p.in[I_QAN] + l * 384};
  gemm_core<96>(al, (const bf16_t*)(ws_ + OFF_WUQ) + (size_t)h * 96 * 384, 384, 384, acc, lds);
  float* Cs = (float*)lds;
  acc_to_lds<96>(acc, Cs);
  const int row = tid >> 1, half = tid & 1, grow = mt * 128 + row;
  float v[48];
#pragma unroll
  for (int i = 0; i < 48; i++) v[i] = Cs[row * 100 + half * 48 + i];
  finish_qk(v, half, p.in[I_QN] + l * 96, grow >= 4096, (grow - 4096) & 1023, QSCALE,
            (bf16_t*)(ws_ + OFF_Q) + ((size_t)grow * 8 + h) * 96);
}

DEV void kv_task(const Params& p, int l, int t, char* lds) {
  char* ws_ = p.ws; asm volatile("" : "+s"(ws_));
  const int tid = otid();
  const int h = t / 72, mt = t % 72;
  const bf16_t* P1 = (const bf16_t*)(ws_ + OFF_P1);
  float* rs = (float*)(lds + LDS_SMALL);
  f32x4 acc[4][4]; zero_acc<4>(acc);
  const bf16_t* Bt = (const bf16_t*)(ws_ + OFF_WUKV) + (size_t)h * 128 * 256;
  if (mt < 64) {
    {
      const int row = tid >> 1, half = tid & 1;
      const bf16_t* src = P1 + (size_t)(mt * 128 + row) * P1W + 384 + half * 128;
      float ss = 0.f;
#pragma unroll
      for (int i = 0; i < 16; i++) { float f[8]; unpack8(*(const u32x4*)(src + i * 8), f);
#pragma unroll
        for (int j = 0; j < 8; j++) ss += f[j] * f[j]; }
      ss += __shfl_xor(ss, 1);
      if (!half) rs[row] = __builtin_amdgcn_rsqf(ss * (1.f / 256.f) + EPSF);
    }
    __syncthreads();
    if (h == 0 && mt < 32) {
#pragma unroll 8
      for (int it = tid; it < 128 * 32; it += 256) {
        const int r = it >> 5, c8 = it & 31, row = mt * 128 + r;
        float f[8]; unpack8(*(const u32x4*)(P1 + (size_t)row * P1W + 384 + c8 * 8), f);
        const float rr = rs[r];
        const float* g = p.in[I_KVAN] + l * 256 + c8 * 8;
        float* o = p.out + OUT_CKV + ((size_t)((row >> 8) * 2 + l) * 256 + (row & 255)) * 256 + c8 * 8;
        *(f32x4*)o = f32x4{f[0] * rr * g[0], f[1] * rr * g[1], f[2] * rr * g[2], f[3] * rr * g[3]};
        *(f32x4*)(o + 4) = f32x4{f[4] * rr * g[4], f[5] * rr * g[5], f[6] * rr * g[6], f[7] * rr * g[7]};
      }
    }
    ALScaled al{P1 + (size_t)mt * 128 * P1W + 384, P1W, rs, p.in[I_KVAN] + l * 256};
    gemm_core<128>(al, Bt, 256, 256, acc, lds);
  } else {
    const int b = (mt - 64) >> 1, p0 = ((mt - 64) & 1) * 128;
    ALF32 al{p.in[I_CCKV] + ((size_t)(b * 2 + l) * 256 + p0) * 256, 256};
    gemm_core<128>(al, Bt, 256, 256, acc, lds);
  }
  float* Cs = (float*)lds;
  acc_to_lds<128>(acc, Cs);
  {
    const int row = tid >> 1, half = tid & 1;
    float v[48];
    int krow; bool do_rope = false; int pos = 0;
    if (mt < 64) {
      const int grow = mt * 128 + row;
      krow = grow; do_rope = grow >= 4096; pos = (grow - 4096) & 1023;
      if (half == 0) {
#pragma unroll
        for (int i = 0; i < 48; i++) v[i] = Cs[row * 132 + i];
      } else {
#pragma unroll
        for (int i = 0; i < 16; i++) v[i] = Cs[row * 132 + 48 + i];
        const bf16_t* kr = P1 + (size_t)grow * P1W + 640;
#pragma unroll
        for (int i = 0; i < 4; i++) { float f[8]; unpack8(*(const u32x4*)(kr + i * 8), f);
#pragma unroll
          for (int j = 0; j < 8; j++) v[16 + i * 8 + j] = f[j]; }
      }
    } else {
      const int b = (mt - 64) >> 1, pp = ((mt - 64) & 1) * 128 + row;
      krow = 8192 + b * 256 + pp;
      if (half == 0) {
#pragma unroll
        for (int i = 0; i < 48; i++) v[i] = Cs[row * 132 + i];
      } else {
#pragma unroll
        for (int i = 0; i < 16; i++) v[i] = Cs[row * 132 + 48 + i];
        const float* kr = p.in[I_CKR] + ((size_t)(b * 2 + l) * 256 + pp) * 32;
#pragma unroll
        for (int i = 0; i < 8; i++) { const f32x4 w = *(const f32x4*)(kr + i * 4); v[16 + i * 4] = w.x; v[17 + i * 4] = w.y; v[18 + i * 4] = w.z; v[19 + i * 4] = w.w; }
      }
    }
    finish_qk(v, half, p.in[I_KN] + l * 96, do_rope, pos, 1.f, (bf16_t*)(ws_ + OFF_K) + ((size_t)krow * 8 + h) * 96);
  }
  {
    size_t vbase; int Tk, key0;
    if (mt < 32) { const int b = mt >> 1; Tk = 256; key0 = (mt & 1) * 128; vbase = (size_t)(b * 8 + h) * 64 * 256; }
    else if (mt < 64) { const int b = (mt - 32) >> 3; Tk = 1280; key0 = 256 + ((mt - 32) & 7) * 128; vbase = VT_LAT_EL + (size_t)(b * 8 + h) * 64 * 1280; }
    else { const int b = (mt - 64) >> 1; Tk = 1280; key0 = ((mt - 64) & 1) * 128; vbase = VT_LAT_EL + (size_t)(b * 8 + h) * 64 * 1280; }
    bf16_t* Vt = (bf16_t*)(ws_ + OFF_VT) + vbase;
#pragma unroll
    for (int i = 0; i < 4; i++) {
      const int it = tid + 256 * i, dv = it & 63, kg = it >> 6;
      float f[8];
#pragma unroll
      for (int j = 0; j < 8; j++) f[j] = Cs[(kg * 8 + j) * 132 + 64 + dv];
      *(u32x4*)(Vt + (size_t)dv * Tk + key0 + kg * 8) = pack8(f);
    }
  }
}

DEV void conv_pass(const Params& p, int l, int seg, int h, int row0, int sbeg, int send, float* F, bf16_t* Vtile) {
  char* ws_ = p.ws; asm volatile("" : "+s"(ws_));
  const int tid = otid(), c8 = tid & 15, tg = tid >> 4;
  const bf16_t* src = (const bf16_t*)(ws_ + OFF_P1) + 672 + seg * 512 + h * 128 + c8 * 8;
  const float* cwp = p.in[I_CONVW] + (size_t)l * 5 * 1536 + seg * 512 + h * 128 + c8 * 8;
  float cw[5][8];
#pragma unroll
  for (int j = 0; j < 5; j++) {
    const f32x4 a = *(const f32x4*)(cwp + j * 1536), b = *(const f32x4*)(cwp + j * 1536 + 4);
    cw[j][0] = a.x; cw[j][1] = a.y; cw[j][2] = a.z; cw[j][3] = a.w; cw[j][4] = b.x; cw[j][5] = b.y; cw[j][6] = b.z; cw[j][7] = b.w;
  }
  const int t0 = row0 + tg * 4;
  u32x4 raw[8];
#pragma unroll
  for (int r = 0; r < 8; r++) {
    const int row = t0 - 2 + r;
    raw[r] = (row >= sbeg && row < send) ? *(const u32x4*)(src + (size_t)row * P1W) : u32x4{0u, 0u, 0u, 0u};
  }
  float acc[4][8];
#pragma unroll
  for (int tt = 0; tt < 4; tt++)
#pragma unroll
    for (int c = 0; c < 8; c++) acc[tt][c] = 0.f;
#pragma unroll
  for (int r = 0; r < 8; r++) {
    float f[8]; unpack8(raw[r], f);
#pragma unroll
    for (int tt = 0; tt < 4; tt++) {
      const int j = r - tt;
      if (j >= 0 && j < 5) {
#pragma unroll
        for (int c = 0; c < 8; c++) acc[tt][c] += cw[j][c] * f[c];
      }
    }
  }
#pragma unroll
  for (int tt = 0; tt < 4; tt++) {
    float y[8];
#pragma unroll
    for (int c = 0; c < 8; c++) y[c] = siluf(acc[tt][c]);
    if (F) {
#pragma unroll
      for (int c = 0; c < 8; c++) F[(tg * 4 + tt) * 129 + c8 * 8 + c] = y[c];
    } else {
      *(u32x4*)(Vtile + (tg * 4 + tt) * 136 + c8 * 8) = pack8(y);
    }
  }
}
DEV void l2norm_rows(const float* F, bf16_t* T) {
  const int tid = otid(), row = tid >> 2, part = tid & 3;
  float ss = 0.f;
#pragma unroll
  for (int i = 0; i < 32; i++) { float x = F[row * 129 + part * 32 + i]; ss += x * x; }
  ss += __shfl_xor(ss, 1); ss += __shfl_xor(ss, 2);
  const float inv = __builtin_amdgcn_rsqf(ss + EPSF);
#pragma unroll
  for (int i = 0; i < 32; i++) T[row * 136 + part * 32 + i] = f2bf(F[row * 129 + part * 32 + i] * inv);
}
DEV void mm64(const bf16_t* At, const bf16_t* Bt_, float* Out, int wave, int l16, int quad) {
  f32x4 acc[4];
#pragma unroll
  for (int ni = 0; ni < 4; ni++) acc[ni] = f32x4{0.f, 0.f, 0.f, 0.f};
#pragma unroll
  for (int ks = 0; ks < 4; ks++) {
    bf16x8 a = *(const bf16x8*)(At + (wave * 16 + l16) * 136 + ks * 32 + quad * 8);
#pragma unroll
    for (int ni = 0; ni < 4; ni++) {
      bf16x8 b = *(const bf16x8*)(Bt_ + (ni * 16 + l16) * 136 + ks * 32 + quad * 8);
      acc[ni] = MFMA(a, b, acc[ni]);
    }
  }
#pragma unroll
  for (int ni = 0; ni < 4; ni++)
#pragma unroll
    for (int j = 0; j < 4; j++) Out[(wave * 16 + quad * 4 + j) * 65 + ni * 16 + l16] = acc[ni][j];
}
DEV void gdn_prep_task(const Params& p, int l, int t, char* lds) {
  char* ws_ = p.ws; asm volatile("" : "+s"(ws_));
  const int tid = otid(), lane = tid & 63, wave = tid >> 6, l16 = lane & 15, quad = lane >> 4;
  const int chunk = t >> 2, h = t & 3, row0 = chunk * 64;
  int sbeg, send;
  if (row0 < 4096) { sbeg = row0 & ~255; send = sbeg + 256; } else { sbeg = 4096 + ((row0 - 4096) & ~1023); send = sbeg + 1024; }
  bf16_t* Kt = (bf16_t*)lds;
  bf16_t* Qt = Kt + 64 * 136;
  float* F = (float*)(lds + 34816);
  float* G = F;
  float* Pm = (float*)(lds + 34816 + 17408);
  float* Am = Pm;
  float* gcs = (float*)(lds + LDS_SMALL);
  float* betas = gcs + 128;
  const float* GAB = (const float*)(ws_ + OFF_GAB);
  if (tid < 128) {
    const int dir = tid >> 6, ip = tid & 63, tok = dir ? 63 - ip : ip, row = row0 + tok;
    const float ga = GAB[(size_t)row * 16 + dir * 4 + h], gb = GAB[(size_t)row * 16 + 8 + dir * 4 + h];
    const float a = __expf(p.in[I_ALOG][(l * 2 + dir) * 4 + h]);
    const float x = ga + p.in[I_DTB][(l * 2 + dir) * 4 + h];
    const float ex = __expf(fminf(x, 20.f));
    const float sp = x > 20.f ? x : (ex < 0.01f ? ex * (1.f - ex * (0.5f - ex * (1.f / 3.f))) : __logf(1.f + ex));
    float g = -a * sp;
#pragma unroll
    for (int off = 1; off < 64; off <<= 1) { float v = __shfl_up(g, off); if (ip >= off) g += v; }
    gcs[dir * 64 + ip] = g;
    betas[dir * 64 + ip] = frcp(1.f + __expf(-gb));
  }
  conv_pass(p, l, 1, h, row0, sbeg, send, F, nullptr);
  __syncthreads();
  l2norm_rows(F, Kt);
  __syncthreads();
  conv_pass(p, l, 0, h, row0, sbeg, send, F, nullptr);
  __syncthreads();
  l2norm_rows(F, Qt);
  __syncthreads();
  mm64(Qt, Kt, Pm, wave, l16, quad);
  bf16_t* recbase = (bf16_t*)(ws_ + OFF_GDN) + (size_t)(chunk * 4 + h) * 2 * REC_EL;
#pragma unroll 1
  for (int dir = 0; dir < 2; dir++) {
    bf16_t* rec = recbase + (size_t)dir * REC_EL;
    const float* gc = gcs + dir * 64;
    const float gl = gc[63];
#pragma unroll
    for (int i = 0; i < 4; i++) {
      const int it = tid + 256 * i, ip = it >> 4, c8 = it & 15, tok = dir ? 63 - ip : ip;
      const float sc = 0.08838834764831845f * __expf(gc[ip]);
      float f[8]; unpack8(*(const u32x4*)(Qt + tok * 136 + c8 * 8), f);
#pragma unroll
      for (int j = 0; j < 8; j++) f[j] *= sc;
      *(u32x4*)(rec + 8192 + ip * 128 + c8 * 8) = pack8(f);
    }
#pragma unroll
    for (int i = 0; i < 4; i++) {
      const int it = tid + 256 * i, d = it & 127, ig = it >> 7;
      float f[8];
#pragma unroll
      for (int j = 0; j < 8; j++) { const int ip = ig * 8 + j, tok = dir ? 63 - ip : ip; f[j] = bf2f(Kt[tok * 136 + d]) * __expf(gl - gc[ip]); }
      *(u32x4*)(rec + 20480 + d * 64 + ig * 8) = pack8(f);
    }
    if (tid == 0) ((float*)(ws_ + OFF_EGL))[(chunk * 4 + h) * 2 + dir] = __expf(gl);
  }
  __syncthreads();
  conv_pass(p, l, 2, h, row0, sbeg, send, nullptr, Qt);
#pragma unroll 1
  for (int dir = 0; dir < 2; dir++) {
    bf16_t* rec = recbase + (size_t)dir * REC_EL;
    const float* gc = gcs + dir * 64;
#pragma unroll
    for (int i = 0; i < 2; i++) {
      const int it = tid + 256 * i, ip = it >> 3, j8 = it & 7, ti = dir ? 63 - ip : ip;
      float f[8];
#pragma unroll
      for (int j = 0; j < 8; j++) {
        const int jp = j8 * 8 + j, tj = dir ? 63 - jp : jp;
        const float e = __expf(fminf(gc[ip] - gc[jp], 0.f));
        f[j] = (ip >= jp) ? Pm[ti * 65 + tj] * 0.08838834764831845f * e : 0.f;
      }
      *(u32x4*)(rec + 16384 + ip * 64 + j8 * 8) = pack8(f);
    }
  }
  __syncthreads();
  const bf16_t* Vtile = Qt;
  float* T = G;
#pragma unroll 1
  for (int dir = 0; dir < 2; dir++) {
    bf16_t* rec = recbase + (size_t)dir * REC_EL;
    const float* gc = gcs + dir * 64;
    const float* be = betas + dir * 64;
    mm64(Kt, Kt, G, wave, l16, quad);
    __syncthreads();
#pragma unroll 2
    for (int i = 0; i < 16; i++) {
      const int it = tid + 256 * i, ip = it >> 6, jp = it & 63;
      const int ti = dir ? 63 - ip : ip, tj = dir ? 63 - jp : jp;
      const float e = __expf(fminf(gc[ip] - gc[jp], 0.f));
      Am[ip * 68 + jp] = (ip > jp) ? be[ip] * G[ti * 65 + tj] * e : 0.f;
    }
    __syncthreads();
    {
      const int cl = lane >> 2, q = lane & 3, c = wave * 16 + cl;
      float r[16];
#pragma unroll
      for (int m = 0; m < 16; m++) r[m] = (q + 4 * m == c) ? 1.f : 0.f;
#pragma unroll
      for (int j = 0; j < 63; j++) {
        const int mj = j >> 2;
        float t;
        switch (j & 3) {
          case 0: t = __int_as_float(__builtin_amdgcn_update_dpp(0, __float_as_int(r[mj]), 0x00, 0xF, 0xF, true)); break;
          case 1: t = __int_as_float(__builtin_amdgcn_update_dpp(0, __float_as_int(r[mj]), 0x55, 0xF, 0xF, true)); break;
          case 2: t = __int_as_float(__builtin_amdgcn_update_dpp(0, __float_as_int(r[mj]), 0xAA, 0xF, 0xF, true)); break;
          default: t = __int_as_float(__builtin_amdgcn_update_dpp(0, __float_as_int(r[mj]), 0xFF, 0xF, 0xF, true)); break;
        }
#pragma unroll
        for (int m = mj; m < 16; m++) r[m] -= Am[(q + 4 * m) * 68 + j] * t;
        if ((j & 7) == 7) asm volatile("" ::: "memory");
      }
#pragma unroll
      for (int m = 0; m < 16; m++) T[(q + 4 * m) * 68 + c] = r[m];
    }
    __syncthreads();
#pragma unroll 1
    for (int which = 0; which < 2; which++) {
      const bf16_t* srcT = which ? Kt : Vtile;
      f32x4 ac[4][2];
      zero_acc<2>(ac);
#pragma unroll
      for (int ks = 0; ks < 2; ks++) {
        float cs[8];
        unsigned short e[2][8];
#pragma unroll
        for (int s = 0; s < 8; s++) {
          const int j = ks * 32 + quad * 8 + s, tok = dir ? 63 - j : j;
          cs[s] = which ? be[j] * __expf(gc[j]) : be[j];
#pragma unroll
          for (int nf = 0; nf < 2; nf++) e[nf][s] = srcT[tok * 136 + wave * 32 + nf * 16 + l16];
        }
        bf16x8 bfr[2];
#pragma unroll
        for (int nf = 0; nf < 2; nf++) {
          u32x4 v;
          v.x = e[nf][0] | ((unsigned)e[nf][1] << 16); v.y = e[nf][2] | ((unsigned)e[nf][3] << 16);
          v.z = e[nf][4] | ((unsigned)e[nf][5] << 16); v.w = e[nf][6] | ((unsigned)e[nf][7] << 16);
          bfr[nf] = as_frag(v);
        }
#pragma unroll
        for (int mi = 0; mi < 4; mi++) {
          const float* tr = T + (mi * 16 + l16) * 68 + ks * 32 + quad * 8;
          const f32x4 t0 = *(const f32x4*)tr, t1 = *(const f32x4*)(tr + 4);
          const float tv[8] = {t0.x, t0.y, t0.z, t0.w, t1.x, t1.y, t1.z, t1.w};
          float a[8], hi[8], lo[8];
#pragma unroll
          for (int s = 0; s < 8; s++) a[s] = tv[s] * cs[s];
          const u32x4 ph = pack8(a);
          unpack8(ph, hi);
#pragma unroll
          for (int s = 0; s < 8; s++) lo[s] = a[s] - hi[s];
          const bf16x8 fh = as_frag(ph), fl = as_frag(pack8(lo));
#pragma unroll
          for (int nf = 0; nf < 2; nf++) { ac[mi][nf] = MFMA(fh, bfr[nf], ac[mi][nf]); ac[mi][nf] = MFMA(fl, bfr[nf], ac[mi][nf]); }
        }
      }
      int qs = quad, ls = l16;
      asm volatile("" : "+v"(qs), "+v"(ls));
      bf16_t* dst = rec + (which ? 0 : 28672);
      const float sg = which ? -1.f : 1.f;
#pragma unroll
      for (int mi = 0; mi < 4; mi++)
#pragma unroll
        for (int nf = 0; nf < 2; nf++)
#pragma unroll
          for (int j = 0; j < 4; j++) {
            const int ip = mi * 16 + qs * 4 + j, col = wave * 32 + nf * 16 + ls;
            dst[ip * 128 + col] = f2bf(sg * ac[mi][nf][j]);
          }
    }
    __syncthreads();
  }
}

DEV void cmlp_task(const Params& p, int l, int t, char* lds) {
  char* ws_ = p.ws; asm volatile("" : "+s"(ws_));
  const int tid = otid(), lane = tid & 63, wave = tid >> 6, l16 = lane & 15, quad = lane >> 4;
  const int wm = wave >> 1, wn = wave & 1;
  const int c = t >> 2, g = t & 3, r0 = c * 128;
  const bf16_t* P3 = (const bf16_t*)(ws_ + OFF_P3);
  const bf16_t* P2 = (const bf16_t*)(ws_ + OFF_P2);
  bf16_t* BR = (bf16_t*)(ws_ + OFF_BR);
  bf16_t* VnT = (bf16_t*)lds;
  bf16_t* Ws = VnT + 128 * 136;
  float* mu = (float*)(lds + LDS_SMALL);
  float* rstd = mu + 128;
  {
    const int row = tid >> 1, half = tid & 1;
    const bf16_t* src = P3 + (size_t)(r0 + row) * P3W + 512 + half * 256;
    float s = 0.f, ss = 0.f;
#pragma unroll 16
    for (int i = 0; i < 32; i++) { float f[8]; unpack8(*(const u32x4*)(src + i * 8), f);
#pragma unroll
      for (int j = 0; j < 8; j++) { float y = geluf(f[j]); s += y; ss += y * y; } }
    s += __shfl_xor(s, 1); ss += __shfl_xor(ss, 1);
    const float mean = s * (1.f / 512.f), var = fmaxf(ss * (1.f / 512.f) - mean * mean, 0.f);
    if (!half) { mu[row] = mean; rstd[row] = __builtin_amdgcn_rsqf(var + EPSF); }
  }
  __syncthreads();
#pragma unroll
  for (int i = 0; i < 8; i++) {
    const int it = tid + 256 * i, q = it >> 4, c8 = it & 15;
    float f[8]; unpack8(*(const u32x4*)(P3 + (size_t)(r0 + q) * P3W + 512 + g * 128 + c8 * 8), f);
    const float m = mu[q], rs = rstd[q];
#pragma unroll
    for (int j = 0; j < 8; j++) {
      const int cc = c8 * 8 + j;
      const float val = (geluf(f[j]) - m) * rs * p.in[I_LNG][l * 512 + g * 128 + cc] + p.in[I_LNB][l * 512 + g * 128 + cc];
      VnT[cc * 136 + q] = f2bf(val);
    }
  }
#pragma unroll
  for (int i = 0; i < 16; i++) {
    const int it = tid + 256 * i, pp = it >> 5, q4 = it & 31;
    const f32x4 w = *(const f32x4*)(p.in[I_WS] + ((size_t)(l * 4 + g) * 128 + pp) * 128 + q4 * 4);
    *(u32x2*)(Ws + pp * 136 + q4 * 4) = pack4(w.x, w.y, w.z, w.w);
  }
  __syncthreads();
  f32x4 acc[4][4]; zero_acc<4>(acc);
#pragma unroll
  for (int ks = 0; ks < 4; ks++) {
    bf16x8 a[4], b[4];
#pragma unroll
    for (int mi = 0; mi < 4; mi++) a[mi] = *(const bf16x8*)(Ws + (wm * 64 + mi * 16 + l16) * 136 + ks * 32 + quad * 8);
#pragma unroll
    for (int ni = 0; ni < 4; ni++) b[ni] = *(const bf16x8*)(VnT + (wn * 64 + ni * 16 + l16) * 136 + ks * 32 + quad * 8);
#pragma unroll
    for (int mi = 0; mi < 4; mi++)
#pragma unroll
      for (int ni = 0; ni < 4; ni++) acc[mi][ni] = MFMA(a[mi], b[ni], acc[mi][ni]);
  }
  float* Cs = (float*)lds;
  __syncthreads();
#pragma unroll
  for (int mi = 0; mi < 4; mi++)
#pragma unroll
    for (int j = 0; j < 4; j++) {
      const int pp = wm * 64 + mi * 16 + quad * 4 + j;
      const float bias = p.in[I_BS][(l * 4 + g) * 128 + pp];
#pragma unroll
      for (int ni = 0; ni < 4; ni++) Cs[pp * 132 + wn * 64 + ni * 16 + l16] = acc[mi][ni][j] + bias;
    }
  __syncthreads();
  u32x4 uu[8], zz[8];
#pragma unroll
  for (int i = 0; i < 8; i++) {
    const int it = tid + 256 * i, r = it >> 4, c8 = it & 15;
    const size_t row = (size_t)(r0 + r);
    uu[i] = *(const u32x4*)(P3 + row * P3W + g * 128 + c8 * 8);
    zz[i] = *(const u32x4*)(P2 + row * P2W + 1024 + g * 128 + c8 * 8);
  }
#pragma unroll
  for (int i = 0; i < 8; i++) {
    const int it = tid + 256 * i, r = it >> 4, c8 = it & 15;
    float u[8], z[8], o[8];
    unpack8(uu[i], u); unpack8(zz[i], z);
    const f32x4 s0 = *(const f32x4*)(Cs + r * 132 + c8 * 8), s1 = *(const f32x4*)(Cs + r * 132 + c8 * 8 + 4);
    const float sv[8] = {s0.x, s0.y, s0.z, s0.w, s1.x, s1.y, s1.z, s1.w};
#pragma unroll
    for (int j = 0; j < 8; j++) o[j] = geluf(u[j]) * sv[j] * siluf(z[j]);
    *(u32x4*)(BR + (size_t)(r0 + r) * BRW + 1024 + g * 128 + c8 * 8) = pack8(o);
  }
}

DEV void attn_task(const Params& p, int l, int t, char* lds) {
  char* ws_ = p.ws; asm volatile("" : "+s"(ws_));
  const int tid = otid(), lane = tid & 63, wave = tid >> 6, l16 = lane & 15, quad = lane >> 4;
  int b, h, qrow0, nkt, Tk; size_t vtb;
  const bool lat = t < 256;
  if (lat) { b = t >> 6; h = (t >> 3) & 7; const int qb = t & 7; qrow0 = 4096 + b * 1024 + qb * 128; nkt = 20; Tk = 1280; vtb = VT_LAT_EL + (size_t)(b * 8 + h) * 64 * 1280; }
  else { const int tt = t - 256; b = tt >> 4; h = (tt >> 1) & 7; const int qb = tt & 1; qrow0 = b * 256 + qb * 128; nkt = 4; Tk = 256; vtb = (size_t)(b * 8 + h) * 64 * 256; }
  if (lat) __builtin_amdgcn_s_setprio(2);
  const bf16_t* Qg = (const bf16_t*)(ws_ + OFF_Q);
  const bf16_t* Kg = (const bf16_t*)(ws_ + OFF_K);
  const bf16_t* Vg = (const bf16_t*)(ws_ + OFF_VT) + vtb;
  bf16_t* Qs = (bf16_t*)lds;
  bf16_t* Ks = Qs + 128 * 104;
  bf16_t* Vs = Ks + 64 * 104;
#pragma unroll
  for (int i = 0; i < 6; i++) {
    const int it = tid + 256 * i, r = it / 12, cc = it % 12;
    *(u32x4*)(Qs + r * 104 + cc * 8) = *(const u32x4*)(Qg + ((size_t)(qrow0 + r) * 8 + h) * 96 + cc * 8);
  }
  __syncthreads();
  bf16x8 qf[2][3];
#pragma unroll
  for (int ni = 0; ni < 2; ni++)
#pragma unroll
    for (int ks = 0; ks < 3; ks++) qf[ni][ks] = *(const bf16x8*)(Qs + (wave * 32 + ni * 16 + l16) * 104 + ks * 32 + quad * 8);
  f32x4 o[4][2];
#pragma unroll
  for (int di = 0; di < 4; di++) { o[di][0] = f32x4{0.f, 0.f, 0.f, 0.f}; o[di][1] = f32x4{0.f, 0.f, 0.f, 0.f}; }
  float mrun[2] = {-1e30f, -1e30f}, lsum[2] = {0.f, 0.f};
  u32x4 pk[3], pv[2];
  {
    const int krow0 = lat ? (8192 + b * 256) : (b * 256);
#pragma unroll
    for (int i = 0; i < 3; i++) { const int it = tid + 256 * i, r = it / 12, cc = it % 12; pk[i] = *(const u32x4*)(Kg + ((size_t)(krow0 + r) * 8 + h) * 96 + cc * 8); }
#pragma unroll
    for (int i = 0; i < 2; i++) { const int it = tid + 256 * i, dv = it >> 3, kg = it & 7; pv[i] = *(const u32x4*)(Vg + (size_t)dv * Tk + kg * 8); }
  }
  for (int kt = 0; kt < nkt; kt++) {
    __syncthreads();
#pragma unroll
    for (int i = 0; i < 3; i++) { const int it = tid + 256 * i, r = it / 12, cc = it % 12; *(u32x4*)(Ks + r * 104 + cc * 8) = pk[i]; }
#pragma unroll
    for (int i = 0; i < 2; i++) { const int it = tid + 256 * i, dv = it >> 3, kg = it & 7; *(u32x4*)(Vs + dv * 72 + kg * 8) = pv[i]; }
    __syncthreads();
    if (kt + 1 < nkt) {
      const int kn = kt + 1;
      int krow0;
      if (lat) krow0 = (kn < 4) ? (8192 + b * 256 + kn * 64) : (4096 + b * 1024 + (kn - 4) * 64);
      else krow0 = b * 256 + kn * 64;
#pragma unroll
      for (int i = 0; i < 3; i++) { const int it = tid + 256 * i, r = it / 12, cc = it % 12; pk[i] = *(const u32x4*)(Kg + ((size_t)(krow0 + r) * 8 + h) * 96 + cc * 8); }
#pragma unroll
      for (int i = 0; i < 2; i++) { const int it = tid + 256 * i, dv = it >> 3, kg = it & 7; pv[i] = *(const u32x4*)(Vg + (size_t)dv * Tk + kn * 64 + kg * 8); }
    }
    __builtin_amdgcn_sched_barrier(0);
    f32x4 s[4][2];
#pragma unroll
    for (int mi = 0; mi < 4; mi++) { s[mi][0] = f32x4{0.f, 0.f, 0.f, 0.f}; s[mi][1] = f32x4{0.f, 0.f, 0.f, 0.f}; }
#pragma unroll
    for (int ks = 0; ks < 3; ks++)
#pragma unroll
      for (int mi = 0; mi < 4; mi++) {
        bf16x8 kf = *(const bf16x8*)(Ks + (mi * 16 + l16) * 104 + ks * 32 + quad * 8);
        s[mi][0] = MFMA(kf, qf[0][ks], s[mi][0]);
        s[mi][1] = MFMA(kf, qf[1][ks], s[mi][1]);
      }
#pragma unroll
    for (int ni = 0; ni < 2; ni++) {
      float mx = -1e30f;
#pragma unroll
      for (int mi = 0; mi < 4; mi++)
#pragma unroll
        for (int j = 0; j < 4; j++) mx = fmaxf(mx, s[mi][ni][j]);
      mx = fmaxf(mx, __shfl_xor(mx, 16)); mx = fmaxf(mx, __shfl_xor(mx, 32));
      const float mnew = fmaxf(mrun[ni], mx);
      const float alpha = __builtin_amdgcn_exp2f(mrun[ni] - mnew);
      mrun[ni] = mnew;
      float rsum = 0.f;
#pragma unroll
      for (int mi = 0; mi < 4; mi++)
#pragma unroll
        for (int j = 0; j < 4; j++) { float pv = __builtin_amdgcn_exp2f(s[mi][ni][j] - mnew); s[mi][ni][j] = pv; rsum += pv; }
      lsum[ni] = lsum[ni] * alpha + rsum;
#pragma unroll
      for (int di = 0; di < 4; di++) o[di][ni] *= alpha;
    }
#pragma unroll
    for (int g = 0; g < 2; g++) {
      bf16x8 pf0 = frag_from(s[2 * g][0], s[2 * g + 1][0]);
      bf16x8 pf1 = frag_from(s[2 * g][1], s[2 * g + 1][1]);
#pragma unroll
      for (int di = 0; di < 4; di++) {
        bf16x8 vf = ld2(Vs + (di * 16 + l16) * 72 + g * 32 + quad * 4);
        o[di][0] = MFMA(vf, pf0, o[di][0]);
        o[di][1] = MFMA(vf, pf1, o[di][1]);
      }
    }
  }
  const bf16_t* P2 = (const bf16_t*)(ws_ + OFF_P2);
  bf16_t* BR = (bf16_t*)(ws_ + OFF_BR);
#pragma unroll
  for (int ni = 0; ni < 2; ni++) {
    float lt = lsum[ni];
    lt += __shfl_xor(lt, 16); lt += __shfl_xor(lt, 32);
    const float inv = frcp(lt);
    const size_t qrow = (size_t)(qrow0 + wave * 32 + ni * 16 + l16);
#pragma unroll
    for (int di = 0; di < 4; di++) {
      const int col = h * 64 + di * 16 + quad * 4;
      float z[4]; unpack4(*(const u32x2*)(P2 + qrow * P2W + col), z);
      *(u32x2*)(BR + qrow * BRW + col) = pack4(o[di][ni][0] * inv * siluf(z[0]), o[di][ni][1] * inv * siluf(z[1]),
                                               o[di][ni][2] * inv * siluf(z[2]), o[di][ni][3] * inv * siluf(z[3]));
    }
  }
  __builtin_amdgcn_s_setprio(0);
}

struct ScanPf { u32x4 w[4], q[4], a[2], k[4], u[2]; float egl; };
DEV void scan_prefetch(ScanPf& f, const bf16_t* rec, const float* eglp, int half, int tid) {
#pragma unroll
  for (int i = 0; i < 4; i++) { const int c = tid + 256 * i; f.w[i] = *(const u32x4*)(rec + c * 8); f.q[i] = *(const u32x4*)(rec + 8192 + c * 8); f.k[i] = *(const u32x4*)(rec + 20480 + c * 8); }
#pragma unroll
  for (int i = 0; i < 2; i++) { const int c = tid + 256 * i; f.a[i] = *(const u32x4*)(rec + 16384 + c * 8); f.u[i] = *(const u32x4*)(rec + 28672 + (c >> 3) * 128 + half * 64 + (c & 7) * 8); }
  f.egl = *eglp;
}
DEV void gdn_scan_task(const Params& p, int l, int t, char* lds) {
  char* ws_ = p.ws; asm volatile("" : "+s"(ws_));
  const int tid = otid(), lane = tid & 63, wave = tid >> 6, l16 = lane & 15, quad = lane >> 4;
  __builtin_amdgcn_s_setprio(3);
  int chain, half, b, chunk0, N; bool lat = t < 64;
  if (lat) { chain = t >> 1; half = t & 1; } else { chain = (t - 64) >> 1; half = (t - 64) & 1; }
  const int dir = chain & 1, h = (chain >> 1) & 3;
  b = chain >> 3;
  if (lat) { chunk0 = 64 + b * 16; N = 16; } else { chunk0 = b * 4; N = 4; }
  const int e0 = (half * 4 + wave) * 16;
  bf16_t* Wl = (bf16_t*)lds;
  bf16_t* Ql = Wl + 64 * 136;
  bf16_t* Al = Ql + 64 * 136;
  bf16_t* Kl = Al + 64 * 72;
  bf16_t* Ul = Kl + 128 * 72;
  f32x4 S[8];
  if (lat) {
    const float* s0 = p.in[I_SGDN] + ((size_t)((b * 2 + l) * 2 + dir) * 4 + h) * 16384;
#pragma unroll
    for (int mf = 0; mf < 8; mf++)
#pragma unroll
      for (int j = 0; j < 4; j++) S[mf][j] = s0[(mf * 16 + quad * 4 + j) * 128 + e0 + l16];
  } else {
#pragma unroll
    for (int mf = 0; mf < 8; mf++) S[mf] = f32x4{0.f, 0.f, 0.f, 0.f};
  }
  float* OD = (float*)(ws_ + OFF_ODIR) + (size_t)dir * NTOK * 512;
  const float* EGL = (const float*)(ws_ + OFF_EGL);
  const bf16_t* GD = (const bf16_t*)(ws_ + OFF_GDN);
  ScanPf pf;
  {
    const int cidx = chunk0 + (dir ? N - 1 : 0);
    scan_prefetch(pf, GD + ((size_t)(cidx * 4 + h) * 2 + dir) * REC_EL, EGL + (cidx * 4 + h) * 2 + dir, half, tid);
  }
#pragma unroll 1
  for (int n = 0; n < N; n++) {
    const int cidx = chunk0 + (dir ? N - 1 - n : n);
    __syncthreads();
#pragma unroll
    for (int i = 0; i < 4; i++) {
      const int c = tid + 256 * i;
      *(u32x4*)(Wl + (c >> 4) * 136 + (c & 15) * 8) = pf.w[i];
      *(u32x4*)(Ql + (c >> 4) * 136 + (c & 15) * 8) = pf.q[i];
      *(u32x4*)(Kl + (c >> 3) * 72 + (c & 7) * 8) = pf.k[i];
    }
#pragma unroll
    for (int i = 0; i < 2; i++) {
      const int c = tid + 256 * i;
      *(u32x4*)(Al + (c >> 3) * 72 + (c & 7) * 8) = pf.a[i];
      *(u32x4*)(Ul + (c >> 3) * 72 + (c & 7) * 8) = pf.u[i];
    }
    const float egl = pf.egl;
    __syncthreads();
    if (n + 1 < N) {
      const int cn = chunk0 + (dir ? N - 2 - n : n + 1);
      scan_prefetch(pf, GD + ((size_t)(cn * 4 + h) * 2 + dir) * REC_EL, EGL + (cn * 4 + h) * 2 + dir, half, tid);
    }
    __builtin_amdgcn_sched_barrier(0);
    bf16x8 Sb[4];
#pragma unroll
    for (int ks = 0; ks < 4; ks++) Sb[ks] = frag_from(S[2 * ks], S[2 * ks + 1]);
    f32x4 vn[4];
#pragma unroll
    for (int mi = 0; mi < 4; mi++)
#pragma unroll
      for (int j = 0; j < 4; j++) vn[mi][j] = bf2f(Ul[(mi * 16 + quad * 4 + j) * 72 + wave * 16 + l16]);
#pragma unroll
    for (int mi = 0; mi < 4; mi++)
#pragma unroll
      for (int ks = 0; ks < 4; ks++) vn[mi] = MFMA(ld2(Wl + (mi * 16 + l16) * 136 + ks * 32 + quad * 4), Sb[ks], vn[mi]);
    bf16x8 vb[2];
    vb[0] = frag_from(vn[0], vn[1]); vb[1] = frag_from(vn[2], vn[3]);
#pragma unroll
    for (int mi = 0; mi < 4; mi++) {
      f32x4 o = f32x4{0.f, 0.f, 0.f, 0.f};
#pragma unroll
      for (int ks = 0; ks < 4; ks++) o = MFMA(ld2(Ql + (mi * 16 + l16) * 136 + ks * 32 + quad * 4), Sb[ks], o);
#pragma unroll
      for (int k2 = 0; k2 < 2; k2++) o = MFMA(ld2(Al + (mi * 16 + l16) * 72 + k2 * 32 + quad * 4), vb[k2], o);
#pragma unroll
      for (int j = 0; j < 4; j++) {
        const int ip = mi * 16 + quad * 4 + j, tok = dir ? 63 - ip : ip;
        OD[(size_t)(cidx * 64 + tok) * 512 + h * 128 + e0 + l16] = o[j];
      }
    }
#pragma unroll
    for (int mf = 0; mf < 8; mf++) {
      S[mf] *= egl;
#pragma unroll
      for (int k2 = 0; k2 < 2; k2++) S[mf] = MFMA(ld2(Kl + (mf * 16 + l16) * 72 + k2 * 32 + quad * 4), vb[k2], S[mf]);
    }
  }
  if (!lat) {
    float* so = p.out + OUT_STATE + ((size_t)((b * 2 + l) * 2 + dir) * 4 + h) * 16384;
#pragma unroll
    for (int mf = 0; mf < 8; mf++)
#pragma unroll
      for (int j = 0; j < 4; j++) so[(mf * 16 + quad * 4 + j) * 128 + e0 + l16] = S[mf][j];
  }
  __builtin_amdgcn_s_setprio(0);
}

DEV void onorm_task(const Params& p, int l, int t) {
  char* ws_ = p.ws; asm volatile("" : "+s"(ws_));
  const int tid = otid(), lane = tid & 63, wave = tid >> 6;
  const float* OD = (const float*)(ws_ + OFF_ODIR);
  const bf16_t* P2 = (const bf16_t*)(ws_ + OFF_P2);
  bf16_t* BR = (bf16_t*)(ws_ + OFF_BR);
#pragma unroll
  for (int rr = 0; rr < 4; rr++) {
    const size_t row = (size_t)t * 16 + wave * 4 + rr;
    const f32x4 a0 = *(const f32x4*)(OD + row * 512 + lane * 8), a1 = *(const f32x4*)(OD + row * 512 + lane * 8 + 4);
    const f32x4 b0 = *(const f32x4*)(OD + (NTOK + row) * 512 + lane * 8), b1 = *(const f32x4*)(OD + (NTOK + row) * 512 + lane * 8 + 4);
    float x[8] = {a0.x + b0.x, a0.y + b0.y, a0.z + b0.z, a0.w + b0.w, a1.x + b1.x, a1.y + b1.y, a1.z + b1.z, a1.w + b1.w};
    float ss = 0.f;
#pragma unroll
    for (int i = 0; i < 8; i++) ss += x[i] * x[i];
#pragma unroll
    for (int o = 8; o >= 1; o >>= 1) ss += __shfl_xor(ss, o);
    const float rstd = __builtin_amdgcn_rsqf(ss * (1.f / 128.f) + EPSF);
    float z[8]; unpack8(*(const u32x4*)(P2 + row * P2W + 512 + lane * 8), z);
    const float* g = p.in[I_ONORM] + l * 128 + (lane & 15) * 8;
    float y[8];
#pragma unroll
    for (int i = 0; i < 8; i++) y[i] = x[i] * rstd * g[i] * siluf(z[i]);
    *(u32x4*)(BR + row * BRW + 512 + lane * 8) = pack8(y);
  }
}

DEV void gate_task(const Params& p, int l, int t, char* lds) {
  char* ws_ = p.ws; asm volatile("" : "+s"(ws_));
  const int tid = otid();
  const int nt = t / 64, mt = t % 64;
  f32x4 acc[4][4]; zero_acc<4>(acc);
  ALPlain al{(const bf16_t*)(ws_ + OFF_H) + (size_t)mt * 128 * 1024, 1024};
  gemm_core<128>(al, (const bf16_t*)(ws_ + OFF_WGL) + (size_t)nt * 128 * 1024, 1024, 1024, acc, lds);
  float* Cs = (float*)lds;
  acc_to_lds<128>(acc, Cs);
  bf16_t* GT = (bf16_t*)(ws_ + OFF_GDN);
#pragma unroll
  for (int i = 0; i < 8; i++) {
    const int it = tid + 256 * i, r = it >> 4, c8 = it & 15;
    const f32x4 a = *(const f32x4*)(Cs + r * 132 + c8 * 8), b = *(const f32x4*)(Cs + r * 132 + c8 * 8 + 4);
    float f[8] = {sigmf(a.x), sigmf(a.y), sigmf(a.z), sigmf(a.w), sigmf(b.x), sigmf(b.y), sigmf(b.z), sigmf(b.w)};
    *(u32x4*)(GT + (size_t)(mt * 128 + r) * 3072 + nt * 128 + c8 * 8) = pack8(f);
  }
}
DEV void d1_task(const Params& p, int l, int t, char* lds) {
  char* ws_ = p.ws; asm volatile("" : "+s"(ws_));
  const int tid = otid(), lane = tid & 63, wave = tid >> 6, l16 = lane & 15, quad = lane >> 4;
  const int wm = wave >> 1, wn = wave & 1;
  const int nt = t >> 6, mt = t & 63;
  const bf16_t* GT = (const bf16_t*)(ws_ + OFF_GDN);
  f32x4 macc[4][2]; zero_acc<2>(macc);
#pragma unroll 1
  for (int n = 0; n < 3; n++) {
    unsigned short gv[4][2][4];
#pragma unroll
    for (int mi = 0; mi < 4; mi++)
#pragma unroll
      for (int ni = 0; ni < 2; ni++)
#pragma unroll
        for (int j = 0; j < 4; j++)
          gv[mi][ni][j] = GT[(size_t)(mt * 128 + wm * 64 + mi * 16 + quad * 4 + j) * 3072 + n * 1024 + nt * 64 + wn * 32 + ni * 16 + l16];
    f32x4 y[4][2]; zero_acc<2>(y);
    ALPlain alb{(const bf16_t*)(ws_ + OFF_BR) + (size_t)mt * 128 * BRW + n * 512, BRW};
    gemm_core<64>(alb, (const bf16_t*)(ws_ + OFF_WBR) + (size_t)(n * 1024 + nt * 64) * 512, 512, 512, y, lds);
#pragma unroll
    for (int mi = 0; mi < 4; mi++)
#pragma unroll
      for (int ni = 0; ni < 2; ni++)
#pragma unroll
        for (int j = 0; j < 4; j++) macc[mi][ni][j] += bf2f(gv[mi][ni][j]) * y[mi][ni][j];
  }
  float* Cs = (float*)lds;
  acc_to_lds<64>(macc, Cs);
  bf16_t* M = (bf16_t*)(ws_ + OFF_M);
#pragma unroll
  for (int i = 0; i < 4; i++) {
    const int it = tid + 256 * i, r = it >> 3, c8 = it & 7;
    float f[8];
#pragma unroll
    for (int j = 0; j < 8; j++) f[j] = Cs[r * 68 + c8 * 8 + j];
    *(u32x4*)(M + (size_t)(mt * 128 + r) * 1024 + nt * 64 + c8 * 8) = pack8(f);
  }
}

DEV void d2_task(const Params& p, int l, int t, char* lds) {
  char* ws_ = p.ws; asm volatile("" : "+s"(ws_));
  const int tid = otid();
  const int nt = t >> 6, mt = t & 63;
  f32x4 acc[4][4]; zero_acc<4>(acc);
  ALPlain al{(const bf16_t*)(ws_ + OFF_M) + (size_t)mt * 128 * 1024, 1024};
  gemm_core<128>(al, (const bf16_t*)(ws_ + OFF_WO) + (size_t)nt * 128 * 1024, 1024, 1024, acc, lds);
  float* Cs = (float*)lds;
  acc_to_lds<128>(acc, Cs);
  const float* mod = (const float*)(ws_ + OFF_MOD);
#pragma unroll
  for (int i = 0; i < 8; i++) {
    const int it = tid + 256 * i, r = it >> 4, c8 = it & 15;
    const int row = mt * 128 + r, col = nt * 128 + c8 * 8;
    const float* x = xrow_ptr(p, l, row) + col;
    const float* gt = mod + (size_t)(l * 5 + modrow(row)) * 3072 + 2048 + col;
    const f32x4 y0 = *(const f32x4*)(Cs + r * 132 + c8 * 8), y1 = *(const f32x4*)(Cs + r * 132 + c8 * 8 + 4);
    const f32x4 x0 = *(const f32x4*)x, x1 = *(const f32x4*)(x + 4);
    const f32x4 g0 = *(const f32x4*)gt, g1 = *(const f32x4*)(gt + 4);
    float* o = p.out + (size_t)row * DM + col;
    *(f32x4*)o = f32x4{x0.x + g0.x * y0.x, x0.y + g0.y * y0.y, x0.z + g0.z * y0.z, x0.w + g0.w * y0.w};
    *(f32x4*)(o + 4) = f32x4{x1.x + g1.x * y1.x, x1.y + g1.y * y1.y, x1.z + g1.z * y1.z, x1.w + g1.w * y1.w};
  }
}

#define NPHASES 15
DEV int phase_nsub(int ph) {
  if (ph == 0) return 48 + 152;
  const int l = (ph - 1) / 7, s = (ph - 1) % 7;
  switch (s) {
    case 0: return 128 + (l == 0 ? 113 : 0);
    case 1: return 304 + 8 + (l == 0 ? 80 : 0);
    case 2: return 64 + 64 + 64;
    case 3: return 8 + 32 + 32 + 32 + 32 + (l == 0 ? 169 : 176);
    case 4: return 192 + 64;
    case 5: return 128;
    default: return 64;
  }
}
DEV void run_task(const Params& p, int ph, int x, int i, char* lds) {
  if (ph == 0) { if (i < 48) mod_task(p, i * 8 + x, lds); else convert_task(p, 0, (i - 48) * 8 + x, lds); return; }
  const int l = (ph - 1) / 7, s = (ph - 1) % 7;
  switch (s) {
    case 0:
      if (i < 128) norm_task(p, l, i * 8 + x);
      else convert_task(p, 0, 1216 + (i - 128) * 8 + x, lds);
      break;
    case 1:
      if (i < 304) projA_task(p, l, (i >> 3) * 64 + (i & 7) * 8 + x, lds);
      else if (i < 312) kv_task(p, l, (i - 304) * 72 + 64 + x, lds);
      else convert_task(p, 0, 2120 + (i - 312) * 8 + x, lds);
      break;
    case 2:
      if (i < 64) gdn_prep_task(p, l, i * 8 + x, lds);
      else if (i < 128) { const int j = i - 64; kv_task(p, l, (j >> 3) * 72 + (j & 7) * 8 + x, lds); }
      else { const int j = i - 128; q_task(p, l, (j >> 3) * 64 + (j & 7) * 8 + x, lds); }
      break;
    case 3:
      if (i < 8) gdn_scan_task(p, l, i * 8 + x, lds);
      else if (i < 40) attn_task(p, l, x * 32 + (i - 8), lds);
      else if (i < 72) cmlp_task(p, l, (i - 40) * 8 + x, lds);
      else if (i < 104) gdn_scan_task(p, l, 64 + (i - 72) * 8 + x, lds);
      else if (i < 136) attn_task(p, l, 256 + x * 32 + (i - 104), lds);
      else if (l == 1) {
        if (i < 232) convert_task(p, 1, 1216 + (i - 136) * 8 + x, lds);
        else convert_task(p, 1, 2120 + (i - 232) * 8 + x, lds);
      }
      else if (i < 288) convert_task(p, 1, (i - 136) * 8 + x, lds);
      else convert_task(p, 1, 1984 + (i - 288) * 8 + x, lds);
      break;
    case 4:
      if (i < 192) gate_task(p, l, (i >> 3) * 64 + (i & 7) * 8 + x, lds);
      else onorm_task(p, l, (i - 192) * 8 + x);
      break;
    case 5:
      d1_task(p, l, (i >> 3) * 64 + (i & 7) * 8 + x, lds);
      break;
    case 6:
      d2_task(p, l, (i >> 3) * 64 + (i & 7) * 8 + x, lds);
      break;
  }
}
#ifndef REP_S
#define REP_S -1
#endif
DEV void run_phase(const Params& p, int ph, char* lds, int* sh, int myx, int rep = 0, int rank = 0, int nloc = 0) {
  unsigned* cb = (unsigned*)(p.ws + OFF_CTR) + ph * 128 + rep * 6144;
  const int n = phase_nsub(ph);
  if (nloc > 0) {
#pragma unroll 1
    for (int i = rank; i < n; i += nloc) { __syncthreads(); run_task(p, ph, myx, i, lds); }
    return;
  }
#pragma unroll 1
  for (int xo = 0; xo < 8; xo++) {
    const int x = (myx + xo) & 7;
    unsigned* c = cb + x * 16;
    int i;
    while ((i = next_task(c, sh, n, xo > 0)) < n) run_task(p, ph, x, i, lds);
  }
}

__global__ void __launch_bounds__(256, 2) k_phase(Params p, int ph) {
  __shared__ __attribute__((aligned(16))) char lds[LDS_BYTES];
  __shared__ int sh[4];
  const Params& pr = *(const Params*)__builtin_amdgcn_kernarg_segment_ptr();
  run_phase(pr, ph, lds, sh, (int)(xb_xcc_id() & 7u));
}

__global__ void __launch_bounds__(256, 2) k_mega(Params p) {
  __shared__ __attribute__((aligned(16))) char lds[LDS_BYTES];
  __shared__ __attribute__((aligned(16))) unsigned xbw[4];
  __shared__ int sh[4];
  const Params& pr = *(const Params*)__builtin_amdgcn_kernarg_segment_ptr();
  if (threadIdx.x == 0) { xbw[0] = 0u; xbw[1] = 0u; xbw[2] = 0u; xbw[3] = 0u; }
  __syncthreads();
  XcdBarrier xb = xcd_barrier_post((unsigned*)(pr.ws + OFF_BAR), (volatile LAS unsigned*)xbw);
  const int myx = (int)(xb.x & 7u);
  if (pr.out == nullptr) cg::this_grid().sync();
#pragma unroll
  for (int ph = 0; ph < NPHASES; ph++) {
    {
      const int sub = ph > 0 ? (ph - 1) % 7 : -1;
      const bool uniform = (sub == 0 || sub == 1 || sub == 2 || sub == 4 || sub == 5 || sub == 6);
      int nloc = 0, rank = 0;
      if (ph > 0 && uniform && xbw[1] == 8u) { nloc = (int)xbw[0]; rank = (int)xbw[2]; }
      run_phase(pr, ph, lds, sh, myx, 0, rank, nloc);
    }
    if ((REP_S == 7 && ph == 0) || (REP_S >= 0 && ph > 0 && (ph - 1) % 7 == REP_S && !(REP_S == 6 && ph > 7))) run_phase(pr, ph, lds, sh, myx, 1);
    if (ph + 1 < NPHASES) xcd_barrier(xb);
  }
}

extern "C" void kernel_launch(void* const* d_in, const int* in_sizes, int n_in, void* d_out, int out_size, void* d_ws,
                              size_t ws_size, hipStream_t stream) {
  Params p{};
  for (int i = 0; i < 27; i++) p.in[i] = (const float*)d_in[i];
  p.out = (float*)d_out;
  p.ws = (char*)d_ws;
  if (ws_size < WS_END) { fprintf(stderr, "workspace too small: %zu < %llu\n", ws_size, (unsigned long long)WS_END); return; }
  (void)hipMemsetAsync(d_ws, 0, 32768, stream);
#if COOP
  static int grid_blocks = 0;
  if (!grid_blocks) {
    int dev = 0, cus = 0, per_cu = 0;
    hipGetDevice(&dev);
    hipDeviceGetAttribute(&cus, hipDeviceAttributeMultiprocessorCount, dev);
    hipOccupancyMaxActiveBlocksPerMultiprocessor(&per_cu, k_mega, 256, 0);
    if (per_cu > 2) per_cu = 2;
    if (per_cu < 1) per_cu = 1;
    grid_blocks = cus * per_cu;
  }
  void* args[] = {&p};
  hipError_t e = hipLaunchCooperativeKernel((void*)k_mega, dim3(grid_blocks), dim3(256), args, 0, stream);
  if (e != hipSuccess) fprintf(stderr, "cooperative launch failed: %s (grid %d)\n", hipGetErrorString(e), grid_blocks);
#else
  for (int ph = 0; ph < NPHASES; ph++) k_phase<<<512, 256, 0, stream>>>(p, ph);
#endif
}
```

```cpp
#include <hip/hip_runtime.h>
#include <hip/hip_cooperative_groups.h>
#include <stdint.h>
#include <stdio.h>
namespace cg = cooperative_groups;

#ifndef COOP
#define COOP 1
#endif

typedef unsigned short bf16_t;
typedef __attribute__((ext_vector_type(8))) short bf16x8;
typedef __attribute__((ext_vector_type(4))) float f32x4;
typedef __attribute__((ext_vector_type(4))) unsigned int u32x4;
typedef __attribute__((ext_vector_type(2))) unsigned int u32x2;
#define DEV __device__ __forceinline__

#define NTOK 8192
#define DM 1024
#define DIN 7856
#define EPSF 1e-6f
#define P1W 2208
#define P3W 1024
#define P2W 1536
#define BRW 1536
#define REC_EL 36864

#define OFF_CTR  0ull
#define OFF_BAR  8192ull
#define OFF_MOD  32768ull
#define OFF_GAB  (OFF_MOD + 122880ull)
#define OFF_EGL  (OFF_GAB + 524288ull)
#define OFF_WTA  (OFF_EGL + 4096ull)
#define OFF_WGL  (OFF_WTA + 9961472ull)
#define OFF_WUQ  (OFF_WGL + 6291456ull)
#define OFF_WUKV (OFF_WUQ + 589824ull)
#define OFF_WBR  (OFF_WUKV + 524288ull)
#define OFF_WO   (OFF_WBR + 3145728ull)
#define OFF_H    (OFF_WO + 2097152ull)
#define OFF_P1   (OFF_H + 16777216ull)
#define OFF_ODIR OFF_P1
#define OFF_P3   (OFF_P1 + 36175872ull)
#define OFF_M    OFF_P3
#define OFF_P2   (OFF_P1 + 52953088ull)
#define OFF_GDN  (OFF_P2 + 25165824ull)
#define OFF_Q    (OFF_GDN + 75497472ull)
#define OFF_K    (OFF_Q + 12582912ull)
#define OFF_VT   (OFF_K + 14155776ull)
#define OFF_BR   (OFF_VT + 9437184ull)
#define WS_END   (OFF_BR + 25165824ull)
#define VT_LAT_EL 2097152

#define OUT_CKV   8388608
#define OUT_KROPE 10485760
#define OUT_STATE 10747904

#define LDS_BYTES 75776
#define LDS_SMALL 73728

struct Params {
  const float* in[27];
  float* out;
  char* ws;
};
enum { I_XP = 0, I_XS, I_CCKV, I_CKR, I_SGDN, I_C, I_CCTX, I_NORMG, I_WMOD, I_BMOD, I_WIN, I_QAN, I_WUQ, I_KVAN, I_WUKV,
       I_QN, I_KN, I_CONVW, I_ALOG, I_DTB, I_ONORM, I_LNG, I_LNB, I_WS, I_BS, I_WBR, I_WO };

DEV float bf2f(bf16_t b) { return __uint_as_float(((unsigned)b) << 16); }
typedef __bf16 hwbf2 __attribute__((ext_vector_type(2)));
typedef float hwf2 __attribute__((ext_vector_type(2)));
DEV unsigned pack2(float a, float b) { hwf2 v = {a, b}; return __builtin_bit_cast(unsigned, __builtin_convertvector(v, hwbf2)); }
DEV bf16_t f2bf(float f) { return (bf16_t)(pack2(f, 0.f) & 0xffffu); }
DEV void unpack8(u32x4 v, float* f) {
  f[0] = __uint_as_float(v.x << 16); f[1] = __uint_as_float(v.x & 0xffff0000u);
  f[2] = __uint_as_float(v.y << 16); f[3] = __uint_as_float(v.y & 0xffff0000u);
  f[4] = __uint_as_float(v.z << 16); f[5] = __uint_as_float(v.z & 0xffff0000u);
  f[6] = __uint_as_float(v.w << 16); f[7] = __uint_as_float(v.w & 0xffff0000u);
}
DEV void unpack4(u32x2 v, float* f) {
  f[0] = __uint_as_float(v.x << 16); f[1] = __uint_as_float(v.x & 0xffff0000u);
  f[2] = __uint_as_float(v.y << 16); f[3] = __uint_as_float(v.y & 0xffff0000u);
}
DEV u32x4 pack8(const float* f) {
  u32x4 v; v.x = pack2(f[0], f[1]); v.y = pack2(f[2], f[3]); v.z = pack2(f[4], f[5]); v.w = pack2(f[6], f[7]); return v;
}
DEV u32x2 pack4(float a, float b, float c, float d) { u32x2 v; v.x = pack2(a, b); v.y = pack2(c, d); return v; }
DEV bf16x8 as_frag(u32x4 v) { union { u32x4 u; bf16x8 b; } x; x.u = v; return x.b; }
DEV bf16x8 frag_from(f32x4 a, f32x4 b) {
  u32x4 v; v.x = pack2(a[0], a[1]); v.y = pack2(a[2], a[3]); v.z = pack2(b[0], b[1]); v.w = pack2(b[2], b[3]); return as_frag(v);
}
DEV bf16x8 ld2(const bf16_t* p) {
  u32x2 a = *(const u32x2*)p; u32x2 b = *(const u32x2*)(p + 16);
  u32x4 v; v.x = a.x; v.y = a.y; v.z = b.x; v.w = b.y; return as_frag(v);
}
DEV float frcp(float x) { return __builtin_amdgcn_rcpf(x); }
DEV float siluf(float x) { return x * frcp(1.f + __expf(-x)); }
DEV float sigmf(float x) { return frcp(1.f + __expf(-x)); }
DEV float geluf(float x) { float u = 0.7978845608028654f * (x + 0.044715f * x * x * x); return x * frcp(1.f + __expf(-2.f * u)); }
#define MFMA(a, b, c) __builtin_amdgcn_mfma_f32_16x16x32_bf16((a), (b), (c), 0, 0, 0)

DEV int otid() { int t = threadIdx.x; asm volatile("" : "+v"(t)); return t; }
DEV int next_task(unsigned* ctr, int* sh, int n, bool precheck) {
  __syncthreads();
  if (threadIdx.x == 0) {
    int v = n;
    if (!precheck || (int)__hip_atomic_load(ctr, __ATOMIC_RELAXED, __HIP_MEMORY_SCOPE_AGENT) < n) v = (int)atomicAdd(ctr, 1u);
    *sh = v;
  }
  __syncthreads();
  return *sh;
}

#define XB_TMO      128
#define XB_XCNT(j)  (256  + 64 * (j))
#define XB_XSUB(j)  (1280 + 64 * (j))
#define XB_XGEN(j)  (2304 + 64 * (j))
#define XB_TOP      3328
#define XB_TOPGEN   3392
#define XCD_BAR_WORDS 3456
#define XB_SPIN_CAP (1u << 22)
#define LAS __attribute__((address_space(3)))
DEV unsigned xb_ld(unsigned* p) { return __hip_atomic_load(p, __ATOMIC_RELAXED, __HIP_MEMORY_SCOPE_AGENT); }
DEV unsigned xb_add(unsigned* p, unsigned v) { return __hip_atomic_fetch_add(p, v, __ATOMIC_RELAXED, __HIP_MEMORY_SCOPE_AGENT); }
DEV unsigned xb_xcc_id() { return (unsigned)__builtin_amdgcn_s_getreg((3 << 11) | 20) & 0xFu; }
#define XB_SPIN(cond, bar) do { unsigned _sp = 0; while (cond) { __builtin_amdgcn_s_sleep(1); \
    if ((++_sp & 255u) == 0u) { if (xb_ld(&(bar)[XB_TMO])) break; if (_sp > XB_SPIN_CAP) { atomicAdd(&(bar)[XB_TMO], 1u); break; } } } } while (0)
struct XcdBarrier { unsigned* bar; unsigned x; volatile LAS unsigned* st; };
DEV XcdBarrier xcd_barrier_post(unsigned* bar, volatile LAS unsigned* st) {
  XcdBarrier b; b.bar = bar; b.x = xb_xcc_id(); b.st = st;
  if (threadIdx.x == 0) st[2] = xb_add(&bar[XB_XCNT(b.x)], 1u);
  return b;
}
DEV void xcd_barrier_complete(unsigned* bar, unsigned x, unsigned& nloc, unsigned& nx) {
  const unsigned G = gridDim.x * gridDim.y * gridDim.z;
  unsigned sum, cnt, mine, sp = 0u;
  for (;;) {
    sum = 0u; cnt = 0u; mine = 0u;
#pragma unroll
    for (unsigned j = 0; j < 16; ++j) { const unsigned c = xb_ld(&bar[XB_XCNT(j)]); sum += c; cnt += (c > 0u) ? 1u : 0u; mine = (j == x) ? c : mine; }
    if (sum == G) break;
    __builtin_amdgcn_s_sleep(1);
    if ((++sp & 255u) == 0u) { if (xb_ld(&bar[XB_TMO])) break; if (sp > XB_SPIN_CAP) { atomicAdd(&bar[XB_TMO], 1u); break; } }
  }
  nloc = mine > 0u ? mine : 1u; nx = cnt > 0u ? cnt : 1u;
}
DEV void xcd_barrier(const XcdBarrier& b) {
  asm volatile("s_waitcnt vmcnt(0)" ::: "memory");
  __syncthreads();
  if (threadIdx.x == 0) {
    unsigned* bar = b.bar;
    __builtin_amdgcn_s_waitcnt(0);
    unsigned nloc = b.st[0], nx = b.st[1];
    if (nloc == 0u) { xcd_barrier_complete(bar, b.x, nloc, nx); b.st[0] = nloc; b.st[1] = nx; }
    const unsigned old = xb_add(&bar[XB_XSUB(b.x)], 1u);
    const unsigned gen = old / nloc;
    if (old + 1u == (gen + 1u) * nloc) {
      __builtin_amdgcn_fence(__ATOMIC_RELEASE, "agent");
      asm volatile("s_waitcnt vmcnt(0)" ::: "memory");
      const unsigned og = xb_add(&bar[XB_TOP], 1u);
      const unsigned tg = og / nx;
      if (og + 1u == (tg + 1u) * nx) xb_add(&bar[XB_TOPGEN], 1u);
      else XB_SPIN(xb_ld(&bar[XB_TOPGEN]) == tg, bar);
      __builtin_amdgcn_fence(__ATOMIC_ACQUIRE, "agent");
      xb_add(&bar[XB_XGEN(b.x)], 1u);
      asm volatile("s_waitcnt vmcnt(0)" ::: "memory");
    } else {
      XB_SPIN(xb_ld(&bar[XB_XGEN(b.x)]) == gen, bar);
      __builtin_amdgcn_fence(__ATOMIC_ACQUIRE, "agent");
      asm volatile("s_waitcnt vmcnt(0)" ::: "memory");
    }
  }
  __syncthreads();
}

DEV const float* xrow_ptr(const Params& p, int l, int row) {
  if (l == 0) return row < 4096 ? p.in[I_XP] + (size_t)row * DM : p.in[I_XS] + (size_t)(row - 4096) * DM;
  return p.out + (size_t)row * DM;
}
DEV int modrow(int row) { return row < 4096 ? 0 : 1 + ((row - 4096) >> 10); }

struct ALPlain {
  const bf16_t* base; int ld;
  DEV u32x4 operator()(int row, int k) const { return *(const u32x4*)(base + (size_t)row * ld + k); }
};
struct ALScaled {
  const bf16_t* base; int ld; const float* rs; const float* g;
  DEV u32x4 operator()(int row, int k) const {
    u32x4 v = *(const u32x4*)(base + (size_t)row * ld + k);
    float f[8]; unpack8(v, f);
    const float r = rs[row];
    const f32x4 g0 = *(const f32x4*)(g + k), g1 = *(const f32x4*)(g + k + 4);
    f[0] *= r * g0.x; f[1] *= r * g0.y; f[2] *= r * g0.z; f[3] *= r * g0.w;
    f[4] *= r * g1.x; f[5] *= r * g1.y; f[6] *= r * g1.z; f[7] *= r * g1.w;
    return pack8(f);
  }
};
struct ALF32 {
  const float* base; int ld;
  DEV u32x4 operator()(int row, int k) const {
    const f32x4 a = *(const f32x4*)(base + (size_t)row * ld + k);
    const f32x4 b = *(const f32x4*)(base + (size_t)row * ld + k + 4);
    u32x4 v; v.x = pack2(a.x, a.y); v.y = pack2(a.z, a.w); v.z = pack2(b.x, b.y); v.w = pack2(b.z, b.w); return v;
  }
};

template <int TN>
DEV void gemm_compute(const bf16_t* As, const bf16_t* Bs, f32x4 (&acc)[4][TN / 32], int wm, int wn, int l16, int quad) {
  constexpr int NF = TN / 32;
#pragma unroll
  for (int ks = 0; ks < 2; ks++) {
    bf16x8 a[4], b[NF];
#pragma unroll
    for (int mi = 0; mi < 4; mi++) a[mi] = *(const bf16x8*)(As + (wm * 64 + mi * 16 + l16) * 72 + ks * 32 + quad * 8);
#pragma unroll
    for (int ni = 0; ni < NF; ni++) b[ni] = *(const bf16x8*)(Bs + (wn * (TN / 2) + ni * 16 + l16) * 72 + ks * 32 + quad * 8);
#pragma unroll
    for (int mi = 0; mi < 4; mi++)
#pragma unroll
      for (int ni = 0; ni < NF; ni++) acc[mi][ni] = MFMA(a[mi], b[ni], acc[mi][ni]);
  }
}
template <int TN, class AL>
DEV void gemm_core(const AL& al, const bf16_t* __restrict__ Bt, int ldb, int K, f32x4 (&acc)[4][TN / 32], char* lds) {
  constexpr int BUF = (128 + TN) * 72;
  constexpr int NF = TN / 32;
  bf16_t* L0 = (bf16_t*)lds;
  bf16_t* L1 = L0 + BUF;
  const int tid = otid(), lane = tid & 63, wave = tid >> 6;
  const int wm = wave >> 1, wn = wave & 1, l16 = lane & 15, quad = lane >> 4;
  u32x4 a0[4], b0[NF], a1[4], b1[NF];
#define G_LOAD(RA, RB, KK) { _Pragma("unroll") for (int i = 0; i < 4; i++) { int it = tid + 256 * i; RA[i] = al(it >> 3, (KK) + (it & 7) * 8); } \
                             _Pragma("unroll") for (int i = 0; i < NF; i++) { int it = tid + 256 * i; RB[i] = *(const u32x4*)(Bt + (size_t)(it >> 3) * ldb + (KK) + (it & 7) * 8); } }
#define G_STORE(LB, RA, RB) { _Pragma("unroll") for (int i = 0; i < 4; i++) { int it = tid + 256 * i; *(u32x4*)((LB) + (it >> 3) * 72 + (it & 7) * 8) = RA[i]; } \
                              _Pragma("unroll") for (int i = 0; i < NF; i++) { int it = tid + 256 * i; *(u32x4*)((LB) + 128 * 72 + (it >> 3) * 72 + (it & 7) * 8) = RB[i]; } }
  G_LOAD(a0, b0, 0);
  G_LOAD(a1, b1, 64);
  __syncthreads();
  G_STORE(L0, a0, b0);
  __syncthreads();
  for (int k0 = 0; k0 + 128 < K; k0 += 128) {
    G_LOAD(a0, b0, k0 + 128);
    __builtin_amdgcn_sched_barrier(0);
    gemm_compute<TN>(L0, L0 + 128 * 72, acc, wm, wn, l16, quad);
    G_STORE(L1, a1, b1);
    __syncthreads();
    G_LOAD(a1, b1, k0 + 192);
    __builtin_amdgcn_sched_barrier(0);
    gemm_compute<TN>(L1, L1 + 128 * 72, acc, wm, wn, l16, quad);
    G_STORE(L0, a0, b0);
    __syncthreads();
  }
  gemm_compute<TN>(L0, L0 + 128 * 72, acc, wm, wn, l16, quad);
  G_STORE(L1, a1, b1);
  __syncthreads();
  gemm_compute<TN>(L1, L1 + 128 * 72, acc, wm, wn, l16, quad);
#undef G_LOAD
#undef G_STORE
}

template <int TN>
DEV void acc_to_lds(f32x4 (&acc)[4][TN / 32], float* Cs) {
  const int tid = otid(), lane = tid & 63, wave = tid >> 6;
  const int wm = wave >> 1, wn = wave & 1, l16 = lane & 15, quad = lane >> 4;
  __syncthreads();
#pragma unroll
  for (int mi = 0; mi < 4; mi++)
#pragma unroll
    for (int ni = 0; ni < TN / 32; ni++)
#pragma unroll
      for (int j = 0; j < 4; j++)
        Cs[(wm * 64 + mi * 16 + quad * 4 + j) * (TN + 4) + wn * (TN / 2) + ni * 16 + l16] = acc[mi][ni][j];
  __syncthreads();
}
template <int NF>
DEV void zero_acc(f32x4 (&acc)[4][NF]) {
#pragma unroll
  for (int mi = 0; mi < 4; mi++)
#pragma unroll
    for (int ni = 0; ni < NF; ni++) acc[mi][ni] = f32x4{0.f, 0.f, 0.f, 0.f};
}

DEV void transpose_tile(const float* __restrict__ src, int ld, int col0, int ncols, int K, bf16_t* dst, int nt, int kt, float* tile) {
  const int tid = otid();
  const int n = tid & 63, kk = tid >> 6, gn = nt * 64 + n;
#pragma unroll
  for (int i = 0; i < 16; i++) {
    int k = kk + 4 * i;
    float v = (gn < ncols) ? src[(size_t)(kt * 64 + k) * ld + col0 + gn] : 0.f;
    tile[k * 65 + n] = v;
  }
  __syncthreads();
#pragma unroll
  for (int i = 0; i < 2; i++) {
    int it = tid + 256 * i, nn = it >> 3, kg = it & 7;
    float f[8];
#pragma unroll
    for (int j = 0; j < 8; j++) f[j] = tile[(kg * 8 + j) * 65 + nn];
    *(u32x4*)(dst + (size_t)(nt * 64 + nn) * K + kt * 64 + kg * 8) = pack8(f);
  }
}
#define NCONV_TASKS 2760
DEV void convert_task(const Params& p, int l, int t, char* lds) {
  char* ws_ = p.ws; asm volatile("" : "+s"(ws_));
  float* tile = (float*)lds;
  char* ws = ws_;
  if (t < 1216) { transpose_tile(p.in[I_WIN] + (size_t)l * 1024 * DIN, DIN, 0, 4784, 1024, (bf16_t*)(ws + OFF_WTA), t % 76, t / 76, tile); return; }
  t -= 1216;
  if (t < 768) { transpose_tile(p.in[I_WIN] + (size_t)l * 1024 * DIN, DIN, 4784, 3072, 1024, (bf16_t*)(ws + OFF_WGL), t % 48, t / 48, tile); return; }
  t -= 768;
  if (t < 72) { transpose_tile(p.in[I_WUQ] + (size_t)l * 384 * 768, 768, 0, 768, 384, (bf16_t*)(ws + OFF_WUQ), t % 12, t / 12, tile); return; }
  t -= 72;
  if (t < 64) { transpose_tile(p.in[I_WUKV] + (size_t)l * 256 * 1024, 1024, 0, 1024, 256, (bf16_t*)(ws + OFF_WUKV), t % 16, t / 16, tile); return; }
  t -= 64;
  if (t < 384) {
    int n = t / 128, tt = t % 128;
    transpose_tile(p.in[I_WBR] + (size_t)(l * 3 + n) * 512 * 1024, 1024, 0, 1024, 512, (bf16_t*)(ws + OFF_WBR) + (size_t)n * 1024 * 512, tt % 16, tt / 16, tile);
    return;
  }
  t -= 384;
  transpose_tile(p.in[I_WO] + (size_t)l * 1024 * 1024, 1024, 0, 1024, 1024, (bf16_t*)(ws + OFF_WO), t % 16, t / 16, tile);
}
DEV void mod_task(const Params& p, int t, char* lds) {
  char* ws_ = p.ws; asm volatile("" : "+s"(ws_));
  const int tid = otid();
  const int l = t / 192, n0 = (t % 192) * 16;
  float* s = (float*)lds;
  float* red = (float*)(lds + 32768);
  for (int idx = tid; idx < 5120; idx += 256) {
    int r = idx >> 10, k = idx & 1023;
    float v = (r == 0) ? p.in[I_CCTX][k] : p.in[I_C][(r - 1) * 1024 + k];
    s[idx] = v * frcp(1.f + __expf(-v));
  }
  __syncthreads();
  const int col = tid & 15, ksl = tid >> 4;
  float acc[5] = {0.f, 0.f, 0.f, 0.f, 0.f};
  const float* w = p.in[I_WMOD] + (size_t)l * 1024 * 3072 + n0 + col;
#pragma unroll 16
  for (int k = ksl * 64; k < ksl * 64 + 64; k++) {
    float wv = w[(size_t)k * 3072];
#pragma unroll
    for (int r = 0; r < 5; r++) acc[r] += s[r * 1024 + k] * wv;
  }
#pragma unroll
  for (int r = 0; r < 5; r++) red[(ksl * 5 + r) * 16 + col] = acc[r];
  __syncthreads();
  float* mod = (float*)(ws_ + OFF_MOD);
  if (tid < 80) {
    int r = tid >> 4, c = tid & 15;
    float v = p.in[I_BMOD][l * 3072 + n0 + c];
#pragma unroll
    for (int q = 0; q < 16; q++) v += red[(q * 5 + r) * 16 + c];
    mod[(l * 5 + r) * 3072 + n0 + c] = v;
  }
}

DEV void norm_task(const Params& p, int l, int t) {
  char* ws_ = p.ws; asm volatile("" : "+s"(ws_));
  const int tid = otid(), lane = tid & 63, wave = tid >> 6;
  const float* mod = (const float*)(ws_ + OFF_MOD);
  bf16_t* H = (bf16_t*)(ws_ + OFF_H);
#pragma unroll
  for (int rr = 0; rr < 2; rr++) {
    const int row = t * 8 + wave * 2 + rr;
    const float* x = xrow_ptr(p, l, row);
    const float* mr = mod + (size_t)(l * 5 + modrow(row)) * 3072;
    f32x4 v[4];
    float ss = 0.f;
#pragma unroll
    for (int i = 0; i < 4; i++) { v[i] = *(const f32x4*)(x + lane * 4 + 256 * i); ss += v[i].x * v[i].x + v[i].y * v[i].y + v[i].z * v[i].z + v[i].w * v[i].w; }
#pragma unroll
    for (int o = 32; o >= 1; o >>= 1) ss += __shfl_xor(ss, o);
    const float rstd = __builtin_amdgcn_rsqf(ss * (1.f / 1024.f) + EPSF);
#pragma unroll
    for (int i = 0; i < 4; i++) {
      const int col = lane * 4 + 256 * i;
      const f32x4 g = *(const f32x4*)(p.in[I_NORMG] + l * 1024 + col);
      const f32x4 sh = *(const f32x4*)(mr + col);
      const f32x4 sc = *(const f32x4*)(mr + 1024 + col);
      float a = v[i].x * rstd * g.x * (1.f + sc.x) + sh.x;
      float b = v[i].y * rstd * g.y * (1.f + sc.y) + sh.y;
      float c = v[i].z * rstd * g.z * (1.f + sc.z) + sh.z;
      float d = v[i].w * rstd * g.w * (1.f + sc.w) + sh.w;
      *(u32x2*)(H + (size_t)row * 1024 + col) = pack4(a, b, c, d);
    }
  }
}

DEV void projA_task(const Params& p, int l, int t, char* lds) {
  char* ws_ = p.ws; asm volatile("" : "+s"(ws_));
  const int tid = otid();
  const int nt = t / 64, mt = t % 64;
  f32x4 acc[4][4]; zero_acc<4>(acc);
  ALPlain al{(const bf16_t*)(ws_ + OFF_H) + (size_t)mt * 128 * 1024, 1024};
  gemm_core<128>(al, (const bf16_t*)(ws_ + OFF_WTA) + (size_t)nt * 128 * 1024, 1024, 1024, acc, lds);
  float* Cs = (float*)lds;
  acc_to_lds<128>(acc, Cs);
  bf16_t* P1 = (bf16_t*)(ws_ + OFF_P1);
  bf16_t* P2 = (bf16_t*)(ws_ + OFF_P2);
  bf16_t* P3 = (bf16_t*)(ws_ + OFF_P3);
  float* GAB = (float*)(ws_ + OFF_GAB);
#pragma unroll
  for (int i = 0; i < 8; i++) {
    const int it = tid + 256 * i, r = it >> 4, c8 = it & 15;
    const int n = nt * 128 + c8 * 8;
    if (n >= 4784) continue;
    const int row = mt * 128 + r;
    float f[8];
    const f32x4 a = *(const f32x4*)(Cs + r * 132 + c8 * 8);
    const f32x4 b = *(const f32x4*)(Cs + r * 132 + c8 * 8 + 4);
    f[0] = a.x; f[1] = a.y; f[2] = a.z; f[3] = a.w; f[4] = b.x; f[5] = b.y; f[6] = b.z; f[7] = b.w;
    if (n >= 2720 && n < 2736) {
      *(f32x4*)(GAB + (size_t)row * 16 + (n - 2720)) = a;
      *(f32x4*)(GAB + (size_t)row * 16 + (n - 2720) + 4) = b;
      continue;
    }
    if (n >= 640 && n < 672 && row < 4096) {
      float* o = p.out + OUT_KROPE + ((size_t)((row >> 8) * 2 + l) * 256 + (row & 255)) * 32 + (n - 640);
      *(f32x4*)o = a; *(f32x4*)(o + 4) = b;
    }
    bf16_t* dst;
    if (n < 672) dst = P1 + (size_t)row * P1W + n;
    else if (n < 1184) dst = P2 + (size_t)row * P2W + (n - 672);
    else if (n < 2720) dst = P1 + (size_t)row * P1W + 672 + (n - 1184);
    else if (n < 3248) dst = P2 + (size_t)row * P2W + 512 + (n - 2736);
    else if (n < 3760) dst = P3 + (size_t)row * P3W + (n - 3248);
    else if (n < 4272) dst = P3 + (size_t)row * P3W + 512 + (n - 3760);
    else dst = P2 + (size_t)row * P2W + 1024 + (n - 4272);
    *(u32x4*)dst = pack8(f);
  }
}

DEV void rope32(float* r, int prow, int pcol) {
  const float inv[8] = {1.f, 0.31622776601683794f, 0.1f, 0.031622776601683794f, 0.01f, 0.0031622776601683794f, 0.001f, 0.00031622776601683794f};
#pragma unroll
  for (int i = 0; i < 8; i++) {
    float a1 = (float)prow * inv[i], a2 = (float)pcol * inv[i];
    float c1 = __cosf(a1), s1 = __sinf(a1), c2 = __cosf(a2), s2 = __sinf(a2);
    float x1 = r[i], x2 = r[8 + i];
    r[i] = x1 * c1 - x2 * s1; r[8 + i] = x1 * s1 + x2 * c1;
    float y1 = r[16 + i], y2 = r[24 + i];
    r[16 + i] = y1 * c2 - y2 * s2; r[24 + i] = y1 * s2 + y2 * c2;
  }
}
DEV void finish_qk(float* v  , int half, const float* normw  , bool do_rope, int pos, float scale, bf16_t* dst  ) {
  float ss = 0.f;
#pragma unroll
  for (int i = 0; i < 48; i++) ss += v[i] * v[i];
  ss += __shfl_xor(ss, 1);
  const float rstd = __builtin_amdgcn_rsqf(ss * (1.f / 96.f) + EPSF);
#pragma unroll
  for (int i = 0; i < 12; i++) {
    const f32x4 w = *(const f32x4*)(normw + half * 48 + i * 4);
    v[i * 4] *= rstd * w.x; v[i * 4 + 1] *= rstd * w.y; v[i * 4 + 2] *= rstd * w.z; v[i * 4 + 3] *= rstd * w.w;
  }
  if (do_rope && half == 1) rope32(v + 16, pos >> 6, pos & 63);
#pragma unroll
  for (int i = 0; i < 6; i++) {
    float f[8];
#pragma unroll
    for (int j = 0; j < 8; j++) f[j] = v[i * 8 + j] * scale;
    *(u32x4*)(dst + half * 48 + i * 8) = pack8(f);
  }
}

#define QSCALE 0.14724306f
DEV void q_task(const Params& p, int l, int t, char* lds) {
  char* ws_ = p.ws; asm volatile("" : "+s"(ws_));
  const int tid = otid();
  const int mt = t & 63, h = t >> 6;
  const bf16_t* P1 = (const bf16_t*)(ws_ + OFF_P1);
  float* rs = (float*)(lds + LDS_SMALL);
  {
    const int row = tid >> 1, half = tid & 1;
    const bf16_t* src = P1 + (size_t)(mt * 128 + row) * P1W + half * 192;
    float ss = 0.f;
#pragma unroll 12
    for (int i = 0; i < 24; i++) { float f[8]; unpack8(*(const u32x4*)(src + i * 8), f);
#pragma unroll
      for (int j = 0; j < 8; j++) ss += f[j] * f[j]; }
    ss += __shfl_xor(ss, 1);
    if (!half) rs[row] = __builtin_amdgcn_rsqf(ss * (1.f / 384.f) + EPSF);
  }
  __syncthreads();
  f32x4 acc[4][3]; zero_acc<3>(acc);
  ALScaled al{P1 + (size_t)mt * 128 * P1W, P1W, rs, p.in[I_QAN] + l * 384};
  gemm_core<96>(al, (const bf16_t*)(ws_ + OFF_WUQ) + (size_t)h * 96 * 384, 384, 384, acc, lds);
  float* Cs = (float*)lds;
  acc_to_lds<96>(acc, Cs);
  const int row = tid >> 1, half = tid & 1, grow = mt * 128 + row;
  float v[48];
#pragma unroll
  for (int i = 0; i < 48; i++) v[i] = Cs[row * 100 + half * 48 + i];
  finish_qk(v, half, p.in[I_QN] + l * 96, grow >= 4096, (grow - 4096) & 1023, QSCALE,
            (bf16_t*)(ws_ + OFF_Q) + ((size_t)grow * 8 + h) * 96);
}

DEV void kv_task(const Params& p, int l, int t, char* lds) {
  char* ws_ = p.ws; asm volatile("" : "+s"(ws_));
  const int tid = otid();
  const int h = t / 72, mt = t % 72;
  const bf16_t* P1 = (const bf16_t*)(ws_ + OFF_P1);
  float* rs = (float*)(lds + LDS_SMALL);
  f32x4 acc[4][4]; zero_acc<4>(acc);
  const bf16_t* Bt = (const bf16_t*)(ws_ + OFF_WUKV) + (size_t)h * 128 * 256;
  if (mt < 64) {
    {
      const int row = tid >> 1, half = tid & 1;
      const bf16_t* src = P1 + (size_t)(mt * 128 + row) * P1W + 384 + half * 128;
      float ss = 0.f;
#pragma unroll
      for (int i = 0; i < 16; i++) { float f[8]; unpack8(*(const u32x4*)(src + i * 8), f);
#pragma unroll
        for (int j = 0; j < 8; j++) ss += f[j] * f[j]; }
      ss += __shfl_xor(ss, 1);
      if (!half) rs[row] = __builtin_amdgcn_rsqf(ss * (1.f / 256.f) + EPSF);
    }
    __syncthreads();
    if (h == 0 && mt < 32) {
#pragma unroll 8
      for (int it = tid; it < 128 * 32; it += 256) {
        const int r = it >> 5, c8 = it & 31, row = mt * 128 + r;
        float f[8]; unpack8(*(const u32x4*)(P1 + (size_t)row * P1W + 384 + c8 * 8), f);
        const float rr = rs[r];
        const float* g = p.in[I_KVAN] + l * 256 + c8 * 8;
        float* o = p.out + OUT_CKV + ((size_t)((row >> 8) * 2 + l) * 256 + (row & 255)) * 256 + c8 * 8;
        *(f32x4*)o = f32x4{f[0] * rr * g[0], f[1] * rr * g[1], f[2] * rr * g[2], f[3] * rr * g[3]};
        *(f32x4*)(o + 4) = f32x4{f[4] * rr * g[4], f[5] * rr * g[5], f[6] * rr * g[6], f[7] * rr * g[7]};
      }
    }
    ALScaled al{P1 + (size_t)mt * 128 * P1W + 384, P1W, rs, p.in[I_KVAN] + l * 256};
    gemm_core<128>(al, Bt, 256, 256, acc, lds);
  } else {
    const int b = (mt - 64) >> 1, p0 = ((mt - 64) & 1) * 128;
    ALF32 al{p.in[I_CCKV] + ((size_t)(b * 2 + l) * 256 + p0) * 256, 256};
    gemm_core<128>(al, Bt, 256, 256, acc, lds);
  }
  float* Cs = (float*)lds;
  acc_to_lds<128>(acc, Cs);
  {
    const int row = tid >> 1, half = tid & 1;
    float v[48];
    int krow; bool do_rope = false; int pos = 0;
    if (mt < 64) {
      const int grow = mt * 128 + row;
      krow = grow; do_rope = grow >= 4096; pos = (grow - 4096) & 1023;
      if (half == 0) {
#pragma unroll
        for (int i = 0; i < 48; i++) v[i] = Cs[row * 132 + i];
      } else {
#pragma unroll
        for (int i = 0; i < 16; i++) v[i] = Cs[row * 132 + 48 + i];
        const bf16_t* kr = P1 + (size_t)grow * P1W + 640;
#pragma unroll
        for (int i = 0; i < 4; i++) { float f[8]; unpack8(*(const u32x4*)(kr + i * 8), f);
#pragma unroll
          for (int j = 0; j < 8; j++) v[16 + i * 8 + j] = f[j]; }
      }
    } else {
      const int b = (mt - 64) >> 1, pp = ((mt - 64) & 1) * 128 + row;
      krow = 8192 + b * 256 + pp;
      if (half == 0) {
#pragma unroll
        for (int i = 0; i < 48; i++) v[i] = Cs[row * 132 + i];
      } else {
#pragma unroll
        for (int i = 0; i < 16; i++) v[i] = Cs[row * 132 + 48 + i];
        const float* kr = p.in[I_CKR] + ((size_t)(b * 2 + l) * 256 + pp) * 32;
#pragma unroll
        for (int i = 0; i < 8; i++) { const f32x4 w = *(const f32x4*)(kr + i * 4); v[16 + i * 4] = w.x; v[17 + i * 4] = w.y; v[18 + i * 4] = w.z; v[19 + i * 4] = w.w; }
      }
    }
    finish_qk(v, half, p.in[I_KN] + l * 96, do_rope, pos, 1.f, (bf16_t*)(ws_ + OFF_K) + ((size_t)krow * 8 + h) * 96);
  }
  {
    size_t vbase; int Tk, key0;
    if (mt < 32) { const int b = mt >> 1; Tk = 256; key0 = (mt & 1) * 128; vbase = (size_t)(b * 8 + h) * 64 * 256; }
    else if (mt < 64) { const int b = (mt - 32) >> 3; Tk = 1280; key0 = 256 + ((mt - 32) & 7) * 128; vbase = VT_LAT_EL + (size_t)(b * 8 + h) * 64 * 1280; }
    else { const int b = (mt - 64) >> 1; Tk = 1280; key0 = ((mt - 64) & 1) * 128; vbase = VT_LAT_EL + (size_t)(b * 8 + h) * 64 * 1280; }
    bf16_t* Vt = (bf16_t*)(ws_ + OFF_VT) + vbase;
#pragma unroll
    for (int i = 0; i < 4; i++) {
      const int it = tid + 256 * i, dv = it & 63, kg = it >> 6;
      float f[8];
#pragma unroll
      for (int j = 0; j < 8; j++) f[j] = Cs[(kg * 8 + j) * 132 + 64 + dv];
      *(u32x4*)(Vt + (size_t)dv * Tk + key0 + kg * 8) = pack8(f);
    }
  }
}

DEV void conv_pass(const Params& p, int l, int seg, int h, int row0, int sbeg, int send, float* F, bf16_t* Vtile) {
  char* ws_ = p.ws; asm volatile("" : "+s"(ws_));
  const int tid = otid(), c8 = tid & 15, tg = tid >> 4;
  const bf16_t* src = (const bf16_t*)(ws_ + OFF_P1) + 672 + seg * 512 + h * 128 + c8 * 8;
  const float* cwp = p.in[I_CONVW] + (size_t)l * 5 * 1536 + seg * 512 + h * 128 + c8 * 8;
  float cw[5][8];
#pragma unroll
  for (int j = 0; j < 5; j++) {
    const f32x4 a = *(const f32x4*)(cwp + j * 1536), b = *(const f32x4*)(cwp + j * 1536 + 4);
    cw[j][0] = a.x; cw[j][1] = a.y; cw[j][2] = a.z; cw[j][3] = a.w; cw[j][4] = b.x; cw[j][5] = b.y; cw[j][6] = b.z; cw[j][7] = b.w;
  }
  const int t0 = row0 + tg * 4;
  u32x4 raw[8];
#pragma unroll
  for (int r = 0; r < 8; r++) {
    const int row = t0 - 2 + r;
    raw[r] = (row >= sbeg && row < send) ? *(const u32x4*)(src + (size_t)row * P1W) : u32x4{0u, 0u, 0u, 0u};
  }
  float acc[4][8];
#pragma unroll
  for (int tt = 0; tt < 4; tt++)
#pragma unroll
    for (int c = 0; c < 8; c++) acc[tt][c] = 0.f;
#pragma unroll
  for (int r = 0; r < 8; r++) {
    float f[8]; unpack8(raw[r], f);
#pragma unroll
    for (int tt = 0; tt < 4; tt++) {
      const int j = r - tt;
      if (j >= 0 && j < 5) {
#pragma unroll
        for (int c = 0; c < 8; c++) acc[tt][c] += cw[j][c] * f[c];
      }
    }
  }
#pragma unroll
  for (int tt = 0; tt < 4; tt++) {
    float y[8];
#pragma unroll
    for (int c = 0; c < 8; c++) y[c] = siluf(acc[tt][c]);
    if (F) {
#pragma unroll
      for (int c = 0; c < 8; c++) F[(tg * 4 + tt) * 129 + c8 * 8 + c] = y[c];
    } else {
      *(u32x4*)(Vtile + (tg * 4 + tt) * 136 + c8 * 8) = pack8(y);
    }
  }
}
DEV void l2norm_rows(const float* F, bf16_t* T) {
  const int tid = otid(), row = tid >> 2, part = tid & 3;
  float ss = 0.f;
#pragma unroll
  for (int i = 0; i < 32; i++) { float x = F[row * 129 + part * 32 + i]; ss += x * x; }
  ss += __shfl_xor(ss, 1); ss += __shfl_xor(ss, 2);
  const float inv = __builtin_amdgcn_rsqf(ss + EPSF);
#pragma unroll
  for (int i = 0; i < 32; i++) T[row * 136 + part * 32 + i] = f2bf(F[row * 129 + part * 32 + i] * inv);
}
DEV void mm64(const bf16_t* At, const bf16_t* Bt_, float* Out, int wave, int l16, int quad) {
  f32x4 acc[4];
#pragma unroll
  for (int ni = 0; ni < 4; ni++) acc[ni] = f32x4{0.f, 0.f, 0.f, 0.f};
#pragma unroll
  for (int ks = 0; ks < 4; ks++) {
    bf16x8 a = *(const bf16x8*)(At + (wave * 16 + l16) * 136 + ks * 32 + quad * 8);
#pragma unroll
    for (int ni = 0; ni < 4; ni++) {
      bf16x8 b = *(const bf16x8*)(Bt_ + (ni * 16 + l16) * 136 + ks * 32 + quad * 8);
      acc[ni] = MFMA(a, b, acc[ni]);
    }
  }
#pragma unroll
  for (int ni = 0; ni < 4; ni++)
#pragma unroll
    for (int j = 0; j < 4; j++) Out[(wave * 16 + quad * 4 + j) * 65 + ni * 16 + l16] = acc[ni][j];
}
DEV void gdn_prep_task(const Params& p, int l, int t, char* lds) {
  char* ws_ = p.ws; asm volatile("" : "+s"(ws_));
  const int tid = otid(), lane = tid & 63, wave = tid >> 6, l16 = lane & 15, quad = lane >> 4;
  const int chunk = t >> 2, h = t & 3, row0 = chunk * 64;
  int sbeg, send;
  if (row0 < 4096) { sbeg = row0 & ~255; send = sbeg + 256; } else { sbeg = 4096 + ((row0 - 4096) & ~1023); send = sbeg + 1024; }
  bf16_t* Kt = (bf16_t*)lds;
  bf16_t* Qt = Kt + 64 * 136;
  float* F = (float*)(lds + 34816);
  float* G = F;
  float* Pm = (float*)(lds + 34816 + 17408);
  float* Am = Pm;
  float* gcs = (float*)(lds + LDS_SMALL);
  float* betas = gcs + 128;
  const float* GAB = (const float*)(ws_ + OFF_GAB);
  if (tid < 128) {
    const int dir = tid >> 6, ip = tid & 63, tok = dir ? 63 - ip : ip, row = row0 + tok;
    const float ga = GAB[(size_t)row * 16 + dir * 4 + h], gb = GAB[(size_t)row * 16 + 8 + dir * 4 + h];
    const float a = __expf(p.in[I_ALOG][(l * 2 + dir) * 4 + h]);
    const float x = ga + p.in[I_DTB][(l * 2 + dir) * 4 + h];
    const float ex = __expf(fminf(x, 20.f));
    const float sp = x > 20.f ? x : (ex < 0.01f ? ex * (1.f - ex * (0.5f - ex * (1.f / 3.f))) : __logf(1.f + ex));
    float g = -a * sp;
#pragma unroll
    for (int off = 1; off < 64; off <<= 1) { float v = __shfl_up(g, off); if (ip >= off) g += v; }
    gcs[dir * 64 + ip] = g;
    betas[dir * 64 + ip] = frcp(1.f + __expf(-gb));
  }
  conv_pass(p, l, 1, h, row0, sbeg, send, F, nullptr);
  __syncthreads();
  l2norm_rows(F, Kt);
  __syncthreads();
  conv_pass(p, l, 0, h, row0, sbeg, send, F, nullptr);
  __syncthreads();
  l2norm_rows(F, Qt);
  __syncthreads();
  mm64(Qt, Kt, Pm, wave, l16, quad);
  bf16_t* recbase = (bf16_t*)(ws_ + OFF_GDN) + (size_t)(chunk * 4 + h) * 2 * REC_EL;
#pragma unroll 1
  for (int dir = 0; dir < 2; dir++) {
    bf16_t* rec = recbase + (size_t)dir * REC_EL;
    const float* gc = gcs + dir * 64;
    const float gl = gc[63];
#pragma unroll
    for (int i = 0; i < 4; i++) {
      const int it = tid + 256 * i, ip = it >> 4, c8 = it & 15, tok = dir ? 63 - ip : ip;
      const float sc = 0.08838834764831845f * __expf(gc[ip]);
      float f[8]; unpack8(*(const u32x4*)(Qt + tok * 136 + c8 * 8), f);
#pragma unroll
      for (int j = 0; j < 8; j++) f[j] *= sc;
      *(u32x4*)(rec + 8192 + ip * 128 + c8 * 8) = pack8(f);
    }
#pragma unroll
    for (int i = 0; i < 4; i++) {
      const int it = tid + 256 * i, d = it & 127, ig = it >> 7;
      float f[8];
#pragma unroll
      for (int j = 0; j < 8; j++) { const int ip = ig * 8 + j, tok = dir ? 63 - ip : ip; f[j] = bf2f(Kt[tok * 136 + d]) * __expf(gl - gc[ip]); }
      *(u32x4*)(rec + 20480 + d * 64 + ig * 8) = pack8(f);
    }
    if (tid == 0) ((float*)(ws_ + OFF_EGL))[(chunk * 4 + h) * 2 + dir] = __expf(gl);
  }
  __syncthreads();
  conv_pass(p, l, 2, h, row0, sbeg, send, nullptr, Qt);
#pragma unroll 1
  for (int dir = 0; dir < 2; dir++) {
    bf16_t* rec = recbase + (size_t)dir * REC_EL;
    const float* gc = gcs + dir * 64;
#pragma unroll
    for (int i = 0; i < 2; i++) {
      const int it = tid + 256 * i, ip = it >> 3, j8 = it & 7, ti = dir ? 63 - ip : ip;
      float f[8];
#pragma unroll
      for (int j = 0; j < 8; j++) {
        const int jp = j8 * 8 + j, tj = dir ? 63 - jp : jp;
        const float e = __expf(fminf(gc[ip] - gc[jp], 0.f));
        f[j] = (ip >= jp) ? Pm[ti * 65 + tj] * 0.08838834764831845f * e : 0.f;
      }
      *(u32x4*)(rec + 16384 + ip * 64 + j8 * 8) = pack8(f);
    }
  }
  __syncthreads();
  const bf16_t* Vtile = Qt;
  float* T = G;
#pragma unroll 1
  for (int dir = 0; dir < 2; dir++) {
    bf16_t* rec = recbase + (size_t)dir * REC_EL;
    const float* gc = gcs + dir * 64;
    const float* be = betas + dir * 64;
    mm64(Kt, Kt, G, wave, l16, quad);
    __syncthreads();
#pragma unroll 2
    for (int i = 0; i < 16; i++) {
      const int it = tid + 256 * i, ip = it >> 6, jp = it & 63;
      const int ti = dir ? 63 - ip : ip, tj = dir ? 63 - jp : jp;
      const float e = __expf(fminf(gc[ip] - gc[jp], 0.f));
      Am[ip * 68 + jp] = (ip > jp) ? be[ip] * G[ti * 65 + tj] * e : 0.f;
    }
    __syncthreads();
    {
      const int cl = lane >> 2, q = lane & 3, c = wave * 16 + cl;
      float r[16];
#pragma unroll
      for (int m = 0; m < 16; m++) r[m] = (q + 4 * m == c) ? 1.f : 0.f;
#pragma unroll
      for (int j = 0; j < 63; j++) {
        const int mj = j >> 2;
        float t;
        switch (j & 3) {
          case 0: t = __int_as_float(__builtin_amdgcn_update_dpp(0, __float_as_int(r[mj]), 0x00, 0xF, 0xF, true)); break;
          case 1: t = __int_as_float(__builtin_amdgcn_update_dpp(0, __float_as_int(r[mj]), 0x55, 0xF, 0xF, true)); break;
          case 2: t = __int_as_float(__builtin_amdgcn_update_dpp(0, __float_as_int(r[mj]), 0xAA, 0xF, 0xF, true)); break;
          default: t = __int_as_float(__builtin_amdgcn_update_dpp(0, __float_as_int(r[mj]), 0xFF, 0xF, 0xF, true)); break;
        }
#pragma unroll
        for (int m = mj; m < 16; m++) r[m] -= Am[(q + 4 * m) * 68 + j] * t;
        if ((j & 7) == 7) asm volatile("" ::: "memory");
      }
#pragma unroll
      for (int m = 0; m < 16; m++) T[(q + 4 * m) * 68 + c] = r[m];
    }
    __syncthreads();
#pragma unroll 1
    for (int which = 0; which < 2; which++) {
      const bf16_t* srcT = which ? Kt : Vtile;
      f32x4 ac[4][2];
      zero_acc<2>(ac);
#pragma unroll
      for (int ks = 0; ks < 2; ks++) {
        float cs[8];
        unsigned short e[2][8];
#pragma unroll
        for (int s = 0; s < 8; s++) {
          const int j = ks * 32 + quad * 8 + s, tok = dir ? 63 - j : j;
          cs[s] = which ? be[j] * __expf(gc[j]) : be[j];
#pragma unroll
          for (int nf = 0; nf < 2; nf++) e[nf][s] = srcT[tok * 136 + wave * 32 + nf * 16 + l16];
        }
        bf16x8 bfr[2];
#pragma unroll
        for (int nf = 0; nf < 2; nf++) {
          u32x4 v;
          v.x = e[nf][0] | ((unsigned)e[nf][1] << 16); v.y = e[nf][2] | ((unsigned)e[nf][3] << 16);
          v.z = e[nf][4] | ((unsigned)e[nf][5] << 16); v.w = e[nf][6] | ((unsigned)e[nf][7] << 16);
          bfr[nf] = as_frag(v);
        }
#pragma unroll
        for (int mi = 0; mi < 4; mi++) {
          const float* tr = T + (mi * 16 + l16) * 68 + ks * 32 + quad * 8;
          const f32x4 t0 = *(const f32x4*)tr, t1 = *(const f32x4*)(tr + 4);
          const float tv[8] = {t0.x, t0.y, t0.z, t0.w, t1.x, t1.y, t1.z, t1.w};
          float a[8], hi[8], lo[8];
#pragma unroll
          for (int s = 0; s < 8; s++) a[s] = tv[s] * cs[s];
          const u32x4 ph = pack8(a);
          unpack8(ph, hi);
#pragma unroll
          for (int s = 0; s < 8; s++) lo[s] = a[s] - hi[s];
          const bf16x8 fh = as_frag(ph), fl = as_frag(pack8(lo));
#pragma unroll
          for (int nf = 0; nf < 2; nf++) { ac[mi][nf] = MFMA(fh, bfr[nf], ac[mi][nf]); ac[mi][nf] = MFMA(fl, bfr[nf], ac[mi][nf]); }
        }
      }
      int qs = quad, ls = l16;
      asm volatile("" : "+v"(qs), "+v"(ls));
      bf16_t* dst = rec + (which ? 0 : 28672);
      const float sg = which ? -1.f : 1.f;
#pragma unroll
      for (int mi = 0; mi < 4; mi++)
#pragma unroll
        for (int nf = 0; nf < 2; nf++)
#pragma unroll
          for (int j = 0; j < 4; j++) {
            const int ip = mi * 16 + qs * 4 + j, col = wave * 32 + nf * 16 + ls;
            dst[ip * 128 + col] = f2bf(sg * ac[mi][nf][j]);
          }
    }
    __syncthreads();
  }
}

DEV void cmlp_task(const Params& p, int l, int t, char* lds) {
  char* ws_ = p.ws; asm volatile("" : "+s"(ws_));
  const int tid = otid(), lane = tid & 63, wave = tid >> 6, l16 = lane & 15, quad = lane >> 4;
  const int wm = wave >> 1, wn = wave & 1;
  const int c = t >> 2, g = t & 3, r0 = c * 128;
  const bf16_t* P3 = (const bf16_t*)(ws_ + OFF_P3);
  const bf16_t* P2 = (const bf16_t*)(ws_ + OFF_P2);
  bf16_t* BR = (bf16_t*)(ws_ + OFF_BR);
  bf16_t* VnT = (bf16_t*)lds;
  bf16_t* Ws = VnT + 128 * 136;
  float* mu = (float*)(lds + LDS_SMALL);
  float* rstd = mu + 128;
  {
    const int row = tid >> 1, half = tid & 1;
    const bf16_t* src = P3 + (size_t)(r0 + row) * P3W + 512 + half * 256;
    float s = 0.f, ss = 0.f;
#pragma unroll 16
    for (int i = 0; i < 32; i++) { float f[8]; unpack8(*(const u32x4*)(src + i * 8), f);
#pragma unroll
      for (int j = 0; j < 8; j++) { float y = geluf(f[j]); s += y; ss += y * y; } }
    s += __shfl_xor(s, 1); ss += __shfl_xor(ss, 1);
    const float mean = s * (1.f / 512.f), var = fmaxf(ss * (1.f / 512.f) - mean * mean, 0.f);
    if (!half) { mu[row] = mean; rstd[row] = __builtin_amdgcn_rsqf(var + EPSF); }
  }
  __syncthreads();
#pragma unroll
  for (int i = 0; i < 8; i++) {
    const int it = tid + 256 * i, q = it >> 4, c8 = it & 15;
    float f[8]; unpack8(*(const u32x4*)(P3 + (size_t)(r0 + q) * P3W + 512 + g * 128 + c8 * 8), f);
    const float m = mu[q], rs = rstd[q];
#pragma unroll
    for (int j = 0; j < 8; j++) {
      const int cc = c8 * 8 + j;
      const float val = (geluf(f[j]) - m) * rs * p.in[I_LNG][l * 512 + g * 128 + cc] + p.in[I_LNB][l * 512 + g * 128 + cc];
      VnT[cc * 136 + q] = f2bf(val);
    }
  }
#pragma unroll
  for (int i = 0; i < 16; i++) {
    const int it = tid + 256 * i, pp = it >> 5, q4 = it & 31;
    const f32x4 w = *(const f32x4*)(p.in[I_WS] + ((size_t)(l * 4 + g) * 128 + pp) * 128 + q4 * 4);
    *(u32x2*)(Ws + pp * 136 + q4 * 4) = pack4(w.x, w.y, w.z, w.w);
  }
  __syncthreads();
  f32x4 acc[4][4]; zero_acc<4>(acc);
#pragma unroll
  for (int ks = 0; ks < 4; ks++) {
    bf16x8 a[4], b[4];
#pragma unroll
    for (int mi = 0; mi < 4; mi++) a[mi] = *(const bf16x8*)(Ws + (wm * 64 + mi * 16 + l16) * 136 + ks * 32 + quad * 8);
#pragma unroll
    for (int ni = 0; ni < 4; ni++) b[ni] = *(const bf16x8*)(VnT + (wn * 64 + ni * 16 + l16) * 136 + ks * 32 + quad * 8);
#pragma unroll
    for (int mi = 0; mi < 4; mi++)
#pragma unroll
      for (int ni = 0; ni < 4; ni++) acc[mi][ni] = MFMA(a[mi], b[ni], acc[mi][ni]);
  }
  float* Cs = (float*)lds;
  __syncthreads();
#pragma unroll
  for (int mi = 0; mi < 4; mi++)
#pragma unroll
    for (int j = 0; j < 4; j++) {
      const int pp = wm * 64 + mi * 16 + quad * 4 + j;
      const float bias = p.in[I_BS][(l * 4 + g) * 128 + pp];
#pragma unroll
      for (int ni = 0; ni < 4; ni++) Cs[pp * 132 + wn * 64 + ni * 16 + l16] = acc[mi][ni][j] + bias;
    }
  __syncthreads();
  u32x4 uu[8], zz[8];
#pragma unroll
  for (int i = 0; i < 8; i++) {
    const int it = tid + 256 * i, r = it >> 4, c8 = it & 15;
    const size_t row = (size_t)(r0 + r);
    uu[i] = *(const u32x4*)(P3 + row * P3W + g * 128 + c8 * 8);
    zz[i] = *(const u32x4*)(P2 + row * P2W + 1024 + g * 128 + c8 * 8);
  }
#pragma unroll
  for (int i = 0; i < 8; i++) {
    const int it = tid + 256 * i, r = it >> 4, c8 = it & 15;
    float u[8], z[8], o[8];
    unpack8(uu[i], u); unpack8(zz[i], z);
    const f32x4 s0 = *(const f32x4*)(Cs + r * 132 + c8 * 8), s1 = *(const f32x4*)(Cs + r * 132 + c8 * 8 + 4);
    const float sv[8] = {s0.x, s0.y, s0.z, s0.w, s1.x, s1.y, s1.z, s1.w};
#pragma unroll
    for (int j = 0; j < 8; j++) o[j] = geluf(u[j]) * sv[j] * siluf(z[j]);
    *(u32x4*)(BR + (size_t)(r0 + r) * BRW + 1024 + g * 128 + c8 * 8) = pack8(o);
  }
}

DEV void attn_task(const Params& p, int l, int t, char* lds) {
  char* ws_ = p.ws; asm volatile("" : "+s"(ws_));
  const int tid = otid(), lane = tid & 63, wave = tid >> 6, l16 = lane & 15, quad = lane >> 4;
  int b, h, qrow0, nkt, Tk; size_t vtb;
  const bool lat = t < 256;
  if (lat) { b = t >> 6; h = (t >> 3) & 7; const int qb = t & 7; qrow0 = 4096 + b * 1024 + qb * 128; nkt = 20; Tk = 1280; vtb = VT_LAT_EL + (size_t)(b * 8 + h) * 64 * 1280; }
  else { const int tt = t - 256; b = tt >> 4; h = (tt >> 1) & 7; const int qb = tt & 1; qrow0 = b * 256 + qb * 128; nkt = 4; Tk = 256; vtb = (size_t)(b * 8 + h) * 64 * 256; }
  if (lat) __builtin_amdgcn_s_setprio(2);
  const bf16_t* Qg = (const bf16_t*)(ws_ + OFF_Q);
  const bf16_t* Kg = (const bf16_t*)(ws_ + OFF_K);
  const bf16_t* Vg = (const bf16_t*)(ws_ + OFF_VT) + vtb;
  bf16_t* Qs = (bf16_t*)lds;
  bf16_t* Ks = Qs + 128 * 104;
  bf16_t* Vs = Ks + 64 * 104;
#pragma unroll
  for (int i = 0; i < 6; i++) {
    const int it = tid + 256 * i, r = it / 12, cc = it % 12;
    *(u32x4*)(Qs + r * 104 + cc * 8) = *(const u32x4*)(Qg + ((size_t)(qrow0 + r) * 8 + h) * 96 + cc * 8);
  }
  __syncthreads();
  bf16x8 qf[2][3];
#pragma unroll
  for (int ni = 0; ni < 2; ni++)
#pragma unroll
    for (int ks = 0; ks < 3; ks++) qf[ni][ks] = *(const bf16x8*)(Qs + (wave * 32 + ni * 16 + l16) * 104 + ks * 32 + quad * 8);
  f32x4 o[4][2];
#pragma unroll
  for (int di = 0; di < 4; di++) { o[di][0] = f32x4{0.f, 0.f, 0.f, 0.f}; o[di][1] = f32x4{0.f, 0.f, 0.f, 0.f}; }
  float mrun[2] = {-1e30f, -1e30f}, lsum[2] = {0.f, 0.f};
  u32x4 pk[3], pv[2];
  {
    const int krow0 = lat ? (8192 + b * 256) : (b * 256);
#pragma unroll
    for (int i = 0; i < 3; i++) { const int it = tid + 256 * i, r = it / 12, cc = it % 12; pk[i] = *(const u32x4*)(Kg + ((size_t)(krow0 + r) * 8 + h) * 96 + cc * 8); }
#pragma unroll
    for (int i = 0; i < 2; i++) { const int it = tid + 256 * i, dv = it >> 3, kg = it & 7; pv[i] = *(const u32x4*)(Vg + (size_t)dv * Tk + kg * 8); }
  }
  for (int kt = 0; kt < nkt; kt++) {
    __syncthreads();
#pragma unroll
    for (int i = 0; i < 3; i++) { const int it = tid + 256 * i, r = it / 12, cc = it % 12; *(u32x4*)(Ks + r * 104 + cc * 8) = pk[i]; }
#pragma unroll
    for (int i = 0; i < 2; i++) { const int it = tid + 256 * i, dv = it >> 3, kg = it & 7; *(u32x4*)(Vs + dv * 72 + kg * 8) = pv[i]; }
    __syncthreads();
    if (kt + 1 < nkt) {
      const int kn = kt + 1;
      int krow0;
      if (lat) krow0 = (kn < 4) ? (8192 + b * 256 + kn * 64) : (4096 + b * 1024 + (kn - 4) * 64);
      else krow0 = b * 256 + kn * 64;
#pragma unroll
      for (int i = 0; i < 3; i++) { const int it = tid + 256 * i, r = it / 12, cc = it % 12; pk[i] = *(const u32x4*)(Kg + ((size_t)(krow0 + r) * 8 + h) * 96 + cc * 8); }
#pragma unroll
      for (int i = 0; i < 2; i++) { const int it = tid + 256 * i, dv = it >> 3, kg = it & 7; pv[i] = *(const u32x4*)(Vg + (size_t)dv * Tk + kn * 64 + kg * 8); }
    }
    __builtin_amdgcn_sched_barrier(0);
    f32x4 s[4][2];
#pragma unroll
    for (int mi = 0; mi < 4; mi++) { s[mi][0] = f32x4{0.f, 0.f, 0.f, 0.f}; s[mi][1] = f32x4{0.f, 0.f, 0.f, 0.f}; }
#pragma unroll
    for (int ks = 0; ks < 3; ks++)
#pragma unroll
      for (int mi = 0; mi < 4; mi++) {
        bf16x8 kf = *(const bf16x8*)(Ks + (mi * 16 + l16) * 104 + ks * 32 + quad * 8);
        s[mi][0] = MFMA(kf, qf[0][ks], s[mi][0]);
        s[mi][1] = MFMA(kf, qf[1][ks], s[mi][1]);
      }
#pragma unroll
    for (int ni = 0; ni < 2; ni++) {
      float mx = -1e30f;
#pragma unroll
      for (int mi = 0; mi < 4; mi++)
#pragma unroll
        for (int j = 0; j < 4; j++) mx = fmaxf(mx, s[mi][ni][j]);
      mx = fmaxf(mx, __shfl_xor(mx, 16)); mx = fmaxf(mx, __shfl_xor(mx, 32));
      const float mnew = fmaxf(mrun[ni], mx);
      const float alpha = __builtin_amdgcn_exp2f(mrun[ni] - mnew);
      mrun[ni] = mnew;
      float rsum = 0.f;
#pragma unroll
      for (int mi = 0; mi < 4; mi++)
#pragma unroll
        for (int j = 0; j < 4; j++) { float pv = __builtin_amdgcn_exp2f(s[mi][ni][j] - mnew); s[mi][ni][j] = pv; rsum += pv; }
      lsum[ni] = lsum[ni] * alpha + rsum;
#pragma unroll
      for (int di = 0; di < 4; di++) o[di][ni] *= alpha;
    }
#pragma unroll
    for (int g = 0; g < 2; g++) {
      bf16x8 pf0 = frag_from(s[2 * g][0], s[2 * g + 1][0]);
      bf16x8 pf1 = frag_from(s[2 * g][1], s[2 * g + 1][1]);
#pragma unroll
      for (int di = 0; di < 4; di++) {
        bf16x8 vf = ld2(Vs + (di * 16 + l16) * 72 + g * 32 + quad * 4);
        o[di][0] = MFMA(vf, pf0, o[di][0]);
        o[di][1] = MFMA(vf, pf1, o[di][1]);
      }
    }
  }
  const bf16_t* P2 = (const bf16_t*)(ws_ + OFF_P2);
  bf16_t* BR = (bf16_t*)(ws_ + OFF_BR);
#pragma unroll
  for (int ni = 0; ni < 2; ni++) {
    float lt = lsum[ni];
    lt += __shfl_xor(lt, 16); lt += __shfl_xor(lt, 32);
    const float inv = frcp(lt);
    const size_t qrow = (size_t)(qrow0 + wave * 32 + ni * 16 + l16);
#pragma unroll
    for (int di = 0; di < 4; di++) {
      const int col = h * 64 + di * 16 + quad * 4;
      float z[4]; unpack4(*(const u32x2*)(P2 + qrow * P2W + col), z);
      *(u32x2*)(BR + qrow * BRW + col) = pack4(o[di][ni][0] * inv * siluf(z[0]), o[di][ni][1] * inv * siluf(z[1]),
                                               o[di][ni][2] * inv * siluf(z[2]), o[di][ni][3] * inv * siluf(z[3]));
    }
  }
  __builtin_amdgcn_s_setprio(0);
}

struct ScanPf { u32x4 w[4], q[4], a[2], k[4], u[2]; float egl; };
DEV void scan_prefetch(ScanPf& f, const bf16_t* rec, const float* eglp, int half, int tid) {
#pragma unroll
  for (int i = 0; i < 4; i++) { const int c = tid + 256 * i; f.w[i] = *(const u32x4*)(rec + c * 8); f.q[i] = *(const u32x4*)(rec + 8192 + c * 8); f.k[i] = *(const u32x4*)(rec + 20480 + c * 8); }
#pragma unroll
  for (int i = 0; i < 2; i++) { const int c = tid + 256 * i; f.a[i] = *(const u32x4*)(rec + 16384 + c * 8); f.u[i] = *(const u32x4*)(rec + 28672 + (c >> 3) * 128 + half * 64 + (c & 7) * 8); }
  f.egl = *eglp;
}
DEV void gdn_scan_task(const Params& p, int l, int t, char* lds) {
  char* ws_ = p.ws; asm volatile("" : "+s"(ws_));
  const int tid = otid(), lane = tid & 63, wave = tid >> 6, l16 = lane & 15, quad = lane >> 4;
  __builtin_amdgcn_s_setprio(3);
  int chain, half, b, chunk0, N; bool lat = t < 64;
  if (lat) { chain = t >> 1; half = t & 1; } else { chain = (t - 64) >> 1; half = (t - 64) & 1; }
  const int dir = chain & 1, h = (chain >> 1) & 3;
  b = chain >> 3;
  if (lat) { chunk0 = 64 + b * 16; N = 16; } else { chunk0 = b * 4; N = 4; }
  const int e0 = (half * 4 + wave) * 16;
  bf16_t* Wl = (bf16_t*)lds;
  bf16_t* Ql = Wl + 64 * 136;
  bf16_t* Al = Ql + 64 * 136;
  bf16_t* Kl = Al + 64 * 72;
  bf16_t* Ul = Kl + 128 * 72;
  f32x4 S[8];
  if (lat) {
    const float* s0 = p.in[I_SGDN] + ((size_t)((b * 2 + l) * 2 + dir) * 4 + h) * 16384;
#pragma unroll
    for (int mf = 0; mf < 8; mf++)
#pragma unroll
      for (int j = 0; j < 4; j++) S[mf][j] = s0[(mf * 16 + quad * 4 + j) * 128 + e0 + l16];
  } else {
#pragma unroll
    for (int mf = 0; mf < 8; mf++) S[mf] = f32x4{0.f, 0.f, 0.f, 0.f};
  }
  float* OD = (float*)(ws_ + OFF_ODIR) + (size_t)dir * NTOK * 512;
  const float* EGL = (const float*)(ws_ + OFF_EGL);
  const bf16_t* GD = (const bf16_t*)(ws_ + OFF_GDN);
  ScanPf pf;
  {
    const int cidx = chunk0 + (dir ? N - 1 : 0);
    scan_prefetch(pf, GD + ((size_t)(cidx * 4 + h) * 2 + dir) * REC_EL, EGL + (cidx * 4 + h) * 2 + dir, half, tid);
  }
#pragma unroll 1
  for (int n = 0; n < N; n++) {
    const int cidx = chunk0 + (dir ? N - 1 - n : n);
    __syncthreads();
#pragma unroll
    for (int i = 0; i < 4; i++) {
      const int c = tid + 256 * i;
      *(u32x4*)(Wl + (c >> 4) * 136 + (c & 15) * 8) = pf.w[i];
      *(u32x4*)(Ql + (c >> 4) * 136 + (c & 15) * 8) = pf.q[i];
      *(u32x4*)(Kl + (c >> 3) * 72 + (c & 7) * 8) = pf.k[i];
    }
#pragma unroll
    for (int i = 0; i < 2; i++) {
      const int c = tid + 256 * i;
      *(u32x4*)(Al + (c >> 3) * 72 + (c & 7) * 8) = pf.a[i];
      *(u32x4*)(Ul + (c >> 3) * 72 + (c & 7) * 8) = pf.u[i];
    }
    const float egl = pf.egl;
    __syncthreads();
    if (n + 1 < N) {
      const int cn = chunk0 + (dir ? N - 2 - n : n + 1);
      scan_prefetch(pf, GD + ((size_t)(cn * 4 + h) * 2 + dir) * REC_EL, EGL + (cn * 4 + h) * 2 + dir, half, tid);
    }
    __builtin_amdgcn_sched_barrier(0);
    bf16x8 Sb[4];
#pragma unroll
    for (int ks = 0; ks < 4; ks++) Sb[ks] = frag_from(S[2 * ks], S[2 * ks + 1]);
    f32x4 vn[4];
#pragma unroll
    for (int mi = 0; mi < 4; mi++)
#pragma unroll
      for (int j = 0; j < 4; j++) vn[mi][j] = bf2f(Ul[(mi * 16 + quad * 4 + j) * 72 + wave * 16 + l16]);
#pragma unroll
    for (int mi = 0; mi < 4; mi++)
#pragma unroll
      for (int ks = 0; ks < 4; ks++) vn[mi] = MFMA(ld2(Wl + (mi * 16 + l16) * 136 + ks * 32 + quad * 4), Sb[ks], vn[mi]);
    bf16x8 vb[2];
    vb[0] = frag_from(vn[0], vn[1]); vb[1] = frag_from(vn[2], vn[3]);
#pragma unroll
    for (int mi = 0; mi < 4; mi++) {
      f32x4 o = f32x4{0.f, 0.f, 0.f, 0.f};
#pragma unroll
      for (int ks = 0; ks < 4; ks++) o = MFMA(ld2(Ql + (mi * 16 + l16) * 136 + ks * 32 + quad * 4), Sb[ks], o);
#pragma unroll
      for (int k2 = 0; k2 < 2; k2++) o = MFMA(ld2(Al + (mi * 16 + l16) * 72 + k2 * 32 + quad * 4), vb[k2], o);
#pragma unroll
      for (int j = 0; j < 4; j++) {
        const int ip = mi * 16 + quad * 4 + j, tok = dir ? 63 - ip : ip;
        OD[(size_t)(cidx * 64 + tok) * 512 + h * 128 + e0 + l16] = o[j];
      }
    }
#pragma unroll
    for (int mf = 0; mf < 8; mf++) {
      S[mf] *= egl;
#pragma unroll
      for (int k2 = 0; k2 < 2; k2++) S[mf] = MFMA(ld2(Kl + (mf * 16 + l16) * 72 + k2 * 32 + quad * 4), vb[k2], S[mf]);
    }
  }
  if (!lat) {
    float* so = p.out + OUT_STATE + ((size_t)((b * 2 + l) * 2 + dir) * 4 + h) * 16384;
#pragma unroll
    for (int mf = 0; mf < 8; mf++)
#pragma unroll
      for (int j = 0; j < 4; j++) so[(mf * 16 + quad * 4 + j) * 128 + e0 + l16] = S[mf][j];
  }
  __builtin_amdgcn_s_setprio(0);
}

DEV void onorm_task(const Params& p, int l, int t) {
  char* ws_ = p.ws; asm volatile("" : "+s"(ws_));
  const int tid = otid(), lane = tid & 63, wave = tid >> 6;
  const float* OD = (const float*)(ws_ + OFF_ODIR);
  const bf16_t* P2 = (const bf16_t*)(ws_ + OFF_P2);
  bf16_t* BR = (bf16_t*)(ws_ + OFF_BR);
#pragma unroll
  for (int rr = 0; rr < 4; rr++) {
    const size_t row = (size_t)t * 16 + wave * 4 + rr;
    const f32x4 a0 = *(const f32x4*)(OD + row * 512 + lane * 8), a1 = *(const f32x4*)(OD + row * 512 + lane * 8 + 4);
    const f32x4 b0 = *(const f32x4*)(OD + (NTOK + row) * 512 + lane * 8), b1 = *(const f32x4*)(OD + (NTOK + row) * 512 + lane * 8 + 4);
    float x[8] = {a0.x + b0.x, a0.y + b0.y, a0.z + b0.z, a0.w + b0.w, a1.x + b1.x, a1.y + b1.y, a1.z + b1.z, a1.w + b1.w};
    float ss = 0.f;
#pragma unroll
    for (int i = 0; i < 8; i++) ss += x[i] * x[i];
#pragma unroll
    for (int o = 8; o >= 1; o >>= 1) ss += __shfl_xor(ss, o);
    const float rstd = __builtin_amdgcn_rsqf(ss * (1.f / 128.f) + EPSF);
    float z[8]; unpack8(*(const u32x4*)(P2 + row * P2W + 512 + lane * 8), z);
    const float* g = p.in[I_ONORM] + l * 128 + (lane & 15) * 8;
    float y[8];
#pragma unroll
    for (int i = 0; i < 8; i++) y[i] = x[i] * rstd * g[i] * siluf(z[i]);
    *(u32x4*)(BR + row * BRW + 512 + lane * 8) = pack8(y);
  }
}

DEV void gate_task(const Params& p, int l, int t, char* lds) {
  char* ws_ = p.ws; asm volatile("" : "+s"(ws_));
  const int tid = otid();
  const int nt = t / 64, mt = t % 64;
  f32x4 acc[4][4]; zero_acc<4>(acc);
  ALPlain al{(const bf16_t*)(ws_ + OFF_H) + (size_t)mt * 128 * 1024, 1024};
  gemm_core<128>(al, (const bf16_t*)(ws_ + OFF_WGL) + (size_t)nt * 128 * 1024, 1024, 1024, acc, lds);
  float* Cs = (float*)lds;
  acc_to_lds<128>(acc, Cs);
  bf16_t* GT = (bf16_t*)(ws_ + OFF_GDN);
#pragma unroll
  for (int i = 0; i < 8; i++) {
    const int it = tid + 256 * i, r = it >> 4, c8 = it & 15;
    const f32x4 a = *(const f32x4*)(Cs + r * 132 + c8 * 8), b = *(const f32x4*)(Cs + r * 132 + c8 * 8 + 4);
    float f[8] = {sigmf(a.x), sigmf(a.y), sigmf(a.z), sigmf(a.w), sigmf(b.x), sigmf(b.y), sigmf(b.z), sigmf(b.w)};
    *(u32x4*)(GT + (size_t)(mt * 128 + r) * 3072 + nt * 128 + c8 * 8) = pack8(f);
  }
}
DEV void d1_task(const Params& p, int l, int t, char* lds) {
  char* ws_ = p.ws; asm volatile("" : "+s"(ws_));
  const int tid = otid(), lane = tid & 63, wave = tid >> 6, l16 = lane & 15, quad = lane >> 4;
  const int wm = wave >> 1, wn = wave & 1;
  const int nt = t >> 6, mt = t & 63;
  const bf16_t* GT = (const bf16_t*)(ws_ + OFF_GDN);
  f32x4 macc[4][2]; zero_acc<2>(macc);
#pragma unroll 1
  for (int n = 0; n < 3; n++) {
    unsigned short gv[4][2][4];
#pragma unroll
    for (int mi = 0; mi < 4; mi++)
#pragma unroll
      for (int ni = 0; ni < 2; ni++)
#pragma unroll
        for (int j = 0; j < 4; j++)
          gv[mi][ni][j] = GT[(size_t)(mt * 128 + wm * 64 + mi * 16 + quad * 4 + j) * 3072 + n * 1024 + nt * 64 + wn * 32 + ni * 16 + l16];
    f32x4 y[4][2]; zero_acc<2>(y);
    ALPlain alb{(const bf16_t*)(ws_ + OFF_BR) + (size_t)mt * 128 * BRW + n * 512, BRW};
    gemm_core<64>(alb, (const bf16_t*)(ws_ + OFF_WBR) + (size_t)(n * 1024 + nt * 64) * 512, 512, 512, y, lds);
#pragma unroll
    for (int mi = 0; mi < 4; mi++)
#pragma unroll
      for (int ni = 0; ni < 2; ni++)
#pragma unroll
        for (int j = 0; j < 4; j++) macc[mi][ni][j] += bf2f(gv[mi][ni][j]) * y[mi][ni][j];
  }
  float* Cs = (float*)lds;
  acc_to_lds<64>(macc, Cs);
  bf16_t* M = (bf16_t*)(ws_ + OFF_M);
#pragma unroll
  for (int i = 0; i < 4; i++) {
    const int it = tid + 256 * i, r = it >> 3, c8 = it & 7;
    float f[8];
#pragma unroll
    for (int j = 0; j < 8; j++) f[j] = Cs[r * 68 + c8 * 8 + j];
    *(u32x4*)(M + (size_t)(mt * 128 + r) * 1024 + nt * 64 + c8 * 8) = pack8(f);
  }
}

DEV void d2_task(const Params& p, int l, int t, char* lds) {
  char* ws_ = p.ws; asm volatile("" : "+s"(ws_));
  const int tid = otid();
  const int nt = t >> 6, mt = t & 63;
  f32x4 acc[4][4]; zero_acc<4>(acc);
  ALPlain al{(const bf16_t*)(ws_ + OFF_M) + (size_t)mt * 128 * 1024, 1024};
  gemm_core<128>(al, (const bf16_t*)(ws_ + OFF_WO) + (size_t)nt * 128 * 1024, 1024, 1024, acc, lds);
  float* Cs = (float*)lds;
  acc_to_lds<128>(acc, Cs);
  const float* mod = (const float*)(ws_ + OFF_MOD);
#pragma unroll
  for (int i = 0; i < 8; i++) {
    const int it = tid + 256 * i, r = it >> 4, c8 = it & 15;
    const int row = mt * 128 + r, col = nt * 128 + c8 * 8;
    const float* x = xrow_ptr(p, l, row) + col;
    const float* gt = mod + (size_t)(l * 5 + modrow(row)) * 3072 + 2048 + col;
    const f32x4 y0 = *(const f32x4*)(Cs + r * 132 + c8 * 8), y1 = *(const f32x4*)(Cs + r * 132 + c8 * 8 + 4);
    const f32x4 x0 = *(const f32x4*)x, x1 = *(const f32x4*)(x + 4);
    const f32x4 g0 = *(const f32x4*)gt, g1 = *(const f32x4*)(gt + 4);
    float* o = p.out + (size_t)row * DM + col;
    *(f32x4*)o = f32x4{x0.x + g0.x * y0.x, x0.y + g0.y * y0.y, x0.z + g0.z * y0.z, x0.w + g0.w * y0.w};
    *(f32x4*)(o + 4) = f32x4{x1.x + g1.x * y1.x, x1.y + g1.y * y1.y, x1.z + g1.z * y1.z, x1.w + g1.w * y1.w};
  }
}

#define NPHASES 15
DEV int phase_nsub(int ph) {
  if (ph == 0) return 48 + 152;
  const int l = (ph - 1) / 7, s = (ph - 1) % 7;
  switch (s) {
    case 0: return 128 + (l == 0 ? 17 : 0);
    case 1: return 304 + 8;
    case 2: return 64 + 64 + 64;
    case 3: return 8 + 32 + 32 + 32 + 32 + (l == 0 ? 169 + 176 : 176);
    case 4: return 192 + 64;
    case 5: return 128;
    default: return 64;
  }
}
DEV void run_task(const Params& p, int ph, int x, int i, char* lds) {
  if (ph == 0) { if (i < 48) mod_task(p, i * 8 + x, lds); else convert_task(p, 0, (i - 48) * 8 + x, lds); return; }
  const int l = (ph - 1) / 7, s = (ph - 1) % 7;
  switch (s) {
    case 0:
      if (i < 128) norm_task(p, l, i * 8 + x);
      else convert_task(p, 0, 1984 + (i - 128) * 8 + x, lds);
      break;
    case 1:
      if (i < 304) projA_task(p, l, (i >> 3) * 64 + (i & 7) * 8 + x, lds);
      else kv_task(p, l, (i - 304) * 72 + 64 + x, lds);
      break;
    case 2:
      if (i < 64) gdn_prep_task(p, l, i * 8 + x, lds);
      else if (i < 128) { const int j = i - 64; kv_task(p, l, (j >> 3) * 72 + (j & 7) * 8 + x, lds); }
      else { const int j = i - 128; q_task(p, l, (j >> 3) * 64 + (j & 7) * 8 + x, lds); }
      break;
    case 3:
      if (i < 8) gdn_scan_task(p, l, i * 8 + x, lds);
      else if (i < 40) attn_task(p, l, x * 32 + (i - 8), lds);
      else if (i < 72) cmlp_task(p, l, (i - 40) * 8 + x, lds);
      else if (i < 104) gdn_scan_task(p, l, 64 + (i - 72) * 8 + x, lds);
      else if (i < 136) attn_task(p, l, 256 + x * 32 + (i - 104), lds);
      else if (l == 1) {
        if (i < 232) convert_task(p, 1, 1216 + (i - 136) * 8 + x, lds);
        else convert_task(p, 1, 2120 + (i - 232) * 8 + x, lds);
      }
      else if (i < 288) convert_task(p, 1, (i - 136) * 8 + x, lds);
      else if (i < 305) convert_task(p, 1, 1984 + (i - 288) * 8 + x, lds);
      else if (i < 401) convert_task(p, 0, 1216 + (i - 305) * 8 + x, lds);
      else convert_task(p, 0, 2120 + (i - 401) * 8 + x, lds);
      break;
    case 4:
      if (i < 192) gate_task(p, l, (i >> 3) * 64 + (i & 7) * 8 + x, lds);
      else onorm_task(p, l, (i - 192) * 8 + x);
      break;
    case 5:
      d1_task(p, l, (i >> 3) * 64 + (i & 7) * 8 + x, lds);
      break;
    case 6:
      d2_task(p, l, (i >> 3) * 64 + (i & 7) * 8 + x, lds);
      break;
  }
}
#ifndef REP_S
#define REP_S -1
#endif
DEV void run_phase(const Params& p, int ph, char* lds, int* sh, int myx, int rep = 0, int rank = 0, int nloc = 0) {
  unsigned* cb = (unsigned*)(p.ws + OFF_CTR) + ph * 128 + rep * 6144;
  const int n = phase_nsub(ph);
  if (nloc > 0) {
#pragma unroll 1
    for (int i = rank; i < n; i += nloc) { __syncthreads(); run_task(p, ph, myx, i, lds); }
    return;
  }
#pragma unroll 1
  for (int xo = 0; xo < 8; xo++) {
    const int x = (myx + xo) & 7;
    unsigned* c = cb + x * 16;
    int i;
    while ((i = next_task(c, sh, n, xo > 0)) < n) run_task(p, ph, x, i, lds);
  }
}

__global__ void __launch_bounds__(256, 2) k_phase(Params p, int ph) {
  __shared__ __attribute__((aligned(16))) char lds[LDS_BYTES];
  __shared__ int sh[4];
  const Params& pr = *(const Params*)__builtin_amdgcn_kernarg_segment_ptr();
  run_phase(pr, ph, lds, sh, (int)(xb_xcc_id() & 7u));
}

__global__ void __launch_bounds__(256, 2) k_mega(Params p) {
  __shared__ __attribute__((aligned(16))) char lds[LDS_BYTES];
  __shared__ __attribute__((aligned(16))) unsigned xbw[4];
  __shared__ int sh[4];
  const Params& pr = *(const Params*)__builtin_amdgcn_kernarg_segment_ptr();
  if (threadIdx.x == 0) { xbw[0] = 0u; xbw[1] = 0u; xbw[2] = 0u; xbw[3] = 0u; }
  __syncthreads();
  XcdBarrier xb = xcd_barrier_post((unsigned*)(pr.ws + OFF_BAR), (volatile LAS unsigned*)xbw);
  const int myx = (int)(xb.x & 7u);
  if (pr.out == nullptr) cg::this_grid().sync();
#pragma unroll
  for (int ph = 0; ph < NPHASES; ph++) {
    {
      const int sub = ph > 0 ? (ph - 1) % 7 : -1;
      const bool uniform = (sub == 0 || sub == 1 || sub == 2 || sub == 4 || sub == 5 || sub == 6);
      int nloc = 0, rank = 0;
      if (ph > 0 && uniform && xbw[1] == 8u) { nloc = (int)xbw[0]; rank = (int)xbw[2]; }
      run_phase(pr, ph, lds, sh, myx, 0, rank, nloc);
    }
    if ((REP_S == 7 && ph == 0) || (REP_S >= 0 && ph > 0 && (ph - 1) % 7 == REP_S && !(REP_S == 6 && ph > 7))) run_phase(pr, ph, lds, sh, myx, 1);
    if (ph + 1 < NPHASES) xcd_barrier(xb);
  }
}

extern "C" void kernel_launch(void* const* d_in, const int* in_sizes, int n_in, void* d_out, int out_size, void* d_ws,
                              size_t ws_size, hipStream_t stream) {
  Params p{};
  for (int i = 0; i < 27; i++) p.in[i] = (const float*)d_in[i];
  p.out = (float*)d_out;
  p.ws = (char*)d_ws;
  if (ws_size < WS_END) { fprintf(stderr, "workspace too small: %zu < %llu\n", ws_size, (unsigned long long)WS_END); return; }
  (void)hipMemsetAsync(d_ws, 0, 32768, stream);
#if COOP
  static int grid_blocks = 0;
  if (!grid_blocks) {
    int dev = 0, cus = 0, per_cu = 0;
    hipGetDevice(&dev);
    hipDeviceGetAttribute(&cus, hipDeviceAttributeMultiprocessorCount, dev);
    hipOccupancyMaxActiveBlocksPerMultiprocessor(&per_cu, k_mega, 256, 0);
    if (per_cu > 2) per_cu = 2;
    if (per_cu < 1) per_cu = 1;
    grid_blocks = cus * per_cu;
  }
  void* args[] = {&p};
  hipError_t e = hipLaunchCooperativeKernel((void*)k_mega, dim3(grid_blocks), dim3(256), args, 0, stream);
  if (e != hipSuccess) fprintf(stderr, "cooperative launch failed: %s (grid %d)\n", hipGetErrorString(e), grid_blocks);
#else
  for (int ph = 0; ph < NPHASES; ph++) k_phase<<<512, 256, 0, stream>>>(p, ph);
#endif
}
```

```cpp
#include <hip/hip_runtime.h>
#include <hip/hip_cooperative_groups.h>
#include <stdint.h>
#include <stdio.h>
namespace cg = cooperative_groups;

#ifndef COOP
#define COOP 1
#endif

typedef unsigned short bf16_t;
typedef __attribute__((ext_vector_type(8))) short bf16x8;
typedef __attribute__((ext_vector_type(4))) float f32x4;
typedef __attribute__((ext_vector_type(4))) unsigned int u32x4;
typedef __attribute__((ext_vector_type(2))) unsigned int u32x2;
#define DEV __device__ __forceinline__

#define NTOK 8192
#define DM 1024
#define DIN 7856
#define EPSF 1e-6f
#define P1W 2208
#define P3W 1024
#define P2W 1536
#define BRW 1536
#define REC_EL 36864

#define OFF_CTR  0ull
#define OFF_BAR  8192ull
#define OFF_MOD  32768ull
#define OFF_GAB  (OFF_MOD + 122880ull)
#define OFF_EGL  (OFF_GAB + 524288ull)
#define OFF_WTA  (OFF_EGL + 4096ull)
#define OFF_WGL  (OFF_WTA + 9961472ull)
#define OFF_WUQ  (OFF_WGL + 6291456ull)
#define OFF_WUKV (OFF_WUQ + 589824ull)
#define OFF_WBR  (OFF_WUKV + 524288ull)
#define OFF_WO   (OFF_WBR + 3145728ull)
#define OFF_H    (OFF_WO + 2097152ull)
#define OFF_P1   (OFF_H + 16777216ull)
#define OFF_ODIR OFF_P1
#define OFF_P3   (OFF_P1 + 36175872ull)
#define OFF_M    OFF_P3
#define OFF_P2   (OFF_P1 + 52953088ull)
#define OFF_GDN  (OFF_P2 + 25165824ull)
#define OFF_Q    (OFF_GDN + 75497472ull)
#define OFF_K    (OFF_Q + 12582912ull)
#define OFF_VT   (OFF_K + 14155776ull)
#define OFF_BR   (OFF_VT + 9437184ull)
#define WS_END   (OFF_BR + 25165824ull)
#define VT_LAT_EL 2097152

#define OUT_CKV   8388608
#define OUT_KROPE 10485760
#define OUT_STATE 10747904

#define LDS_BYTES 75776
#define LDS_SMALL 73728

struct Params {
  const float* in[27];
  float* out;
  char* ws;
};
enum { I_XP = 0, I_XS, I_CCKV, I_CKR, I_SGDN, I_C, I_CCTX, I_NORMG, I_WMOD, I_BMOD, I_WIN, I_QAN, I_WUQ, I_KVAN, I_WUKV,
       I_QN, I_KN, I_CONVW, I_ALOG, I_DTB, I_ONORM, I_LNG, I_LNB, I_WS, I_BS, I_WBR, I_WO };

DEV float bf2f(bf16_t b) { return __uint_as_float(((unsigned)b) << 16); }
typedef __bf16 hwbf2 __attribute__((ext_vector_type(2)));
typedef float hwf2 __attribute__((ext_vector_type(2)));
DEV unsigned pack2(float a, float b) { hwf2 v = {a, b}; return __builtin_bit_cast(unsigned, __builtin_convertvector(v, hwbf2)); }
DEV bf16_t f2bf(float f) { return (bf16_t)(pack2(f, 0.f) & 0xffffu); }
DEV void unpack8(u32x4 v, float* f) {
  f[0] = __uint_as_float(v.x << 16); f[1] = __uint_as_float(v.x & 0xffff0000u);
  f[2] = __uint_as_float(v.y << 16); f[3] = __uint_as_float(v.y & 0xffff0000u);
  f[4] = __uint_as_float(v.z << 16); f[5] = __uint_as_float(v.z & 0xffff0000u);
  f[6] = __uint_as_float(v.w << 16); f[7] = __uint_as_float(v.w & 0xffff0000u);
}
DEV void unpack4(u32x2 v, float* f) {
  f[0] = __uint_as_float(v.x << 16); f[1] = __uint_as_float(v.x & 0xffff0000u);
  f[2] = __uint_as_float(v.y << 16); f[3] = __uint_as_float(v.y & 0xffff0000u);
}
DEV u32x4 pack8(const float* f) {
  u32x4 v; v.x = pack2(f[0], f[1]); v.y = pack2(f[2], f[3]); v.z = pack2(f[4], f[5]); v.w = pack2(f[6], f[7]); return v;
}
DEV u32x2 pack4(float a, float b, float c, float d) { u32x2 v; v.x = pack2(a, b); v.y = pack2(c, d); return v; }
DEV bf16x8 as_frag(u32x4 v) { union { u32x4 u; bf16x8 b; } x; x.u = v; return x.b; }
DEV bf16x8 frag_from(f32x4 a, f32x4 b) {
  u32x4 v; v.x = pack2(a[0], a[1]); v.y = pack2(a[2], a[3]); v.z = pack2(b[0], b[1]); v.w = pack2(b[2], b[3]); return as_frag(v);
}
DEV bf16x8 ld2(const bf16_t* p) {
  u32x2 a = *(const u32x2*)p; u32x2 b = *(const u32x2*)(p + 16);
  u32x4 v; v.x = a.x; v.y = a.y; v.z = b.x; v.w = b.y; return as_frag(v);
}
DEV float frcp(float x) { return __builtin_amdgcn_rcpf(x); }
DEV float siluf(float x) { return x * frcp(1.f + __expf(-x)); }
DEV float sigmf(float x) { return frcp(1.f + __expf(-x)); }
DEV float geluf(float x) { float u = 0.7978845608028654f * (x + 0.044715f * x * x * x); return x * frcp(1.f + __expf(-2.f * u)); }
#define MFMA(a, b, c) __builtin_amdgcn_mfma_f32_16x16x32_bf16((a), (b), (c), 0, 0, 0)

DEV int otid() { int t = threadIdx.x; asm volatile("" : "+v"(t)); return t; }
DEV int next_task(unsigned* ctr, int* sh, int n, bool precheck) {
  __syncthreads();
  if (threadIdx.x == 0) {
    int v = n;
    if (!precheck || (int)__hip_atomic_load(ctr, __ATOMIC_RELAXED, __HIP_MEMORY_SCOPE_AGENT) < n) v = (int)atomicAdd(ctr, 1u);
    *sh = v;
  }
  __syncthreads();
  return *sh;
}

#define XB_TMO      128
#define XB_XCNT(j)  (256  + 64 * (j))
#define XB_XSUB(j)  (1280 + 64 * (j))
#define XB_XGEN(j)  (2304 + 64 * (j))
#define XB_TOP      3328
#define XB_TOPGEN   3392
#define XCD_BAR_WORDS 3456
#define XB_SPIN_CAP (1u << 22)
#define LAS __attribute__((address_space(3)))
DEV unsigned xb_ld(unsigned* p) { return __hip_atomic_load(p, __ATOMIC_RELAXED, __HIP_MEMORY_SCOPE_AGENT); }
DEV unsigned xb_add(unsigned* p, unsigned v) { return __hip_atomic_fetch_add(p, v, __ATOMIC_RELAXED, __HIP_MEMORY_SCOPE_AGENT); }
DEV unsigned xb_xcc_id() { return (unsigned)__builtin_amdgcn_s_getreg((3 << 11) | 20) & 0xFu; }
#define XB_SPIN(cond, bar) do { unsigned _sp = 0; while (cond) { __builtin_amdgcn_s_sleep(1); \
    if ((++_sp & 255u) == 0u) { if (xb_ld(&(bar)[XB_TMO])) break; if (_sp > XB_SPIN_CAP) { atomicAdd(&(bar)[XB_TMO], 1u); break; } } } } while (0)
struct XcdBarrier { unsigned* bar; unsigned x; volatile LAS unsigned* st; };
DEV XcdBarrier xcd_barrier_post(unsigned* bar, volatile LAS unsigned* st) {
  XcdBarrier b; b.bar = bar; b.x = xb_xcc_id(); b.st = st;
  if (threadIdx.x == 0) st[2] = xb_add(&bar[XB_XCNT(b.x)], 1u);
  return b;
}
DEV void xcd_barrier_complete(unsigned* bar, unsigned x, unsigned& nloc, unsigned& nx) {
  const unsigned G = gridDim.x * gridDim.y * gridDim.z;
  unsigned sum, cnt, mine, sp = 0u;
  for (;;) {
    sum = 0u; cnt = 0u; mine = 0u;
#pragma unroll
    for (unsigned j = 0; j < 16; ++j) { const unsigned c = xb_ld(&bar[XB_XCNT(j)]); sum += c; cnt += (c > 0u) ? 1u : 0u; mine = (j == x) ? c : mine; }
    if (sum == G) break;
    __builtin_amdgcn_s_sleep(1);
    if ((++sp & 255u) == 0u) { if (xb_ld(&bar[XB_TMO])) break; if (sp > XB_SPIN_CAP) { atomicAdd(&bar[XB_TMO], 1u); break; } }
  }
  nloc = mine > 0u ? mine : 1u; nx = cnt > 0u ? cnt : 1u;
}
DEV void xcd_barrier(const XcdBarrier& b) {
  asm volatile("s_waitcnt vmcnt(0)" ::: "memory");
  __syncthreads();
  if (threadIdx.x == 0) {
    unsigned* bar = b.bar;
    __builtin_amdgcn_s_waitcnt(0);
    unsigned nloc = b.st[0], nx = b.st[1];
    if (nloc == 0u) { xcd_barrier_complete(bar, b.x, nloc, nx); b.st[0] = nloc; b.st[1] = nx; }
    const unsigned old = xb_add(&bar[XB_XSUB(b.x)], 1u);
    const unsigned gen = old / nloc;
    if (old + 1u == (gen + 1u) * nloc) {
      __builtin_amdgcn_fence(__ATOMIC_RELEASE, "agent");
      asm volatile("s_waitcnt vmcnt(0)" ::: "memory");
      const unsigned og = xb_add(&bar[XB_TOP], 1u);
      const unsigned tg = og / nx;
      if (og + 1u == (tg + 1u) * nx) xb_add(&bar[XB_TOPGEN], 1u);
      else XB_SPIN(xb_ld(&bar[XB_TOPGEN]) == tg, bar);
      __builtin_amdgcn_fence(__ATOMIC_ACQUIRE, "agent");
      xb_add(&bar[XB_XGEN(b.x)], 1u);
      asm volatile("s_waitcnt vmcnt(0)" ::: "memory");
    } else {
      XB_SPIN(xb_ld(&bar[XB_XGEN(b.x)]) == gen, bar);
      __builtin_amdgcn_fence(__ATOMIC_ACQUIRE, "agent");
      asm volatile("s_waitcnt vmcnt(0)" ::: "memory");
    }
  }
  __syncthreads();
}

DEV const float* xrow_ptr(const Params& p, int l, int row) {
  if (l == 0) return row < 4096 ? p.in[I_XP] + (size_t)row * DM : p.in[I_XS] + (size_t)(row - 4096) * DM;
  return p.out + (size_t)row * DM;
}
DEV int modrow(int row) { return row < 4096 ? 0 : 1 + ((row - 4096) >> 10); }

struct ALPlain {
  const bf16_t* base; int ld;
  DEV u32x4 operator()(int row, int k) const { return *(const u32x4*)(base + (size_t)row * ld + k); }
};
struct ALScaled {
  const bf16_t* base; int ld; const float* rs; const float* g;
  DEV u32x4 operator()(int row, int k) const {
    u32x4 v = *(const u32x4*)(base + (size_t)row * ld + k);
    float f[8]; unpack8(v, f);
    const float r = rs[row];
    const f32x4 g0 = *(const f32x4*)(g + k), g1 = *(const f32x4*)(g + k + 4);
    f[0] *= r * g0.x; f[1] *= r * g0.y; f[2] *= r * g0.z; f[3] *= r * g0.w;
    f[4] *= r * g1.x; f[5] *= r * g1.y; f[6] *= r * g1.z; f[7] *= r * g1.w;
    return pack8(f);
  }
};
struct ALF32 {
  const float* base; int ld;
  DEV u32x4 operator()(int row, int k) const {
    const f32x4 a = *(const f32x4*)(base + (size_t)row * ld + k);
    const f32x4 b = *(const f32x4*)(base + (size_t)row * ld + k + 4);
    u32x4 v; v.x = pack2(a.x, a.y); v.y = pack2(a.z, a.w); v.z = pack2(b.x, b.y); v.w = pack2(b.z, b.w); return v;
  }
};

template <int TN>
DEV void gemm_compute(const bf16_t* As, const bf16_t* Bs, f32x4 (&acc)[4][TN / 32], int wm, int wn, int l16, int quad) {
  constexpr int NF = TN / 32;
#pragma unroll
  for (int ks = 0; ks < 2; ks++) {
    bf16x8 a[4], b[NF];
#pragma unroll
    for (int mi = 0; mi < 4; mi++) a[mi] = *(const bf16x8*)(As + (wm * 64 + mi * 16 + l16) * 72 + ks * 32 + quad * 8);
#pragma unroll
    for (int ni = 0; ni < NF; ni++) b[ni] = *(const bf16x8*)(Bs + (wn * (TN / 2) + ni * 16 + l16) * 72 + ks * 32 + quad * 8);
#pragma unroll
    for (int mi = 0; mi < 4; mi++)
#pragma unroll
      for (int ni = 0; ni < NF; ni++) acc[mi][ni] = MFMA(a[mi], b[ni], acc[mi][ni]);
  }
}
template <int TN, class AL>
DEV void gemm_core(const AL& al, const bf16_t* __restrict__ Bt, int ldb, int K, f32x4 (&acc)[4][TN / 32], char* lds) {
  constexpr int BUF = (128 + TN) * 72;
  constexpr int NF = TN / 32;
  bf16_t* L0 = (bf16_t*)lds;
  bf16_t* L1 = L0 + BUF;
  const int tid = otid(), lane = tid & 63, wave = tid >> 6;
  const int wm = wave >> 1, wn = wave & 1, l16 = lane & 15, quad = lane >> 4;
  u32x4 a0[4], b0[NF], a1[4], b1[NF];
#define G_LOAD(RA, RB, KK) { _Pragma("unroll") for (int i = 0; i < 4; i++) { int it = tid + 256 * i; RA[i] = al(it >> 3, (KK) + (it & 7) * 8); } \
                             _Pragma("unroll") for (int i = 0; i < NF; i++) { int it = tid + 256 * i; RB[i] = *(const u32x4*)(Bt + (size_t)(it >> 3) * ldb + (KK) + (it & 7) * 8); } }
#define G_STORE(LB, RA, RB) { _Pragma("unroll") for (int i = 0; i < 4; i++) { int it = tid + 256 * i; *(u32x4*)((LB) + (it >> 3) * 72 + (it & 7) * 8) = RA[i]; } \
                              _Pragma("unroll") for (int i = 0; i < NF; i++) { int it = tid + 256 * i; *(u32x4*)((LB) + 128 * 72 + (it >> 3) * 72 + (it & 7) * 8) = RB[i]; } }
  G_LOAD(a0, b0, 0);
  G_LOAD(a1, b1, 64);
  __syncthreads();
  G_STORE(L0, a0, b0);
  __syncthreads();
  for (int k0 = 0; k0 + 128 < K; k0 += 128) {
    G_LOAD(a0, b0, k0 + 128);
    __builtin_amdgcn_sched_barrier(0);
    gemm_compute<TN>(L0, L0 + 128 * 72, acc, wm, wn, l16, quad);
    G_STORE(L1, a1, b1);
    __syncthreads();
    G_LOAD(a1, b1, k0 + 192);
    __builtin_amdgcn_sched_barrier(0);
    gemm_compute<TN>(L1, L1 + 128 * 72, acc, wm, wn, l16, quad);
    G_STORE(L0, a0, b0);
    __syncthreads();
  }
  gemm_compute<TN>(L0, L0 + 128 * 72, acc, wm, wn, l16, quad);
  G_STORE(L1, a1, b1);
  __syncthreads();
  gemm_compute<TN>(L1, L1 + 128 * 72, acc, wm, wn, l16, quad);
#undef G_LOAD
#undef G_STORE
}

template <int TN>
DEV void acc_to_lds(f32x4 (&acc)[4][TN / 32], float* Cs) {
  const int tid = otid(), lane = tid & 63, wave = tid >> 6;
  const int wm = wave >> 1, wn = wave & 1, l16 = lane & 15, quad = lane >> 4;
  __syncthreads();
#pragma unroll
  for (int mi = 0; mi < 4; mi++)
#pragma unroll
    for (int ni = 0; ni < TN / 32; ni++)
#pragma unroll
      for (int j = 0; j < 4; j++)
        Cs[(wm * 64 + mi * 16 + quad * 4 + j) * (TN + 4) + wn * (TN / 2) + ni * 16 + l16] = acc[mi][ni][j];
  __syncthreads();
}
template <int NF>
DEV void zero_acc(f32x4 (&acc)[4][NF]) {
#pragma unroll
  for (int mi = 0; mi < 4; mi++)
#pragma unroll
    for (int ni = 0; ni < NF; ni++) acc[mi][ni] = f32x4{0.f, 0.f, 0.f, 0.f};
}

DEV void transpose_tile(const float* __restrict__ src, int ld, int col0, int ncols, int K, bf16_t* dst, int nt, int kt, float* tile) {
  const int tid = otid();
  const int n = tid & 63, kk = tid >> 6, gn = nt * 64 + n;
#pragma unroll
  for (int i = 0; i < 16; i++) {
    int k = kk + 4 * i;
    float v = (gn < ncols) ? src[(size_t)(kt * 64 + k) * ld + col0 + gn] : 0.f;
    tile[k * 65 + n] = v;
  }
  __syncthreads();
#pragma unroll
  for (int i = 0; i < 2; i++) {
    int it = tid + 256 * i, nn = it >> 3, kg = it & 7;
    float f[8];
#pragma unroll
    for (int j = 0; j < 8; j++) f[j] = tile[(kg * 8 + j) * 65 + nn];
    *(u32x4*)(dst + (size_t)(nt * 64 + nn) * K + kt * 64 + kg * 8) = pack8(f);
  }
}
#define NCONV_TASKS 2760
DEV void convert_task(const Params& p, int l, int t, char* lds) {
  char* ws_ = p.ws; asm volatile("" : "+s"(ws_));
  float* tile = (float*)lds;
  char* ws = ws_;
  if (t < 1216) { transpose_tile(p.in[I_WIN] + (size_t)l * 1024 * DIN, DIN, 0, 4784, 1024, (bf16_t*)(ws + OFF_WTA), t % 76, t / 76, tile); return; }
  t -= 1216;
  if (t < 768) { transpose_tile(p.in[I_WIN] + (size_t)l * 1024 * DIN, DIN, 4784, 3072, 1024, (bf16_t*)(ws + OFF_WGL), t % 48, t / 48, tile); return; }
  t -= 768;
  if (t < 72) { transpose_tile(p.in[I_WUQ] + (size_t)l * 384 * 768, 768, 0, 768, 384, (bf16_t*)(ws + OFF_WUQ), t % 12, t / 12, tile); return; }
  t -= 72;
  if (t < 64) { transpose_tile(p.in[I_WUKV] + (size_t)l * 256 * 1024, 1024, 0, 1024, 256, (bf16_t*)(ws + OFF_WUKV), t % 16, t / 16, tile); return; }
  t -= 64;
  if (t < 384) {
    int n = t / 128, tt = t % 128;
    transpose_tile(p.in[I_WBR] + (size_t)(l * 3 + n) * 512 * 1024, 1024, 0, 1024, 512, (bf16_t*)(ws + OFF_WBR) + (size_t)n * 1024 * 512, tt % 16, tt / 16, tile);
    return;
  }
  t -= 384;
  transpose_tile(p.in[I_WO] + (size_t)l * 1024 * 1024, 1024, 0, 1024, 1024, (bf16_t*)(ws + OFF_WO), t % 16, t / 16, tile);
}
DEV void mod_task(const Params& p, int t, char* lds) {
  char* ws_ = p.ws; asm volatile("" : "+s"(ws_));
  const int tid = otid();
  const int l = t / 192, n0 = (t % 192) * 16;
  float* s = (float*)lds;
  float* red = (float*)(lds + 32768);
  for (int idx = tid; idx < 5120; idx += 256) {
    int r = idx >> 10, k = idx & 1023;
    float v = (r == 0) ? p.in[I_CCTX][k] : p.in[I_C][(r - 1) * 1024 + k];
    s[idx] = v * frcp(1.f + __expf(-v));
  }
  __syncthreads();
  const int col = tid & 15, ksl = tid >> 4;
  float acc[5] = {0.f, 0.f, 0.f, 0.f, 0.f};
  const float* w = p.in[I_WMOD] + (size_t)l * 1024 * 3072 + n0 + col;
#pragma unroll 16
  for (int k = ksl * 64; k < ksl * 64 + 64; k++) {
    float wv = w[(size_t)k * 3072];
#pragma unroll
    for (int r = 0; r < 5; r++) acc[r] += s[r * 1024 + k] * wv;
  }
#pragma unroll
  for (int r = 0; r < 5; r++) red[(ksl * 5 + r) * 16 + col] = acc[r];
  __syncthreads();
  float* mod = (float*)(ws_ + OFF_MOD);
  if (tid < 80) {
    int r = tid >> 4, c = tid & 15;
    float v = p.in[I_BMOD][l * 3072 + n0 + c];
#pragma unroll
    for (int q = 0; q < 16; q++) v += red[(q * 5 + r) * 16 + c];
    mod[(l * 5 + r) * 3072 + n0 + c] = v;
  }
}

DEV void norm_task(const Params& p, int l, int t) {
  char* ws_ = p.ws; asm volatile("" : "+s"(ws_));
  const int tid = otid(), lane = tid & 63, wave = tid >> 6;
  const float* mod = (const float*)(ws_ + OFF_MOD);
  bf16_t* H = (bf16_t*)(ws_ + OFF_H);
#pragma unroll
  for (int rr = 0; rr < 2; rr++) {
    const int row = t * 8 + wave * 2 + rr;
    const float* x = xrow_ptr(p, l, row);
    const float* mr = mod + (size_t)(l * 5 + modrow(row)) * 3072;
    f32x4 v[4];
    float ss = 0.f;
#pragma unroll
    for (int i = 0; i < 4; i++) { v[i] = *(const f32x4*)(x + lane * 4 + 256 * i); ss += v[i].x * v[i].x + v[i].y * v[i].y + v[i].z * v[i].z + v[i].w * v[i].w; }
#pragma unroll
    for (int o = 32; o >= 1; o >>= 1) ss += __shfl_xor(ss, o);
    const float rstd = __builtin_amdgcn_rsqf(ss * (1.f / 1024.f) + EPSF);
#pragma unroll
    for (int i = 0; i < 4; i++) {
      const int col = lane * 4 + 256 * i;
      const f32x4 g = *(const f32x4*)(p.in[I_NORMG] + l * 1024 + col);
      const f32x4 sh = *(const f32x4*)(mr + col);
      const f32x4 sc = *(const f32x4*)(mr + 1024 + col);
      float a = v[i].x * rstd * g.x * (1.f + sc.x) + sh.x;
      float b = v[i].y * rstd * g.y * (1.f + sc.y) + sh.y;
      float c = v[i].z * rstd * g.z * (1.f + sc.z) + sh.z;
      float d = v[i].w * rstd * g.w * (1.f + sc.w) + sh.w;
      *(u32x2*)(H + (size_t)row * 1024 + col) = pack4(a, b, c, d);
    }
  }
}

DEV void projA_task(const Params& p, int l, int t, char* lds) {
  char* ws_ = p.ws; asm volatile("" : "+s"(ws_));
  const int tid = otid();
  const int nt = t / 64, mt = t % 64;
  f32x4 acc[4][4]; zero_acc<4>(acc);
  ALPlain al{(const bf16_t*)(ws_ + OFF_H) + (size_t)mt * 128 * 1024, 1024};
  gemm_core<128>(al, (const bf16_t*)(ws_ + OFF_WTA) + (size_t)nt * 128 * 1024, 1024, 1024, acc, lds);
  float* Cs = (float*)lds;
  acc_to_lds<128>(acc, Cs);
  bf16_t* P1 = (bf16_t*)(ws_ + OFF_P1);
  bf16_t* P2 = (bf16_t*)(ws_ + OFF_P2);
  bf16_t* P3 = (bf16_t*)(ws_ + OFF_P3);
  float* GAB = (float*)(ws_ + OFF_GAB);
#pragma unroll
  for (int i = 0; i < 8; i++) {
    const int it = tid + 256 * i, r = it >> 4, c8 = it & 15;
    const int n = nt * 128 + c8 * 8;
    if (n >= 4784) continue;
    const int row = mt * 128 + r;
    float f[8];
    const f32x4 a = *(const f32x4*)(Cs + r * 132 + c8 * 8);
    const f32x4 b = *(const f32x4*)(Cs + r * 132 + c8 * 8 + 4);
    f[0] = a.x; f[1] = a.y; f[2] = a.z; f[3] = a.w; f[4] = b.x; f[5] = b.y; f[6] = b.z; f[7] = b.w;
    if (n >= 2720 && n < 2736) {
      *(f32x4*)(GAB + (size_t)row * 16 + (n - 2720)) = a;
      *(f32x4*)(GAB + (size_t)row * 16 + (n - 2720) + 4) = b;
      continue;
    }
    if (n >= 640 && n < 672 && row < 4096) {
      float* o = p.out + OUT_KROPE + ((size_t)((row >> 8) * 2 + l) * 256 + (row & 255)) * 32 + (n - 640);
      *(f32x4*)o = a; *(f32x4*)(o + 4) = b;
    }
    bf16_t* dst;
    if (n < 672) dst = P1 + (size_t)row * P1W + n;
    else if (n < 1184) dst = P2 + (size_t)row * P2W + (n - 672);
    else if (n < 2720) dst = P1 + (size_t)row * P1W + 672 + (n - 1184);
    else if (n < 3248) dst = P2 + (size_t)row * P2W + 512 + (n - 2736);
    else if (n < 3760) dst = P3 + (size_t)row * P3W + (n - 3248);
    else if (n < 4272) dst = P3 + (size_t)row * P3W + 512 + (n - 3760);
    else dst = P2 + (size_t)row * P2W + 1024 + (n - 4272);
    *(u32x4*)dst = pack8(f);
  }
}

DEV void rope32(float* r, int prow, int pcol) {
  const float inv[8] = {1.f, 0.31622776601683794f, 0.1f, 0.031622776601683794f, 0.01f, 0.0031622776601683794f, 0.001f, 0.00031622776601683794f};
#pragma unroll
  for (int i = 0; i < 8; i++) {
    float a1 = (float)prow * inv[i], a2 = (float)pcol * inv[i];
    float c1 = __cosf(a1), s1 = __sinf(a1), c2 = __cosf(a2), s2 = __sinf(a2);
    float x1 = r[i], x2 = r[8 + i];
    r[i] = x1 * c1 - x2 * s1; r[8 + i] = x1 * s1 + x2 * c1;
    float y1 = r[16 + i], y2 = r[24 + i];
    r[16 + i] = y1 * c2 - y2 * s2; r[24 + i] = y1 * s2 + y2 * c2;
  }
}
DEV void finish_qk(float* v  , int half, const float* normw  , bool do_rope, int pos, float scale, bf16_t* dst  ) {
  float ss = 0.f;
#pragma unroll
  for (int i = 0; i < 48; i++) ss += v[i] * v[i];
  ss += __shfl_xor(ss, 1);
  const float rstd = __builtin_amdgcn_rsqf(ss * (1.f / 96.f) + EPSF);
#pragma unroll
  for (int i = 0; i < 12; i++) {
    const f32x4 w = *(const f32x4*)(normw + half * 48 + i * 4);
    v[i * 4] *= rstd * w.x; v[i * 4 + 1] *= rstd * w.y; v[i * 4 + 2] *= rstd * w.z; v[i * 4 + 3] *= rstd * w.w;
  }
  if (do_rope && half == 1) rope32(v + 16, pos >> 6, pos & 63);
#pragma unroll
  for (int i = 0; i < 6; i++) {
    float f[8];
#pragma unroll
    for (int j = 0; j < 8; j++) f[j] = v[i * 8 + j] * scale;
    *(u32x4*)(dst + half * 48 + i * 8) = pack8(f);
  }
}

#define QSCALE 0.14724306f
DEV void q_task(const Params& p, int l, int t, char* lds) {
  char* ws_ = p.ws; asm volatile("" : "+s"(ws_));
  const int tid = otid();
  const int mt = t & 63, h = t >> 6;
  const bf16_t* P1 = (const bf16_t*)(ws_ + OFF_P1);
  float* rs = (float*)(lds + LDS_SMALL);
  {
    const int row = tid >> 1, half = tid & 1;
    const bf16_t* src = P1 + (size_t)(mt * 128 + row) * P1W + half * 192;
    float ss = 0.f;
#pragma unroll 12
    for (int i = 0; i < 24; i++) { float f[8]; unpack8(*(const u32x4*)(src + i * 8), f);
#pragma unroll
      for (int j = 0; j < 8; j++) ss += f[j] * f[j]; }
    ss += __shfl_xor(ss, 1);
    if (!half) rs[row] = __builtin_amdgcn_rsqf(ss * (1.f / 384.f) + EPSF);
  }
  __syncthreads();
  f32x4 acc[4][3]; zero_acc<3>(acc);
  ALScaled al{P1 + (size_t)mt * 128 * P1W, P1W, rs, p.in[I_QAN] + l * 384};
  gemm_core<96>(al, (const bf16_t*)(ws_ + OFF_WUQ) + (size_t)h * 96 * 384, 384, 384, acc, lds);
  float* Cs = (float*)lds;
  acc_to_lds<96>(acc, Cs);
  const int row = tid >> 1, half = tid & 1, grow = mt * 128 + row;
  float v[48];
#pragma unroll
  for (int i = 0; i < 48; i++) v[i] = Cs[row * 100 + half * 48 + i];
  finish_qk(v, half, p.in[I_QN] + l * 96, grow >= 4096, (grow - 4096) & 1023, QSCALE,
            (bf16_t*)(ws_ + OFF_Q) + ((size_t)grow * 8 + h) * 96);
}

DEV void kv_task(const Params& p, int l, int t, char* lds) {
  char* ws_ = p.ws; asm volatile("" : "+s"(ws_));
  const int tid = otid();
  const int h = t / 72, mt = t % 72;
  const bf16_t* P1 = (const bf16_t*)(ws_ + OFF_P1);
  float* rs = (float*)(lds + LDS_SMALL);
  f32x4 acc[4][4]; zero_acc<4>(acc);
  const bf16_t* Bt = (const bf16_t*)(ws_ + OFF_WUKV) + (size_t)h * 128 * 256;
  if (mt < 64) {
    {
      const int row = tid >> 1, half = tid & 1;
      const bf16_t* src = P1 + (size_t)(mt * 128 + row) * P1W + 384 + half * 128;
      float ss = 0.f;
#pragma unroll
      for (int i = 0; i < 16; i++) { float f[8]; unpack8(*(const u32x4*)(src + i * 8), f);
#pragma unroll
        for (int j = 0; j < 8; j++) ss += f[j] * f[j]; }
      ss += __shfl_xor(ss, 1);
      if (!half) rs[row] = __builtin_amdgcn_rsqf(ss * (1.f / 256.f) + EPSF);
    }
    __syncthreads();
    if (h == 0 && mt < 32) {
#pragma unroll 8
      for (int it = tid; it < 128 * 32; it += 256) {
        const int r = it >> 5, c8 = it & 31, row = mt * 128 + r;
        float f[8]; unpack8(*(const u32x4*)(P1 + (size_t)row * P1W + 384 + c8 * 8), f);
        const float rr = rs[r];
        const float* g = p.in[I_KVAN] + l * 256 + c8 * 8;
        float* o = p.out + OUT_CKV + ((size_t)((row >> 8) * 2 + l) * 256 + (row & 255)) * 256 + c8 * 8;
        *(f32x4*)o = f32x4{f[0] * rr * g[0], f[1] * rr * g[1], f[2] * rr * g[2], f[3] * rr * g[3]};
        *(f32x4*)(o + 4) = f32x4{f[4] * rr * g[4], f[5] * rr * g[5], f[6] * rr * g[6], f[7] * rr * g[7]};
      }
    }
    ALScaled al{P1 + (size_t)mt * 128 * P1W + 384, P1W, rs, p.in[I_KVAN] + l * 256};
    gemm_core<128>(al, Bt, 256, 256, acc, lds);
  } else {
    const int b = (mt - 64) >> 1, p0 = ((mt - 64) & 1) * 128;
    ALF32 al{p.in[I_CCKV] + ((size_t)(b * 2 + l) * 256 + p0) * 256, 256};
    gemm_core<128>(al, Bt, 256, 256, acc, lds);
  }
  float* Cs = (float*)lds;
  acc_to_lds<128>(acc, Cs);
  {
    const int row = tid >> 1, half = tid & 1;
    float v[48];
    int krow; bool do_rope = false; int pos = 0;
    if (mt < 64) {
      const int grow = mt * 128 + row;
      krow = grow; do_rope = grow >= 4096; pos = (grow - 4096) & 1023;
      if (half == 0) {
#pragma unroll
        for (int i = 0; i < 48; i++) v[i] = Cs[row * 132 + i];
      } else {
#pragma unroll
        for (int i = 0; i < 16; i++) v[i] = Cs[row * 132 + 48 + i];
        const bf16_t* kr = P1 + (size_t)grow * P1W + 640;
#pragma unroll
        for (int i = 0; i < 4; i++) { float f[8]; unpack8(*(const u32x4*)(kr + i * 8), f);
#pragma unroll
          for (int j = 0; j < 8; j++) v[16 + i * 8 + j] = f[j]; }
      }
    } else {
      const int b = (mt - 64) >> 1, pp = ((mt - 64) & 1) * 128 + row;
      krow = 8192 + b * 256 + pp;
      if (half == 0) {
#pragma unroll
        for (int i = 0; i < 48; i++) v[i] = Cs[row * 132 + i];
      } else {
#pragma unroll
        for (int i = 0; i < 16; i++) v[i] = Cs[row * 132 + 48 + i];
        const float* kr = p.in[I_CKR] + ((size_t)(b * 2 + l) * 256 + pp) * 32;
#pragma unroll
        for (int i = 0; i < 8; i++) { const f32x4 w = *(const f32x4*)(kr + i * 4); v[16 + i * 4] = w.x; v[17 + i * 4] = w.y; v[18 + i * 4] = w.z; v[19 + i * 4] = w.w; }
      }
    }
    finish_qk(v, half, p.in[I_KN] + l * 96, do_rope, pos, 1.f, (bf16_t*)(ws_ + OFF_K) + ((size_t)krow * 8 + h) * 96);
  }
  {
    size_t vbase; int Tk, key0;
    if (mt < 32) { const int b = mt >> 1; Tk = 256; key0 = (mt & 1) * 128; vbase = (size_t)(b * 8 + h) * 64 * 256; }
    else if (mt < 64) { const int b = (mt - 32) >> 3; Tk = 1280; key0 = 256 + ((mt - 32) & 7) * 128; vbase = VT_LAT_EL + (size_t)(b * 8 + h) * 64 * 1280; }
    else { const int b = (mt - 64) >> 1; Tk = 1280; key0 = ((mt - 64) & 1) * 128; vbase = VT_LAT_EL + (size_t)(b * 8 + h) * 64 * 1280; }
    bf16_t* Vt = (bf16_t*)(ws_ + OFF_VT) + vbase;
#pragma unroll
    for (int i = 0; i < 4; i++) {
      const int it = tid + 256 * i, dv = it & 63, kg = it >> 6;
      float f[8];
#pragma unroll
      for (int j = 0; j < 8; j++) f[j] = Cs[(kg * 8 + j) * 132 + 64 + dv];
      *(u32x4*)(Vt + (size_t)dv * Tk + key0 + kg * 8) = pack8(f);
    }
  }
}

DEV void conv_pass(const Params& p, int l, int seg, int h, int row0, int sbeg, int send, float* F, bf16_t* Vtile) {
  char* ws_ = p.ws; asm volatile("" : "+s"(ws_));
  const int tid = otid(), c8 = tid & 15, tg = tid >> 4;
  const bf16_t* src = (const bf16_t*)(ws_ + OFF_P1) + 672 + seg * 512 + h * 128 + c8 * 8;
  const float* cwp = p.in[I_CONVW] + (size_t)l * 5 * 1536 + seg * 512 + h * 128 + c8 * 8;
  float cw[5][8];
#pragma unroll
  for (int j = 0; j < 5; j++) {
    const f32x4 a = *(const f32x4*)(cwp + j * 1536), b = *(const f32x4*)(cwp + j * 1536 + 4);
    cw[j][0] = a.x; cw[j][1] = a.y; cw[j][2] = a.z; cw[j][3] = a.w; cw[j][4] = b.x; cw[j][5] = b.y; cw[j][6] = b.z; cw[j][7] = b.w;
  }
  const int t0 = row0 + tg * 4;
  u32x4 raw[8];
#pragma unroll
  for (int r = 0; r < 8; r++) {
    const int row = t0 - 2 + r;
    raw[r] = (row >= sbeg && row < send) ? *(const u32x4*)(src + (size_t)row * P1W) : u32x4{0u, 0u, 0u, 0u};
  }
  float acc[4][8];
#pragma unroll
  for (int tt = 0; tt < 4; tt++)
#pragma unroll
    for (int c = 0; c < 8; c++) acc[tt][c] = 0.f;
#pragma unroll
  for (int r = 0; r < 8; r++) {
    float f[8]; unpack8(raw[r], f);
#pragma unroll
    for (int tt = 0; tt < 4; tt++) {
      const int j = r - tt;
      if (j >= 0 && j < 5) {
#pragma unroll
        for (int c = 0; c < 8; c++) acc[tt][c] += cw[j][c] * f[c];
      }
    }
  }
#pragma unroll
  for (int tt = 0; tt < 4; tt++) {
    float y[8];
#pragma unroll
    for (int c = 0; c < 8; c++) y[c] = siluf(acc[tt][c]);
    if (F) {
#pragma unroll
      for (int c = 0; c < 8; c++) F[(tg * 4 + tt) * 129 + c8 * 8 + c] = y[c];
    } else {
      *(u32x4*)(Vtile + (tg * 4 + tt) * 136 + c8 * 8) = pack8(y);
    }
  }
}
DEV void l2norm_rows(const float* F, bf16_t* T) {
  const int tid = otid(), row = tid >> 2, part = tid & 3;
  float ss = 0.f;
#pragma unroll
  for (int i = 0; i < 32; i++) { float x = F[row * 129 + part * 32 + i]; ss += x * x; }
  ss += __shfl_xor(ss, 1); ss += __shfl_xor(ss, 2);
  const float inv = __builtin_amdgcn_rsqf(ss + EPSF);
#pragma unroll
  for (int i = 0; i < 32; i++) T[row * 136 + part * 32 + i] = f2bf(F[row * 129 + part * 32 + i] * inv);
}
DEV void mm64(const bf16_t* At, const bf16_t* Bt_, float* Out, int wave, int l16, int quad) {
  f32x4 acc[4];
#pragma unroll
  for (int ni = 0; ni < 4; ni++) acc[ni] = f32x4{0.f, 0.f, 0.f, 0.f};
#pragma unroll
  for (int ks = 0; ks < 4; ks++) {
    bf16x8 a = *(const bf16x8*)(At + (wave * 16 + l16) * 136 + ks * 32 + quad * 8);
#pragma unroll
    for (int ni = 0; ni < 4; ni++) {
      bf16x8 b = *(const bf16x8*)(Bt_ + (ni * 16 + l16) * 136 + ks * 32 + quad * 8);
      acc[ni] = MFMA(a, b, acc[ni]);
    }
  }
#pragma unroll
  for (int ni = 0; ni < 4; ni++)
#pragma unroll
    for (int j = 0; j < 4; j++) Out[(wave * 16 + quad * 4 + j) * 65 + ni * 16 + l16] = acc[ni][j];
}
DEV void gdn_prep_task(const Params& p, int l, int t, char* lds) {
  char* ws_ = p.ws; asm volatile("" : "+s"(ws_));
  const int tid = otid(), lane = tid & 63, wave = tid >> 6, l16 = lane & 15, quad = lane >> 4;
  const int chunk = t >> 2, h = t & 3, row0 = chunk * 64;
  int sbeg, send;
  if (row0 < 4096) { sbeg = row0 & ~255; send = sbeg + 256; } else { sbeg = 4096 + ((row0 - 4096) & ~1023); send = sbeg + 1024; }
  bf16_t* Kt = (bf16_t*)lds;
  bf16_t* Qt = Kt + 64 * 136;
  float* F = (float*)(lds + 34816);
  float* G = F;
  float* Pm = (float*)(lds + 34816 + 17408);
  float* Am = Pm;
  float* gcs = (float*)(lds + LDS_SMALL);
  float* betas = gcs + 128;
  const float* GAB = (const float*)(ws_ + OFF_GAB);
  if (tid < 128) {
    const int dir = tid >> 6, ip = tid & 63, tok = dir ? 63 - ip : ip, row = row0 + tok;
    const float ga = GAB[(size_t)row * 16 + dir * 4 + h], gb = GAB[(size_t)row * 16 + 8 + dir * 4 + h];
    const float a = __expf(p.in[I_ALOG][(l * 2 + dir) * 4 + h]);
    const float x = ga + p.in[I_DTB][(l * 2 + dir) * 4 + h];
    const float ex = __expf(fminf(x, 20.f));
    const float sp = x > 20.f ? x : (ex < 0.01f ? ex * (1.f - ex * (0.5f - ex * (1.f / 3.f))) : __logf(1.f + ex));
    float g = -a * sp;
#pragma unroll
    for (int off = 1; off < 64; off <<= 1) { float v = __shfl_up(g, off); if (ip >= off) g += v; }
    gcs[dir * 64 + ip] = g;
    betas[dir * 64 + ip] = frcp(1.f + __expf(-gb));
  }
  conv_pass(p, l, 1, h, row0, sbeg, send, F, nullptr);
  __syncthreads();
  l2norm_rows(F, Kt);
  __syncthreads();
  conv_pass(p, l, 0, h, row0, sbeg, send, F, nullptr);
  __syncthreads();
  l2norm_rows(F, Qt);
  __syncthreads();
  mm64(Qt, Kt, Pm, wave, l16, quad);
  bf16_t* recbase = (bf16_t*)(ws_ + OFF_GDN) + (size_t)(chunk * 4 + h) * 2 * REC_EL;
#pragma unroll 1
  for (int dir = 0; dir < 2; dir++) {
    bf16_t* rec = recbase + (size_t)dir * REC_EL;
    const float* gc = gcs + dir * 64;
    const float gl = gc[63];
#pragma unroll
    for (int i = 0; i < 4; i++) {
      const int it = tid + 256 * i, ip = it >> 4, c8 = it & 15, tok = dir ? 63 - ip : ip;
      const float sc = 0.08838834764831845f * __expf(gc[ip]);
      float f[8]; unpack8(*(const u32x4*)(Qt + tok * 136 + c8 * 8), f);
#pragma unroll
      for (int j = 0; j < 8; j++) f[j] *= sc;
      *(u32x4*)(rec + 8192 + ip * 128 + c8 * 8) = pack8(f);
    }
#pragma unroll
    for (int i = 0; i < 4; i++) {
      const int it = tid + 256 * i, d = it & 127, ig = it >> 7;
      float f[8];
#pragma unroll
      for (int j = 0; j < 8; j++) { const int ip = ig * 8 + j, tok = dir ? 63 - ip : ip; f[j] = bf2f(Kt[tok * 136 + d]) * __expf(gl - gc[ip]); }
      *(u32x4*)(rec + 20480 + d * 64 + ig * 8) = pack8(f);
    }
    if (tid == 0) ((float*)(ws_ + OFF_EGL))[(chunk * 4 + h) * 2 + dir] = __expf(gl);
  }
  __syncthreads();
  conv_pass(p, l, 2, h, row0, sbeg, send, nullptr, Qt);
#pragma unroll 1
  for (int dir = 0; dir < 2; dir++) {
    bf16_t* rec = recbase + (size_t)dir * REC_EL;
    const float* gc = gcs + dir * 64;
#pragma unroll
    for (int i = 0; i < 2; i++) {
      const int it = tid + 256 * i, ip = it >> 3, j8 = it & 7, ti = dir ? 63 - ip : ip;
      float f[8];
#pragma unroll
      for (int j = 0; j < 8; j++) {
        const int jp = j8 * 8 + j, tj = dir ? 63 - jp : jp;
        const float e = __expf(fminf(gc[ip] - gc[jp], 0.f));
        f[j] = (ip >= jp) ? Pm[ti * 65 + tj] * 0.08838834764831845f * e : 0.f;
      }
      *(u32x4*)(rec + 16384 + ip * 64 + j8 * 8) = pack8(f);
    }
  }
  __syncthreads();
  const bf16_t* Vtile = Qt;
  float* T = G;
#pragma unroll 1
  for (int dir = 0; dir < 2; dir++) {
    bf16_t* rec = recbase + (size_t)dir * REC_EL;
    const float* gc = gcs + dir * 64;
    const float* be = betas + dir * 64;
    mm64(Kt, Kt, G, wave, l16, quad);
    __syncthreads();
#pragma unroll 2
    for (int i = 0; i < 16; i++) {
      const int it = tid + 256 * i, ip = it >> 6, jp = it & 63;
      const int ti = dir ? 63 - ip : ip, tj = dir ? 63 - jp : jp;
      const float e = __expf(fminf(gc[ip] - gc[jp], 0.f));
      Am[ip * 68 + jp] = (ip > jp) ? be[ip] * G[ti * 65 + tj] * e : 0.f;
    }
    __syncthreads();
    {
      const int cl = lane >> 2, q = lane & 3, c = wave * 16 + cl;
      float r[16];
#pragma unroll
      for (int m = 0; m < 16; m++) r[m] = (q + 4 * m == c) ? 1.f : 0.f;
#pragma unroll
      for (int j = 0; j < 63; j++) {
        const int mj = j >> 2;
        float t;
        switch (j & 3) {
          case 0: t = __int_as_float(__builtin_amdgcn_update_dpp(0, __float_as_int(r[mj]), 0x00, 0xF, 0xF, true)); break;
          case 1: t = __int_as_float(__builtin_amdgcn_update_dpp(0, __float_as_int(r[mj]), 0x55, 0xF, 0xF, true)); break;
          case 2: t = __int_as_float(__builtin_amdgcn_update_dpp(0, __float_as_int(r[mj]), 0xAA, 0xF, 0xF, true)); break;
          default: t = __int_as_float(__builtin_amdgcn_update_dpp(0, __float_as_int(r[mj]), 0xFF, 0xF, 0xF, true)); break;
        }
#pragma unroll
        for (int m = mj; m < 16; m++) r[m] -= Am[(q + 4 * m) * 68 + j] * t;
        if ((j & 15) == 15) asm volatile("" ::: "memory");
      }
#pragma unroll
      for (int m = 0; m < 16; m++) T[(q + 4 * m) * 68 + c] = r[m];
    }
    __syncthreads();
#pragma unroll 1
    for (int which = 0; which < 2; which++) {
      const bf16_t* srcT = which ? Kt : Vtile;
      f32x4 ac[4][2];
      zero_acc<2>(ac);
#pragma unroll
      for (int ks = 0; ks < 2; ks++) {
        float cs[8];
        unsigned short e[2][8];
#pragma unroll
        for (int s = 0; s < 8; s++) {
          const int j = ks * 32 + quad * 8 + s, tok = dir ? 63 - j : j;
          cs[s] = which ? be[j] * __expf(gc[j]) : be[j];
#pragma unroll
          for (int nf = 0; nf < 2; nf++) e[nf][s] = srcT[tok * 136 + wave * 32 + nf * 16 + l16];
        }
        bf16x8 bfr[2];
#pragma unroll
        for (int nf = 0; nf < 2; nf++) {
          u32x4 v;
          v.x = e[nf][0] | ((unsigned)e[nf][1] << 16); v.y = e[nf][2] | ((unsigned)e[nf][3] << 16);
          v.z = e[nf][4] | ((unsigned)e[nf][5] << 16); v.w = e[nf][6] | ((unsigned)e[nf][7] << 16);
          bfr[nf] = as_frag(v);
        }
#pragma unroll
        for (int mi = 0; mi < 4; mi++) {
          const float* tr = T + (mi * 16 + l16) * 68 + ks * 32 + quad * 8;
          const f32x4 t0 = *(const f32x4*)tr, t1 = *(const f32x4*)(tr + 4);
          const float tv[8] = {t0.x, t0.y, t0.z, t0.w, t1.x, t1.y, t1.z, t1.w};
          float a[8], hi[8], lo[8];
#pragma unroll
          for (int s = 0; s < 8; s++) a[s] = tv[s] * cs[s];
          const u32x4 ph = pack8(a);
          unpack8(ph, hi);
#pragma unroll
          for (int s = 0; s < 8; s++) lo[s] = a[s] - hi[s];
          const bf16x8 fh = as_frag(ph), fl = as_frag(pack8(lo));
#pragma unroll
          for (int nf = 0; nf < 2; nf++) { ac[mi][nf] = MFMA(fh, bfr[nf], ac[mi][nf]); ac[mi][nf] = MFMA(fl, bfr[nf], ac[mi][nf]); }
        }
      }
      int qs = quad, ls = l16;
      asm volatile("" : "+v"(qs), "+v"(ls));
      bf16_t* dst = rec + (which ? 0 : 28672);
      const float sg = which ? -1.f : 1.f;
#pragma unroll
      for (int mi = 0; mi < 4; mi++)
#pragma unroll
        for (int nf = 0; nf < 2; nf++)
#pragma unroll
          for (int j = 0; j < 4; j++) {
            const int ip = mi * 16 + qs * 4 + j, col = wave * 32 + nf * 16 + ls;
            dst[ip * 128 + col] = f2bf(sg * ac[mi][nf][j]);
          }
    }
    __syncthreads();
  }
}

DEV void cmlp_task(const Params& p, int l, int t, char* lds) {
  char* ws_ = p.ws; asm volatile("" : "+s"(ws_));
  const int tid = otid(), lane = tid & 63, wave = tid >> 6, l16 = lane & 15, quad = lane >> 4;
  const int wm = wave >> 1, wn = wave & 1;
  const int c = t >> 2, g = t & 3, r0 = c * 128;
  const bf16_t* P3 = (const bf16_t*)(ws_ + OFF_P3);
  const bf16_t* P2 = (const bf16_t*)(ws_ + OFF_P2);
  bf16_t* BR = (bf16_t*)(ws_ + OFF_BR);
  bf16_t* VnT = (bf16_t*)lds;
  bf16_t* Ws = VnT + 128 * 136;
  float* mu = (float*)(lds + LDS_SMALL);
  float* rstd = mu + 128;
  {
    const int row = tid >> 1, half = tid & 1;
    const bf16_t* src = P3 + (size_t)(r0 + row) * P3W + 512 + half * 256;
    float s = 0.f, ss = 0.f;
#pragma unroll 16
    for (int i = 0; i < 32; i++) { float f[8]; unpack8(*(const u32x4*)(src + i * 8), f);
#pragma unroll
      for (int j = 0; j < 8; j++) { float y = geluf(f[j]); s += y; ss += y * y; } }
    s += __shfl_xor(s, 1); ss += __shfl_xor(ss, 1);
    const float mean = s * (1.f / 512.f), var = fmaxf(ss * (1.f / 512.f) - mean * mean, 0.f);
    if (!half) { mu[row] = mean; rstd[row] = __builtin_amdgcn_rsqf(var + EPSF); }
  }
  __syncthreads();
#pragma unroll
  for (int i = 0; i < 8; i++) {
    const int it = tid + 256 * i, q = it >> 4, c8 = it & 15;
    float f[8]; unpack8(*(const u32x4*)(P3 + (size_t)(r0 + q) * P3W + 512 + g * 128 + c8 * 8), f);
    const float m = mu[q], rs = rstd[q];
#pragma unroll
    for (int j = 0; j < 8; j++) {
      const int cc = c8 * 8 + j;
      const float val = (geluf(f[j]) - m) * rs * p.in[I_LNG][l * 512 + g * 128 + cc] + p.in[I_LNB][l * 512 + g * 128 + cc];
      VnT[cc * 136 + q] = f2bf(val);
    }
  }
#pragma unroll
  for (int i = 0; i < 16; i++) {
    const int it = tid + 256 * i, pp = it >> 5, q4 = it & 31;
    const f32x4 w = *(const f32x4*)(p.in[I_WS] + ((size_t)(l * 4 + g) * 128 + pp) * 128 + q4 * 4);
    *(u32x2*)(Ws + pp * 136 + q4 * 4) = pack4(w.x, w.y, w.z, w.w);
  }
  __syncthreads();
  f32x4 acc[4][4]; zero_acc<4>(acc);
#pragma unroll
  for (int ks = 0; ks < 4; ks++) {
    bf16x8 a[4], b[4];
#pragma unroll
    for (int mi = 0; mi < 4; mi++) a[mi] = *(const bf16x8*)(Ws + (wm * 64 + mi * 16 + l16) * 136 + ks * 32 + quad * 8);
#pragma unroll
    for (int ni = 0; ni < 4; ni++) b[ni] = *(const bf16x8*)(VnT + (wn * 64 + ni * 16 + l16) * 136 + ks * 32 + quad * 8);
#pragma unroll
    for (int mi = 0; mi < 4; mi++)
#pragma unroll
      for (int ni = 0; ni < 4; ni++) acc[mi][ni] = MFMA(a[mi], b[ni], acc[mi][ni]);
  }
  float* Cs = (float*)lds;
  __syncthreads();
#pragma unroll
  for (int mi = 0; mi < 4; mi++)
#pragma unroll
    for (int j = 0; j < 4; j++) {
      const int pp = wm * 64 + mi * 16 + quad * 4 + j;
      const float bias = p.in[I_BS][(l * 4 + g) * 128 + pp];
#pragma unroll
      for (int ni = 0; ni < 4; ni++) Cs[pp * 132 + wn * 64 + ni * 16 + l16] = acc[mi][ni][j] + bias;
    }
  __syncthreads();
  u32x4 uu[8], zz[8];
#pragma unroll
  for (int i = 0; i < 8; i++) {
    const int it = tid + 256 * i, r = it >> 4, c8 = it & 15;
    const size_t row = (size_t)(r0 + r);
    uu[i] = *(const u32x4*)(P3 + row * P3W + g * 128 + c8 * 8);
    zz[i] = *(const u32x4*)(P2 + row * P2W + 1024 + g * 128 + c8 * 8);
  }
#pragma unroll
  for (int i = 0; i < 8; i++) {
    const int it = tid + 256 * i, r = it >> 4, c8 = it & 15;
    float u[8], z[8], o[8];
    unpack8(uu[i], u); unpack8(zz[i], z);
    const f32x4 s0 = *(const f32x4*)(Cs + r * 132 + c8 * 8), s1 = *(const f32x4*)(Cs + r * 132 + c8 * 8 + 4);
    const float sv[8] = {s0.x, s0.y, s0.z, s0.w, s1.x, s1.y, s1.z, s1.w};
#pragma unroll
    for (int j = 0; j < 8; j++) o[j] = geluf(u[j]) * sv[j] * siluf(z[j]);
    *(u32x4*)(BR + (size_t)(r0 + r) * BRW + 1024 + g * 128 + c8 * 8) = pack8(o);
  }
}

DEV void attn_task(const Params& p, int l, int t, char* lds) {
  char* ws_ = p.ws; asm volatile("" : "+s"(ws_));
  const int tid = otid(), lane = tid & 63, wave = tid >> 6, l16 = lane & 15, quad = lane >> 4;
  int b, h, qrow0, nkt, Tk; size_t vtb;
  const bool lat = t < 256;
  if (lat) { b = t >> 6; h = (t >> 3) & 7; const int qb = t & 7; qrow0 = 4096 + b * 1024 + qb * 128; nkt = 20; Tk = 1280; vtb = VT_LAT_EL + (size_t)(b * 8 + h) * 64 * 1280; }
  else { const int tt = t - 256; b = tt >> 4; h = (tt >> 1) & 7; const int qb = tt & 1; qrow0 = b * 256 + qb * 128; nkt = 4; Tk = 256; vtb = (size_t)(b * 8 + h) * 64 * 256; }
  if (lat) __builtin_amdgcn_s_setprio(2);
  const bf16_t* Qg = (const bf16_t*)(ws_ + OFF_Q);
  const bf16_t* Kg = (const bf16_t*)(ws_ + OFF_K);
  const bf16_t* Vg = (const bf16_t*)(ws_ + OFF_VT) + vtb;
  bf16_t* Qs = (bf16_t*)lds;
  bf16_t* Ks = Qs + 128 * 104;
  bf16_t* Vs = Ks + 64 * 104;
#pragma unroll
  for (int i = 0; i < 6; i++) {
    const int it = tid + 256 * i, r = it / 12, cc = it % 12;
    *(u32x4*)(Qs + r * 104 + cc * 8) = *(const u32x4*)(Qg + ((size_t)(qrow0 + r) * 8 + h) * 96 + cc * 8);
  }
  __syncthreads();
  bf16x8 qf[2][3];
#pragma unroll
  for (int ni = 0; ni < 2; ni++)
#pragma unroll
    for (int ks = 0; ks < 3; ks++) qf[ni][ks] = *(const bf16x8*)(Qs + (wave * 32 + ni * 16 + l16) * 104 + ks * 32 + quad * 8);
  f32x4 o[4][2];
#pragma unroll
  for (int di = 0; di < 4; di++) { o[di][0] = f32x4{0.f, 0.f, 0.f, 0.f}; o[di][1] = f32x4{0.f, 0.f, 0.f, 0.f}; }
  float mrun[2] = {-1e30f, -1e30f}, lsum[2] = {0.f, 0.f};
  u32x4 pk[3], pv[2];
  {
    const int krow0 = lat ? (8192 + b * 256) : (b * 256);
#pragma unroll
    for (int i = 0; i < 3; i++) { const int it = tid + 256 * i, r = it / 12, cc = it % 12; pk[i] = *(const u32x4*)(Kg + ((size_t)(krow0 + r) * 8 + h) * 96 + cc * 8); }
#pragma unroll
    for (int i = 0; i < 2; i++) { const int it = tid + 256 * i, dv = it >> 3, kg = it & 7; pv[i] = *(const u32x4*)(Vg + (size_t)dv * Tk + kg * 8); }
  }
  for (int kt = 0; kt < nkt; kt++) {
    __syncthreads();
#pragma unroll
    for (int i = 0; i < 3; i++) { const int it = tid + 256 * i, r = it / 12, cc = it % 12; *(u32x4*)(Ks + r * 104 + cc * 8) = pk[i]; }
#pragma unroll
    for (int i = 0; i < 2; i++) { const int it = tid + 256 * i, dv = it >> 3, kg = it & 7; *(u32x4*)(Vs + dv * 72 + kg * 8) = pv[i]; }
    __syncthreads();
    if (kt + 1 < nkt) {
      const int kn = kt + 1;
      int krow0;
      if (lat) krow0 = (kn < 4) ? (8192 + b * 256 + kn * 64) : (4096 + b * 1024 + (kn - 4) * 64);
      else krow0 = b * 256 + kn * 64;
#pragma unroll
      for (int i = 0; i < 3; i++) { const int it = tid + 256 * i, r = it / 12, cc = it % 12; pk[i] = *(const u32x4*)(Kg + ((size_t)(krow0 + r) * 8 + h) * 96 + cc * 8); }
#pragma unroll
      for (int i = 0; i < 2; i++) { const int it = tid + 256 * i, dv = it >> 3, kg = it & 7; pv[i] = *(const u32x4*)(Vg + (size_t)dv * Tk + kn * 64 + kg * 8); }
    }
    __builtin_amdgcn_sched_barrier(0);
    f32x4 s[4][2];
#pragma unroll
    for (int mi = 0; mi < 4; mi++) { s[mi][0] = f32x4{0.f, 0.f, 0.f, 0.f}; s[mi][1] = f32x4{0.f, 0.f, 0.f, 0.f}; }
#pragma unroll
    for (int ks = 0; ks < 3; ks++)
#pragma unroll
      for (int mi = 0; mi < 4; mi++) {
        bf16x8 kf = *(const bf16x8*)(Ks + (mi * 16 + l16) * 104 + ks * 32 + quad * 8);
        s[mi][0] = MFMA(kf, qf[0][ks], s[mi][0]);
        s[mi][1] = MFMA(kf, qf[1][ks], s[mi][1]);
      }
#pragma unroll
    for (int ni = 0; ni < 2; ni++) {
      float mx = -1e30f;
#pragma unroll
      for (int mi = 0; mi < 4; mi++)
#pragma unroll
        for (int j = 0; j < 4; j++) mx = fmaxf(mx, s[mi][ni][j]);
      mx = fmaxf(mx, __shfl_xor(mx, 16)); mx = fmaxf(mx, __shfl_xor(mx, 32));
      const float mnew = fmaxf(mrun[ni], mx);
      const float alpha = __builtin_amdgcn_exp2f(mrun[ni] - mnew);
      mrun[ni] = mnew;
      float rsum = 0.f;
#pragma unroll
      for (int mi = 0; mi < 4; mi++)
#pragma unroll
        for (int j = 0; j < 4; j++) { float pv = __builtin_amdgcn_exp2f(s[mi][ni][j] - mnew); s[mi][ni][j] = pv; rsum += pv; }
      lsum[ni] = lsum[ni] * alpha + rsum;
#pragma unroll
      for (int di = 0; di < 4; di++) o[di][ni] *= alpha;
    }
#pragma unroll
    for (int g = 0; g < 2; g++) {
      bf16x8 pf0 = frag_from(s[2 * g][0], s[2 * g + 1][0]);
      bf16x8 pf1 = frag_from(s[2 * g][1], s[2 * g + 1][1]);
#pragma unroll
      for (int di = 0; di < 4; di++) {
        bf16x8 vf = ld2(Vs + (di * 16 + l16) * 72 + g * 32 + quad * 4);
        o[di][0] = MFMA(vf, pf0, o[di][0]);
        o[di][1] = MFMA(vf, pf1, o[di][1]);
      }
    }
  }
  const bf16_t* P2 = (const bf16_t*)(ws_ + OFF_P2);
  bf16_t* BR = (bf16_t*)(ws_ + OFF_BR);
#pragma unroll
  for (int ni = 0; ni < 2; ni++) {
    float lt = lsum[ni];
    lt += __shfl_xor(lt, 16); lt += __shfl_xor(lt, 32);
    const float inv = frcp(lt);
    const size_t qrow = (size_t)(qrow0 + wave * 32 + ni * 16 + l16);
#pragma unroll
    for (int di = 0; di < 4; di++) {
      const int col = h * 64 + di * 16 + quad * 4;
      float z[4]; unpack4(*(const u32x2*)(P2 + qrow * P2W + col), z);
      *(u32x2*)(BR + qrow * BRW + col) = pack4(o[di][ni][0] * inv * siluf(z[0]), o[di][ni][1] * inv * siluf(z[1]),
                                               o[di][ni][2] * inv * siluf(z[2]), o[di][ni][3] * inv * siluf(z[3]));
    }
  }
  __builtin_amdgcn_s_setprio(0);
}

struct ScanPf { u32x4 w[4], q[4], a[2], k[4], u[2]; float egl; };
DEV void scan_prefetch(ScanPf& f, const bf16_t* rec, const float* eglp, int half, int tid) {
#pragma unroll
  for (int i = 0; i < 4; i++) { const int c = tid + 256 * i; f.w[i] = *(const u32x4*)(rec + c * 8); f.q[i] = *(const u32x4*)(rec + 8192 + c * 8); f.k[i] = *(const u32x4*)(rec + 20480 + c * 8); }
#pragma unroll
  for (int i = 0; i < 2; i++) { const int c = tid + 256 * i; f.a[i] = *(const u32x4*)(rec + 16384 + c * 8); f.u[i] = *(const u32x4*)(rec + 28672 + (c >> 3) * 128 + half * 64 + (c & 7) * 8); }
  f.egl = *eglp;
}
DEV void gdn_scan_task(const Params& p, int l, int t, char* lds) {
  char* ws_ = p.ws; asm volatile("" : "+s"(ws_));
  const int tid = otid(), lane = tid & 63, wave = tid >> 6, l16 = lane & 15, quad = lane >> 4;
  __builtin_amdgcn_s_setprio(3);
  int chain, half, b, chunk0, N; bool lat = t < 64;
  if (lat) { chain = t >> 1; half = t & 1; } else { chain = (t - 64) >> 1; half = (t - 64) & 1; }
  const int dir = chain & 1, h = (chain >> 1) & 3;
  b = chain >> 3;
  if (lat) { chunk0 = 64 + b * 16; N = 16; } else { chunk0 = b * 4; N = 4; }
  const int e0 = (half * 4 + wave) * 16;
  bf16_t* Wl = (bf16_t*)lds;
  bf16_t* Ql = Wl + 64 * 136;
  bf16_t* Al = Ql + 64 * 136;
  bf16_t* Kl = Al + 64 * 72;
  bf16_t* Ul = Kl + 128 * 72;
  f32x4 S[8];
  if (lat) {
    const float* s0 = p.in[I_SGDN] + ((size_t)((b * 2 + l) * 2 + dir) * 4 + h) * 16384;
#pragma unroll
    for (int mf = 0; mf < 8; mf++)
#pragma unroll
      for (int j = 0; j < 4; j++) S[mf][j] = s0[(mf * 16 + quad * 4 + j) * 128 + e0 + l16];
  } else {
#pragma unroll
    for (int mf = 0; mf < 8; mf++) S[mf] = f32x4{0.f, 0.f, 0.f, 0.f};
  }
  float* OD = (float*)(ws_ + OFF_ODIR) + (size_t)dir * NTOK * 512;
  const float* EGL = (const float*)(ws_ + OFF_EGL);
  const bf16_t* GD = (const bf16_t*)(ws_ + OFF_GDN);
  ScanPf pf;
  {
    const int cidx = chunk0 + (dir ? N - 1 : 0);
    scan_prefetch(pf, GD + ((size_t)(cidx * 4 + h) * 2 + dir) * REC_EL, EGL + (cidx * 4 + h) * 2 + dir, half, tid);
  }
#pragma unroll 1
  for (int n = 0; n < N; n++) {
    const int cidx = chunk0 + (dir ? N - 1 - n : n);
    __syncthreads();
#pragma unroll
    for (int i = 0; i < 4; i++) {
      const int c = tid + 256 * i;
      *(u32x4*)(Wl + (c >> 4) * 136 + (c & 15) * 8) = pf.w[i];
      *(u32x4*)(Ql + (c >> 4) * 136 + (c & 15) * 8) = pf.q[i];
      *(u32x4*)(Kl + (c >> 3) * 72 + (c & 7) * 8) = pf.k[i];
    }
#pragma unroll
    for (int i = 0; i < 2; i++) {
      const int c = tid + 256 * i;
      *(u32x4*)(Al + (c >> 3) * 72 + (c & 7) * 8) = pf.a[i];
      *(u32x4*)(Ul + (c >> 3) * 72 + (c & 7) * 8) = pf.u[i];
    }
    const float egl = pf.egl;
    __syncthreads();
    if (n + 1 < N) {
      const int cn = chunk0 + (dir ? N - 2 - n : n + 1);
      scan_prefetch(pf, GD + ((size_t)(cn * 4 + h) * 2 + dir) * REC_EL, EGL + (cn * 4 + h) * 2 + dir, half, tid);
    }
    __builtin_amdgcn_sched_barrier(0);
    bf16x8 Sb[4];
#pragma unroll
    for (int ks = 0; ks < 4; ks++) Sb[ks] = frag_from(S[2 * ks], S[2 * ks + 1]);
    f32x4 vn[4];
#pragma unroll
    for (int mi = 0; mi < 4; mi++)
#pragma unroll
      for (int j = 0; j < 4; j++) vn[mi][j] = bf2f(Ul[(mi * 16 + quad * 4 + j) * 72 + wave * 16 + l16]);
#pragma unroll
    for (int mi = 0; mi < 4; mi++)
#pragma unroll
      for (int ks = 0; ks < 4; ks++) vn[mi] = MFMA(ld2(Wl + (mi * 16 + l16) * 136 + ks * 32 + quad * 4), Sb[ks], vn[mi]);
    bf16x8 vb[2];
    vb[0] = frag_from(vn[0], vn[1]); vb[1] = frag_from(vn[2], vn[3]);
#pragma unroll
    for (int mi = 0; mi < 4; mi++) {
      f32x4 o = f32x4{0.f, 0.f, 0.f, 0.f};
#pragma unroll
      for (int ks = 0; ks < 4; ks++) o = MFMA(ld2(Ql + (mi * 16 + l16) * 136 + ks * 32 + quad * 4), Sb[ks], o);
#pragma unroll
      for (int k2 = 0; k2 < 2; k2++) o = MFMA(ld2(Al + (mi * 16 + l16) * 72 + k2 * 32 + quad * 4), vb[k2], o);
#pragma unroll
      for (int j = 0; j < 4; j++) {
        const int ip = mi * 16 + quad * 4 + j, tok = dir ? 63 - ip : ip;
        OD[(size_t)(cidx * 64 + tok) * 512 + h * 128 + e0 + l16] = o[j];
      }
    }
#pragma unroll
    for (int mf = 0; mf < 8; mf++) {
      S[mf] *= egl;
#pragma unroll
      for (int k2 = 0; k2 < 2; k2++) S[mf] = MFMA(ld2(Kl + (mf * 16 + l16) * 72 + k2 * 32 + quad * 4), vb[k2], S[mf]);
    }
  }
  if (!lat) {
    float* so = p.out + OUT_STATE + ((size_t)((b * 2 + l) * 2 + dir) * 4 + h) * 16384;
#pragma unroll
    for (int mf = 0; mf < 8; mf++)
#pragma unroll
      for (int j = 0; j < 4; j++) so[(mf * 16 + quad * 4 + j) * 128 + e0 + l16] = S[mf][j];
  }
  __builtin_amdgcn_s_setprio(0);
}

DEV void onorm_task(const Params& p, int l, int t) {
  char* ws_ = p.ws; asm volatile("" : "+s"(ws_));
  const int tid = otid(), lane = tid & 63, wave = tid >> 6;
  const float* OD = (const float*)(ws_ + OFF_ODIR);
  const bf16_t* P2 = (const bf16_t*)(ws_ + OFF_P2);
  bf16_t* BR = (bf16_t*)(ws_ + OFF_BR);
#pragma unroll
  for (int rr = 0; rr < 4; rr++) {
    const size_t row = (size_t)t * 16 + wave * 4 + rr;
    const f32x4 a0 = *(const f32x4*)(OD + row * 512 + lane * 8), a1 = *(const f32x4*)(OD + row * 512 + lane * 8 + 4);
    const f32x4 b0 = *(const f32x4*)(OD + (NTOK + row) * 512 + lane * 8), b1 = *(const f32x4*)(OD + (NTOK + row) * 512 + lane * 8 + 4);
    float x[8] = {a0.x + b0.x, a0.y + b0.y, a0.z + b0.z, a0.w + b0.w, a1.x + b1.x, a1.y + b1.y, a1.z + b1.z, a1.w + b1.w};
    float ss = 0.f;
#pragma unroll
    for (int i = 0; i < 8; i++) ss += x[i] * x[i];
#pragma unroll
    for (int o = 8; o >= 1; o >>= 1) ss += __shfl_xor(ss, o);
    const float rstd = __builtin_amdgcn_rsqf(ss * (1.f / 128.f) + EPSF);
    float z[8]; unpack8(*(const u32x4*)(P2 + row * P2W + 512 + lane * 8), z);
    const float* g = p.in[I_ONORM] + l * 128 + (lane & 15) * 8;
    float y[8];
#pragma unroll
    for (int i = 0; i < 8; i++) y[i] = x[i] * rstd * g[i] * siluf(z[i]);
    *(u32x4*)(BR + row * BRW + 512 + lane * 8) = pack8(y);
  }
}

DEV void gate_task(const Params& p, int l, int t, char* lds) {
  char* ws_ = p.ws; asm volatile("" : "+s"(ws_));
  const int tid = otid();
  const int nt = t / 64, mt = t % 64;
  f32x4 acc[4][4]; zero_acc<4>(acc);
  ALPlain al{(const bf16_t*)(ws_ + OFF_H) + (size_t)mt * 128 * 1024, 1024};
  gemm_core<128>(al, (const bf16_t*)(ws_ + OFF_WGL) + (size_t)nt * 128 * 1024, 1024, 1024, acc, lds);
  float* Cs = (float*)lds;
  acc_to_lds<128>(acc, Cs);
  bf16_t* GT = (bf16_t*)(ws_ + OFF_GDN);
#pragma unroll
  for (int i = 0; i < 8; i++) {
    const int it = tid + 256 * i, r = it >> 4, c8 = it & 15;
    const f32x4 a = *(const f32x4*)(Cs + r * 132 + c8 * 8), b = *(const f32x4*)(Cs + r * 132 + c8 * 8 + 4);
    float f[8] = {sigmf(a.x), sigmf(a.y), sigmf(a.z), sigmf(a.w), sigmf(b.x), sigmf(b.y), sigmf(b.z), sigmf(b.w)};
    *(u32x4*)(GT + (size_t)(mt * 128 + r) * 3072 + nt * 128 + c8 * 8) = pack8(f);
  }
}
DEV void d1_task(const Params& p, int l, int t, char* lds) {
  char* ws_ = p.ws; asm volatile("" : "+s"(ws_));
  const int tid = otid(), lane = tid & 63, wave = tid >> 6, l16 = lane & 15, quad = lane >> 4;
  const int wm = wave >> 1, wn = wave & 1;
  const int nt = t >> 6, mt = t & 63;
  const bf16_t* GT = (const bf16_t*)(ws_ + OFF_GDN);
  f32x4 macc[4][2]; zero_acc<2>(macc);
#pragma unroll 1
  for (int n = 0; n < 3; n++) {
    unsigned short gv[4][2][4];
#pragma unroll
    for (int mi = 0; mi < 4; mi++)
#pragma unroll
      for (int ni = 0; ni < 2; ni++)
#pragma unroll
        for (int j = 0; j < 4; j++)
          gv[mi][ni][j] = GT[(size_t)(mt * 128 + wm * 64 + mi * 16 + quad * 4 + j) * 3072 + n * 1024 + nt * 64 + wn * 32 + ni * 16 + l16];
    f32x4 y[4][2]; zero_acc<2>(y);
    ALPlain alb{(const bf16_t*)(ws_ + OFF_BR) + (size_t)mt * 128 * BRW + n * 512, BRW};
    gemm_core<64>(alb, (const bf16_t*)(ws_ + OFF_WBR) + (size_t)(n * 1024 + nt * 64) * 512, 512, 512, y, lds);
#pragma unroll
    for (int mi = 0; mi < 4; mi++)
#pragma unroll
      for (int ni = 0; ni < 2; ni++)
#pragma unroll
        for (int j = 0; j < 4; j++) macc[mi][ni][j] += bf2f(gv[mi][ni][j]) * y[mi][ni][j];
  }
  float* Cs = (float*)lds;
  acc_to_lds<64>(macc, Cs);
  bf16_t* M = (bf16_t*)(ws_ + OFF_M);
#pragma unroll
  for (int i = 0; i < 4; i++) {
    const int it = tid + 256 * i, r = it >> 3, c8 = it & 7;
    float f[8];
#pragma unroll
    for (int j = 0; j < 8; j++) f[j] = Cs[r * 68 + c8 * 8 + j];
    *(u32x4*)(M + (size_t)(mt * 128 + r) * 1024 + nt * 64 + c8 * 8) = pack8(f);
  }
}

DEV void d2_task(const Params& p, int l, int t, char* lds) {
  char* ws_ = p.ws; asm volatile("" : "+s"(ws_));
  const int tid = otid();
  const int nt = t >> 6, mt = t & 63;
  f32x4 acc[4][4]; zero_acc<4>(acc);
  ALPlain al{(const bf16_t*)(ws_ + OFF_M) + (size_t)mt * 128 * 1024, 1024};
  gemm_core<128>(al, (const bf16_t*)(ws_ + OFF_WO) + (size_t)nt * 128 * 1024, 1024, 1024, acc, lds);
  float* Cs = (float*)lds;
  acc_to_lds<128>(acc, Cs);
  const float* mod = (const float*)(ws_ + OFF_MOD);
#pragma unroll
  for (int i = 0; i < 8; i++) {
    const int it = tid + 256 * i, r = it >> 4, c8 = it & 15;
    const int row = mt * 128 + r, col = nt * 128 + c8 * 8;
    const float* x = xrow_ptr(p, l, row) + col;
    const float* gt = mod + (size_t)(l * 5 + modrow(row)) * 3072 + 2048 + col;
    const f32x4 y0 = *(const f32x4*)(Cs + r * 132 + c8 * 8), y1 = *(const f32x4*)(Cs + r * 132 + c8 * 8 + 4);
    const f32x4 x0 = *(const f32x4*)x, x1 = *(const f32x4*)(x + 4);
    const f32x4 g0 = *(const f32x4*)gt, g1 = *(const f32x4*)(gt + 4);
    float* o = p.out + (size_t)row * DM + col;
    *(f32x4*)o = f32x4{x0.x + g0.x * y0.x, x0.y + g0.y * y0.y, x0.z + g0.z * y0.z, x0.w + g0.w * y0.w};
    *(f32x4*)(o + 4) = f32x4{x1.x + g1.x * y1.x, x1.y + g1.y * y1.y, x1.z + g1.z * y1.z, x1.w + g1.w * y1.w};
  }
}

#define NPHASES 15
DEV int phase_nsub(int ph) {
  if (ph == 0) return 48 + 152;
  const int l = (ph - 1) / 7, s = (ph - 1) % 7;
  switch (s) {
    case 0: return 128 + (l == 0 ? 17 : 0);
    case 1: return 304 + 8;
    case 2: return 64 + 64 + 64;
    case 3: return 8 + 32 + 32 + 32 + 32 + (l == 0 ? 169 + 176 : 176);
    case 4: return 192 + 64;
    case 5: return 128;
    default: return 64;
  }
}
DEV void run_task(const Params& p, int ph, int x, int i, char* lds) {
  if (ph == 0) { if (i < 48) mod_task(p, i * 8 + x, lds); else convert_task(p, 0, (i - 48) * 8 + x, lds); return; }
  const int l = (ph - 1) / 7, s = (ph - 1) % 7;
  switch (s) {
    case 0:
      if (i < 128) norm_task(p, l, i * 8 + x);
      else convert_task(p, 0, 1984 + (i - 128) * 8 + x, lds);
      break;
    case 1:
      if (i < 304) projA_task(p, l, (i >> 3) * 64 + (i & 7) * 8 + x, lds);
      else kv_task(p, l, (i - 304) * 72 + 64 + x, lds);
      break;
    case 2:
      if (i < 64) gdn_prep_task(p, l, i * 8 + x, lds);
      else if (i < 128) { const int j = i - 64; kv_task(p, l, (j >> 3) * 72 + (j & 7) * 8 + x, lds); }
      else { const int j = i - 128; q_task(p, l, (j >> 3) * 64 + (j & 7) * 8 + x, lds); }
      break;
    case 3:
      if (i < 8) gdn_scan_task(p, l, i * 8 + x, lds);
      else if (i < 40) attn_task(p, l, x * 32 + (i - 8), lds);
      else if (i < 72) cmlp_task(p, l, (i - 40) * 8 + x, lds);
      else if (i < 104) gdn_scan_task(p, l, 64 + (i - 72) * 8 + x, lds);
      else if (i < 136) attn_task(p, l, 256 + x * 32 + (i - 104), lds);
      else if (l == 1) {
        if (i < 232) convert_task(p, 1, 1216 + (i - 136) * 8 + x, lds);
        else convert_task(p, 1, 2120 + (i - 232) * 8 + x, lds);
      }
      else if (i < 288) convert_task(p, 1, (i - 136) * 8 + x, lds);
      else if (i < 305) convert_task(p, 1, 1984 + (i - 288) * 8 + x, lds);
      else if (i < 401) convert_task(p, 0, 1216 + (i - 305) * 8 + x, lds);
      else convert_task(p, 0, 2120 + (i - 401) * 8 + x, lds);
      break;
    case 4:
      if (i < 192) gate_task(p, l, (i >> 3) * 64 + (i & 7) * 8 + x, lds);
      else onorm_task(p, l, (i - 192) * 8 + x);
      break;
    case 5:
      d1_task(p, l, (i >> 3) * 64 + (i & 7) * 8 + x, lds);
      break;
    case 6:
      d2_task(p, l, (i >> 3) * 64 + (i & 7) * 8 + x, lds);
      break;
  }
}
#ifndef REP_S
#define REP_S -1
#endif
DEV void run_phase(const Params& p, int ph, char* lds, int* sh, int myx, int rep = 0, int rank = 0, int nloc = 0) {
  unsigned* cb = (unsigned*)(p.ws + OFF_CTR) + ph * 128 + rep * 6144;
  const int n = phase_nsub(ph);
  if (nloc > 0) {
#pragma unroll 1
    for (int i = rank; i < n; i += nloc) { __syncthreads(); run_task(p, ph, myx, i, lds); }
    return;
  }
#pragma unroll 1
  for (int xo = 0; xo < 8; xo++) {
    const int x = (myx + xo) & 7;
    unsigned* c = cb + x * 16;
    int i;
    while ((i = next_task(c, sh, n, xo > 0)) < n) run_task(p, ph, x, i, lds);
  }
}

__global__ void __launch_bounds__(256, 2) k_phase(Params p, int ph) {
  __shared__ __attribute__((aligned(16))) char lds[LDS_BYTES];
  __shared__ int sh[4];
  const Params& pr = *(const Params*)__builtin_amdgcn_kernarg_segment_ptr();
  run_phase(pr, ph, lds, sh, (int)(xb_xcc_id() & 7u));
}

__global__ void __launch_bounds__(256, 2) k_mega(Params p) {
  __shared__ __attribute__((aligned(16))) char lds[LDS_BYTES];
  __shared__ __attribute__((aligned(16))) unsigned xbw[4];
  __shared__ int sh[4];
  const Params& pr = *(const Params*)__builtin_amdgcn_kernarg_segment_ptr();
  if (threadIdx.x == 0) { xbw[0] = 0u; xbw[1] = 0u; xbw[2] = 0u; xbw[3] = 0u; }
  __syncthreads();
  XcdBarrier xb = xcd_barrier_post((unsigned*)(pr.ws + OFF_BAR), (volatile LAS unsigned*)xbw);
  const int myx = (int)(xb.x & 7u);
  if (pr.out == nullptr) cg::this_grid().sync();
#pragma unroll
  for (int ph = 0; ph < NPHASES; ph++) {
    {
      const int sub = ph > 0 ? (ph - 1) % 7 : -1;
      const bool uniform = (sub == 0 || sub == 1 || sub == 2 || sub == 4 || sub == 5 || sub == 6);
      int nloc = 0, rank = 0;
      if (ph > 0 && uniform && xbw[1] == 8u) { nloc = (int)xbw[0]; rank = (int)xbw[2]; }
      run_phase(pr, ph, lds, sh, myx, 0, rank, nloc);
    }
    if ((REP_S == 7 && ph == 0) || (REP_S >= 0 && ph > 0 && (ph - 1) % 7 == REP_S && !(REP_S == 6 && ph > 7))) run_phase(pr, ph, lds, sh, myx, 1);
    if (ph + 1 < NPHASES) xcd_barrier(xb);
  }
}

extern "C" void kernel_launch(void* const* d_in, const int* in_sizes, int n_in, void* d_out, int out_size, void* d_ws,
                              size_t ws_size, hipStream_t stream) {
  Params p{};
  for (int i = 0; i < 27; i++) p.in[i] = (const float*)d_in[i];
  p.out = (float*)d_out;
  p.ws = (char*)d_ws;
  if (ws_size < WS_END) { fprintf(stderr, "workspace too small: %zu < %llu\n", ws_size, (unsigned long long)WS_END); return; }
  (void)hipMemsetAsync(d_ws, 0, 32768, stream);
#if COOP
  static int grid_blocks = 0;
  if (!grid_blocks) {
    int dev = 0, cus = 0, per_cu = 0;
    hipGetDevice(&dev);
    hipDeviceGetAttribute(&cus, hipDeviceAttributeMultiprocessorCount, dev);
    hipOccupancyMaxActiveBlocksPerMultiprocessor(&per_cu, k_mega, 256, 0);
    if (per_cu > 2) per_cu = 2;
    if (per_cu < 1) per_cu = 1;
    grid_blocks = cus * per_cu;
  }
  void* args[] = {&p};
  hipError_t e = hipLaunchCooperativeKernel((void*)k_mega, dim3(grid_blocks), dim3(256), args, 0, stream);
  if (e != hipSuccess) fprintf(stderr, "cooperative launch failed: %s (grid %d)\n", hipGetErrorString(e), grid_blocks);
#else
  for (int ph = 0; ph < NPHASES; ph++) k_phase<<<512, 256, 0, stream>>>(p, ph);
#endif
}
```
